# Optimizing an MI355X kernel written in HIP

```python
import jax, jax.numpy as jnp
from jax import lax
import numpy as np

D_MODEL = 1024
BATCH = 8
SEQ = 2048
DEPTH = 1
DEC_BATCH = 128
DEC_SEQ = 1
PAST_LEN = 16384
PAGE_SIZE = 128

D_CONV = D_MODEL // 2
CONF_KERNEL = 31
N_HEADS = 8
HEAD_K = 128
HEAD_V = 128
QK_DIM = N_HEADS * HEAD_K
V_DIM = N_HEADS * HEAD_V
QKV_DIM = 2 * QK_DIM + V_DIM
SHORT_CONV = 4
CHUNK = 64
D_FF = 4 * D_MODEL
N_MOD = 6
EPS = 1e-6
IN_SIZES = (2 * D_CONV, QKV_DIM, V_DIM, N_HEADS, N_HEADS, D_MODEL, D_MODEL)
IN_OFFSETS = tuple(int(o) for o in np.cumsum(IN_SIZES)[:-1])
D_IN = int(sum(IN_SIZES))

kernel_name = 'hybrid_conformer_gdn_step'


def rms_norm(x, w):
    xf = x.astype(jnp.float32)
    y = xf * lax.rsqrt(jnp.mean(xf * xf, axis=-1, keepdims=True) + EPS)
    return (y * w.astype(jnp.float32)).astype(x.dtype)


def layer_norm(x, w, b):
    xf = x.astype(jnp.float32)
    mu = jnp.mean(xf, axis=-1, keepdims=True)
    xc = xf - mu
    var = jnp.mean(xc * xc, axis=-1, keepdims=True)
    y = xc * lax.rsqrt(var + EPS) * w.astype(jnp.float32) + b.astype(jnp.float32)
    return y.astype(x.dtype)


def l2norm(x):
    return x * lax.rsqrt(jnp.sum(x * x, axis=-1, keepdims=True) + EPS)


def causal_depthwise_conv(x_ext, w):
    c = x_ext.shape[-1]
    return lax.conv_general_dilated(
        x_ext, w.astype(x_ext.dtype)[:, None, :], window_strides=(1,), padding='VALID',
        dimension_numbers=('NWC', 'WIO', 'NWC'), feature_group_count=c)


def gated_delta_rule(q, k, v, g, beta, s0):
    bsz, seqlen, nh, dk = q.shape
    dv = v.shape[-1]
    f32 = jnp.float32
    q = l2norm(q.astype(f32)) * (dk ** -0.5)
    k = l2norm(k.astype(f32))
    v = v.astype(f32)
    g = g.astype(f32)
    beta = beta.astype(f32)
    csz = min(CHUNK, seqlen)
    pad = (-seqlen) % csz
    if pad:
        padf = lambda t: jnp.pad(t, [(0, 0), (0, pad)] + [(0, 0)] * (t.ndim - 2))
        q, k, v, g, beta = padf(q), padf(k), padf(v), padf(g), padf(beta)
    lp = seqlen + pad
    nc = lp // csz
    to_c = lambda t: t.reshape(bsz, nc, csz, nh, t.shape[-1]).transpose(0, 3, 1, 2, 4)
    q, k, v = to_c(q), to_c(k), to_c(v)
    g = g.reshape(bsz, nc, csz, nh).transpose(0, 3, 1, 2)
    beta = beta.reshape(bsz, nc, csz, nh).transpose(0, 3, 1, 2)
    g = jnp.cumsum(g, axis=-1)
    tri_incl = jnp.tril(jnp.ones((csz, csz), dtype=bool))
    tri_strict = jnp.tril(jnp.ones((csz, csz), dtype=bool), -1)
    decay = jnp.exp(jnp.where(tri_incl, g[..., :, None] - g[..., None, :], -jnp.inf))
    k_beta = k * beta[..., None]
    v_beta = v * beta[..., None]
    lower = jnp.where(tri_strict, jnp.einsum('bhncd,bhnsd->bhncs', k_beta, k) * decay, 0.0)
    eye = jnp.eye(csz, dtype=f32)
    t_inv = lax.linalg.triangular_solve(eye + lower, jnp.broadcast_to(eye, lower.shape),
                                        left_side=True, lower=True, unit_diagonal=True)
    value = jnp.einsum('bhncs,bhnsv->bhncv', t_inv, v_beta)
    k_cumdecay = jnp.einsum('bhncs,bhnsd->bhncd', t_inv, k_beta * jnp.exp(g)[..., None])
    attn_intra = jnp.einsum('bhncd,bhnsd->bhncs', q, k) * decay

    def step(s, inp):
        q_c, k_c, val_c, kcd_c, att_c, g_c = inp
        v_new = val_c - jnp.einsum('bhck,bhkv->bhcv', kcd_c, s)
        o_c = (jnp.einsum('bhck,bhkv->bhcv', q_c * jnp.exp(g_c)[..., None], s)
               + jnp.einsum('bhcs,bhsv->bhcv', att_c, v_new))
        g_last = g_c[..., -1]
        s = (s * jnp.exp(g_last)[..., None, None]
             + jnp.einsum('bhck,bhcv->bhkv', k_c * jnp.exp(g_last[..., None] - g_c)[..., None], v_new))
        return s, o_c

    xs = tuple(jnp.moveaxis(t, 2, 0) for t in (q, k, value, k_cumdecay, attn_intra, g))
    s_fin, o = lax.scan(step, s0.astype(f32), xs)
    o = o.transpose(1, 0, 3, 2, 4).reshape(bsz, lp, nh, dv)[:, :seqlen]
    return o, s_fin


def hybrid_layer(x, c, conf_buf, qkv_buf, s0, w_ada, b_ada, norm1_w, w_in, conf_dw_w, conf_dw_b,
                 conf_ln_w, conf_ln_b, w_conf_out, gdn_conv_w, a_log, dt_bias, gdn_norm_w,
                 w_gdn_out, w_o, norm2_w, w_ff1, w_ff2):
    bsz, seqlen, _ = x.shape
    f32 = jnp.float32
    mod = jnp.einsum('bd,de->be', jax.nn.silu(c), w_ada) + b_ada
    shift1, scale1, gate1, shift2, scale2, gate2 = [m[:, None, :] for m in jnp.split(mod, N_MOD, axis=-1)]
    h = rms_norm(x, norm1_w) * (1 + scale1) + shift1
    proj = jnp.einsum('bld,de->ble', h, w_in)
    u_glu, qkv_raw, z, b_raw, a_raw, gate_a, gate_b = jnp.split(proj, IN_OFFSETS, axis=-1)

    glu = u_glu[..., :D_CONV] * jax.nn.sigmoid(u_glu[..., D_CONV:])
    glu_ext = jnp.concatenate([conf_buf.astype(glu.dtype), glu], axis=1)
    new_conf = glu_ext[:, glu_ext.shape[1] - (CONF_KERNEL - 1):]
    a = causal_depthwise_conv(glu_ext, conf_dw_w) + conf_dw_b
    a = jax.nn.silu(layer_norm(a, conf_ln_w, conf_ln_b))
    y_a = jnp.einsum('blc,cd->bld', a, w_conf_out)

    qkv_ext = jnp.concatenate([qkv_buf.astype(qkv_raw.dtype), qkv_raw], axis=1)
    new_qkv = qkv_ext[:, qkv_ext.shape[1] - (SHORT_CONV - 1):]
    qkv = jax.nn.silu(causal_depthwise_conv(qkv_ext, gdn_conv_w))
    q, k, v = jnp.split(qkv, (QK_DIM, 2 * QK_DIM), axis=-1)
    q = q.reshape(bsz, seqlen, N_HEADS, HEAD_K)
    k = k.reshape(bsz, seqlen, N_HEADS, HEAD_K)
    v = v.reshape(bsz, seqlen, N_HEADS, HEAD_V)
    beta = jax.nn.sigmoid(b_raw.astype(f32))
    g = -jnp.exp(a_log.astype(f32)) * jax.nn.softplus(a_raw.astype(f32) + dt_bias.astype(f32))
    o, s_new = gated_delta_rule(q, k, v, g, beta, s0)
    o = rms_norm(o.astype(x.dtype), gdn_norm_w) * jax.nn.silu(z.reshape(bsz, seqlen, N_HEADS, HEAD_V))
    y_b = jnp.einsum('blhv,hvd->bld', o, w_gdn_out.reshape(N_HEADS, HEAD_V, D_MODEL))

    merged = jax.nn.sigmoid(gate_a) * y_a + jax.nn.sigmoid(gate_b) * y_b
    x = x + gate1 * jnp.einsum('bld,de->ble', merged, w_o)

    h2 = rms_norm(x, norm2_w) * (1 + scale2) + shift2
    f = jnp.square(jax.nn.relu(jnp.einsum('bld,df->blf', h2, w_ff1)))
    x = x + gate2 * jnp.einsum('blf,fd->bld', f, w_ff2)
    return x, new_conf, new_qkv, s_new.astype(x.dtype)


def _normal(k, shape, scale):
    return jax.random.normal(k, shape, jnp.float32) * scale


def setup_inputs(seed: int = 0) -> dict:
    key = jax.random.key(seed)
    ks = jax.random.split(key, 32)
    dt = jnp.exp(jax.random.uniform(ks[20], (DEPTH, N_HEADS), jnp.float32, np.log(1e-3), np.log(1e-1)))
    return {
        'x_prompt': _normal(ks[0], (BATCH, SEQ, D_MODEL), 1.0),
        'x_sample': _normal(ks[1], (DEC_BATCH, DEC_SEQ, D_MODEL), 1.0),
        'c_prompt': _normal(ks[2], (BATCH, D_MODEL), 1.0),
        'c_sample': _normal(ks[3], (DEC_BATCH, D_MODEL), 1.0),
        'state_conf_conv': _normal(ks[4], (DEPTH, DEC_BATCH, CONF_KERNEL - 1, D_CONV), 0.5),
        'state_qkv_conv': _normal(ks[5], (DEPTH, DEC_BATCH, SHORT_CONV - 1, QKV_DIM), 1.0),
        'state_delta': _normal(ks[6], (DEPTH, DEC_BATCH, N_HEADS, HEAD_K, HEAD_V), 0.1),
        'w_ada': _normal(ks[7], (DEPTH, D_MODEL, N_MOD * D_MODEL), D_MODEL ** -0.5),
        'b_ada': _normal(ks[8], (DEPTH, N_MOD * D_MODEL), 0.02),
        'norm1_w': 1.0 + _normal(ks[9], (DEPTH, D_MODEL), 0.02),
        'w_in': _normal(ks[10], (DEPTH, D_MODEL, D_IN), D_MODEL ** -0.5),
        'conf_dw_w': _normal(ks[11], (DEPTH, CONF_KERNEL, D_CONV), CONF_KERNEL ** -0.5),
        'conf_dw_b': _normal(ks[12], (DEPTH, D_CONV), 0.02),
        'conf_ln_w': 1.0 + _normal(ks[13], (DEPTH, D_CONV), 0.02),
        'conf_ln_b': _normal(ks[14], (DEPTH, D_CONV), 0.02),
        'w_conf_out': _normal(ks[15], (DEPTH, D_CONV, D_MODEL), D_CONV ** -0.5),
        'gdn_conv_w': _normal(ks[16], (DEPTH, SHORT_CONV, QKV_DIM), SHORT_CONV ** -0.5),
        'a_log': jnp.log(jax.random.uniform(ks[17], (DEPTH, N_HEADS), jnp.float32, 1.0, 16.0)),
        'dt_bias': dt + jnp.log(-jnp.expm1(-dt)),
        'gdn_norm_w': 1.0 + _normal(ks[18], (DEPTH, HEAD_V), 0.02),
        'w_gdn_out': _normal(ks[19], (DEPTH, V_DIM, D_MODEL), V_DIM ** -0.5),
        'w_o': _normal(ks[21], (DEPTH, D_MODEL, D_MODEL), D_MODEL ** -0.5),
        'norm2_w': 1.0 + _normal(ks[22], (DEPTH, D_MODEL), 0.02),
        'w_ff1': _normal(ks[23], (DEPTH, D_MODEL, D_FF), D_MODEL ** -0.5),
        'w_ff2': _normal(ks[24], (DEPTH, D_FF, D_MODEL), D_FF ** -0.5),
        'final_norm_w': 1.0 + _normal(ks[25], (D_MODEL,), 0.02),
    }


def reference(x_prompt, x_sample, c_prompt, c_sample, state_conf_conv, state_qkv_conv, state_delta,
              w_ada, b_ada, norm1_w, w_in, conf_dw_w, conf_dw_b, conf_ln_w, conf_ln_b, w_conf_out,
              gdn_conv_w, a_log, dt_bias, gdn_norm_w, w_gdn_out, w_o, norm2_w, w_ff1, w_ff2,
              final_norm_w):
    bp = x_prompt.shape[0]
    hp, hs = x_prompt, x_sample
    conf_p, qkv_p, delta_p = [], [], []
    conf_s, qkv_s, delta_s = [], [], []
    for l in range(DEPTH):
        lw = (w_ada[l], b_ada[l], norm1_w[l], w_in[l], conf_dw_w[l], conf_dw_b[l], conf_ln_w[l],
              conf_ln_b[l], w_conf_out[l], gdn_conv_w[l], a_log[l], dt_bias[l], gdn_norm_w[l],
              w_gdn_out[l], w_o[l], norm2_w[l], w_ff1[l], w_ff2[l])
        conf0 = jnp.zeros((bp, CONF_KERNEL - 1, D_CONV), x_prompt.dtype)
        qkv0 = jnp.zeros((bp, SHORT_CONV - 1, QKV_DIM), x_prompt.dtype)
        s00 = jnp.zeros((bp, N_HEADS, HEAD_K, HEAD_V), jnp.float32)
        hp, cp, qp, sp = hybrid_layer(hp, c_prompt, conf0, qkv0, s00, *lw)
        hs, cs, qs, ss = hybrid_layer(hs, c_sample, state_conf_conv[l], state_qkv_conv[l], state_delta[l], *lw)
        conf_p.append(cp); qkv_p.append(qp); delta_p.append(sp)
        conf_s.append(cs); qkv_s.append(qs); delta_s.append(ss)
    y_prompt = rms_norm(hp, final_norm_w)
    y_sample = rms_norm(hs, final_norm_w)
    return (y_prompt, y_sample, jnp.stack(conf_p), jnp.stack(qkv_p), jnp.stack(delta_p),
            jnp.stack(conf_s), jnp.stack(qkv_s), jnp.stack(delta_s))
```

```cpp
#include <hip/hip_runtime.h>
#include <stdint.h>
#include <cstdio>

#define DI __device__ __forceinline__
typedef unsigned short u16;
typedef __bf16 bf2_t __attribute__((ext_vector_type(2)));
typedef float f2_t __attribute__((ext_vector_type(2)));
using bf16x8 = __attribute__((ext_vector_type(8))) short;
using f32x16 = __attribute__((ext_vector_type(16))) float;
using f32x4 = __attribute__((ext_vector_type(4))) float;
using u32x4 = __attribute__((ext_vector_type(4))) unsigned;
#define MFMA(a, b, c) __builtin_amdgcn_mfma_f32_32x32x16_bf16((a), (b), (c), 0, 0, 0)

constexpr int R = 16512, RP = 16384, D = 1024, DC = 512, QKV = 3072, NIN = 4096, DFF = 4096;
constexpr float EPS = 1e-6f;
constexpr int LDF = 4160;
constexpr float QSCALE = 0.08838834764831845f;

constexpr size_t OFF_BAR   = 0;
constexpr size_t OFF_MOD   = 16384;
constexpr size_t OFF_GB    = OFF_MOD + 3342336;
constexpr size_t OFF_EGL   = OFF_GB + 1056768;
constexpr size_t OFF_SSQ   = OFF_EGL + 8192;
constexpr size_t OFF_WIN   = OFF_SSQ + 2113536;
constexpr size_t OFF_WZ    = OFF_WIN + 8650752;
constexpr size_t OFF_WGA   = OFF_WZ + 2097152;
constexpr size_t OFF_WGB   = OFF_WGA + 2097152;
constexpr size_t OFF_WCONF = OFF_WGB + 2097152;
constexpr size_t OFF_WGDN  = OFF_WCONF + 1048576;
constexpr size_t OFF_WO    = OFF_WGDN + 2097152;
constexpr size_t OFF_W1    = OFF_WO + 2097152;
constexpr size_t OFF_W2    = OFF_W1 + 8388608;
constexpr size_t OFF_GLU   = OFF_W2 + 8650752;
constexpr size_t OFF_AACT  = OFF_GLU + 16908288;
constexpr size_t OFF_QKV   = OFF_AACT + 16908288;
constexpr size_t OFF_HALO  = OFF_QKV + 101449728;
constexpr size_t OFF_EXTRA = OFF_HALO + 4718592;
constexpr size_t OFF_WADA  = OFF_EXTRA;
constexpr size_t OFF_AC    = OFF_EXTRA + 12582912;
constexpr size_t OFF_MERGED= OFF_EXTRA;
constexpr size_t OFF_H2    = OFF_GLU;
constexpr size_t OFF_F     = OFF_QKV;
constexpr size_t OFF_TMP2  = OFF_QKV;
constexpr size_t WS_NEED   = OFF_EXTRA + 50331648;
constexpr size_t OUT_Y = 0, OUT_CONFP = 16908288, OUT_QKVP = 17031168, OUT_DELTAP = 17104896,
                 OUT_CONFS = 18153472, OUT_QKVS = 20119552, OUT_DELTAS = 21299200;

constexpr int HALF_SMEM = 73728;
constexpr int SMEM_BYTES = 2 * HALF_SMEM + 1024;
constexpr int NT = 512;
#ifndef PHASE_MASK
#define PHASE_MASK 0xFFFF
#endif
#define PH(k) if constexpr ((PHASE_MASK >> (k)) & 1)

struct Params {
  const float *x_prompt, *x_sample, *c_prompt, *c_sample, *st_conf, *st_qkv, *st_delta;
  const float *w_ada, *b_ada, *norm1_w, *w_in, *conf_dw_w, *conf_dw_b, *conf_ln_w, *conf_ln_b, *w_conf_out,
              *gdn_conv_w, *a_log, *dt_bias, *gdn_norm_w, *w_gdn_out, *w_o, *norm2_w, *w_ff1, *w_ff2, *final_norm_w;
  float* out; char* ws;
};

DI unsigned pk2(float a, float b) { f2_t v = {a, b}; bf2_t r = __builtin_convertvector(v, bf2_t); return __builtin_bit_cast(unsigned, r); }
DI float bf_lo(unsigned u) { return __uint_as_float(u << 16); }
DI float bf_hi(unsigned u) { return __uint_as_float(u & 0xffff0000u); }
DI float bf1(u16 u) { return __uint_as_float(((unsigned)u) << 16); }
DI u16 f2bf(float a) { return (u16)(pk2(a, 0.f) & 0xffffu); }
DI float sigmoidf_(float x) { return __builtin_amdgcn_rcpf(1.f + __expf(-x)); }
DI float siluf_(float x) { return x * __builtin_amdgcn_rcpf(1.f + __expf(-x)); }
DI float softplusf_(float x) { return fmaxf(x, 0.f) + log1pf(__expf(-fabsf(x))); }
DI float wsum(float v) {
#pragma unroll
  for (int m = 32; m >= 1; m >>= 1) v += __shfl_xor(v, m, 64);
  return v;
}
DI int crow(int reg, int hh) { return (reg & 3) + 8 * (reg >> 2) + 4 * hh; }
DI int mrow_of(int r) { return r < RP ? (r >> 11) : (8 + r - RP); }
DI bf16x8 pack8(const f32x16& x, int s) {
  uint4 p;
  p.x = pk2(x[8 * s + 0], x[8 * s + 1]); p.y = pk2(x[8 * s + 2], x[8 * s + 3]);
  p.z = pk2(x[8 * s + 4], x[8 * s + 5]); p.w = pk2(x[8 * s + 6], x[8 * s + 7]);
  return __builtin_bit_cast(bf16x8, p);
}
DI f32x16 zero16() { f32x16 z; for (int i = 0; i < 16; ++i) z[i] = 0.f; return z; }

#define XB_TMO      128
#define XB_XCNT(j)  (256  + 64 * (j))
#define XB_XSUB(j)  (1280 + 64 * (j))
#define XB_XGEN(j)  (2304 + 64 * (j))
#define XB_TOP      3328
#define XB_TOPGEN   3392
#define XCD_BAR_WORDS 3456
#define XB_SPIN_CAP (1u << 24)
#define LAS __attribute__((address_space(3)))
DI unsigned xb_ld(unsigned* p) { return __hip_atomic_load(p, __ATOMIC_RELAXED, __HIP_MEMORY_SCOPE_AGENT); }
DI unsigned xb_add(unsigned* p, unsigned v) { return __hip_atomic_fetch_add(p, v, __ATOMIC_RELAXED, __HIP_MEMORY_SCOPE_AGENT); }
DI unsigned xb_xcc_id() { return (unsigned)__builtin_amdgcn_s_getreg((3 << 11) | 20) & 0xFu; }
#define XB_SPIN(cond, bar) do { unsigned _sp = 0; while (cond) { __builtin_amdgcn_s_sleep(1); \
    if ((++_sp & 255u) == 0u) { if (xb_ld(&(bar)[XB_TMO])) break; if (_sp > XB_SPIN_CAP) { atomicAdd(&(bar)[XB_TMO], 1u); break; } } } } while (0)
struct XcdBarrier { unsigned* bar; unsigned x; volatile LAS unsigned* st; };
DI XcdBarrier xcd_barrier_post(unsigned* bar, volatile LAS unsigned* st) {
  XcdBarrier b; b.bar = bar; b.x = xb_xcc_id(); b.st = st;
  if (threadIdx.x == 0) (void)xb_add(&bar[XB_XCNT(b.x)], 1u);
  return b;
}
DI void xcd_barrier_complete(unsigned* bar, unsigned x, unsigned& nloc, unsigned& nx) {
  const unsigned G = gridDim.x * gridDim.y * gridDim.z;
  unsigned sum, cnt, mine, sp = 0u;
  for (;;) {
    sum = 0u; cnt = 0u; mine = 0u;
#pragma unroll
    for (unsigned j = 0; j < 16; ++j) { const unsigned c = xb_ld(&bar[XB_XCNT(j)]); sum += c; cnt += (c > 0u) ? 1u : 0u; mine = (j == x) ? c : mine; }
    if (sum == G) break;
    __builtin_amdgcn_s_sleep(1);
    if ((++sp & 255u) == 0u) { if (xb_ld(&bar[XB_TMO])) break; if (sp > XB_SPIN_CAP) { atomicAdd(&bar[XB_TMO], 1u); break; } }
  }
  nloc = mine > 0u ? mine : 1u; nx = cnt > 0u ? cnt : 1u;
}
DI void xcd_barrier(const XcdBarrier& b) {
  asm volatile("s_waitcnt vmcnt(0)" ::: "memory");
  __syncthreads();
  if (threadIdx.x == 0) {
    unsigned* bar = b.bar;
    __builtin_amdgcn_s_waitcnt(0);
    unsigned nloc = b.st[0], nx = b.st[1];
    if (nloc == 0u) { xcd_barrier_complete(bar, b.x, nloc, nx); b.st[0] = nloc; b.st[1] = nx; }
    const unsigned old = xb_add(&bar[XB_XSUB(b.x)], 1u);
    const unsigned gen = old / nloc;
    if (old + 1u == (gen + 1u) * nloc) {
      __builtin_amdgcn_fence(__ATOMIC_RELEASE, "agent");
      asm volatile("s_waitcnt vmcnt(0)" ::: "memory");
      const unsigned og = xb_add(&bar[XB_TOP], 1u);
      const unsigned tg = og / nx;
      if (og + 1u == (tg + 1u) * nx) xb_add(&bar[XB_TOPGEN], 1u);
      else XB_SPIN(xb_ld(&bar[XB_TOPGEN]) == tg, bar);
      __builtin_amdgcn_fence(__ATOMIC_ACQUIRE, "agent");
      xb_add(&bar[XB_XGEN(b.x)], 1u);
      asm volatile("s_waitcnt vmcnt(0)" ::: "memory");
    } else {
      XB_SPIN(xb_ld(&bar[XB_XGEN(b.x)]) == gen, bar);
      __builtin_amdgcn_fence(__ATOMIC_ACQUIRE, "agent");
      asm volatile("s_waitcnt vmcnt(0)" ::: "memory");
    }
  }
  __syncthreads();
}

constexpr int HTB = 128 * 64 * 2;
DI int lds_byte(int r, int c) { const int st = (r >> 4) * 2 + (c >> 5), rr = r & 15, cc = c & 31, ob = rr * 64 + cc * 2; return st * 1024 + (ob ^ (((ob >> 9) & 1) << 5)); }
DI void stage_rc(int b, int& Rr, int& Cc) { const int st = b / 1024, sb = b % 1024, swz = sb ^ (((sb >> 9) & 1) << 5); Rr = (st >> 1) * 16 + swz / 64; Cc = (st & 1) * 32 + (swz % 64) / 2; }
DI void gemm256(f32x4 (&acc)[2][2][4][2], const u16* __restrict__ A, const int lda, const u16* __restrict__ Bt, const int ldb,
                const int brow, const int bcol, const int K, char* shm) {
#define SA(b, h) (shm + ((b) * 2 + (h)) * HTB)
#define SB(b, h) (shm + (4 + (b) * 2 + (h)) * HTB)
#define STAGE_A(P, br, kt) do { const char* _u = (const char*)A + ((size_t)(br) * lda + (size_t)(kt) * 64) * 2; \
    __builtin_amdgcn_global_load_lds((const unsigned*)(_u + voA0), (unsigned*)((char*)(P) + sb0), 16, 0, 0); \
    __builtin_amdgcn_global_load_lds((const unsigned*)(_u + voA1), (unsigned*)((char*)(P) + sb1), 16, 0, 0); } while (0)
#define STAGE_B(P, br, kt) do { const char* _u = (const char*)Bt + ((size_t)(br) * ldb + (size_t)(kt) * 64) * 2; \
    __builtin_amdgcn_global_load_lds((const unsigned*)(_u + voB0), (unsigned*)((char*)(P) + sb0), 16, 0, 0); \
    __builtin_amdgcn_global_load_lds((const unsigned*)(_u + voB1), (unsigned*)((char*)(P) + sb1), 16, 0, 0); } while (0)
#define LDA(dst, b, h) _Pragma("unroll") for (int m = 0; m < 4; ++m) _Pragma("unroll") for (int k = 0; k < 2; ++k) \
    dst[m][k] = *reinterpret_cast<const bf16x8*>((char*)SA(b, h) + lds_byte(wr * 64 + m * 16 + fr, k * 32 + fq * 8))
#define LDB(dst, b, h) _Pragma("unroll") for (int n = 0; n < 2; ++n) _Pragma("unroll") for (int k = 0; k < 2; ++k) \
    dst[n][k] = *reinterpret_cast<const bf16x8*>((char*)SB(b, h) + lds_byte(wc * 32 + n * 16 + fr, k * 32 + fq * 8))
#define MMA(ai, bj, At_, Bt_) do { __builtin_amdgcn_s_setprio(1); \
    _Pragma("unroll") for (int m = 0; m < 4; ++m) _Pragma("unroll") for (int n = 0; n < 2; ++n) _Pragma("unroll") for (int k = 0; k < 2; ++k) \
      acc[ai][bj][m][n] = __builtin_amdgcn_mfma_f32_16x16x32_bf16(Bt_[n][k], At_[m][k], acc[ai][bj][m][n], 0, 0, 0); \
    __builtin_amdgcn_s_setprio(0); } while (0)
#define WAIT_V(n) asm volatile("s_waitcnt vmcnt(" #n ")" ::: "memory")
#define WAIT_L(n) asm volatile("s_waitcnt lgkmcnt(" #n ")" ::: "memory")
#define BAR __builtin_amdgcn_s_barrier()
#define SCHED __builtin_amdgcn_sched_barrier(0)
  int t_ = threadIdx.x;
  asm volatile("" : "+v"(t_));
  const int wid = __builtin_amdgcn_readfirstlane(t_ >> 6), lane = t_ & 63, wr = wid >> 2, wc = wid & 3, fr = lane & 15, fq = lane >> 4;
  const int sb0 = t_ * 16, sb1 = sb0 + 8192;
  int sr0, sc0, sr1, sc1; stage_rc(sb0, sr0, sc0); stage_rc(sb1, sr1, sc1);
  const unsigned voA0 = (unsigned)(sr0 * lda + sc0) * 2u, voA1 = (unsigned)(sr1 * lda + sc1) * 2u;
  const unsigned voB0 = (unsigned)(sr0 * ldb + sc0) * 2u, voB1 = (unsigned)(sr1 * ldb + sc1) * 2u;
  bf16x8 At[4][2], B0[2][2], B1[2][2];
  const int nt = K / 64;
  STAGE_B(SB(0, 0), bcol, 0); STAGE_A(SA(0, 0), brow, 0);
  STAGE_B(SB(0, 1), bcol + 128, 0); STAGE_A(SA(0, 1), brow + 128, 0);
  if (wr == 1) BAR;
  WAIT_V(4); BAR;
  STAGE_B(SB(1, 0), bcol, 1); STAGE_A(SA(1, 0), brow, 1); STAGE_B(SB(1, 1), bcol + 128, 1);
  WAIT_V(6); BAR;
  for (int t = 0; t < nt - 2; t += 2) {
    LDB(B0, 0, 0); SCHED; LDA(At, 0, 0); STAGE_A(SA(1, 1), brow + 128, t + 1);
    WAIT_L(8); BAR; WAIT_L(0); MMA(0, 0, At, B0); BAR; SCHED;
    LDB(B1, 0, 1); STAGE_B(SB(0, 0), bcol, t + 2);
    BAR; WAIT_L(0); MMA(0, 1, At, B1); BAR;
    LDA(At, 0, 1); STAGE_A(SA(0, 0), brow, t + 2);
    BAR; WAIT_L(0); MMA(1, 0, At, B0); BAR; SCHED;
    STAGE_B(SB(0, 1), bcol + 128, t + 2);
    WAIT_V(6); BAR; MMA(1, 1, At, B1); BAR;
    LDB(B0, 1, 0); SCHED; LDA(At, 1, 0); STAGE_A(SA(0, 1), brow + 128, t + 2);
    WAIT_L(8); BAR; WAIT_L(0); MMA(0, 0, At, B0); BAR; SCHED;
    LDB(B1, 1, 1); STAGE_B(SB(1, 0), bcol, t + 3);
    BAR; WAIT_L(0); MMA(0, 1, At, B1); BAR;
    LDA(At, 1, 1); STAGE_A(SA(1, 0), brow, t + 3);
    BAR; WAIT_L(0); MMA(1, 0, At, B0); BAR; SCHED;
    STAGE_B(SB(1, 1), bcol + 128, t + 3);
    WAIT_V(6); BAR; MMA(1, 1, At, B1); BAR;
  }
  { LDB(B0, 0, 0); LDA(At, 0, 0); STAGE_A(SA(1, 1), brow + 128, nt - 1);
    BAR; WAIT_L(0); MMA(0, 0, At, B0); BAR;
    LDB(B1, 0, 1); BAR; WAIT_L(0); MMA(0, 1, At, B1); BAR;
    LDA(At, 0, 1); WAIT_V(4); BAR; WAIT_L(0); MMA(1, 0, At, B0); MMA(1, 1, At, B1); BAR; }
  { LDB(B0, 1, 0); LDA(At, 1, 0); WAIT_V(2); BAR; WAIT_L(0); MMA(0, 0, At, B0); BAR;
    LDB(B1, 1, 1); WAIT_V(0); BAR; WAIT_L(0); MMA(0, 1, At, B1); BAR;
    LDA(At, 1, 1); BAR; WAIT_L(0); MMA(1, 0, At, B0); MMA(1, 1, At, B1); BAR; }
  if (wr == 0) BAR;
#undef SA
#undef SB
#undef STAGE_A
#undef STAGE_B
#undef LDA
#undef LDB
#undef MMA
}
DI void zero_acc(f32x4 (&acc)[2][2][4][2]) {
#pragma unroll
  for (int a = 0; a < 2; ++a)
#pragma unroll
    for (int b = 0; b < 2; ++b)
#pragma unroll
      for (int m = 0; m < 4; ++m)
#pragma unroll
        for (int n = 0; n < 2; ++n) acc[a][b][m][n] = (f32x4){0.f, 0.f, 0.f, 0.f};
}
template <class F> DI void tile_apply(const f32x4 (&acc)[2][2][4][2], int brow, int bcol, F f) {
  int t_ = threadIdx.x;
  asm volatile("" : "+v"(t_));
  const int wid = t_ >> 6, lane = t_ & 63, wr = wid >> 2, wc = wid & 3, fr = lane & 15, fq = lane >> 4;
#pragma unroll
  for (int ai = 0; ai < 2; ++ai)
#pragma unroll
    for (int m = 0; m < 4; ++m) {
      const int row = brow + ai * 128 + wr * 64 + m * 16 + fr;
#pragma unroll
      for (int bj = 0; bj < 2; ++bj)
#pragma unroll
        for (int n = 0; n < 2; ++n) f(row, bcol + bj * 128 + wc * 32 + n * 16 + 4 * fq, acc[ai][bj][m][n]);
      __builtin_amdgcn_sched_barrier(0);
    }
}
constexpr int TLD = 132;
template <class F> DI void tile_epilogue(const f32x4 (&acc)[2][2][4][2], int brow, int bcol, char* shm, F f) {
  int t_ = threadIdx.x;
  asm volatile("" : "+v"(t_));
  const int wid = t_ >> 6, lane = t_ & 63, wr = wid >> 2, wc = wid & 3, fr = lane & 15, fq = lane >> 4;
  float* T = (float*)shm;
#pragma unroll
  for (int bj = 0; bj < 2; ++bj) {
#pragma unroll
    for (int ai = 0; ai < 2; ++ai)
#pragma unroll
      for (int m = 0; m < 4; ++m)
#pragma unroll
        for (int n = 0; n < 2; ++n)
          *(f32x4*)(T + (ai * 128 + wr * 64 + m * 16 + fr) * TLD + wc * 32 + n * 16 + 4 * fq) = acc[ai][bj][m][n];
    __syncthreads();
    const int cg = (t_ & 31) * 4, r0 = t_ >> 5;
#pragma unroll 4
    for (int i = 0; i < 16; ++i) {
      const int rl = r0 + 16 * i;
      const f32x4 v = *(const f32x4*)(T + rl * TLD + cg);
      f(brow + rl, bcol + bj * 128 + cg, v);
    }
    __syncthreads();
  }
}
template <class F> DI void gemm_pass(const u16* A, int lda, const u16* Bt, int ldb, int N, int K, char* shm, F f) {
  const int nN = N >> 8, nunits = 64 * nN;
  for (int u = blockIdx.x; u < nunits; u += gridDim.x) {
    const int pm = u % 64, pn = u / 64;
    f32x4 acc[2][2][4][2];
    zero_acc(acc);
    gemm256(acc, A, lda, Bt, ldb, pm * 256, pn * 256, K, shm);
    tile_epilogue(acc, pm * 256, pn * 256, shm, f);
  }
}
template <int NTL, class CM, class E> DI void skinny(const u16* __restrict__ A, int lda, int row0, int nrows, const u16* __restrict__ Bt, int ldb, int K, CM cm, E epi) {
  int t_ = threadIdx.x;
  asm volatile("" : "+v"(t_));
  const int wid = t_ >> 6, lane = t_ & 63, fr = lane & 15, fq = lane >> 4;
  for (int mt = wid; mt * 16 < nrows; mt += 8) {
    int rr = mt * 16 + fr; const bool valid = rr < nrows; if (!valid) rr = nrows - 1;
    const u16* ap = A + (size_t)(row0 + rr) * lda + 8 * fq;
#pragma unroll
    for (int ntl = 0; ntl < NTL; ++ntl) {
      const u16* bp = Bt + (size_t)cm(ntl * 16 + fr) * ldb + 8 * fq;
      f32x4 acc = {0.f, 0.f, 0.f, 0.f};
#pragma unroll 16
      for (int ks = 0; ks < (K >> 5); ++ks) {
        const bf16x8 a = *(const bf16x8*)(ap + ks * 32);
        const bf16x8 b = *(const bf16x8*)(bp + ks * 32);
        acc = __builtin_amdgcn_mfma_f32_16x16x32_bf16(b, a, acc, 0, 0, 0);
      }
      if (valid) epi(row0 + rr, ntl, fq, acc, lane);
    }
  }
}
DI int map_in(int n) {
  if (n < 1024) { const int pn = n >> 8, c = n & 255; return c < 128 ? (pn * 128 + c) : (512 + pn * 128 + c - 128); }
  return n;
}
DI void phase_convert(const Params& p, char* smem) {
  float* tile = (float*)smem;
  const int tid = threadIdx.x;
  constexpr int NJ = 10;
  constexpr int pre[NJ + 1] = {0, 1024, 1280, 1536, 1792, 1920, 2176, 2432, 3456, 4480, 6016};
  for (int t = blockIdx.x; t < 6016; t += gridDim.x) {
    int j = 0, base = 0;
#pragma unroll
    for (int q = 1; q < NJ; ++q) if (t >= pre[q]) { j = q; base = pre[q]; }
    const int lt = t - base;
    const float* src; int ld, K; u16* dst; int moff = 0; int ldd = 0;
    switch (j) {
      case 0: src = p.w_in; ld = 7184; K = 1024; dst = (u16*)(p.ws + OFF_WIN); break;
      case 1: src = p.w_in; ld = 7184; K = 1024; dst = (u16*)(p.ws + OFF_WZ); moff = 4096; break;
      case 2: src = p.w_in; ld = 7184; K = 1024; dst = (u16*)(p.ws + OFF_WGA); moff = 5136; break;
      case 3: src = p.w_in; ld = 7184; K = 1024; dst = (u16*)(p.ws + OFF_WGB); moff = 6160; break;
      case 4: src = p.w_conf_out; ld = 1024; K = 512; dst = (u16*)(p.ws + OFF_WCONF); break;
      case 5: src = p.w_gdn_out; ld = 1024; K = 1024; dst = (u16*)(p.ws + OFF_WGDN); break;
      case 6: src = p.w_o; ld = 1024; K = 1024; dst = (u16*)(p.ws + OFF_WO); break;
      case 7: src = p.w_ff1; ld = 4096; K = 1024; dst = (u16*)(p.ws + OFF_W1); break;
      case 8: src = p.w_ff2; ld = 1024; K = 4096; dst = (u16*)(p.ws + OFF_W2); ldd = LDF; break;
      default: src = p.w_ada; ld = 6144; K = 1024; dst = (u16*)(p.ws + OFF_WADA); break;
    }
    const int nkt = K >> 6;
    const int n0 = (lt / nkt) * 64, k0 = (lt % nkt) * 64;
    {
      const int nn = tid & 63, ty = tid >> 6;
      const int sc = (j == 0) ? map_in(n0 + nn) : (n0 + nn + moff);
#pragma unroll
      for (int i = 0; i < 8; ++i) {
        const int kk = ty + 8 * i;
        tile[kk * 65 + nn] = src[(size_t)(k0 + kk) * ld + sc];
      }
    }
    __syncthreads();
    {
      const int nn = tid >> 3, kq = (tid & 7) * 8;
      uint4 o0;
      const float* tp = tile + kq * 65 + nn;
      o0.x = pk2(tp[0 * 65], tp[1 * 65]);  o0.y = pk2(tp[2 * 65], tp[3 * 65]);
      o0.z = pk2(tp[4 * 65], tp[5 * 65]);  o0.w = pk2(tp[6 * 65], tp[7 * 65]);
      *(uint4*)(dst + (size_t)(n0 + nn) * (ldd ? ldd : K) + k0 + kq) = o0;
    }
    __syncthreads();
  }
  u16* Ac = (u16*)(p.ws + OFF_AC);
  for (int e = blockIdx.x * NT + tid; e < 256 * 256; e += gridDim.x * NT) {
    const int row = e >> 8, c4 = (e & 255) * 4;
    float4 v = make_float4(0.f, 0.f, 0.f, 0.f);
    if (row < 8) v = *(const float4*)(p.c_prompt + row * 1024 + c4);
    else if (row < 136) v = *(const float4*)(p.c_sample + (row - 8) * 1024 + c4);
    uint2 o; o.x = pk2(siluf_(v.x), siluf_(v.y)); o.y = pk2(siluf_(v.z), siluf_(v.w));
    *(uint2*)(Ac + row * 1024 + c4) = o;
  }
}

constexpr int WBA_LD = 1028;
template <bool BA> DI void phase_modnorm(const Params& p, const float* xa, const float* xb, const float* nw, int shift_off, int scale_off, u16* dst, char* smem) {
  const int lane = threadIdx.x & 63;
  const int gw = blockIdx.x * 8 + (threadIdx.x >> 6), nw_ = gridDim.x * 8;
  const float* mod = (const float*)(p.ws + OFF_MOD);
  float* wba = (float*)smem;
  if (BA) {
    for (int e = threadIdx.x; e < 16384; e += NT) { const int c = e >> 4, j = e & 15; wba[j * WBA_LD + c] = p.w_in[(size_t)c * 7184 + 5120 + j]; }
    __syncthreads();
  }
  float* gb = (float*)(p.ws + OFF_GB);
  for (int row = gw; row < R; row += nw_) {
    const float* xr = row < RP ? xa + (size_t)row * 1024 : xb + (size_t)(row - RP) * 1024;
    float4 v[4]; float ss = 0.f;
#pragma unroll
    for (int i = 0; i < 4; ++i) { v[i] = *(const float4*)(xr + (lane + 64 * i) * 4); ss += v[i].x * v[i].x + v[i].y * v[i].y + v[i].z * v[i].z + v[i].w * v[i].w; }
    ss = wsum(ss);
    const float rstd = rsqrtf(ss * (1.f / 1024.f) + EPS);
    const float* mr = mod + (size_t)mrow_of(row) * 6144;
    float ba[16];
    if (BA) {
#pragma unroll
      for (int j = 0; j < 16; ++j) ba[j] = 0.f;
    }
#pragma unroll
    for (int i = 0; i < 4; ++i) {
      const int c = (lane + 64 * i) * 4;
      const float4 w = *(const float4*)(nw + c), sc = *(const float4*)(mr + scale_off + c), sh = *(const float4*)(mr + shift_off + c);
      const float h0 = v[i].x * rstd * w.x * (1.f + sc.x) + sh.x, h1 = v[i].y * rstd * w.y * (1.f + sc.y) + sh.y;
      const float h2 = v[i].z * rstd * w.z * (1.f + sc.z) + sh.z, h3 = v[i].w * rstd * w.w * (1.f + sc.w) + sh.w;
      uint2 o; o.x = pk2(h0, h1); o.y = pk2(h2, h3);
      *(uint2*)(dst + (size_t)row * 1024 + c) = o;
      if (BA) {
#pragma unroll
        for (int j = 0; j < 16; ++j) { const float4 ww = *(const float4*)(wba + j * WBA_LD + c); ba[j] += h0 * ww.x + h1 * ww.y + h2 * ww.z + h3 * ww.w; }
        __builtin_amdgcn_sched_barrier(0);
      }
    }
    if (BA) {
#pragma unroll
      for (int w = 8; w >= 1; w >>= 1) {
        const bool up = (lane & w) != 0;
#pragma unroll
        for (int j = 0; j < w; ++j) {
          const float keep = up ? ba[j + w] : ba[j];
          const float send = up ? ba[j] : ba[j + w];
          ba[j] = keep + __shfl_xor(send, w, 64);
        }
      }
      float tot = ba[0];
      tot += __shfl_xor(tot, 16, 64); tot += __shfl_xor(tot, 32, 64);
      if (lane < 8) gb[(size_t)row * 16 + lane] = sigmoidf_(tot);
      else if (lane < 16) gb[(size_t)row * 16 + lane] = -__expf(p.a_log[lane - 8]) * softplusf_(tot + p.dt_bias[lane - 8]);
    }
  }
  if (BA) __syncthreads();
}

constexpr int LKN = 136, LKT = 72;
DI void d1_item(const Params& p, int item, char* smem) {
  int tid = threadIdx.x & 255;
  asm volatile("" : "+v"(tid));
  const int lane = tid & 63, wave = __builtin_amdgcn_readfirstlane(tid >> 6);
  const int r = lane & 31, hh = lane >> 5;
  const int h = item & 7, n = (item >> 3) & 31, b = item >> 8;
  const int rowbase = b * 2048 + n * 64;
  u16* kn  = (u16*)smem;
  u16* qn  = (u16*)(smem + 17408);
  u16* knT = (u16*)(smem + 34816);
  u16* vT  = (u16*)(smem + 53248);
  float* Gs = (float*)(smem + 71680);
  float* Bs = Gs + 64;
  float* Amat = (float*)(smem + 17408);
  u16* Tb = (u16*)smem;
  u16* Tg = (u16*)(smem + 17408);
  u16* qkv = (u16*)(p.ws + OFF_QKV);
  const u16* halo = (const u16*)(p.ws + OFF_HALO);
  const float* gb = (const float*)(p.ws + OFF_GB);

  if (wave == 0) {
    float g = gb[(size_t)(rowbase + lane) * 16 + 8 + h];
    const float be = gb[(size_t)(rowbase + lane) * 16 + h];
#pragma unroll
    for (int m = 1; m < 64; m <<= 1) { float t = __shfl_up(g, m, 64); if (lane >= m) g += t; }
    Gs[lane] = g; Bs[lane] = be;
  }
  {
    const int cp = lane;
#pragma unroll
    for (int X = 0; X < 3; ++X) {
      const int cb = X * 1024 + h * 128 + 2 * cp;
      float w[4][2];
#pragma unroll
      for (int j = 0; j < 4; ++j) { float2 t = *(const float2*)(p.gdn_conv_w + j * 3072 + cb); w[j][0] = t.x; w[j][1] = t.y; }
      float xw[3][2];
#pragma unroll
      for (int j = 0; j < 3; ++j) {
        const int rr = wave * 16 - 3 + j;
        unsigned u = 0u;
        if (rr >= 0) u = *(const unsigned*)(qkv + (size_t)(rowbase + rr) * 3072 + cb);
        else if (n > 0) u = *(const unsigned*)(halo + ((size_t)((b * 32 + n - 1) * 3 + (rr + 3))) * 3072 + cb);
        xw[j][0] = bf_lo(u); xw[j][1] = bf_hi(u);
      }
      float o[16][2];
#pragma unroll
      for (int t = 0; t < 16; ++t) {
        const unsigned u = *(const unsigned*)(qkv + (size_t)(rowbase + wave * 16 + t) * 3072 + cb);
        const float x0 = bf_lo(u), x1 = bf_hi(u);
        const float a0 = w[0][0] * xw[0][0] + w[1][0] * xw[1][0] + w[2][0] * xw[2][0] + w[3][0] * x0;
        const float a1 = w[0][1] * xw[0][1] + w[1][1] * xw[1][1] + w[2][1] * xw[2][1] + w[3][1] * x1;
        o[t][0] = siluf_(a0); o[t][1] = siluf_(a1);
        xw[0][0] = xw[1][0]; xw[0][1] = xw[1][1]; xw[1][0] = xw[2][0]; xw[1][1] = xw[2][1]; xw[2][0] = x0; xw[2][1] = x1;
      }
      if (X < 2) {
#pragma unroll
        for (int t = 0; t < 16; ++t) {
          const float ss = wsum(o[t][0] * o[t][0] + o[t][1] * o[t][1]);
          const float rs = rsqrtf(ss + EPS);
          o[t][0] *= rs; o[t][1] *= rs;
        }
      }
#pragma unroll
      for (int t = 0; t < 16; ++t) {
        const int row = wave * 16 + t;
        const unsigned pk = pk2(o[t][0], o[t][1]);
        if (X == 0) { *(unsigned*)(qn + row * LKN + 2 * cp) = pk; }
        else if (X == 1) {
          *(unsigned*)(kn + row * LKN + 2 * cp) = pk;
          knT[(2 * cp) * LKT + row] = (u16)(pk & 0xffffu); knT[(2 * cp + 1) * LKT + row] = (u16)(pk >> 16);
        } else {
          vT[(2 * cp) * LKT + row] = (u16)(pk & 0xffffu); vT[(2 * cp + 1) * LKT + row] = (u16)(pk >> 16);
        }
      }
    }
  }
  __syncthreads();
  const float Glast = Gs[63];
#pragma unroll
  for (int ff = 0; ff < 4; ++ff) {
    const int f = wave * 4 + ff;
    const int it = f >> 3, kb = (f >> 1) & 3, s = f & 1;
    const int i = it * 32 + r;
    const float sc = QSCALE * __expf(Gs[i]);
    const uint2 a = *(const uint2*)(qn + i * LKN + kb * 32 + 16 * s + 4 * hh);
    const uint2 c = *(const uint2*)(qn + i * LKN + kb * 32 + 16 * s + 4 * hh + 8);
    uint4 o;
    o.x = pk2(bf_lo(a.x) * sc, bf_hi(a.x) * sc); o.y = pk2(bf_lo(a.y) * sc, bf_hi(a.y) * sc);
    o.z = pk2(bf_lo(c.x) * sc, bf_hi(c.x) * sc); o.w = pk2(bf_lo(c.y) * sc, bf_hi(c.y) * sc);
    *(uint4*)((char*)qkv + (size_t)(rowbase + 4 * f + (lane >> 4)) * 6144 + h * 256 + (lane & 15) * 16) = o;
  }
  char* ext = p.ws + OFF_EXTRA + (size_t)item * 24576;
#pragma unroll
  for (int ff = 0; ff < 4; ++ff) {
    const int f = wave * 4 + ff;
    const int kt = f >> 2, pb = (f >> 1) & 1, s = f & 1;
    const int k = kt * 32 + r;
    const int p0 = pb * 32 + 16 * s + 4 * hh;
    const uint2 a = *(const uint2*)(knT + k * LKT + p0);
    const uint2 c = *(const uint2*)(knT + k * LKT + p0 + 8);
    const float4 g0 = *(const float4*)(Gs + p0), g1 = *(const float4*)(Gs + p0 + 8);
    uint4 o;
    o.x = pk2(bf_lo(a.x) * __expf(Glast - g0.x), bf_hi(a.x) * __expf(Glast - g0.y));
    o.y = pk2(bf_lo(a.y) * __expf(Glast - g0.z), bf_hi(a.y) * __expf(Glast - g0.w));
    o.z = pk2(bf_lo(c.x) * __expf(Glast - g1.x), bf_hi(c.x) * __expf(Glast - g1.y));
    o.w = pk2(bf_lo(c.y) * __expf(Glast - g1.z), bf_hi(c.y) * __expf(Glast - g1.w));
    *(uint4*)(ext + f * 1024 + lane * 16) = o;
  }
  f32x16 akk = zero16(), aqk = zero16();
  const int ta = (wave == 0) ? 0 : 1, tb = (wave == 2) ? 1 : 0;
  if (wave < 3) {
#pragma unroll
    for (int ks = 0; ks < 8; ++ks) {
      const bf16x8 fa = *(const bf16x8*)(kn + (ta * 32 + r) * LKN + ks * 16 + 8 * hh);
      const bf16x8 fb = *(const bf16x8*)(kn + (tb * 32 + r) * LKN + ks * 16 + 8 * hh);
      const bf16x8 fq = *(const bf16x8*)(qn + (ta * 32 + r) * LKN + ks * 16 + 8 * hh);
      akk = MFMA(fa, fb, akk);
      aqk = MFMA(fb, fq, aqk);
    }
  }
  __syncthreads();
  if (wave < 3) {
    const int m = tb * 32 + r; const float Gm = Gs[m];
#pragma unroll
    for (int reg = 0; reg < 16; ++reg) {
      const int i = ta * 32 + crow(reg, hh);
      const float v = (m < i) ? Bs[i] * akk[reg] * __expf(Gs[i] - Gm) : 0.f;
      Amat[i * 64 + m] = v;
    }
    const int i = ta * 32 + r; const float Gi = Gs[i];
    f32x16 av;
#pragma unroll
    for (int reg = 0; reg < 16; ++reg) {
      const int j = tb * 32 + crow(reg, hh);
      av[reg] = (j <= i) ? aqk[reg] * QSCALE * __expf(Gi - Gs[j]) : 0.f;
    }
    const int fbase = 16 + (wave * 2);
#pragma unroll
    for (int s = 0; s < 2; ++s) {
      bf16x8 fr8 = pack8(av, s);
      *(bf16x8*)(ext + (fbase + s) * 1024 + lane * 16) = fr8;
    }
  } else {
    for (int e = lane; e < 32 * 32; e += 64) Amat[(e >> 5) * 64 + 32 + (e & 31)] = 0.f;
    if (lane == 0) *(float*)(ext + 22 * 1024) = __expf(Glast);
  }
  __syncthreads();
  float* Tq = (float*)(smem + 9216);
  if (wave == 0) {
    float x[32];
    const int c = lane & 31, hb = lane >> 5;
    const float* Ab = Amat + (hb * 32) * 64 + hb * 32;
#pragma unroll
    for (int i = 0; i < 32; ++i) {
      float s0 = (c == i) ? 1.f : 0.f, s1 = 0.f;
#pragma unroll
      for (int m4 = 0; m4 < (i + 3) / 4; ++m4) {
        const float4 a4 = *(const float4*)(Ab + i * 64 + m4 * 4);
        if (m4 * 4 + 0 < i) s0 -= a4.x * x[m4 * 4 + 0];
        if (m4 * 4 + 1 < i) s1 -= a4.y * x[m4 * 4 + 1];
        if (m4 * 4 + 2 < i) s0 -= a4.z * x[m4 * 4 + 2];
        if (m4 * 4 + 3 < i) s1 -= a4.w * x[m4 * 4 + 3];
      }
      x[i] = s0 + s1;
      __builtin_amdgcn_sched_barrier(0);
    }
#pragma unroll
    for (int i = 0; i < 32; ++i) Tq[hb * 1024 + i * 32 + c] = x[i];
  }
  __syncthreads();
  const int c32 = tid & 31, g8 = tid >> 5;
  {
    float bm[4] = {0.f, 0.f, 0.f, 0.f};
#pragma unroll
    for (int j4 = 0; j4 < 8; ++j4) {
      float t[4];
#pragma unroll
      for (int e = 0; e < 4; ++e) t[e] = Tq[(j4 * 4 + e) * 32 + c32];
#pragma unroll
      for (int e = 0; e < 4; ++e) {
        const float4 a4 = *(const float4*)(Amat + (32 + g8 * 4 + e) * 64 + j4 * 4);
        bm[e] += a4.x * t[0] + a4.y * t[1] + a4.z * t[2] + a4.w * t[3];
      }
    }
#pragma unroll
    for (int e = 0; e < 4; ++e) Amat[(g8 * 4 + e) * 64 + 32 + c32] = bm[e];
  }
  __syncthreads();
  float t21[4] = {0.f, 0.f, 0.f, 0.f};
  {
#pragma unroll
    for (int m4 = 0; m4 < 8; ++m4) {
      float bv[4];
#pragma unroll
      for (int e = 0; e < 4; ++e) bv[e] = Amat[(m4 * 4 + e) * 64 + 32 + c32];
#pragma unroll
      for (int e = 0; e < 4; ++e) {
        const float4 a4 = *(const float4*)(Tq + 1024 + (g8 * 4 + e) * 32 + m4 * 4);
        t21[e] -= a4.x * bv[0] + a4.y * bv[1] + a4.z * bv[2] + a4.w * bv[3];
      }
    }
  }
  float t11[4], t22[4];
#pragma unroll
  for (int e = 0; e < 4; ++e) { t11[e] = Tq[(g8 * 4 + e) * 32 + c32]; t22[e] = Tq[1024 + (g8 * 4 + e) * 32 + c32]; }
  const float bcl = Bs[c32], bgl = bcl * __expf(Gs[c32]);
  const float bch = Bs[32 + c32], bgh = bch * __expf(Gs[32 + c32]);
  __syncthreads();
#pragma unroll
  for (int e = 0; e < 4; ++e) {
    const int i = g8 * 4 + e;
    Tb[i * LKT + c32] = f2bf(t11[e] * bcl);               Tg[i * LKT + c32] = f2bf(t11[e] * bgl);
    Tb[i * LKT + 32 + c32] = (u16)0;                      Tg[i * LKT + 32 + c32] = (u16)0;
    Tb[(32 + i) * LKT + c32] = f2bf(t21[e] * bcl);        Tg[(32 + i) * LKT + c32] = f2bf(t21[e] * bgl);
    Tb[(32 + i) * LKT + 32 + c32] = f2bf(t22[e] * bch);   Tg[(32 + i) * LKT + 32 + c32] = f2bf(t22[e] * bgh);
  }
  __syncthreads();
#pragma unroll
  for (int it = 0; it < 2; ++it) {
    f32x16 av = zero16(), ak = zero16();
#pragma unroll
    for (int ks = 0; ks < 4; ++ks) {
      const bf16x8 fT = *(const bf16x8*)(Tb + (it * 32 + r) * LKT + ks * 16 + 8 * hh);
      const bf16x8 fV = *(const bf16x8*)(vT + (wave * 32 + r) * LKT + ks * 16 + 8 * hh);
      const bf16x8 fK = *(const bf16x8*)(knT + (wave * 32 + r) * LKT + ks * 16 + 8 * hh);
      const bf16x8 fG = *(const bf16x8*)(Tg + (it * 32 + r) * LKT + ks * 16 + 8 * hh);
      av = MFMA(fT, fV, av);
      ak = MFMA(fK, fG, ak);
    }
    {
      const int fv = wave * 2 + it;
      char* d = (char*)qkv + (size_t)(rowbase + 8 * fv + (lane >> 3)) * 6144 + 4096 + h * 256 + (lane & 7) * 32;
      *(bf16x8*)d = pack8(av, 0); *(bf16x8*)(d + 16) = pack8(av, 1);
    }
#pragma unroll
    for (int s = 0; s < 2; ++s) {
      const int f = it * 8 + wave * 2 + s;
      *(bf16x8*)((char*)qkv + (size_t)(rowbase + 4 * f + (lane >> 4)) * 6144 + 2048 + h * 256 + (lane & 15) * 16) = pack8(ak, s);
    }
  }
  __syncthreads();
}

DI void d2_issue(u32x4 (&rg)[18], const Params& p, int b, int h, int lt, int n) {
  const char* qseg = p.ws + OFF_QKV + (size_t)(b * 2048 + n * 64) * 6144 + h * 256;
  const char* ext = p.ws + OFF_EXTRA + (size_t)((b * 32 + n) * 8 + h) * 24576;
#pragma unroll
  for (int sg = 0; sg < 3; ++sg)
#pragma unroll
    for (int i = 0; i < 4; ++i) rg[sg * 4 + i] = *(const u32x4*)(qseg + (size_t)((lt >> 4) + 16 * i) * 6144 + sg * 2048 + (lt & 15) * 16);
#pragma unroll
  for (int i = 0; i < 6; ++i) rg[12 + i] = *(const u32x4*)(ext + lt * 16 + i * 4096);
}
DI void d2_put(const u32x4 (&rg)[18], char* buf, int lt) {
#pragma unroll
  for (int sg = 0; sg < 3; ++sg)
#pragma unroll
    for (int i = 0; i < 4; ++i) *(u32x4*)(buf + sg * 16384 + ((lt >> 4) + 16 * i) * 256 + (lt & 15) * 16) = rg[sg * 4 + i];
#pragma unroll
  for (int i = 0; i < 6; ++i) *(u32x4*)(buf + 49152 + lt * 16 + i * 4096) = rg[12 + i];
}
DI void d2_block(const Params& p, int unit, char* smem) {
  const int tid = threadIdx.x, half = tid >> 8, lt = tid & 255, lane = tid & 63, wave = (tid >> 6) & 3;
  const int r = lane & 31, hh = lane >> 5;
  const int b = unit >> 3, h = unit & 7;
  const char* qkv = p.ws + OFF_QKV;
  const float* egl = (const float*)(p.ws + OFF_EGL);
  u16* obuf = (u16*)((char*)p.out + (size_t)R * 1024 * 2);
  if (half == 1) {
    u32x4 rg0[18], rg1[18];
    u32x4 og[4], sg4;
    u16* obuf_ = (u16*)((char*)p.out + (size_t)R * 1024 * 2);
    float* ssq_ = (float*)(p.ws + OFF_SSQ);
    const int orow = lt >> 2, opos = lt & 3, ocol = 8 * (opos ^ ((orow >> 1) & 3));
    d2_issue(rg0, p, b, h, lt, 0); d2_put(rg0, smem, lt); d2_issue(rg1, p, b, h, lt, 1); d2_issue(rg0, p, b, h, lt, 2);
    __syncthreads();
#define D2_LOADER_STEP(n_, RG)                                                                                              \
    {                                                                                                                        \
      const int n = (n_);                                                                                                    \
      char* ob = smem + ((n + 1) & 1) * HALF_SMEM;                                                                           \
      if (n >= 1) {                                                                                                          \
        _Pragma("unroll") for (int i = 0; i < 4; ++i) og[i] = *(const u32x4*)(ob + 32768 + (lt + 256 * i) * 16);            \
        if (lt >= 192) sg4 = *(const u32x4*)(ob + 49152 + 20480 + lt * 16);                                                  \
      }                                                                                                                      \
      if (n + 1 < 32) { d2_put(RG, ob, lt); if (n + 3 < 32) d2_issue(RG, p, b, h, lt, n + 3); }                              \
      if (n >= 1) {                                                                                                          \
        const int rowbase = b * 2048 + (n - 1) * 64;                                                                         \
        _Pragma("unroll") for (int i = 0; i < 4; ++i)                                                                        \
          *(u32x4*)(obuf_ + (size_t)(rowbase + orow) * 1024 + h * 128 + 32 * i + ocol) = og[i];                              \
        if (lt >= 192) *(u32x4*)(ssq_ + ((size_t)(rowbase + lt - 192) * 8 + h) * 4) = sg4;                                   \
      }                                                                                                                      \
      if (n < 32) { asm volatile("s_waitcnt lgkmcnt(0)" ::: "memory"); __builtin_amdgcn_s_barrier(); asm volatile("" ::: "memory"); } \
    }
#pragma unroll 1
    for (int n2 = 0; n2 <= 32; n2 += 2) {
      D2_LOADER_STEP(n2, rg1)
      if (n2 + 1 <= 32) D2_LOADER_STEP(n2 + 1, rg0)
    }
#undef D2_LOADER_STEP
    return;
  }
  f32x16 S[4];
#pragma unroll
  for (int k = 0; k < 4; ++k) S[k] = zero16();
  const unsigned voff_l = (unsigned)(lane * 16);
  bf16x8 If0, If1;
#pragma unroll
  for (int j = 0; j < 8; ++j) {
    const int k0 = 8 * (j >> 2) + 4 * hh + (j & 3);
    If0[j] = (short)((k0 == r) ? 0x3F80 : 0); If1[j] = (short)((16 + k0 == r) ? 0x3F80 : 0);
  }
  const unsigned voff_v = (unsigned)((16 * wave + (lane >> 3)) * 256 + (lane & 7) * 32);
  __syncthreads();
#pragma unroll 1
  for (int n = 0; n < 32; ++n) {
    const int item = (b * 32 + n) * 8 + h;
    const int rowbase = b * 2048 + n * 64;
    const char* buf = smem + (n & 1) * HALF_SMEM;
    const char* ext = buf + 49152;
    const float eg = *(const float*)(ext + 22 * 1024);
    bf16x8 fk[16];
#pragma unroll
    for (int f = 0; f < 16; ++f) fk[f] = *(const bf16x8*)(buf + 16384 + f * 1024 + voff_l);
    uint4 vv[2][2];
#pragma unroll
    for (int it = 0; it < 2; ++it) { const char* d = buf + 32768 + it * 2048 + voff_v; vv[it][0] = *(const uint4*)d; vv[it][1] = *(const uint4*)(d + 16); }
    bf16x8 Sf[4][2];
#pragma unroll
    for (int kb = 0; kb < 4; ++kb) { Sf[kb][0] = pack8(S[kb], 0); Sf[kb][1] = pack8(S[kb], 1); }
    __builtin_amdgcn_sched_barrier(0);
    f32x16 P1[2];
    P1[0] = zero16(); P1[1] = zero16();
#pragma unroll
    for (int kb = 0; kb < 4; ++kb)
#pragma unroll
      for (int s = 0; s < 2; ++s) {
        P1[0] = MFMA(fk[kb * 2 + s], Sf[kb][s], P1[0]);
        P1[1] = MFMA(fk[8 + kb * 2 + s], Sf[kb][s], P1[1]);
      }
    bf16x8 fq[8];
#pragma unroll
    for (int f = 0; f < 8; ++f) fq[f] = *(const bf16x8*)(buf + f * 1024 + voff_l);
    bf16x8 Vf[2][2];
#pragma unroll
    for (int it = 0; it < 2; ++it) {
      const uint4 v0 = vv[it][0], v1 = vv[it][1];
      f32x16 vn;
      vn[0] = bf_lo(v0.x) - P1[it][0];  vn[1] = bf_hi(v0.x) - P1[it][1];
      vn[2] = bf_lo(v0.y) - P1[it][2];  vn[3] = bf_hi(v0.y) - P1[it][3];
      vn[4] = bf_lo(v0.z) - P1[it][4];  vn[5] = bf_hi(v0.z) - P1[it][5];
      vn[6] = bf_lo(v0.w) - P1[it][6];  vn[7] = bf_hi(v0.w) - P1[it][7];
      vn[8] = bf_lo(v1.x) - P1[it][8];  vn[9] = bf_hi(v1.x) - P1[it][9];
      vn[10] = bf_lo(v1.y) - P1[it][10]; vn[11] = bf_hi(v1.y) - P1[it][11];
      vn[12] = bf_lo(v1.z) - P1[it][12]; vn[13] = bf_hi(v1.z) - P1[it][13];
      vn[14] = bf_lo(v1.w) - P1[it][14]; vn[15] = bf_hi(v1.w) - P1[it][15];
      Vf[it][0] = pack8(vn, 0); Vf[it][1] = pack8(vn, 1);
    }
    bf16x8 fa[6];
#pragma unroll
    for (int i = 0; i < 6; ++i) fa[i] = *(const bf16x8*)(ext + (16 + i) * 1024 + voff_l);
    f32x16 P2[2];
    P2[0] = zero16(); P2[1] = zero16();
#pragma unroll
    for (int kb = 0; kb < 4; ++kb)
#pragma unroll
      for (int s = 0; s < 2; ++s) {
        P2[0] = MFMA(fq[kb * 2 + s], Sf[kb][s], P2[0]);
        const bf16x8 fq1 = *(const bf16x8*)(buf + (8 + kb * 2 + s) * 1024 + voff_l);
        P2[1] = MFMA(fq1, Sf[kb][s], P2[1]);
      }
    __builtin_amdgcn_sched_barrier(0);
    bf16x8 fkd[16];
#pragma unroll
    for (int i = 0; i < 16; ++i) fkd[i] = *(const bf16x8*)(ext + i * 1024 + voff_l);
#pragma unroll
    for (int s = 0; s < 2; ++s) {
      P2[0] = MFMA(fa[0 + s], Vf[0][s], P2[0]);
      P2[1] = MFMA(fa[2 + s], Vf[0][s], P2[1]);
      P2[1] = MFMA(fa[4 + s], Vf[1][s], P2[1]);
    }
    {
      char* ow = (char*)buf + 32768 + wave * 4096;
      float* sqw = (float*)((char*)buf + 49152 + 23 * 1024);
      const int xs = (r >> 1) & 3;
#pragma unroll
      for (int it = 0; it < 2; ++it) {
        f32x16 Z = MFMA(pack8(P2[it], 0), If0, zero16());
        Z = MFMA(pack8(P2[it], 1), If1, Z);
        float ssl = 0.f;
#pragma unroll
        for (int reg = 0; reg < 16; ++reg) ssl += Z[reg] * Z[reg];
        ssl += __shfl_xor(ssl, 32, 64);
        if (hh == 0) sqw[(it * 32 + r) * 4 + wave] = ssl;
#pragma unroll
        for (int g = 0; g < 4; ++g) {
          uint2 pv; pv.x = pk2(Z[4 * g], Z[4 * g + 1]); pv.y = pk2(Z[4 * g + 2], Z[4 * g + 3]);
          *(uint2*)(ow + (it * 32 + r) * 64 + ((g ^ xs) * 16) + hh * 8) = pv;
        }
      }
    }
#pragma unroll
    for (int kt = 0; kt < 4; ++kt) {
#pragma unroll
      for (int reg = 0; reg < 16; ++reg) S[kt][reg] *= eg;
#pragma unroll
      for (int pb = 0; pb < 2; ++pb)
#pragma unroll
        for (int s = 0; s < 2; ++s) {
          S[kt] = MFMA(fkd[kt * 4 + pb * 2 + s], Vf[pb][s], S[kt]);
        }
    }
    asm volatile("s_waitcnt lgkmcnt(0)" ::: "memory"); __builtin_amdgcn_s_barrier(); asm volatile("" ::: "memory");
  }
  float* od = p.out + OUT_DELTAP + (size_t)(b * 8 + h) * 16384;
#pragma unroll
  for (int kt = 0; kt < 4; ++kt)
#pragma unroll
    for (int reg = 0; reg < 16; ++reg) od[(kt * 32 + crow(reg, hh)) * 128 + wave * 32 + r] = S[kt][reg];
}

DI void conf_prompt_item(const Params& p, int item, char* smem) {
  const int tid = threadIdx.x & 255, lane = tid & 63, wave = tid >> 6;
  const int b = item >> 6, t0 = (item & 63) * 32;
  unsigned* tile = (unsigned*)smem;
  float* red = (float*)(smem + 63488);
  const u16* glu = (const u16*)(p.ws + OFF_GLU);
  u16* aact = (u16*)(p.ws + OFF_AACT);
#pragma unroll 1
  for (int hb = 0; hb < 2; ++hb) {
    u32x4 fv[8];
#pragma unroll
    for (int i = 0; i < 8; ++i) {
      const int e = tid + 256 * (hb * 8 + i), rr = e >> 6, c8 = (e & 63) * 8;
      const int t = t0 - 30 + rr;
      fv[i] = (u32x4){0u, 0u, 0u, 0u};
      if (rr < 62 && t >= 0) fv[i] = *(const u32x4*)(glu + (size_t)(b * 2048 + t) * 512 + c8);
    }
#pragma unroll
    for (int i = 0; i < 8; ++i) {
      const int e = tid + 256 * (hb * 8 + i), rr = e >> 6, c8 = (e & 63) * 8;
      if (rr < 62) *(u32x4*)(tile + rr * 256 + (c8 >> 1)) = fv[i];
    }
  }
  float w[31][2];
#pragma unroll
  for (int j = 0; j < 31; ++j) { const float2 t = *(const float2*)(p.conf_dw_w + j * 512 + 2 * tid); w[j][0] = t.x; w[j][1] = t.y; }
  const float2 bias = *(const float2*)(p.conf_dw_b + 2 * tid);
  const float2 lw = *(const float2*)(p.conf_ln_w + 2 * tid), lb = *(const float2*)(p.conf_ln_b + 2 * tid);
  __syncthreads();
#pragma unroll 1
  for (int tg = 0; tg < 4; ++tg) {
    float a[8][2];
#pragma unroll
    for (int t = 0; t < 8; ++t) { a[t][0] = bias.x; a[t][1] = bias.y; }
#pragma unroll
    for (int i = 0; i < 38; ++i) {
      const unsigned u = tile[(tg * 8 + i) * 256 + tid];
      const float x0 = bf_lo(u), x1 = bf_hi(u);
#pragma unroll
      for (int t = 0; t < 8; ++t) {
        const int j = i - t;
        if (j >= 0 && j < 31) { a[t][0] += w[j][0] * x0; a[t][1] += w[j][1] * x1; }
      }
    }
#pragma unroll
    for (int t = 0; t < 8; ++t) {
      const float s1 = wsum(a[t][0] + a[t][1]);
      const float s2 = wsum(a[t][0] * a[t][0] + a[t][1] * a[t][1]);
      if (lane == 0) { red[(wave * 8 + t) * 2] = s1; red[(wave * 8 + t) * 2 + 1] = s2; }
    }
    __syncthreads();
#pragma unroll
    for (int t = 0; t < 8; ++t) {
      const float s1 = red[t * 2] + red[(8 + t) * 2] + red[(16 + t) * 2] + red[(24 + t) * 2];
      const float s2 = red[t * 2 + 1] + red[(8 + t) * 2 + 1] + red[(16 + t) * 2 + 1] + red[(24 + t) * 2 + 1];
      const float mu = s1 * (1.f / 512.f);
      const float var = fmaxf(s2 * (1.f / 512.f) - mu * mu, 0.f);
      const float rs = rsqrtf(var + EPS);
      const float y0 = (a[t][0] - mu) * rs * lw.x + lb.x, y1 = (a[t][1] - mu) * rs * lw.y + lb.y;
      *(unsigned*)(aact + (size_t)(b * 2048 + t0 + tg * 8 + t) * 512 + 2 * tid) = pk2(siluf_(y0), siluf_(y1));
    }
    __syncthreads();
  }
}
DI void conf_sample_item(const Params& p, int item) {
  const int lane = threadIdx.x & 63, wave = (threadIdx.x >> 6) & 3;
  const int s = item * 4 + wave;
  const int c = lane * 8;
  const u16* glu = (const u16*)(p.ws + OFF_GLU);
  u16* aact = (u16*)(p.ws + OFF_AACT);
  float a[8];
  {
    const float4 b0 = *(const float4*)(p.conf_dw_b + c), b1 = *(const float4*)(p.conf_dw_b + c + 4);
    a[0] = b0.x; a[1] = b0.y; a[2] = b0.z; a[3] = b0.w; a[4] = b1.x; a[5] = b1.y; a[6] = b1.z; a[7] = b1.w;
  }
  const float* st = p.st_conf + (size_t)s * 30 * 512;
  float* oc = p.out + OUT_CONFS + (size_t)s * 30 * 512;
#pragma unroll 1
  for (int j = 0; j < 30; ++j) {
    const float4 x0 = *(const float4*)(st + j * 512 + c), x1 = *(const float4*)(st + j * 512 + c + 4);
    const float4 w0 = *(const float4*)(p.conf_dw_w + j * 512 + c), w1 = *(const float4*)(p.conf_dw_w + j * 512 + c + 4);
    a[0] += w0.x * x0.x; a[1] += w0.y * x0.y; a[2] += w0.z * x0.z; a[3] += w0.w * x0.w;
    a[4] += w1.x * x1.x; a[5] += w1.y * x1.y; a[6] += w1.z * x1.z; a[7] += w1.w * x1.w;
    if (j >= 1) { *(float4*)(oc + (j - 1) * 512 + c) = x0; *(float4*)(oc + (j - 1) * 512 + c + 4) = x1; }
  }
  {
    const uint4 g = *(const uint4*)(glu + (size_t)(RP + s) * 512 + c);
    const float4 w0 = *(const float4*)(p.conf_dw_w + 30 * 512 + c), w1 = *(const float4*)(p.conf_dw_w + 30 * 512 + c + 4);
    a[0] += w0.x * bf_lo(g.x); a[1] += w0.y * bf_hi(g.x); a[2] += w0.z * bf_lo(g.y); a[3] += w0.w * bf_hi(g.y);
    a[4] += w1.x * bf_lo(g.z); a[5] += w1.y * bf_hi(g.z); a[6] += w1.z * bf_lo(g.w); a[7] += w1.w * bf_hi(g.w);
  }
  float s1 = 0.f, s2 = 0.f;
#pragma unroll
  for (int i = 0; i < 8; ++i) { s1 += a[i]; s2 += a[i] * a[i]; }
  s1 = wsum(s1); s2 = wsum(s2);
  const float mu = s1 * (1.f / 512.f);
  const float rs = rsqrtf(fmaxf(s2 * (1.f / 512.f) - mu * mu, 0.f) + EPS);
  float y[8];
#pragma unroll
  for (int i = 0; i < 8; ++i) y[i] = siluf_((a[i] - mu) * rs * p.conf_ln_w[c + i] + p.conf_ln_b[c + i]);
  uint4 o; o.x = pk2(y[0], y[1]); o.y = pk2(y[2], y[3]); o.z = pk2(y[4], y[5]); o.w = pk2(y[6], y[7]);
  *(uint4*)(aact + (size_t)(RP + s) * 512 + c) = o;
}
DI void delta_sample_item(const Params& p, int item, char* smem) {
  const int tid = threadIdx.x & 255, lane = tid & 63, wave = tid >> 6;
  const int s = item >> 3, h = item & 7;
  float* qs = (float*)smem; float* ks = qs + 128; float* vs = ks + 128; float* part = vs + 128;
  float* red = part + 768;
  const u16* qkv = (const u16*)(p.ws + OFF_QKV);
  const float* gb = (const float*)(p.ws + OFF_GB);
  const int row = RP + s;
  const int v = tid & 127, kh = tid >> 7;
  const float* S0 = p.st_delta + (size_t)(s * 8 + h) * 16384 + (size_t)(kh * 64) * 128 + v;
  float Sr[64];
#pragma unroll
  for (int kk = 0; kk < 64; ++kk) Sr[kk] = S0[kk * 128];
  const float g = gb[(size_t)row * 16 + 8 + h], beta = gb[(size_t)row * 16 + h];
  float cq = 0.f, ck = 0.f, cv = 0.f;
  if (tid < 128) {
    float cx[3];
#pragma unroll
    for (int X = 0; X < 3; ++X) {
      const int cg = X * 1024 + h * 128 + tid;
      const float s0 = p.st_qkv[(size_t)(s * 3 + 0) * 3072 + cg], s1 = p.st_qkv[(size_t)(s * 3 + 1) * 3072 + cg], s2 = p.st_qkv[(size_t)(s * 3 + 2) * 3072 + cg];
      const float x = bf1(qkv[(size_t)row * 3072 + cg]);
      const float a = p.gdn_conv_w[cg] * s0 + p.gdn_conv_w[3072 + cg] * s1 + p.gdn_conv_w[2 * 3072 + cg] * s2 + p.gdn_conv_w[3 * 3072 + cg] * x;
      cx[X] = siluf_(a);
      p.out[OUT_QKVS + (size_t)(s * 3 + 0) * 3072 + cg] = s1;
      p.out[OUT_QKVS + (size_t)(s * 3 + 1) * 3072 + cg] = s2;
    }
    cq = cx[0]; ck = cx[1]; cv = cx[2];
  }
  {
    const float sq = wsum(cq * cq), sk = wsum(ck * ck);
    if (lane == 0) { red[wave * 2] = sq; red[wave * 2 + 1] = sk; }
  }
  __syncthreads();
  if (tid < 128) {
    const float rq = rsqrtf(red[0] + red[2] + EPS), rk = rsqrtf(red[1] + red[3] + EPS);
    qs[tid] = cq * rq * QSCALE; ks[tid] = ck * rk; vs[tid] = cv;
  }
  __syncthreads();
  const float eg = __expf(g);
  float kS = 0.f, qS = 0.f, qk = 0.f;
#pragma unroll
  for (int kk = 0; kk < 64; ++kk) {
    const float kv = ks[kh * 64 + kk], qv = qs[kh * 64 + kk];
    kS += kv * Sr[kk]; qS += qv * Sr[kk]; qk += kv * qv;
  }
  part[(kh * 3 + 0) * 128 + v] = kS; part[(kh * 3 + 1) * 128 + v] = qS; part[(kh * 3 + 2) * 128 + v] = qk;
  __syncthreads();
  kS = part[0 * 128 + v] + part[3 * 128 + v];
  qS = part[1 * 128 + v] + part[4 * 128 + v];
  qk = part[2 * 128 + v] + part[5 * 128 + v];
  const float vnew = vs[v] * beta - beta * eg * kS;
  const float o = eg * qS + qk * vnew;
  float* Sd = p.out + OUT_DELTAS + (size_t)(s * 8 + h) * 16384 + (size_t)(kh * 64) * 128 + v;
#pragma unroll
  for (int kk = 0; kk < 64; ++kk) Sd[kk * 128] = Sr[kk] * eg + ks[kh * 64 + kk] * vnew;
  if (kh == 0) {
    ((u16*)((char*)p.out + (size_t)R * 1024 * 2))[(size_t)row * 1024 + h * 128 + v] = f2bf(o);
    const float so = wsum(o * o);
    if (lane == 0) { float* sq = (float*)(p.ws + OFF_SSQ) + ((size_t)row * 8 + h) * 4; sq[wave] = so; sq[wave + 2] = 0.f; }
  }
  __syncthreads();
}

__global__ void __launch_bounds__(512, 2) fwd_megakernel(Params p) {
  __shared__ __attribute__((aligned(1024))) char smem[SMEM_BYTES];
  const int tid = threadIdx.x, lane = tid & 63, wave = tid >> 6;
  const int fr = lane & 15, fq = lane >> 4;
  uint4* xb_words = (uint4*)(smem + 2 * HALF_SMEM);
  if (tid == 0) *xb_words = make_uint4(0u, 0u, 0u, 0u);
  __syncthreads();
  XcdBarrier xb = xcd_barrier_post((unsigned*)(p.ws + OFF_BAR), (volatile LAS unsigned*)xb_words);
  const int G = gridDim.x, bid = blockIdx.x;
  float* mod = (float*)(p.ws + OFF_MOD);
  u16* hbuf = (u16*)p.out;
  u16* obuf = (u16*)((char*)p.out + (size_t)R * 1024 * 2);
  const float* ssq = (const float*)(p.ws + OFF_SSQ);
  u16* merged = (u16*)(p.ws + OFF_MERGED);
  u16* tmp2 = (u16*)(p.ws + OFF_TMP2);

  PH(0) phase_convert(p, smem);
  xcd_barrier(xb);

  PH(1) for (int sb = bid; sb < 256; sb += G) {
    skinny<2>((const u16*)(p.ws + OFF_AC), 1024, 0, 136, (const u16*)(p.ws + OFF_WADA), 1024, 1024,
      [&](int j) { return sb * 24 + (j < 24 ? j : 23); },
      [&](int row, int ntl, int q, f32x4 v, int ln) {
        const int j = ntl * 16 + 4 * q;
        if (j < 24) {
          const int col = sb * 24 + j;
          const float4 bb = *(const float4*)(p.b_ada + col);
          *(float4*)(mod + (size_t)row * 6144 + col) = make_float4(v[0] + bb.x, v[1] + bb.y, v[2] + bb.z, v[3] + bb.w);
        }
      });
  }
  xcd_barrier(xb);

  PH(2) phase_modnorm<true>(p, p.x_prompt, p.x_sample, p.norm1_w, 0, 1024, hbuf, smem);
  xcd_barrier(xb);

  PH(3) {
    u16* glu = (u16*)(p.ws + OFF_GLU);
    u16* qkv = (u16*)(p.ws + OFF_QKV);
    u16* halo = (u16*)(p.ws + OFF_HALO);
    auto f_glu_st = [&](int row, int ch, f32x4 gl) {
      uint2 o; o.x = pk2(gl[0], gl[1]); o.y = pk2(gl[2], gl[3]);
      *(uint2*)(glu + (size_t)row * 512 + ch) = o;
      if (row < RP) { const int b = row >> 11, tt = row & 2047; if (tt >= 2018) *(float4*)(p.out + OUT_CONFP + (size_t)(b * 30 + tt - 2018) * 512 + ch) = make_float4(gl[0], gl[1], gl[2], gl[3]); }
      else *(float4*)(p.out + OUT_CONFS + (size_t)((row - RP) * 30 + 29) * 512 + ch) = make_float4(gl[0], gl[1], gl[2], gl[3]);
    };
    auto f_glu = [&](int row, int ch, f32x4 a, f32x4 g) {
      f32x4 gl;
#pragma unroll
      for (int j = 0; j < 4; ++j) gl[j] = a[j] * sigmoidf_(g[j]);
      f_glu_st(row, ch, gl);
    };
    auto f_qkv = [&](int row, int col, f32x4 a) {
      const float4 v = make_float4(a[0], a[1], a[2], a[3]);
      uint2 o; o.x = pk2(v.x, v.y); o.y = pk2(v.z, v.w);
      *(uint2*)(qkv + (size_t)row * 3072 + col) = o;
      if (row < RP) {
        const int b = row >> 11, tt = row & 2047;
        if ((tt & 63) >= 61) *(uint2*)(halo + (size_t)((b * 32 + (tt >> 6)) * 3 + (tt & 63) - 61) * 3072 + col) = o;
        if (tt >= 2045) *(float4*)(p.out + OUT_QKVP + (size_t)(b * 3 + tt - 2045) * 3072 + col) = v;
      } else *(float4*)(p.out + OUT_QKVS + (size_t)((row - RP) * 3 + 2) * 3072 + col) = v;
    };
    int u = bid;
    for (; u < 64 * 4; u += G) {
      const int pm = u % 64, pn = u / 64;
      f32x4 acc[2][2][4][2];
      zero_acc(acc);
      gemm256(acc, hbuf, 1024, (const u16*)(p.ws + OFF_WIN), 1024, pm * 256, pn * 256, 1024, smem);
      {
        int t_ = threadIdx.x;
        asm volatile("" : "+v"(t_));
        const int wr = t_ >> 8, wc = (t_ >> 6) & 3, fr_ = t_ & 15, fq_ = (t_ >> 4) & 3;
        float* T = (float*)smem;
#pragma unroll
        for (int ai = 0; ai < 2; ++ai)
#pragma unroll
          for (int m = 0; m < 4; ++m)
#pragma unroll
            for (int n = 0; n < 2; ++n) {
              f32x4 gl;
#pragma unroll
              for (int j = 0; j < 4; ++j) gl[j] = acc[ai][0][m][n][j] * sigmoidf_(acc[ai][1][m][n][j]);
              *(f32x4*)(T + (ai * 128 + wr * 64 + m * 16 + fr_) * TLD + wc * 32 + n * 16 + 4 * fq_) = gl;
            }
        __syncthreads();
        const int cg = (t_ & 31) * 4, r0 = t_ >> 5;
#pragma unroll 4
        for (int i = 0; i < 16; ++i) {
          const int rl = r0 + 16 * i;
          const f32x4 v = *(const f32x4*)(T + rl * TLD + cg);
          f_glu_st(pm * 256 + rl, pn * 128 + cg, v);
        }
        __syncthreads();
      }
    }
    for (; u < 64 * 16; u += G) {
      const int pm = u % 64, pn = u / 64;
      f32x4 acc[2][2][4][2];
      zero_acc(acc);
      gemm256(acc, hbuf, 1024, (const u16*)(p.ws + OFF_WIN), 1024, pm * 256, pn * 256, 1024, smem);
      tile_epilogue(acc, pm * 256, pn * 256 - 1024, smem, f_qkv);
    }
    for (int sb = bid; sb < 256; sb += G) {
      if (sb < 64) {
        skinny<1>(hbuf, 1024, RP, 128, (const u16*)(p.ws + OFF_WIN), 1024, 1024,
          [&](int j) { const int ch = sb * 8 + (j & 7); return (ch >> 7) * 256 + (ch & 127) + ((j >> 3) << 7); },
          [&](int row, int ntl, int q, f32x4 v, int ln) {
            f32x4 g;
#pragma unroll
            for (int j = 0; j < 4; ++j) g[j] = __shfl(v[j], (ln + 32) & 63, 64);
            if (q < 2) f_glu(row, sb * 8 + 4 * q, v, g);
          });
      } else {
        skinny<1>(hbuf, 1024, RP, 128, (const u16*)(p.ws + OFF_WIN), 1024, 1024,
          [&](int j) { return 1024 + (sb - 64) * 16 + j; },
          [&](int row, int ntl, int q, f32x4 v, int ln) { f_qkv(row, (sb - 64) * 16 + 4 * q, v); });
      }
    }
  }
  xcd_barrier(xb);

  PH(4) for (int base = bid * 2; base < 2048; base += 2 * G) d1_item(p, base + (tid >> 8), smem + (tid >> 8) * HALF_SMEM);
  xcd_barrier(xb);

  PH(5) {
    const int half = tid >> 8;
    char* hs = smem + half * HALF_SMEM;
    if (G >= 128) {
      if (bid < 64) d2_block(p, bid, smem);
      else {
        const int hb = (bid - 64) * 2, st = (G - 64) * 2;
        for (int base = hb; base < 512; base += st) conf_prompt_item(p, base + half, hs);
        for (int base = hb; base < 32; base += st) conf_sample_item(p, base + half);
        if (st == 384) {
          delta_sample_item(p, hb + half, hs);
          delta_sample_item(p, 384 + hb + half, hs);
          if (hb >= 128) delta_sample_item(p, 768 + (hb - 128) + half, hs);
        } else {
          for (int base = hb; base < 1024; base += st) delta_sample_item(p, base + half, hs);
        }
      }
    } else {
      for (int u = bid; u < 64; u += G) { d2_block(p, u, smem); __syncthreads(); }
      for (int base = bid * 2; base < 512; base += 2 * G) conf_prompt_item(p, base + half, hs);
      for (int base = bid * 2; base < 32; base += 2 * G) conf_sample_item(p, base + half);
      for (int base = bid * 2; base < 1024; base += 2 * G) delta_sample_item(p, base + half, hs);
    }
  }
  xcd_barrier(xb);

  PH(6) {
    auto f_z = [&](int row, int col, f32x4 a) {
      const float4 sq4 = *(const float4*)(ssq + ((size_t)row * 8 + (col >> 7)) * 4);
      const float rstd = rsqrtf((sq4.x + sq4.y + sq4.z + sq4.w) * (1.f / 128.f) + EPS);
      const float4 gw = *(const float4*)(p.gdn_norm_w + (col & 127));
      u16* op = obuf + (size_t)row * 1024 + col;
      const uint2 u = *(const uint2*)op;
      uint2 o;
      o.x = pk2(bf_lo(u.x) * rstd * gw.x * siluf_(a[0]), bf_hi(u.x) * rstd * gw.y * siluf_(a[1]));
      o.y = pk2(bf_lo(u.y) * rstd * gw.z * siluf_(a[2]), bf_hi(u.y) * rstd * gw.w * siluf_(a[3]));
      *(uint2*)op = o;
    };
    gemm_pass(hbuf, 1024, (const u16*)(p.ws + OFF_WZ), 1024, 1024, 1024, smem, f_z);
    for (int sb = bid; sb < 256; sb += G)
      skinny<1>(hbuf, 1024, RP, 128, (const u16*)(p.ws + OFF_WZ), 1024, 1024, [&](int j) { return sb * 4 + (j & 3); },
                [&](int row, int ntl, int q, f32x4 v, int ln) { if (q == 0) f_z(row, sb * 4, v); });
  }
  xcd_barrier(xb);

  PH(7) {
    auto f_ga = [&](int row, int col, f32x4 a) {
      uint2 o; o.x = pk2(sigmoidf_(a[0]), sigmoidf_(a[1])); o.y = pk2(sigmoidf_(a[2]), sigmoidf_(a[3]));
      *(uint2*)(merged + (size_t)row * 1024 + col) = o;
    };
    auto f_ya = [&](int row, int col, f32x4 a) {
      u16* mp = merged + (size_t)row * 1024 + col;
      const uint2 u = *(const uint2*)mp;
      uint2 o; o.x = pk2(bf_lo(u.x) * a[0], bf_hi(u.x) * a[1]); o.y = pk2(bf_lo(u.y) * a[2], bf_hi(u.y) * a[3]);
      *(uint2*)mp = o;
    };
    auto f_gb = [&](int row, int col, f32x4 a) {
      uint2 o; o.x = pk2(sigmoidf_(a[0]), sigmoidf_(a[1])); o.y = pk2(sigmoidf_(a[2]), sigmoidf_(a[3]));
      *(uint2*)(tmp2 + (size_t)row * 1024 + col) = o;
    };
    auto f_yb = [&](int row, int col, f32x4 a) {
      u16* mp = merged + (size_t)row * 1024 + col;
      const uint2 u = *(const uint2*)mp, s2 = *(const uint2*)(tmp2 + (size_t)row * 1024 + col);
      uint2 o; o.x = pk2(bf_lo(u.x) + bf_lo(s2.x) * a[0], bf_hi(u.x) + bf_hi(s2.x) * a[1]); o.y = pk2(bf_lo(u.y) + bf_lo(s2.y) * a[2], bf_hi(u.y) + bf_hi(s2.y) * a[3]);
      *(uint2*)mp = o;
    };
    auto cm4 = [&](int sb) { return [sb](int j) { return sb * 4 + (j & 3); }; };
    gemm_pass(hbuf, 1024, (const u16*)(p.ws + OFF_WGA), 1024, 1024, 1024, smem, f_ga);
    gemm_pass((const u16*)(p.ws + OFF_AACT), 512, (const u16*)(p.ws + OFF_WCONF), 512, 1024, 512, smem, f_ya);
    gemm_pass(hbuf, 1024, (const u16*)(p.ws + OFF_WGB), 1024, 1024, 1024, smem, f_gb);
    gemm_pass(obuf, 1024, (const u16*)(p.ws + OFF_WGDN), 1024, 1024, 1024, smem, f_yb);
    for (int sb = bid; sb < 256; sb += G) {
      skinny<1>(hbuf, 1024, RP, 128, (const u16*)(p.ws + OFF_WGA), 1024, 1024, cm4(sb), [&](int row, int ntl, int q, f32x4 v, int ln) { if (q == 0) f_ga(row, sb * 4, v); });
      skinny<1>((const u16*)(p.ws + OFF_AACT), 512, RP, 128, (const u16*)(p.ws + OFF_WCONF), 512, 512, cm4(sb), [&](int row, int ntl, int q, f32x4 v, int ln) { if (q == 0) f_ya(row, sb * 4, v); });
      skinny<1>(hbuf, 1024, RP, 128, (const u16*)(p.ws + OFF_WGB), 1024, 1024, cm4(sb), [&](int row, int ntl, int q, f32x4 v, int ln) { if (q == 0) f_gb(row, sb * 4, v); });
      skinny<1>(obuf, 1024, RP, 128, (const u16*)(p.ws + OFF_WGDN), 1024, 1024, cm4(sb), [&](int row, int ntl, int q, f32x4 v, int ln) { if (q == 0) f_yb(row, sb * 4, v); });
    }
  }
  xcd_barrier(xb);

  PH(8) {
    auto f_o = [&](int row, int col, f32x4 a) {
      const float* xr = row < RP ? p.x_prompt + (size_t)row * 1024 : p.x_sample + (size_t)(row - RP) * 1024;
      const float4 xv = *(const float4*)(xr + col), gv = *(const float4*)(mod + (size_t)mrow_of(row) * 6144 + 2048 + col);
      *(float4*)(p.out + (size_t)row * 1024 + col) = make_float4(xv.x + gv.x * a[0], xv.y + gv.y * a[1], xv.z + gv.z * a[2], xv.w + gv.w * a[3]);
    };
    gemm_pass(merged, 1024, (const u16*)(p.ws + OFF_WO), 1024, 1024, 1024, smem, f_o);
    for (int sb = bid; sb < 256; sb += G)
      skinny<1>(merged, 1024, RP, 128, (const u16*)(p.ws + OFF_WO), 1024, 1024, [&](int j) { return sb * 4 + (j & 3); },
                [&](int row, int ntl, int q, f32x4 v, int ln) { if (q == 0) f_o(row, sb * 4, v); });
  }
  xcd_barrier(xb);

  PH(9) phase_modnorm<false>(p, p.out, p.out + (size_t)RP * 1024, p.norm2_w, 3072, 4096, (u16*)(p.ws + OFF_H2), smem);
  xcd_barrier(xb);

  PH(10) {
    u16* f = (u16*)(p.ws + OFF_F);
    auto f_ff1 = [&](int row, int col, f32x4 a) {
      float v[4];
#pragma unroll
      for (int j = 0; j < 4; ++j) { const float t = fmaxf(a[j], 0.f); v[j] = t * t; }
      uint2 o; o.x = pk2(v[0], v[1]); o.y = pk2(v[2], v[3]);
      *(uint2*)(f + (size_t)row * LDF + col) = o;
    };
    gemm_pass((const u16*)(p.ws + OFF_H2), 1024, (const u16*)(p.ws + OFF_W1), 1024, 4096, 1024, smem, f_ff1);
    for (int sb = bid; sb < 256; sb += G)
      skinny<1>((const u16*)(p.ws + OFF_H2), 1024, RP, 128, (const u16*)(p.ws + OFF_W1), 1024, 1024, [&](int j) { return sb * 16 + j; },
                [&](int row, int ntl, int q, f32x4 v, int ln) { f_ff1(row, sb * 16 + 4 * q, v); });
  }
  xcd_barrier(xb);

  PH(11) {
    auto f_ff2 = [&](int row, int col, f32x4 a) {
      float* xp = p.out + (size_t)row * 1024 + col;
      const float4 xv = *(const float4*)xp, gv = *(const float4*)(mod + (size_t)mrow_of(row) * 6144 + 5120 + col);
      *(float4*)xp = make_float4(xv.x + gv.x * a[0], xv.y + gv.y * a[1], xv.z + gv.z * a[2], xv.w + gv.w * a[3]);
    };
    gemm_pass((const u16*)(p.ws + OFF_F), LDF, (const u16*)(p.ws + OFF_W2), LDF, 1024, 4096, smem, f_ff2);
    for (int sb = bid; sb < 256; sb += G)
      skinny<1>((const u16*)(p.ws + OFF_F), LDF, RP, 128, (const u16*)(p.ws + OFF_W2), LDF, 4096, [&](int j) { return sb * 4 + (j & 3); },
                [&](int row, int ntl, int q, f32x4 v, int ln) { if (q == 0) f_ff2(row, sb * 4, v); });
  }
  xcd_barrier(xb);

  PH(12) {
    const int gw = bid * 8 + wave, nw_ = G * 8;
    for (int row = gw; row < R; row += nw_) {
      float* xr = p.out + (size_t)row * 1024;
      float4 v[4]; float ss = 0.f;
#pragma unroll
      for (int i = 0; i < 4; ++i) { v[i] = *(const float4*)(xr + (lane + 64 * i) * 4); ss += v[i].x * v[i].x + v[i].y * v[i].y + v[i].z * v[i].z + v[i].w * v[i].w; }
      ss = wsum(ss);
      const float rstd = rsqrtf(ss * (1.f / 1024.f) + EPS);
#pragma unroll
      for (int i = 0; i < 4; ++i) {
        const int c = (lane + 64 * i) * 4;
        const float4 w = *(const float4*)(p.final_norm_w + c);
        *(float4*)(xr + c) = make_float4(v[i].x * rstd * w.x, v[i].y * rstd * w.y, v[i].z * rstd * w.z, v[i].w * rstd * w.w);
      }
    }
  }
}

extern "C" void kernel_launch(void* const* d_in, const int* in_sizes, int n_in, void* d_out, int out_size, void* d_ws, size_t ws_size,
                              hipStream_t stream) {
  static int grid_blocks = 0;
  if (!grid_blocks) {
    int dev = 0, cus = 0, per_cu = 0;
    hipGetDevice(&dev);
    hipDeviceGetAttribute(&cus, hipDeviceAttributeMultiprocessorCount, dev);
    hipOccupancyMaxActiveBlocksPerMultiprocessor(&per_cu, (const void*)fwd_megakernel, NT, 0);
    if (per_cu > 1) per_cu = 1;
    if (per_cu < 1) per_cu = 1;
    grid_blocks = cus * per_cu;
  }
  Params p{};
  const float** pp = (const float**)&p;
  for (int i = 0; i < 26; ++i) pp[i] = (const float*)d_in[i];
  p.out = (float*)d_out; p.ws = (char*)d_ws;
  if (ws_size < WS_NEED) { fprintf(stderr, "workspace too small: %zu < %zu\n", ws_size, (size_t)WS_NEED); return; }
  hipMemsetAsync(d_ws, 0, XCD_BAR_WORDS * 4, stream);
  void* args[] = {&p};
  hipError_t e = hipLaunchCooperativeKernel((const void*)fwd_megakernel, dim3(grid_blocks), dim3(NT), args, 0, stream);
  if (e != hipSuccess) fprintf(stderr, "cooperative launch failed: %s (grid %d)\n", hipGetErrorString(e), grid_blocks);
}
```

```cpp
#include <hip/hip_runtime.h>
#include <stdint.h>
#include <cstdio>

#define DI __device__ __forceinline__
typedef unsigned short u16;
typedef __bf16 bf2_t __attribute__((ext_vector_type(2)));
typedef float f2_t __attribute__((ext_vector_type(2)));
using bf16x8 = __attribute__((ext_vector_type(8))) short;
using f32x16 = __attribute__((ext_vector_type(16))) float;
using f32x4 = __attribute__((ext_vector_type(4))) float;
using u32x4 = __attribute__((ext_vector_type(4))) unsigned;
#define MFMA(a, b, c) __builtin_amdgcn_mfma_f32_32x32x16_bf16((a), (b), (c), 0, 0, 0)

constexpr int R = 16512, RP = 16384, D = 1024, DC = 512, QKV = 3072, NIN = 4096, DFF = 4096;
constexpr float EPS = 1e-6f;
constexpr int LDF = 4160;
constexpr float QSCALE = 0.08838834764831845f;

constexpr size_t OFF_BAR   = 0;
constexpr size_t OFF_MOD   = 16384;
constexpr size_t OFF_GB    = OFF_MOD + 3342336;
constexpr size_t OFF_EGL   = OFF_GB + 1056768;
constexpr size_t OFF_SSQ   = OFF_EGL + 8192;
constexpr size_t OFF_WIN   = OFF_SSQ + 2113536;
constexpr size_t OFF_WZ    = OFF_WIN + 8650752;
constexpr size_t OFF_WGA   = OFF_WZ + 2097152;
constexpr size_t OFF_WGB   = OFF_WGA + 2097152;
constexpr size_t OFF_WCONF = OFF_WGB + 2097152;
constexpr size_t OFF_WGDN  = OFF_WCONF + 1048576;
constexpr size_t OFF_WO    = OFF_WGDN + 2097152;
constexpr size_t OFF_W1    = OFF_WO + 2097152;
constexpr size_t OFF_W2    = OFF_W1 + 8388608;
constexpr size_t OFF_GLU   = OFF_W2 + 8650752;
constexpr size_t OFF_AACT  = OFF_GLU + 16908288;
constexpr size_t OFF_QKV   = OFF_AACT + 16908288;
constexpr size_t OFF_HALO  = OFF_QKV + 101449728;
constexpr size_t OFF_EXTRA = OFF_HALO + 4718592;
constexpr size_t OFF_WADA  = OFF_EXTRA;
constexpr size_t OFF_AC    = OFF_EXTRA + 12582912;
constexpr size_t OFF_MERGED= OFF_EXTRA;
constexpr size_t OFF_H2    = OFF_GLU;
constexpr size_t OFF_F     = OFF_QKV;
constexpr size_t OFF_TMP2  = OFF_QKV;
constexpr size_t WS_NEED   = OFF_EXTRA + 50331648;
constexpr size_t OUT_Y = 0, OUT_CONFP = 16908288, OUT_QKVP = 17031168, OUT_DELTAP = 17104896,
                 OUT_CONFS = 18153472, OUT_QKVS = 20119552, OUT_DELTAS = 21299200;

constexpr int HALF_SMEM = 73728;
constexpr int SMEM_BYTES = 2 * HALF_SMEM + 1024;
constexpr int NT = 512;
#ifndef PHASE_MASK
#define PHASE_MASK 0xFFFF
#endif
#define PH(k) if constexpr ((PHASE_MASK >> (k)) & 1)

struct Params {
  const float *x_prompt, *x_sample, *c_prompt, *c_sample, *st_conf, *st_qkv, *st_delta;
  const float *w_ada, *b_ada, *norm1_w, *w_in, *conf_dw_w, *conf_dw_b, *conf_ln_w, *conf_ln_b, *w_conf_out,
              *gdn_conv_w, *a_log, *dt_bias, *gdn_norm_w, *w_gdn_out, *w_o, *norm2_w, *w_ff1, *w_ff2, *final_norm_w;
  float* out; char* ws;
};

DI unsigned pk2(float a, float b) { f2_t v = {a, b}; bf2_t r = __builtin_convertvector(v, bf2_t); return __builtin_bit_cast(unsigned, r); }
DI float bf_lo(unsigned u) { return __uint_as_float(u << 16); }
DI float bf_hi(unsigned u) { return __uint_as_float(u & 0xffff0000u); }
DI float bf1(u16 u) { return __uint_as_float(((unsigned)u) << 16); }
DI u16 f2bf(float a) { return (u16)(pk2(a, 0.f) & 0xffffu); }
DI float sigmoidf_(float x) { return __builtin_amdgcn_rcpf(1.f + __expf(-x)); }
DI float siluf_(float x) { return x * __builtin_amdgcn_rcpf(1.f + __expf(-x)); }
DI float softplusf_(float x) { return fmaxf(x, 0.f) + log1pf(__expf(-fabsf(x))); }
DI float wsum(float v) {
#pragma unroll
  for (int m = 32; m >= 1; m >>= 1) v += __shfl_xor(v, m, 64);
  return v;
}
DI int crow(int reg, int hh) { return (reg & 3) + 8 * (reg >> 2) + 4 * hh; }
DI int mrow_of(int r) { return r < RP ? (r >> 11) : (8 + r - RP); }
DI bf16x8 pack8(const f32x16& x, int s) {
  uint4 p;
  p.x = pk2(x[8 * s + 0], x[8 * s + 1]); p.y = pk2(x[8 * s + 2], x[8 * s + 3]);
  p.z = pk2(x[8 * s + 4], x[8 * s + 5]); p.w = pk2(x[8 * s + 6], x[8 * s + 7]);
  return __builtin_bit_cast(bf16x8, p);
}
DI f32x16 zero16() { f32x16 z; for (int i = 0; i < 16; ++i) z[i] = 0.f; return z; }

#define XB_TMO      128
#define XB_XCNT(j)  (256  + 64 * (j))
#define XB_XSUB(j)  (1280 + 64 * (j))
#define XB_XGEN(j)  (2304 + 64 * (j))
#define XB_TOP      3328
#define XB_TOPGEN   3392
#define XCD_BAR_WORDS 3456
#define XB_SPIN_CAP (1u << 24)
#define LAS __attribute__((address_space(3)))
DI unsigned xb_ld(unsigned* p) { return __hip_atomic_load(p, __ATOMIC_RELAXED, __HIP_MEMORY_SCOPE_AGENT); }
DI unsigned xb_add(unsigned* p, unsigned v) { return __hip_atomic_fetch_add(p, v, __ATOMIC_RELAXED, __HIP_MEMORY_SCOPE_AGENT); }
DI unsigned xb_xcc_id() { return (unsigned)__builtin_amdgcn_s_getreg((3 << 11) | 20) & 0xFu; }
#define XB_SPIN(cond, bar) do { unsigned _sp = 0; while (cond) { __builtin_amdgcn_s_sleep(1); \
    if ((++_sp & 255u) == 0u) { if (xb_ld(&(bar)[XB_TMO])) break; if (_sp > XB_SPIN_CAP) { atomicAdd(&(bar)[XB_TMO], 1u); break; } } } } while (0)
struct XcdBarrier { unsigned* bar; unsigned x; volatile LAS unsigned* st; };
DI XcdBarrier xcd_barrier_post(unsigned* bar, volatile LAS unsigned* st) {
  XcdBarrier b; b.bar = bar; b.x = xb_xcc_id(); b.st = st;
  if (threadIdx.x == 0) (void)xb_add(&bar[XB_XCNT(b.x)], 1u);
  return b;
}
DI void xcd_barrier_complete(unsigned* bar, unsigned x, unsigned& nloc, unsigned& nx) {
  const unsigned G = gridDim.x * gridDim.y * gridDim.z;
  unsigned sum, cnt, mine, sp = 0u;
  for (;;) {
    sum = 0u; cnt = 0u; mine = 0u;
#pragma unroll
    for (unsigned j = 0; j < 16; ++j) { const unsigned c = xb_ld(&bar[XB_XCNT(j)]); sum += c; cnt += (c > 0u) ? 1u : 0u; mine = (j == x) ? c : mine; }
    if (sum == G) break;
    __builtin_amdgcn_s_sleep(1);
    if ((++sp & 255u) == 0u) { if (xb_ld(&bar[XB_TMO])) break; if (sp > XB_SPIN_CAP) { atomicAdd(&bar[XB_TMO], 1u); break; } }
  }
  nloc = mine > 0u ? mine : 1u; nx = cnt > 0u ? cnt : 1u;
}
DI void xcd_barrier(const XcdBarrier& b) {
  asm volatile("s_waitcnt vmcnt(0)" ::: "memory");
  __syncthreads();
  if (threadIdx.x == 0) {
    unsigned* bar = b.bar;
    __builtin_amdgcn_s_waitcnt(0);
    unsigned nloc = b.st[0], nx = b.st[1];
    if (nloc == 0u) { xcd_barrier_complete(bar, b.x, nloc, nx); b.st[0] = nloc; b.st[1] = nx; }
    const unsigned old = xb_add(&bar[XB_XSUB(b.x)], 1u);
    const unsigned gen = old / nloc;
    if (old + 1u == (gen + 1u) * nloc) {
      __builtin_amdgcn_fence(__ATOMIC_RELEASE, "agent");
      asm volatile("s_waitcnt vmcnt(0)" ::: "memory");
      const unsigned og = xb_add(&bar[XB_TOP], 1u);
      const unsigned tg = og / nx;
      if (og + 1u == (tg + 1u) * nx) xb_add(&bar[XB_TOPGEN], 1u);
      else XB_SPIN(xb_ld(&bar[XB_TOPGEN]) == tg, bar);
      __builtin_amdgcn_fence(__ATOMIC_ACQUIRE, "agent");
      xb_add(&bar[XB_XGEN(b.x)], 1u);
      asm volatile("s_waitcnt vmcnt(0)" ::: "memory");
    } else {
      XB_SPIN(xb_ld(&bar[XB_XGEN(b.x)]) == gen, bar);
      __builtin_amdgcn_fence(__ATOMIC_ACQUIRE, "agent");
      asm volatile("s_waitcnt vmcnt(0)" ::: "memory");
    }
  }
  __syncthreads();
}

constexpr int HTB = 128 * 64 * 2;
DI int lds_byte(int r, int c) { const int st = (r >> 4) * 2 + (c >> 5), rr = r & 15, cc = c & 31, ob = rr * 64 + cc * 2; return st * 1024 + (ob ^ (((ob >> 9) & 1) << 5)); }
DI void stage_rc(int b, int& Rr, int& Cc) { const int st = b / 1024, sb = b % 1024, swz = sb ^ (((sb >> 9) & 1) << 5); Rr = (st >> 1) * 16 + swz / 64; Cc = (st & 1) * 32 + (swz % 64) / 2; }
DI void gemm256(f32x4 (&acc)[2][2][4][2], const u16* __restrict__ A, const int lda, const u16* __restrict__ Bt, const int ldb,
                const int brow, const int bcol, const int K, char* shm) {
#define SA(b, h) (shm + ((b) * 2 + (h)) * HTB)
#define SB(b, h) (shm + (4 + (b) * 2 + (h)) * HTB)
#define STAGE_A(P, br, kt) do { const char* _u = (const char*)A + ((size_t)(br) * lda + (size_t)(kt) * 64) * 2; \
    __builtin_amdgcn_global_load_lds((const unsigned*)(_u + voA0), (unsigned*)((char*)(P) + sb0), 16, 0, 0); \
    __builtin_amdgcn_global_load_lds((const unsigned*)(_u + voA1), (unsigned*)((char*)(P) + sb1), 16, 0, 0); } while (0)
#define STAGE_B(P, br, kt) do { const char* _u = (const char*)Bt + ((size_t)(br) * ldb + (size_t)(kt) * 64) * 2; \
    __builtin_amdgcn_global_load_lds((const unsigned*)(_u + voB0), (unsigned*)((char*)(P) + sb0), 16, 0, 0); \
    __builtin_amdgcn_global_load_lds((const unsigned*)(_u + voB1), (unsigned*)((char*)(P) + sb1), 16, 0, 0); } while (0)
#define LDA(dst, b, h) _Pragma("unroll") for (int m = 0; m < 4; ++m) _Pragma("unroll") for (int k = 0; k < 2; ++k) \
    dst[m][k] = *reinterpret_cast<const bf16x8*>((char*)SA(b, h) + lds_byte(wr * 64 + m * 16 + fr, k * 32 + fq * 8))
#define LDB(dst, b, h) _Pragma("unroll") for (int n = 0; n < 2; ++n) _Pragma("unroll") for (int k = 0; k < 2; ++k) \
    dst[n][k] = *reinterpret_cast<const bf16x8*>((char*)SB(b, h) + lds_byte(wc * 32 + n * 16 + fr, k * 32 + fq * 8))
#define MMA(ai, bj, At_, Bt_) do { __builtin_amdgcn_s_setprio(1); \
    _Pragma("unroll") for (int m = 0; m < 4; ++m) _Pragma("unroll") for (int n = 0; n < 2; ++n) _Pragma("unroll") for (int k = 0; k < 2; ++k) \
      acc[ai][bj][m][n] = __builtin_amdgcn_mfma_f32_16x16x32_bf16(Bt_[n][k], At_[m][k], acc[ai][bj][m][n], 0, 0, 0); \
    __builtin_amdgcn_s_setprio(0); } while (0)
#define WAIT_V(n) asm volatile("s_waitcnt vmcnt(" #n ")" ::: "memory")
#define WAIT_L(n) asm volatile("s_waitcnt lgkmcnt(" #n ")" ::: "memory")
#define BAR __builtin_amdgcn_s_barrier()
#define SCHED __builtin_amdgcn_sched_barrier(0)
  int t_ = threadIdx.x;
  asm volatile("" : "+v"(t_));
  const int wid = __builtin_amdgcn_readfirstlane(t_ >> 6), lane = t_ & 63, wr = wid >> 2, wc = wid & 3, fr = lane & 15, fq = lane >> 4;
  const int sb0 = t_ * 16, sb1 = sb0 + 8192;
  int sr0, sc0, sr1, sc1; stage_rc(sb0, sr0, sc0); stage_rc(sb1, sr1, sc1);
  const unsigned voA0 = (unsigned)(sr0 * lda + sc0) * 2u, voA1 = (unsigned)(sr1 * lda + sc1) * 2u;
  const unsigned voB0 = (unsigned)(sr0 * ldb + sc0) * 2u, voB1 = (unsigned)(sr1 * ldb + sc1) * 2u;
  bf16x8 At[4][2], B0[2][2], B1[2][2];
  const int nt = K / 64;
  STAGE_B(SB(0, 0), bcol, 0); STAGE_A(SA(0, 0), brow, 0);
  STAGE_B(SB(0, 1), bcol + 128, 0); STAGE_A(SA(0, 1), brow + 128, 0);
  if (wr == 1) BAR;
  WAIT_V(4); BAR;
  STAGE_B(SB(1, 0), bcol, 1); STAGE_A(SA(1, 0), brow, 1); STAGE_B(SB(1, 1), bcol + 128, 1);
  WAIT_V(6); BAR;
  for (int t = 0; t < nt - 2; t += 2) {
    LDB(B0, 0, 0); SCHED; LDA(At, 0, 0); STAGE_A(SA(1, 1), brow + 128, t + 1);
    WAIT_L(8); BAR; WAIT_L(0); MMA(0, 0, At, B0); BAR; SCHED;
    LDB(B1, 0, 1); STAGE_B(SB(0, 0), bcol, t + 2);
    BAR; WAIT_L(0); MMA(0, 1, At, B1); BAR;
    LDA(At, 0, 1); STAGE_A(SA(0, 0), brow, t + 2);
    BAR; WAIT_L(0); MMA(1, 0, At, B0); BAR; SCHED;
    STAGE_B(SB(0, 1), bcol + 128, t + 2);
    WAIT_V(6); BAR; MMA(1, 1, At, B1); BAR;
    LDB(B0, 1, 0); SCHED; LDA(At, 1, 0); STAGE_A(SA(0, 1), brow + 128, t + 2);
    WAIT_L(8); BAR; WAIT_L(0); MMA(0, 0, At, B0); BAR; SCHED;
    LDB(B1, 1, 1); STAGE_B(SB(1, 0), bcol, t + 3);
    BAR; WAIT_L(0); MMA(0, 1, At, B1); BAR;
    LDA(At, 1, 1); STAGE_A(SA(1, 0), brow, t + 3);
    BAR; WAIT_L(0); MMA(1, 0, At, B0); BAR; SCHED;
    STAGE_B(SB(1, 1), bcol + 128, t + 3);
    WAIT_V(6); BAR; MMA(1, 1, At, B1); BAR;
  }
  { LDB(B0, 0, 0); LDA(At, 0, 0); STAGE_A(SA(1, 1), brow + 128, nt - 1);
    BAR; WAIT_L(0); MMA(0, 0, At, B0); BAR;
    LDB(B1, 0, 1); BAR; WAIT_L(0); MMA(0, 1, At, B1); BAR;
    LDA(At, 0, 1); WAIT_V(4); BAR; WAIT_L(0); MMA(1, 0, At, B0); MMA(1, 1, At, B1); BAR; }
  { LDB(B0, 1, 0); LDA(At, 1, 0); WAIT_V(2); BAR; WAIT_L(0); MMA(0, 0, At, B0); BAR;
    LDB(B1, 1, 1); WAIT_V(0); BAR; WAIT_L(0); MMA(0, 1, At, B1); BAR;
    LDA(At, 1, 1); BAR; WAIT_L(0); MMA(1, 0, At, B0); MMA(1, 1, At, B1); BAR; }
  if (wr == 0) BAR;
#undef SA
#undef SB
#undef STAGE_A
#undef STAGE_B
#undef LDA
#undef LDB
#undef MMA
}
DI void zero_acc(f32x4 (&acc)[2][2][4][2]) {
#pragma unroll
  for (int a = 0; a < 2; ++a)
#pragma unroll
    for (int b = 0; b < 2; ++b)
#pragma unroll
      for (int m = 0; m < 4; ++m)
#pragma unroll
        for (int n = 0; n < 2; ++n) acc[a][b][m][n] = (f32x4){0.f, 0.f, 0.f, 0.f};
}
template <class F> DI void tile_apply(const f32x4 (&acc)[2][2][4][2], int brow, int bcol, F f) {
  int t_ = threadIdx.x;
  asm volatile("" : "+v"(t_));
  const int wid = t_ >> 6, lane = t_ & 63, wr = wid >> 2, wc = wid & 3, fr = lane & 15, fq = lane >> 4;
#pragma unroll
  for (int ai = 0; ai < 2; ++ai)
#pragma unroll
    for (int m = 0; m < 4; ++m) {
      const int row = brow + ai * 128 + wr * 64 + m * 16 + fr;
#pragma unroll
      for (int bj = 0; bj < 2; ++bj)
#pragma unroll
        for (int n = 0; n < 2; ++n) f(row, bcol + bj * 128 + wc * 32 + n * 16 + 4 * fq, acc[ai][bj][m][n]);
      __builtin_amdgcn_sched_barrier(0);
    }
}
constexpr int TLD = 132;
template <class F> DI void tile_epilogue(const f32x4 (&acc)[2][2][4][2], int brow, int bcol, char* shm, F f) {
  int t_ = threadIdx.x;
  asm volatile("" : "+v"(t_));
  const int wid = t_ >> 6, lane = t_ & 63, wr = wid >> 2, wc = wid & 3, fr = lane & 15, fq = lane >> 4;
  float* T = (float*)shm;
#pragma unroll
  for (int bj = 0; bj < 2; ++bj) {
#pragma unroll
    for (int ai = 0; ai < 2; ++ai)
#pragma unroll
      for (int m = 0; m < 4; ++m)
#pragma unroll
        for (int n = 0; n < 2; ++n)
          *(f32x4*)(T + (ai * 128 + wr * 64 + m * 16 + fr) * TLD + wc * 32 + n * 16 + 4 * fq) = acc[ai][bj][m][n];
    __syncthreads();
    const int cg = (t_ & 31) * 4, r0 = t_ >> 5;
#pragma unroll 4
    for (int i = 0; i < 16; ++i) {
      const int rl = r0 + 16 * i;
      const f32x4 v = *(const f32x4*)(T + rl * TLD + cg);
      f(brow + rl, bcol + bj * 128 + cg, v);
    }
    __syncthreads();
  }
}
template <class F> DI void gemm_pass(const u16* A, int lda, const u16* Bt, int ldb, int N, int K, char* shm, F f) {
  const int nN = N >> 8, nunits = 64 * nN;
  for (int u = blockIdx.x; u < nunits; u += gridDim.x) {
    const int pm = u % 64, pn = u / 64;
    f32x4 acc[2][2][4][2];
    zero_acc(acc);
    gemm256(acc, A, lda, Bt, ldb, pm * 256, pn * 256, K, shm);
    tile_epilogue(acc, pm * 256, pn * 256, shm, f);
  }
}
template <int NTL, class CM, class E> DI void skinny(const u16* __restrict__ A, int lda, int row0, int nrows, const u16* __restrict__ Bt, int ldb, int K, CM cm, E epi) {
  int t_ = threadIdx.x;
  asm volatile("" : "+v"(t_));
  const int wid = t_ >> 6, lane = t_ & 63, fr = lane & 15, fq = lane >> 4;
  for (int mt = wid; mt * 16 < nrows; mt += 8) {
    int rr = mt * 16 + fr; const bool valid = rr < nrows; if (!valid) rr = nrows - 1;
    const u16* ap = A + (size_t)(row0 + rr) * lda + 8 * fq;
#pragma unroll
    for (int ntl = 0; ntl < NTL; ++ntl) {
      const u16* bp = Bt + (size_t)cm(ntl * 16 + fr) * ldb + 8 * fq;
      f32x4 acc = {0.f, 0.f, 0.f, 0.f};
#pragma unroll 16
      for (int ks = 0; ks < (K >> 5); ++ks) {
        const bf16x8 a = *(const bf16x8*)(ap + ks * 32);
        const bf16x8 b = *(const bf16x8*)(bp + ks * 32);
        acc = __builtin_amdgcn_mfma_f32_16x16x32_bf16(b, a, acc, 0, 0, 0);
      }
      if (valid) epi(row0 + rr, ntl, fq, acc, lane);
    }
  }
}
DI int map_in(int n) {
  if (n < 1024) { const int pn = n >> 8, c = n & 255; return c < 128 ? (pn * 128 + c) : (512 + pn * 128 + c - 128); }
  return n;
}
DI void phase_convert(const Params& p, char* smem) {
  float* tile = (float*)smem;
  const int tid = threadIdx.x;
  constexpr int NJ = 10;
  constexpr int pre[NJ + 1] = {0, 1024, 1280, 1536, 1792, 1920, 2176, 2432, 3456, 4480, 6016};
  for (int t = blockIdx.x; t < 6016; t += gridDim.x) {
    int j = 0, base = 0;
#pragma unroll
    for (int q = 1; q < NJ; ++q) if (t >= pre[q]) { j = q; base = pre[q]; }
    const int lt = t - base;
    const float* src; int ld, K; u16* dst; int moff = 0; int ldd = 0;
    switch (j) {
      case 0: src = p.w_in; ld = 7184; K = 1024; dst = (u16*)(p.ws + OFF_WIN); break;
      case 1: src = p.w_in; ld = 7184; K = 1024; dst = (u16*)(p.ws + OFF_WZ); moff = 4096; break;
      case 2: src = p.w_in; ld = 7184; K = 1024; dst = (u16*)(p.ws + OFF_WGA); moff = 5136; break;
      case 3: src = p.w_in; ld = 7184; K = 1024; dst = (u16*)(p.ws + OFF_WGB); moff = 6160; break;
      case 4: src = p.w_conf_out; ld = 1024; K = 512; dst = (u16*)(p.ws + OFF_WCONF); break;
      case 5: src = p.w_gdn_out; ld = 1024; K = 1024; dst = (u16*)(p.ws + OFF_WGDN); break;
      case 6: src = p.w_o; ld = 1024; K = 1024; dst = (u16*)(p.ws + OFF_WO); break;
      case 7: src = p.w_ff1; ld = 4096; K = 1024; dst = (u16*)(p.ws + OFF_W1); break;
      case 8: src = p.w_ff2; ld = 1024; K = 4096; dst = (u16*)(p.ws + OFF_W2); ldd = LDF; break;
      default: src = p.w_ada; ld = 6144; K = 1024; dst = (u16*)(p.ws + OFF_WADA); break;
    }
    const int nkt = K >> 6;
    const int n0 = (lt / nkt) * 64, k0 = (lt % nkt) * 64;
    {
      const int nn = tid & 63, ty = tid >> 6;
      const int sc = (j == 0) ? map_in(n0 + nn) : (n0 + nn + moff);
#pragma unroll
      for (int i = 0; i < 8; ++i) {
        const int kk = ty + 8 * i;
        tile[kk * 65 + nn] = src[(size_t)(k0 + kk) * ld + sc];
      }
    }
    __syncthreads();
    {
      const int nn = tid >> 3, kq = (tid & 7) * 8;
      uint4 o0;
      const float* tp = tile + kq * 65 + nn;
      o0.x = pk2(tp[0 * 65], tp[1 * 65]);  o0.y = pk2(tp[2 * 65], tp[3 * 65]);
      o0.z = pk2(tp[4 * 65], tp[5 * 65]);  o0.w = pk2(tp[6 * 65], tp[7 * 65]);
      *(uint4*)(dst + (size_t)(n0 + nn) * (ldd ? ldd : K) + k0 + kq) = o0;
    }
    __syncthreads();
  }
  u16* Ac = (u16*)(p.ws + OFF_AC);
  for (int e = blockIdx.x * NT + tid; e < 256 * 256; e += gridDim.x * NT) {
    const int row = e >> 8, c4 = (e & 255) * 4;
    float4 v = make_float4(0.f, 0.f, 0.f, 0.f);
    if (row < 8) v = *(const float4*)(p.c_prompt + row * 1024 + c4);
    else if (row < 136) v = *(const float4*)(p.c_sample + (row - 8) * 1024 + c4);
    uint2 o; o.x = pk2(siluf_(v.x), siluf_(v.y)); o.y = pk2(siluf_(v.z), siluf_(v.w));
    *(uint2*)(Ac + row * 1024 + c4) = o;
  }
}

constexpr int WBA_LD = 1028;
template <bool BA> DI void phase_modnorm(const Params& p, const float* xa, const float* xb, const float* nw, int shift_off, int scale_off, u16* dst, char* smem) {
  const int lane = threadIdx.x & 63;
  const int gw = blockIdx.x * 8 + (threadIdx.x >> 6), nw_ = gridDim.x * 8;
  const float* mod = (const float*)(p.ws + OFF_MOD);
  float* wba = (float*)smem;
  if (BA) {
    for (int e = threadIdx.x; e < 16384; e += NT) { const int c = e >> 4, j = e & 15; wba[j * WBA_LD + c] = p.w_in[(size_t)c * 7184 + 5120 + j]; }
    __syncthreads();
  }
  float* gb = (float*)(p.ws + OFF_GB);
  for (int row = gw; row < R; row += nw_) {
    const float* xr = row < RP ? xa + (size_t)row * 1024 : xb + (size_t)(row - RP) * 1024;
    float4 v[4]; float ss = 0.f;
#pragma unroll
    for (int i = 0; i < 4; ++i) { v[i] = *(const float4*)(xr + (lane + 64 * i) * 4); ss += v[i].x * v[i].x + v[i].y * v[i].y + v[i].z * v[i].z + v[i].w * v[i].w; }
    ss = wsum(ss);
    const float rstd = rsqrtf(ss * (1.f / 1024.f) + EPS);
    const float* mr = mod + (size_t)mrow_of(row) * 6144;
    float ba[16];
    if (BA) {
#pragma unroll
      for (int j = 0; j < 16; ++j) ba[j] = 0.f;
    }
#pragma unroll
    for (int i = 0; i < 4; ++i) {
      const int c = (lane + 64 * i) * 4;
      const float4 w = *(const float4*)(nw + c), sc = *(const float4*)(mr + scale_off + c), sh = *(const float4*)(mr + shift_off + c);
      const float h0 = v[i].x * rstd * w.x * (1.f + sc.x) + sh.x, h1 = v[i].y * rstd * w.y * (1.f + sc.y) + sh.y;
      const float h2 = v[i].z * rstd * w.z * (1.f + sc.z) + sh.z, h3 = v[i].w * rstd * w.w * (1.f + sc.w) + sh.w;
      uint2 o; o.x = pk2(h0, h1); o.y = pk2(h2, h3);
      *(uint2*)(dst + (size_t)row * 1024 + c) = o;
      if (BA) {
#pragma unroll
        for (int j = 0; j < 16; ++j) { const float4 ww = *(const float4*)(wba + j * WBA_LD + c); ba[j] += h0 * ww.x + h1 * ww.y + h2 * ww.z + h3 * ww.w; }
        __builtin_amdgcn_sched_barrier(0);
      }
    }
    if (BA) {
#pragma unroll
      for (int w = 8; w >= 1; w >>= 1) {
        const bool up = (lane & w) != 0;
#pragma unroll
        for (int j = 0; j < w; ++j) {
          const float keep = up ? ba[j + w] : ba[j];
          const float send = up ? ba[j] : ba[j + w];
          ba[j] = keep + __shfl_xor(send, w, 64);
        }
      }
      float tot = ba[0];
      tot += __shfl_xor(tot, 16, 64); tot += __shfl_xor(tot, 32, 64);
      if (lane < 8) gb[(size_t)row * 16 + lane] = sigmoidf_(tot);
      else if (lane < 16) gb[(size_t)row * 16 + lane] = -__expf(p.a_log[lane - 8]) * softplusf_(tot + p.dt_bias[lane - 8]);
    }
  }
  if (BA) __syncthreads();
}

constexpr int LKN = 136, LKT = 72;
DI void d1_item(const Params& p, int item, char* smem) {
  int tid = threadIdx.x & 255;
  asm volatile("" : "+v"(tid));
  const int lane = tid & 63, wave = __builtin_amdgcn_readfirstlane(tid >> 6);
  const int r = lane & 31, hh = lane >> 5;
  const int h = item & 7, n = (item >> 3) & 31, b = item >> 8;
  const int rowbase = b * 2048 + n * 64;
  u16* kn  = (u16*)smem;
  u16* qn  = (u16*)(smem + 17408);
  u16* knT = (u16*)(smem + 34816);
  u16* vT  = (u16*)(smem + 53248);
  float* Gs = (float*)(smem + 71680);
  float* Bs = Gs + 64;
  float* Amat = (float*)(smem + 17408);
  u16* Tb = (u16*)smem;
  u16* Tg = (u16*)(smem + 17408);
  u16* qkv = (u16*)(p.ws + OFF_QKV);
  const u16* halo = (const u16*)(p.ws + OFF_HALO);
  const float* gb = (const float*)(p.ws + OFF_GB);

  if (wave == 0) {
    float g = gb[(size_t)(rowbase + lane) * 16 + 8 + h];
    const float be = gb[(size_t)(rowbase + lane) * 16 + h];
#pragma unroll
    for (int m = 1; m < 64; m <<= 1) { float t = __shfl_up(g, m, 64); if (lane >= m) g += t; }
    Gs[lane] = g; Bs[lane] = be;
  }
  {
    const int cp = lane;
#pragma unroll
    for (int X = 0; X < 3; ++X) {
      const int cb = X * 1024 + h * 128 + 2 * cp;
      float w[4][2];
#pragma unroll
      for (int j = 0; j < 4; ++j) { float2 t = *(const float2*)(p.gdn_conv_w + j * 3072 + cb); w[j][0] = t.x; w[j][1] = t.y; }
      float xw[3][2];
#pragma unroll
      for (int j = 0; j < 3; ++j) {
        const int rr = wave * 16 - 3 + j;
        unsigned u = 0u;
        if (rr >= 0) u = *(const unsigned*)(qkv + (size_t)(rowbase + rr) * 3072 + cb);
        else if (n > 0) u = *(const unsigned*)(halo + ((size_t)((b * 32 + n - 1) * 3 + (rr + 3))) * 3072 + cb);
        xw[j][0] = bf_lo(u); xw[j][1] = bf_hi(u);
      }
      float o[16][2];
#pragma unroll
      for (int t = 0; t < 16; ++t) {
        const unsigned u = *(const unsigned*)(qkv + (size_t)(rowbase + wave * 16 + t) * 3072 + cb);
        const float x0 = bf_lo(u), x1 = bf_hi(u);
        const float a0 = w[0][0] * xw[0][0] + w[1][0] * xw[1][0] + w[2][0] * xw[2][0] + w[3][0] * x0;
        const float a1 = w[0][1] * xw[0][1] + w[1][1] * xw[1][1] + w[2][1] * xw[2][1] + w[3][1] * x1;
        o[t][0] = siluf_(a0); o[t][1] = siluf_(a1);
        xw[0][0] = xw[1][0]; xw[0][1] = xw[1][1]; xw[1][0] = xw[2][0]; xw[1][1] = xw[2][1]; xw[2][0] = x0; xw[2][1] = x1;
      }
      if (X < 2) {
#pragma unroll
        for (int t = 0; t < 16; ++t) {
          const float ss = wsum(o[t][0] * o[t][0] + o[t][1] * o[t][1]);
          const float rs = rsqrtf(ss + EPS);
          o[t][0] *= rs; o[t][1] *= rs;
        }
      }
#pragma unroll
      for (int t = 0; t < 16; ++t) {
        const int row = wave * 16 + t;
        const unsigned pk = pk2(o[t][0], o[t][1]);
        if (X == 0) { *(unsigned*)(qn + row * LKN + 2 * cp) = pk; }
        else if (X == 1) {
          *(unsigned*)(kn + row * LKN + 2 * cp) = pk;
          knT[(2 * cp) * LKT + row] = (u16)(pk & 0xffffu); knT[(2 * cp + 1) * LKT + row] = (u16)(pk >> 16);
        } else {
          vT[(2 * cp) * LKT + row] = (u16)(pk & 0xffffu); vT[(2 * cp + 1) * LKT + row] = (u16)(pk >> 16);
        }
      }
    }
  }
  __syncthreads();
  const float Glast = Gs[63];
#pragma unroll
  for (int ff = 0; ff < 4; ++ff) {
    const int f = wave * 4 + ff;
    const int it = f >> 3, kb = (f >> 1) & 3, s = f & 1;
    const int i = it * 32 + r;
    const float sc = QSCALE * __expf(Gs[i]);
    const uint2 a = *(const uint2*)(qn + i * LKN + kb * 32 + 16 * s + 4 * hh);
    const uint2 c = *(const uint2*)(qn + i * LKN + kb * 32 + 16 * s + 4 * hh + 8);
    uint4 o;
    o.x = pk2(bf_lo(a.x) * sc, bf_hi(a.x) * sc); o.y = pk2(bf_lo(a.y) * sc, bf_hi(a.y) * sc);
    o.z = pk2(bf_lo(c.x) * sc, bf_hi(c.x) * sc); o.w = pk2(bf_lo(c.y) * sc, bf_hi(c.y) * sc);
    *(uint4*)((char*)qkv + (size_t)(rowbase + 4 * f + (lane >> 4)) * 6144 + h * 256 + (lane & 15) * 16) = o;
  }
  char* ext = p.ws + OFF_EXTRA + (size_t)item * 24576;
#pragma unroll
  for (int ff = 0; ff < 4; ++ff) {
    const int f = wave * 4 + ff;
    const int kt = f >> 2, pb = (f >> 1) & 1, s = f & 1;
    const int k = kt * 32 + r;
    const int p0 = pb * 32 + 16 * s + 4 * hh;
    const uint2 a = *(const uint2*)(knT + k * LKT + p0);
    const uint2 c = *(const uint2*)(knT + k * LKT + p0 + 8);
    const float4 g0 = *(const float4*)(Gs + p0), g1 = *(const float4*)(Gs + p0 + 8);
    uint4 o;
    o.x = pk2(bf_lo(a.x) * __expf(Glast - g0.x), bf_hi(a.x) * __expf(Glast - g0.y));
    o.y = pk2(bf_lo(a.y) * __expf(Glast - g0.z), bf_hi(a.y) * __expf(Glast - g0.w));
    o.z = pk2(bf_lo(c.x) * __expf(Glast - g1.x), bf_hi(c.x) * __expf(Glast - g1.y));
    o.w = pk2(bf_lo(c.y) * __expf(Glast - g1.z), bf_hi(c.y) * __expf(Glast - g1.w));
    *(uint4*)(ext + f * 1024 + lane * 16) = o;
  }
  f32x16 akk = zero16(), aqk = zero16();
  const int ta = (wave == 0) ? 0 : 1, tb = (wave == 2) ? 1 : 0;
  if (wave < 3) {
#pragma unroll
    for (int ks = 0; ks < 8; ++ks) {
      const bf16x8 fa = *(const bf16x8*)(kn + (ta * 32 + r) * LKN + ks * 16 + 8 * hh);
      const bf16x8 fb = *(const bf16x8*)(kn + (tb * 32 + r) * LKN + ks * 16 + 8 * hh);
      const bf16x8 fq = *(const bf16x8*)(qn + (ta * 32 + r) * LKN + ks * 16 + 8 * hh);
      akk = MFMA(fa, fb, akk);
      aqk = MFMA(fb, fq, aqk);
    }
  }
  __syncthreads();
  if (wave < 3) {
    const int m = tb * 32 + r; const float Gm = Gs[m];
#pragma unroll
    for (int reg = 0; reg < 16; ++reg) {
      const int i = ta * 32 + crow(reg, hh);
      const float v = (m < i) ? Bs[i] * akk[reg] * __expf(Gs[i] - Gm) : 0.f;
      Amat[i * 64 + m] = v;
    }
    const int i = ta * 32 + r; const float Gi = Gs[i];
    f32x16 av;
#pragma unroll
    for (int reg = 0; reg < 16; ++reg) {
      const int j = tb * 32 + crow(reg, hh);
      av[reg] = (j <= i) ? aqk[reg] * QSCALE * __expf(Gi - Gs[j]) : 0.f;
    }
    const int fbase = 16 + (wave * 2);
#pragma unroll
    for (int s = 0; s < 2; ++s) {
      bf16x8 fr8 = pack8(av, s);
      *(bf16x8*)(ext + (fbase + s) * 1024 + lane * 16) = fr8;
    }
  } else {
    for (int e = lane; e < 32 * 32; e += 64) Amat[(e >> 5) * 64 + 32 + (e & 31)] = 0.f;
    if (lane == 0) *(float*)(ext + 22 * 1024) = __expf(Glast);
  }
  __syncthreads();
  float* Tq = (float*)(smem + 9216);
  if (wave == 0) {
    float x[32];
    const int c = lane & 31, hb = lane >> 5;
    const float* Ab = Amat + (hb * 32) * 64 + hb * 32;
#pragma unroll
    for (int i = 0; i < 32; ++i) {
      float s0 = (c == i) ? 1.f : 0.f, s1 = 0.f;
#pragma unroll
      for (int m4 = 0; m4 < (i + 3) / 4; ++m4) {
        const float4 a4 = *(const float4*)(Ab + i * 64 + m4 * 4);
        if (m4 * 4 + 0 < i) s0 -= a4.x * x[m4 * 4 + 0];
        if (m4 * 4 + 1 < i) s1 -= a4.y * x[m4 * 4 + 1];
        if (m4 * 4 + 2 < i) s0 -= a4.z * x[m4 * 4 + 2];
        if (m4 * 4 + 3 < i) s1 -= a4.w * x[m4 * 4 + 3];
      }
      x[i] = s0 + s1;
      __builtin_amdgcn_sched_barrier(0);
    }
#pragma unroll
    for (int i = 0; i < 32; ++i) Tq[hb * 1024 + i * 32 + c] = x[i];
  }
  __syncthreads();
  const int c32 = tid & 31, g8 = tid >> 5;
  {
    float bm[4] = {0.f, 0.f, 0.f, 0.f};
#pragma unroll
    for (int j4 = 0; j4 < 8; ++j4) {
      float t[4];
#pragma unroll
      for (int e = 0; e < 4; ++e) t[e] = Tq[(j4 * 4 + e) * 32 + c32];
#pragma unroll
      for (int e = 0; e < 4; ++e) {
        const float4 a4 = *(const float4*)(Amat + (32 + g8 * 4 + e) * 64 + j4 * 4);
        bm[e] += a4.x * t[0] + a4.y * t[1] + a4.z * t[2] + a4.w * t[3];
      }
    }
#pragma unroll
    for (int e = 0; e < 4; ++e) Amat[(g8 * 4 + e) * 64 + 32 + c32] = bm[e];
  }
  __syncthreads();
  float t21[4] = {0.f, 0.f, 0.f, 0.f};
  {
#pragma unroll
    for (int m4 = 0; m4 < 8; ++m4) {
      float bv[4];
#pragma unroll
      for (int e = 0; e < 4; ++e) bv[e] = Amat[(m4 * 4 + e) * 64 + 32 + c32];
#pragma unroll
      for (int e = 0; e < 4; ++e) {
        const float4 a4 = *(const float4*)(Tq + 1024 + (g8 * 4 + e) * 32 + m4 * 4);
        t21[e] -= a4.x * bv[0] + a4.y * bv[1] + a4.z * bv[2] + a4.w * bv[3];
      }
    }
  }
  float t11[4], t22[4];
#pragma unroll
  for (int e = 0; e < 4; ++e) { t11[e] = Tq[(g8 * 4 + e) * 32 + c32]; t22[e] = Tq[1024 + (g8 * 4 + e) * 32 + c32]; }
  const float bcl = Bs[c32], bgl = bcl * __expf(Gs[c32]);
  const float bch = Bs[32 + c32], bgh = bch * __expf(Gs[32 + c32]);
  __syncthreads();
#pragma unroll
  for (int e = 0; e < 4; ++e) {
    const int i = g8 * 4 + e;
    Tb[i * LKT + c32] = f2bf(t11[e] * bcl);               Tg[i * LKT + c32] = f2bf(t11[e] * bgl);
    Tb[i * LKT + 32 + c32] = (u16)0;                      Tg[i * LKT + 32 + c32] = (u16)0;
    Tb[(32 + i) * LKT + c32] = f2bf(t21[e] * bcl);        Tg[(32 + i) * LKT + c32] = f2bf(t21[e] * bgl);
    Tb[(32 + i) * LKT + 32 + c32] = f2bf(t22[e] * bch);   Tg[(32 + i) * LKT + 32 + c32] = f2bf(t22[e] * bgh);
  }
  __syncthreads();
#pragma unroll
  for (int it = 0; it < 2; ++it) {
    f32x16 av = zero16(), ak = zero16();
#pragma unroll
    for (int ks = 0; ks < 4; ++ks) {
      const bf16x8 fT = *(const bf16x8*)(Tb + (it * 32 + r) * LKT + ks * 16 + 8 * hh);
      const bf16x8 fV = *(const bf16x8*)(vT + (wave * 32 + r) * LKT + ks * 16 + 8 * hh);
      const bf16x8 fK = *(const bf16x8*)(knT + (wave * 32 + r) * LKT + ks * 16 + 8 * hh);
      const bf16x8 fG = *(const bf16x8*)(Tg + (it * 32 + r) * LKT + ks * 16 + 8 * hh);
      av = MFMA(fT, fV, av);
      ak = MFMA(fK, fG, ak);
    }
    {
      const int fv = wave * 2 + it;
      char* d = (char*)qkv + (size_t)(rowbase + 8 * fv + (lane >> 3)) * 6144 + 4096 + h * 256 + (lane & 7) * 32;
      *(bf16x8*)d = pack8(av, 0); *(bf16x8*)(d + 16) = pack8(av, 1);
    }
#pragma unroll
    for (int s = 0; s < 2; ++s) {
      const int f = it * 8 + wave * 2 + s;
      *(bf16x8*)((char*)qkv + (size_t)(rowbase + 4 * f + (lane >> 4)) * 6144 + 2048 + h * 256 + (lane & 15) * 16) = pack8(ak, s);
    }
  }
  __syncthreads();
}

DI void d2_issue(u32x4 (&rg)[18], const Params& p, int b, int h, int lt, int n) {
  const char* qseg = p.ws + OFF_QKV + (size_t)(b * 2048 + n * 64) * 6144 + h * 256;
  const char* ext = p.ws + OFF_EXTRA + (size_t)((b * 32 + n) * 8 + h) * 24576;
#pragma unroll
  for (int sg = 0; sg < 3; ++sg)
#pragma unroll
    for (int i = 0; i < 4; ++i) rg[sg * 4 + i] = *(const u32x4*)(qseg + (size_t)((lt >> 4) + 16 * i) * 6144 + sg * 2048 + (lt & 15) * 16);
#pragma unroll
  for (int i = 0; i < 6; ++i) rg[12 + i] = *(const u32x4*)(ext + lt * 16 + i * 4096);
}
DI void d2_put(const u32x4 (&rg)[18], char* buf, int lt) {
#pragma unroll
  for (int sg = 0; sg < 3; ++sg)
#pragma unroll
    for (int i = 0; i < 4; ++i) *(u32x4*)(buf + sg * 16384 + ((lt >> 4) + 16 * i) * 256 + (lt & 15) * 16) = rg[sg * 4 + i];
#pragma unroll
  for (int i = 0; i < 6; ++i) *(u32x4*)(buf + 49152 + lt * 16 + i * 4096) = rg[12 + i];
}
DI void d2_block(const Params& p, int unit, char* smem) {
  const int tid = threadIdx.x, half = tid >> 8, lt = tid & 255, lane = tid & 63, wave = (tid >> 6) & 3;
  const int r = lane & 31, hh = lane >> 5;
  const int b = unit >> 3, h = unit & 7;
  const char* qkv = p.ws + OFF_QKV;
  const float* egl = (const float*)(p.ws + OFF_EGL);
  u16* obuf = (u16*)((char*)p.out + (size_t)R * 1024 * 2);
  if (half == 1) {
    u32x4 rg0[18], rg1[18];
    u32x4 og[4], sg4;
    u16* obuf_ = (u16*)((char*)p.out + (size_t)R * 1024 * 2);
    float* ssq_ = (float*)(p.ws + OFF_SSQ);
    const int orow = lt >> 2, opos = lt & 3, ocol = 8 * (opos ^ ((orow >> 1) & 3));
    d2_issue(rg0, p, b, h, lt, 0); d2_put(rg0, smem, lt); d2_issue(rg1, p, b, h, lt, 1); d2_issue(rg0, p, b, h, lt, 2);
    __syncthreads();
#define D2_LOADER_STEP(n_, RG)                                                                                              \
    {                                                                                                                        \
      const int n = (n_);                                                                                                    \
      char* ob = smem + ((n + 1) & 1) * HALF_SMEM;                                                                           \
      if (n >= 1) {                                                                                                          \
        _Pragma("unroll") for (int i = 0; i < 4; ++i) og[i] = *(const u32x4*)(ob + 32768 + (lt + 256 * i) * 16);            \
        if (lt >= 192) sg4 = *(const u32x4*)(ob + 49152 + 20480 + lt * 16);                                                  \
      }                                                                                                                      \
      if (n + 1 < 32) { d2_put(RG, ob, lt); if (n + 3 < 32) d2_issue(RG, p, b, h, lt, n + 3); }                              \
      if (n >= 1) {                                                                                                          \
        const int rowbase = b * 2048 + (n - 1) * 64;                                                                         \
        _Pragma("unroll") for (int i = 0; i < 4; ++i)                                                                        \
          *(u32x4*)(obuf_ + (size_t)(rowbase + orow) * 1024 + h * 128 + 32 * i + ocol) = og[i];                              \
        if (lt >= 192) *(u32x4*)(ssq_ + ((size_t)(rowbase + lt - 192) * 8 + h) * 4) = sg4;                                   \
      }                                                                                                                      \
      if (n < 32) { asm volatile("s_waitcnt lgkmcnt(0)" ::: "memory"); __builtin_amdgcn_s_barrier(); asm volatile("" ::: "memory"); } \
    }
#pragma unroll 1
    for (int n2 = 0; n2 <= 32; n2 += 2) {
      D2_LOADER_STEP(n2, rg1)
      if (n2 + 1 <= 32) D2_LOADER_STEP(n2 + 1, rg0)
    }
#undef D2_LOADER_STEP
    return;
  }
  f32x16 S[4];
#pragma unroll
  for (int k = 0; k < 4; ++k) S[k] = zero16();
  const unsigned voff_l = (unsigned)(lane * 16);
  bf16x8 If0, If1;
#pragma unroll
  for (int j = 0; j < 8; ++j) {
    const int k0 = 8 * (j >> 2) + 4 * hh + (j & 3);
    If0[j] = (short)((k0 == r) ? 0x3F80 : 0); If1[j] = (short)((16 + k0 == r) ? 0x3F80 : 0);
  }
  const unsigned voff_v = (unsigned)((16 * wave + (lane >> 3)) * 256 + (lane & 7) * 32);
  __syncthreads();
#pragma unroll 1
  for (int n = 0; n < 32; ++n) {
    const int item = (b * 32 + n) * 8 + h;
    const int rowbase = b * 2048 + n * 64;
    const char* buf = smem + (n & 1) * HALF_SMEM;
    const char* ext = buf + 49152;
    const float eg = *(const float*)(ext + 22 * 1024);
    bf16x8 fk[16];
#pragma unroll
    for (int f = 0; f < 16; ++f) fk[f] = *(const bf16x8*)(buf + 16384 + f * 1024 + voff_l);
    uint4 vv[2][2];
#pragma unroll
    for (int it = 0; it < 2; ++it) { const char* d = buf + 32768 + it * 2048 + voff_v; vv[it][0] = *(const uint4*)d; vv[it][1] = *(const uint4*)(d + 16); }
    bf16x8 Sf[4][2];
#pragma unroll
    for (int kb = 0; kb < 4; ++kb) { Sf[kb][0] = pack8(S[kb], 0); Sf[kb][1] = pack8(S[kb], 1); }
    __builtin_amdgcn_sched_barrier(0);
    f32x16 P1[2];
    P1[0] = zero16(); P1[1] = zero16();
#pragma unroll
    for (int kb = 0; kb < 4; ++kb)
#pragma unroll
      for (int s = 0; s < 2; ++s) {
        P1[0] = MFMA(fk[kb * 2 + s], Sf[kb][s], P1[0]);
        P1[1] = MFMA(fk[8 + kb * 2 + s], Sf[kb][s], P1[1]);
      }
    bf16x8 fq[8];
#pragma unroll
    for (int f = 0; f < 8; ++f) fq[f] = *(const bf16x8*)(buf + f * 1024 + voff_l);
    bf16x8 Vf[2][2];
#pragma unroll
    for (int it = 0; it < 2; ++it) {
      const uint4 v0 = vv[it][0], v1 = vv[it][1];
      f32x16 vn;
      vn[0] = bf_lo(v0.x) - P1[it][0];  vn[1] = bf_hi(v0.x) - P1[it][1];
      vn[2] = bf_lo(v0.y) - P1[it][2];  vn[3] = bf_hi(v0.y) - P1[it][3];
      vn[4] = bf_lo(v0.z) - P1[it][4];  vn[5] = bf_hi(v0.z) - P1[it][5];
      vn[6] = bf_lo(v0.w) - P1[it][6];  vn[7] = bf_hi(v0.w) - P1[it][7];
      vn[8] = bf_lo(v1.x) - P1[it][8];  vn[9] = bf_hi(v1.x) - P1[it][9];
      vn[10] = bf_lo(v1.y) - P1[it][10]; vn[11] = bf_hi(v1.y) - P1[it][11];
      vn[12] = bf_lo(v1.z) - P1[it][12]; vn[13] = bf_hi(v1.z) - P1[it][13];
      vn[14] = bf_lo(v1.w) - P1[it][14]; vn[15] = bf_hi(v1.w) - P1[it][15];
      Vf[it][0] = pack8(vn, 0); Vf[it][1] = pack8(vn, 1);
    }
    bf16x8 fa[6];
#pragma unroll
    for (int i = 0; i < 6; ++i) fa[i] = *(const bf16x8*)(ext + (16 + i) * 1024 + voff_l);
    f32x16 P2[2];
    P2[0] = zero16(); P2[1] = zero16();
#pragma unroll
    for (int kb = 0; kb < 4; ++kb)
#pragma unroll
      for (int s = 0; s < 2; ++s) {
        P2[0] = MFMA(fq[kb * 2 + s], Sf[kb][s], P2[0]);
        const bf16x8 fq1 = *(const bf16x8*)(buf + (8 + kb * 2 + s) * 1024 + voff_l);
        P2[1] = MFMA(fq1, Sf[kb][s], P2[1]);
      }
    __builtin_amdgcn_sched_barrier(0);
    bf16x8 fkd[16];
#pragma unroll
    for (int i = 0; i < 16; ++i) fkd[i] = *(const bf16x8*)(ext + i * 1024 + voff_l);
#pragma unroll
    for (int s = 0; s < 2; ++s) {
      P2[0] = MFMA(fa[0 + s], Vf[0][s], P2[0]);
      P2[1] = MFMA(fa[2 + s], Vf[0][s], P2[1]);
      P2[1] = MFMA(fa[4 + s], Vf[1][s], P2[1]);
    }
    {
      char* ow = (char*)buf + 32768 + wave * 4096;
      float* sqw = (float*)((char*)buf + 49152 + 23 * 1024);
      const int xs = (r >> 1) & 3;
#pragma unroll
      for (int it = 0; it < 2; ++it) {
        f32x16 Z = MFMA(pack8(P2[it], 0), If0, zero16());
        Z = MFMA(pack8(P2[it], 1), If1, Z);
        float ssl = 0.f;
#pragma unroll
        for (int reg = 0; reg < 16; ++reg) ssl += Z[reg] * Z[reg];
        ssl += __shfl_xor(ssl, 32, 64);
        if (hh == 0) sqw[(it * 32 + r) * 4 + wave] = ssl;
#pragma unroll
        for (int g = 0; g < 4; ++g) {
          uint2 pv; pv.x = pk2(Z[4 * g], Z[4 * g + 1]); pv.y = pk2(Z[4 * g + 2], Z[4 * g + 3]);
          *(uint2*)(ow + (it * 32 + r) * 64 + ((g ^ xs) * 16) + hh * 8) = pv;
        }
      }
    }
#pragma unroll
    for (int kt = 0; kt < 4; ++kt) {
#pragma unroll
      for (int reg = 0; reg < 16; ++reg) S[kt][reg] *= eg;
#pragma unroll
      for (int pb = 0; pb < 2; ++pb)
#pragma unroll
        for (int s = 0; s < 2; ++s) {
          S[kt] = MFMA(fkd[kt * 4 + pb * 2 + s], Vf[pb][s], S[kt]);
        }
    }
    asm volatile("s_waitcnt lgkmcnt(0)" ::: "memory"); __builtin_amdgcn_s_barrier(); asm volatile("" ::: "memory");
  }
  float* od = p.out + OUT_DELTAP + (size_t)(b * 8 + h) * 16384;
#pragma unroll
  for (int kt = 0; kt < 4; ++kt)
#pragma unroll
    for (int reg = 0; reg < 16; ++reg) od[(kt * 32 + crow(reg, hh)) * 128 + wave * 32 + r] = S[kt][reg];
}

DI void conf_prompt_item(const Params& p, int item, char* smem) {
  const int tid = threadIdx.x & 255, lane = tid & 63, wave = tid >> 6;
  const int b = item >> 6, t0 = (item & 63) * 32;
  unsigned* tile = (unsigned*)smem;
  float* red = (float*)(smem + 63488);
  const u16* glu = (const u16*)(p.ws + OFF_GLU);
  u16* aact = (u16*)(p.ws + OFF_AACT);
#pragma unroll 1
  for (int hb = 0; hb < 2; ++hb) {
    u32x4 fv[8];
#pragma unroll
    for (int i = 0; i < 8; ++i) {
      const int e = tid + 256 * (hb * 8 + i), rr = e >> 6, c8 = (e & 63) * 8;
      const int t = t0 - 30 + rr;
      fv[i] = (u32x4){0u, 0u, 0u, 0u};
      if (rr < 62 && t >= 0) fv[i] = *(const u32x4*)(glu + (size_t)(b * 2048 + t) * 512 + c8);
    }
#pragma unroll
    for (int i = 0; i < 8; ++i) {
      const int e = tid + 256 * (hb * 8 + i), rr = e >> 6, c8 = (e & 63) * 8;
      if (rr < 62) *(u32x4*)(tile + rr * 256 + (c8 >> 1)) = fv[i];
    }
  }
  float w[31][2];
#pragma unroll
  for (int j = 0; j < 31; ++j) { const float2 t = *(const float2*)(p.conf_dw_w + j * 512 + 2 * tid); w[j][0] = t.x; w[j][1] = t.y; }
  const float2 bias = *(const float2*)(p.conf_dw_b + 2 * tid);
  const float2 lw = *(const float2*)(p.conf_ln_w + 2 * tid), lb = *(const float2*)(p.conf_ln_b + 2 * tid);
  __syncthreads();
#pragma unroll 1
  for (int tg = 0; tg < 4; ++tg) {
    float a[8][2];
#pragma unroll
    for (int t = 0; t < 8; ++t) { a[t][0] = bias.x; a[t][1] = bias.y; }
#pragma unroll
    for (int i = 0; i < 38; ++i) {
      const unsigned u = tile[(tg * 8 + i) * 256 + tid];
      const float x0 = bf_lo(u), x1 = bf_hi(u);
#pragma unroll
      for (int t = 0; t < 8; ++t) {
        const int j = i - t;
        if (j >= 0 && j < 31) { a[t][0] += w[j][0] * x0; a[t][1] += w[j][1] * x1; }
      }
    }
#pragma unroll
    for (int t = 0; t < 8; ++t) {
      const float s1 = wsum(a[t][0] + a[t][1]);
      const float s2 = wsum(a[t][0] * a[t][0] + a[t][1] * a[t][1]);
      if (lane == 0) { red[(wave * 8 + t) * 2] = s1; red[(wave * 8 + t) * 2 + 1] = s2; }
    }
    __syncthreads();
#pragma unroll
    for (int t = 0; t < 8; ++t) {
      const float s1 = red[t * 2] + red[(8 + t) * 2] + red[(16 + t) * 2] + red[(24 + t) * 2];
      const float s2 = red[t * 2 + 1] + red[(8 + t) * 2 + 1] + red[(16 + t) * 2 + 1] + red[(24 + t) * 2 + 1];
      const float mu = s1 * (1.f / 512.f);
      const float var = fmaxf(s2 * (1.f / 512.f) - mu * mu, 0.f);
      const float rs = rsqrtf(var + EPS);
      const float y0 = (a[t][0] - mu) * rs * lw.x + lb.x, y1 = (a[t][1] - mu) * rs * lw.y + lb.y;
      *(unsigned*)(aact + (size_t)(b * 2048 + t0 + tg * 8 + t) * 512 + 2 * tid) = pk2(siluf_(y0), siluf_(y1));
    }
    __syncthreads();
  }
}
DI void conf_sample_item(const Params& p, int item) {
  const int lane = threadIdx.x & 63, wave = (threadIdx.x >> 6) & 3;
  const int s = item * 4 + wave;
  const int c = lane * 8;
  const u16* glu = (const u16*)(p.ws + OFF_GLU);
  u16* aact = (u16*)(p.ws + OFF_AACT);
  float a[8];
  {
    const float4 b0 = *(const float4*)(p.conf_dw_b + c), b1 = *(const float4*)(p.conf_dw_b + c + 4);
    a[0] = b0.x; a[1] = b0.y; a[2] = b0.z; a[3] = b0.w; a[4] = b1.x; a[5] = b1.y; a[6] = b1.z; a[7] = b1.w;
  }
  const float* st = p.st_conf + (size_t)s * 30 * 512;
  float* oc = p.out + OUT_CONFS + (size_t)s * 30 * 512;
#pragma unroll 1
  for (int j = 0; j < 30; ++j) {
    const float4 x0 = *(const float4*)(st + j * 512 + c), x1 = *(const float4*)(st + j * 512 + c + 4);
    const float4 w0 = *(const float4*)(p.conf_dw_w + j * 512 + c), w1 = *(const float4*)(p.conf_dw_w + j * 512 + c + 4);
    a[0] += w0.x * x0.x; a[1] += w0.y * x0.y; a[2] += w0.z * x0.z; a[3] += w0.w * x0.w;
    a[4] += w1.x * x1.x; a[5] += w1.y * x1.y; a[6] += w1.z * x1.z; a[7] += w1.w * x1.w;
    if (j >= 1) { *(float4*)(oc + (j - 1) * 512 + c) = x0; *(float4*)(oc + (j - 1) * 512 + c + 4) = x1; }
  }
  {
    const uint4 g = *(const uint4*)(glu + (size_t)(RP + s) * 512 + c);
    const float4 w0 = *(const float4*)(p.conf_dw_w + 30 * 512 + c), w1 = *(const float4*)(p.conf_dw_w + 30 * 512 + c + 4);
    a[0] += w0.x * bf_lo(g.x); a[1] += w0.y * bf_hi(g.x); a[2] += w0.z * bf_lo(g.y); a[3] += w0.w * bf_hi(g.y);
    a[4] += w1.x * bf_lo(g.z); a[5] += w1.y * bf_hi(g.z); a[6] += w1.z * bf_lo(g.w); a[7] += w1.w * bf_hi(g.w);
  }
  float s1 = 0.f, s2 = 0.f;
#pragma unroll
  for (int i = 0; i < 8; ++i) { s1 += a[i]; s2 += a[i] * a[i]; }
  s1 = wsum(s1); s2 = wsum(s2);
  const float mu = s1 * (1.f / 512.f);
  const float rs = rsqrtf(fmaxf(s2 * (1.f / 512.f) - mu * mu, 0.f) + EPS);
  float y[8];
#pragma unroll
  for (int i = 0; i < 8; ++i) y[i] = siluf_((a[i] - mu) * rs * p.conf_ln_w[c + i] + p.conf_ln_b[c + i]);
  uint4 o; o.x = pk2(y[0], y[1]); o.y = pk2(y[2], y[3]); o.z = pk2(y[4], y[5]); o.w = pk2(y[6], y[7]);
  *(uint4*)(aact + (size_t)(RP + s) * 512 + c) = o;
}
DI void delta_sample_item(const Params& p, int item, char* smem) {
  const int tid = threadIdx.x & 255, lane = tid & 63, wave = tid >> 6;
  const int s = item >> 3, h = item & 7;
  float* qs = (float*)smem; float* ks = qs + 128; float* vs = ks + 128; float* part = vs + 128;
  float* red = part + 768;
  const u16* qkv = (const u16*)(p.ws + OFF_QKV);
  const float* gb = (const float*)(p.ws + OFF_GB);
  const int row = RP + s;
  const int v = tid & 127, kh = tid >> 7;
  const float* S0 = p.st_delta + (size_t)(s * 8 + h) * 16384 + (size_t)(kh * 64) * 128 + v;
  float Sr[64];
#pragma unroll
  for (int kk = 0; kk < 64; ++kk) Sr[kk] = S0[kk * 128];
  const float g = gb[(size_t)row * 16 + 8 + h], beta = gb[(size_t)row * 16 + h];
  float cq = 0.f, ck = 0.f, cv = 0.f;
  if (tid < 128) {
    float cx[3];
#pragma unroll
    for (int X = 0; X < 3; ++X) {
      const int cg = X * 1024 + h * 128 + tid;
      const float s0 = p.st_qkv[(size_t)(s * 3 + 0) * 3072 + cg], s1 = p.st_qkv[(size_t)(s * 3 + 1) * 3072 + cg], s2 = p.st_qkv[(size_t)(s * 3 + 2) * 3072 + cg];
      const float x = bf1(qkv[(size_t)row * 3072 + cg]);
      const float a = p.gdn_conv_w[cg] * s0 + p.gdn_conv_w[3072 + cg] * s1 + p.gdn_conv_w[2 * 3072 + cg] * s2 + p.gdn_conv_w[3 * 3072 + cg] * x;
      cx[X] = siluf_(a);
      p.out[OUT_QKVS + (size_t)(s * 3 + 0) * 3072 + cg] = s1;
      p.out[OUT_QKVS + (size_t)(s * 3 + 1) * 3072 + cg] = s2;
    }
    cq = cx[0]; ck = cx[1]; cv = cx[2];
  }
  {
    const float sq = wsum(cq * cq), sk = wsum(ck * ck);
    if (lane == 0) { red[wave * 2] = sq; red[wave * 2 + 1] = sk; }
  }
  __syncthreads();
  if (tid < 128) {
    const float rq = rsqrtf(red[0] + red[2] + EPS), rk = rsqrtf(red[1] + red[3] + EPS);
    qs[tid] = cq * rq * QSCALE; ks[tid] = ck * rk; vs[tid] = cv;
  }
  __syncthreads();
  const float eg = __expf(g);
  float kS = 0.f, qS = 0.f, qk = 0.f;
#pragma unroll
  for (int k4 = 0; k4 < 16; ++k4) {
    const float4 kv = *(const float4*)(ks + kh * 64 + k4 * 4), qv = *(const float4*)(qs + kh * 64 + k4 * 4);
    kS += kv.x * Sr[4 * k4] + kv.y * Sr[4 * k4 + 1] + kv.z * Sr[4 * k4 + 2] + kv.w * Sr[4 * k4 + 3];
    qS += qv.x * Sr[4 * k4] + qv.y * Sr[4 * k4 + 1] + qv.z * Sr[4 * k4 + 2] + qv.w * Sr[4 * k4 + 3];
    qk += kv.x * qv.x + kv.y * qv.y + kv.z * qv.z + kv.w * qv.w;
  }
  part[(kh * 3 + 0) * 128 + v] = kS; part[(kh * 3 + 1) * 128 + v] = qS; part[(kh * 3 + 2) * 128 + v] = qk;
  __syncthreads();
  kS = part[0 * 128 + v] + part[3 * 128 + v];
  qS = part[1 * 128 + v] + part[4 * 128 + v];
  qk = part[2 * 128 + v] + part[5 * 128 + v];
  const float vnew = vs[v] * beta - beta * eg * kS;
  const float o = eg * qS + qk * vnew;
  float* Sd = p.out + OUT_DELTAS + (size_t)(s * 8 + h) * 16384 + (size_t)(kh * 64) * 128 + v;
#pragma unroll
  for (int k4 = 0; k4 < 16; ++k4) {
    const float4 kv = *(const float4*)(ks + kh * 64 + k4 * 4);
    Sd[(4 * k4 + 0) * 128] = Sr[4 * k4 + 0] * eg + kv.x * vnew;
    Sd[(4 * k4 + 1) * 128] = Sr[4 * k4 + 1] * eg + kv.y * vnew;
    Sd[(4 * k4 + 2) * 128] = Sr[4 * k4 + 2] * eg + kv.z * vnew;
    Sd[(4 * k4 + 3) * 128] = Sr[4 * k4 + 3] * eg + kv.w * vnew;
  }
  if (kh == 0) {
    ((u16*)((char*)p.out + (size_t)R * 1024 * 2))[(size_t)row * 1024 + h * 128 + v] = f2bf(o);
    const float so = wsum(o * o);
    if (lane == 0) { float* sq = (float*)(p.ws + OFF_SSQ) + ((size_t)row * 8 + h) * 4; sq[wave] = so; sq[wave + 2] = 0.f; }
  }
  __syncthreads();
}

__global__ void __launch_bounds__(512, 2) fwd_megakernel(Params p) {
  __shared__ __attribute__((aligned(1024))) char smem[SMEM_BYTES];
  const int tid = threadIdx.x, lane = tid & 63, wave = tid >> 6;
  const int fr = lane & 15, fq = lane >> 4;
  uint4* xb_words = (uint4*)(smem + 2 * HALF_SMEM);
  if (tid == 0) *xb_words = make_uint4(0u, 0u, 0u, 0u);
  __syncthreads();
  XcdBarrier xb = xcd_barrier_post((unsigned*)(p.ws + OFF_BAR), (volatile LAS unsigned*)xb_words);
  const int G = gridDim.x, bid = blockIdx.x;
  float* mod = (float*)(p.ws + OFF_MOD);
  u16* hbuf = (u16*)p.out;
  u16* obuf = (u16*)((char*)p.out + (size_t)R * 1024 * 2);
  const float* ssq = (const float*)(p.ws + OFF_SSQ);
  u16* merged = (u16*)(p.ws + OFF_MERGED);
  u16* tmp2 = (u16*)(p.ws + OFF_TMP2);

  PH(0) phase_convert(p, smem);
  xcd_barrier(xb);

  PH(1) for (int sb = bid; sb < 256; sb += G) {
    skinny<2>((const u16*)(p.ws + OFF_AC), 1024, 0, 136, (const u16*)(p.ws + OFF_WADA), 1024, 1024,
      [&](int j) { return sb * 24 + (j < 24 ? j : 23); },
      [&](int row, int ntl, int q, f32x4 v, int ln) {
        const int j = ntl * 16 + 4 * q;
        if (j < 24) {
          const int col = sb * 24 + j;
          const float4 bb = *(const float4*)(p.b_ada + col);
          *(float4*)(mod + (size_t)row * 6144 + col) = make_float4(v[0] + bb.x, v[1] + bb.y, v[2] + bb.z, v[3] + bb.w);
        }
      });
  }
  xcd_barrier(xb);

  PH(2) phase_modnorm<true>(p, p.x_prompt, p.x_sample, p.norm1_w, 0, 1024, hbuf, smem);
  xcd_barrier(xb);

  PH(3) {
    u16* glu = (u16*)(p.ws + OFF_GLU);
    u16* qkv = (u16*)(p.ws + OFF_QKV);
    u16* halo = (u16*)(p.ws + OFF_HALO);
    auto f_glu_st = [&](int row, int ch, f32x4 gl) {
      uint2 o; o.x = pk2(gl[0], gl[1]); o.y = pk2(gl[2], gl[3]);
      *(uint2*)(glu + (size_t)row * 512 + ch) = o;
      if (row < RP) { const int b = row >> 11, tt = row & 2047; if (tt >= 2018) *(float4*)(p.out + OUT_CONFP + (size_t)(b * 30 + tt - 2018) * 512 + ch) = make_float4(gl[0], gl[1], gl[2], gl[3]); }
      else *(float4*)(p.out + OUT_CONFS + (size_t)((row - RP) * 30 + 29) * 512 + ch) = make_float4(gl[0], gl[1], gl[2], gl[3]);
    };
    auto f_glu = [&](int row, int ch, f32x4 a, f32x4 g) {
      f32x4 gl;
#pragma unroll
      for (int j = 0; j < 4; ++j) gl[j] = a[j] * sigmoidf_(g[j]);
      f_glu_st(row, ch, gl);
    };
    auto f_qkv = [&](int row, int col, f32x4 a) {
      const float4 v = make_float4(a[0], a[1], a[2], a[3]);
      uint2 o; o.x = pk2(v.x, v.y); o.y = pk2(v.z, v.w);
      *(uint2*)(qkv + (size_t)row * 3072 + col) = o;
      if (row < RP) {
        const int b = row >> 11, tt = row & 2047;
        if ((tt & 63) >= 61) *(uint2*)(halo + (size_t)((b * 32 + (tt >> 6)) * 3 + (tt & 63) - 61) * 3072 + col) = o;
        if (tt >= 2045) *(float4*)(p.out + OUT_QKVP + (size_t)(b * 3 + tt - 2045) * 3072 + col) = v;
      } else *(float4*)(p.out + OUT_QKVS + (size_t)((row - RP) * 3 + 2) * 3072 + col) = v;
    };
    int u = bid;
    for (; u < 64 * 4; u += G) {
      const int pm = u % 64, pn = u / 64;
      f32x4 acc[2][2][4][2];
      zero_acc(acc);
      gemm256(acc, hbuf, 1024, (const u16*)(p.ws + OFF_WIN), 1024, pm * 256, pn * 256, 1024, smem);
      {
        int t_ = threadIdx.x;
        asm volatile("" : "+v"(t_));
        const int wr = t_ >> 8, wc = (t_ >> 6) & 3, fr_ = t_ & 15, fq_ = (t_ >> 4) & 3;
        float* T = (float*)smem;
#pragma unroll
        for (int ai = 0; ai < 2; ++ai)
#pragma unroll
          for (int m = 0; m < 4; ++m)
#pragma unroll
            for (int n = 0; n < 2; ++n) {
              f32x4 gl;
#pragma unroll
              for (int j = 0; j < 4; ++j) gl[j] = acc[ai][0][m][n][j] * sigmoidf_(acc[ai][1][m][n][j]);
              *(f32x4*)(T + (ai * 128 + wr * 64 + m * 16 + fr_) * TLD + wc * 32 + n * 16 + 4 * fq_) = gl;
            }
        __syncthreads();
        const int cg = (t_ & 31) * 4, r0 = t_ >> 5;
#pragma unroll 4
        for (int i = 0; i < 16; ++i) {
          const int rl = r0 + 16 * i;
          const f32x4 v = *(const f32x4*)(T + rl * TLD + cg);
          f_glu_st(pm * 256 + rl, pn * 128 + cg, v);
        }
        __syncthreads();
      }
    }
    for (; u < 64 * 16; u += G) {
      const int pm = u % 64, pn = u / 64;
      f32x4 acc[2][2][4][2];
      zero_acc(acc);
      gemm256(acc, hbuf, 1024, (const u16*)(p.ws + OFF_WIN), 1024, pm * 256, pn * 256, 1024, smem);
      tile_epilogue(acc, pm * 256, pn * 256 - 1024, smem, f_qkv);
    }
    for (int sb = bid; sb < 256; sb += G) {
      if (sb < 64) {
        skinny<1>(hbuf, 1024, RP, 128, (const u16*)(p.ws + OFF_WIN), 1024, 1024,
          [&](int j) { const int ch = sb * 8 + (j & 7); return (ch >> 7) * 256 + (ch & 127) + ((j >> 3) << 7); },
          [&](int row, int ntl, int q, f32x4 v, int ln) {
            f32x4 g;
#pragma unroll
            for (int j = 0; j < 4; ++j) g[j] = __shfl(v[j], (ln + 32) & 63, 64);
            if (q < 2) f_glu(row, sb * 8 + 4 * q, v, g);
          });
      } else {
        skinny<1>(hbuf, 1024, RP, 128, (const u16*)(p.ws + OFF_WIN), 1024, 1024,
          [&](int j) { return 1024 + (sb - 64) * 16 + j; },
          [&](int row, int ntl, int q, f32x4 v, int ln) { f_qkv(row, (sb - 64) * 16 + 4 * q, v); });
      }
    }
  }
  xcd_barrier(xb);

  PH(4) for (int base = bid * 2; base < 2048; base += 2 * G) d1_item(p, base + (tid >> 8), smem + (tid >> 8) * HALF_SMEM);
  xcd_barrier(xb);

  PH(5) {
    const int half = tid >> 8;
    char* hs = smem + half * HALF_SMEM;
    if (G >= 128) {
      if (bid < 64) d2_block(p, bid, smem);
      else {
        const int hb = (bid - 64) * 2, st = (G - 64) * 2;
        for (int base = hb; base < 512; base += st) conf_prompt_item(p, base + half, hs);
        for (int base = hb; base < 32; base += st) conf_sample_item(p, base + half);
        if (st == 384) {
          delta_sample_item(p, hb + half, hs);
          delta_sample_item(p, 384 + hb + half, hs);
          if (hb >= 128) delta_sample_item(p, 768 + (hb - 128) + half, hs);
        } else {
          for (int base = hb; base < 1024; base += st) delta_sample_item(p, base + half, hs);
        }
      }
    } else {
      for (int u = bid; u < 64; u += G) { d2_block(p, u, smem); __syncthreads(); }
      for (int base = bid * 2; base < 512; base += 2 * G) conf_prompt_item(p, base + half, hs);
      for (int base = bid * 2; base < 32; base += 2 * G) conf_sample_item(p, base + half);
      for (int base = bid * 2; base < 1024; base += 2 * G) delta_sample_item(p, base + half, hs);
    }
  }
  xcd_barrier(xb);

  PH(6) {
    auto f_z = [&](int row, int col, f32x4 a) {
      const float4 sq4 = *(const float4*)(ssq + ((size_t)row * 8 + (col >> 7)) * 4);
      const float rstd = rsqrtf((sq4.x + sq4.y + sq4.z + sq4.w) * (1.f / 128.f) + EPS);
      const float4 gw = *(const float4*)(p.gdn_norm_w + (col & 127));
      u16* op = obuf + (size_t)row * 1024 + col;
      const uint2 u = *(const uint2*)op;
      uint2 o;
      o.x = pk2(bf_lo(u.x) * rstd * gw.x * siluf_(a[0]), bf_hi(u.x) * rstd * gw.y * siluf_(a[1]));
      o.y = pk2(bf_lo(u.y) * rstd * gw.z * siluf_(a[2]), bf_hi(u.y) * rstd * gw.w * siluf_(a[3]));
      *(uint2*)op = o;
    };
    gemm_pass(hbuf, 1024, (const u16*)(p.ws + OFF_WZ), 1024, 1024, 1024, smem, f_z);
    for (int sb = bid; sb < 256; sb += G)
      skinny<1>(hbuf, 1024, RP, 128, (const u16*)(p.ws + OFF_WZ), 1024, 1024, [&](int j) { return sb * 4 + (j & 3); },
                [&](int row, int ntl, int q, f32x4 v, int ln) { if (q == 0) f_z(row, sb * 4, v); });
  }
  xcd_barrier(xb);

  PH(7) {
    auto f_ga = [&](int row, int col, f32x4 a) {
      uint2 o; o.x = pk2(sigmoidf_(a[0]), sigmoidf_(a[1])); o.y = pk2(sigmoidf_(a[2]), sigmoidf_(a[3]));
      *(uint2*)(merged + (size_t)row * 1024 + col) = o;
    };
    auto f_ya = [&](int row, int col, f32x4 a) {
      u16* mp = merged + (size_t)row * 1024 + col;
      const uint2 u = *(const uint2*)mp;
      uint2 o; o.x = pk2(bf_lo(u.x) * a[0], bf_hi(u.x) * a[1]); o.y = pk2(bf_lo(u.y) * a[2], bf_hi(u.y) * a[3]);
      *(uint2*)mp = o;
    };
    auto f_gb = [&](int row, int col, f32x4 a) {
      uint2 o; o.x = pk2(sigmoidf_(a[0]), sigmoidf_(a[1])); o.y = pk2(sigmoidf_(a[2]), sigmoidf_(a[3]));
      *(uint2*)(tmp2 + (size_t)row * 1024 + col) = o;
    };
    auto f_yb = [&](int row, int col, f32x4 a) {
      u16* mp = merged + (size_t)row * 1024 + col;
      const uint2 u = *(const uint2*)mp, s2 = *(const uint2*)(tmp2 + (size_t)row * 1024 + col);
      uint2 o; o.x = pk2(bf_lo(u.x) + bf_lo(s2.x) * a[0], bf_hi(u.x) + bf_hi(s2.x) * a[1]); o.y = pk2(bf_lo(u.y) + bf_lo(s2.y) * a[2], bf_hi(u.y) + bf_hi(s2.y) * a[3]);
      *(uint2*)mp = o;
    };
    auto cm4 = [&](int sb) { return [sb](int j) { return sb * 4 + (j & 3); }; };
    gemm_pass(hbuf, 1024, (const u16*)(p.ws + OFF_WGA), 1024, 1024, 1024, smem, f_ga);
    gemm_pass((const u16*)(p.ws + OFF_AACT), 512, (const u16*)(p.ws + OFF_WCONF), 512, 1024, 512, smem, f_ya);
    gemm_pass(hbuf, 1024, (const u16*)(p.ws + OFF_WGB), 1024, 1024, 1024, smem, f_gb);
    gemm_pass(obuf, 1024, (const u16*)(p.ws + OFF_WGDN), 1024, 1024, 1024, smem, f_yb);
    for (int sb = bid; sb < 256; sb += G) {
      skinny<1>(hbuf, 1024, RP, 128, (const u16*)(p.ws + OFF_WGA), 1024, 1024, cm4(sb), [&](int row, int ntl, int q, f32x4 v, int ln) { if (q == 0) f_ga(row, sb * 4, v); });
      skinny<1>((const u16*)(p.ws + OFF_AACT), 512, RP, 128, (const u16*)(p.ws + OFF_WCONF), 512, 512, cm4(sb), [&](int row, int ntl, int q, f32x4 v, int ln) { if (q == 0) f_ya(row, sb * 4, v); });
      skinny<1>(hbuf, 1024, RP, 128, (const u16*)(p.ws + OFF_WGB), 1024, 1024, cm4(sb), [&](int row, int ntl, int q, f32x4 v, int ln) { if (q == 0) f_gb(row, sb * 4, v); });
      skinny<1>(obuf, 1024, RP, 128, (const u16*)(p.ws + OFF_WGDN), 1024, 1024, cm4(sb), [&](int row, int ntl, int q, f32x4 v, int ln) { if (q == 0) f_yb(row, sb * 4, v); });
    }
  }
  xcd_barrier(xb);

  PH(8) {
    auto f_o = [&](int row, int col, f32x4 a) {
      const float* xr = row < RP ? p.x_prompt + (size_t)row * 1024 : p.x_sample + (size_t)(row - RP) * 1024;
      const float4 xv = *(const float4*)(xr + col), gv = *(const float4*)(mod + (size_t)mrow_of(row) * 6144 + 2048 + col);
      *(float4*)(p.out + (size_t)row * 1024 + col) = make_float4(xv.x + gv.x * a[0], xv.y + gv.y * a[1], xv.z + gv.z * a[2], xv.w + gv.w * a[3]);
    };
    gemm_pass(merged, 1024, (const u16*)(p.ws + OFF_WO), 1024, 1024, 1024, smem, f_o);
    for (int sb = bid; sb < 256; sb += G)
      skinny<1>(merged, 1024, RP, 128, (const u16*)(p.ws + OFF_WO), 1024, 1024, [&](int j) { return sb * 4 + (j & 3); },
                [&](int row, int ntl, int q, f32x4 v, int ln) { if (q == 0) f_o(row, sb * 4, v); });
  }
  xcd_barrier(xb);

  PH(9) phase_modnorm<false>(p, p.out, p.out + (size_t)RP * 1024, p.norm2_w, 3072, 4096, (u16*)(p.ws + OFF_H2), smem);
  xcd_barrier(xb);

  PH(10) {
    u16* f = (u16*)(p.ws + OFF_F);
    auto f_ff1 = [&](int row, int col, f32x4 a) {
      float v[4];
#pragma unroll
      for (int j = 0; j < 4; ++j) { const float t = fmaxf(a[j], 0.f); v[j] = t * t; }
      uint2 o; o.x = pk2(v[0], v[1]); o.y = pk2(v[2], v[3]);
      *(uint2*)(f + (size_t)row * LDF + col) = o;
    };
    gemm_pass((const u16*)(p.ws + OFF_H2), 1024, (const u16*)(p.ws + OFF_W1), 1024, 4096, 1024, smem, f_ff1);
    for (int sb = bid; sb < 256; sb += G)
      skinny<1>((const u16*)(p.ws + OFF_H2), 1024, RP, 128, (const u16*)(p.ws + OFF_W1), 1024, 1024, [&](int j) { return sb * 16 + j; },
                [&](int row, int ntl, int q, f32x4 v, int ln) { f_ff1(row, sb * 16 + 4 * q, v); });
  }
  xcd_barrier(xb);

  PH(11) {
    auto f_ff2 = [&](int row, int col, f32x4 a) {
      float* xp = p.out + (size_t)row * 1024 + col;
      const float4 xv = *(const float4*)xp, gv = *(const float4*)(mod + (size_t)mrow_of(row) * 6144 + 5120 + col);
      *(float4*)xp = make_float4(xv.x + gv.x * a[0], xv.y + gv.y * a[1], xv.z + gv.z * a[2], xv.w + gv.w * a[3]);
    };
    gemm_pass((const u16*)(p.ws + OFF_F), LDF, (const u16*)(p.ws + OFF_W2), LDF, 1024, 4096, smem, f_ff2);
    for (int sb = bid; sb < 256; sb += G)
      skinny<1>((const u16*)(p.ws + OFF_F), LDF, RP, 128, (const u16*)(p.ws + OFF_W2), LDF, 4096, [&](int j) { return sb * 4 + (j & 3); },
                [&](int row, int ntl, int q, f32x4 v, int ln) { if (q == 0) f_ff2(row, sb * 4, v); });
  }
  xcd_barrier(xb);

  PH(12) {
    const int gw = bid * 8 + wave, nw_ = G * 8;
    for (int row = gw; row < R; row += nw_) {
      float* xr = p.out + (size_t)row * 1024;
      float4 v[4]; float ss = 0.f;
#pragma unroll
      for (int i = 0; i < 4; ++i) { v[i] = *(const float4*)(xr + (lane + 64 * i) * 4); ss += v[i].x * v[i].x + v[i].y * v[i].y + v[i].z * v[i].z + v[i].w * v[i].w; }
      ss = wsum(ss);
      const float rstd = rsqrtf(ss * (1.f / 1024.f) + EPS);
#pragma unroll
      for (int i = 0; i < 4; ++i) {
        const int c = (lane + 64 * i) * 4;
        const float4 w = *(const float4*)(p.final_norm_w + c);
        *(float4*)(xr + c) = make_float4(v[i].x * rstd * w.x, v[i].y * rstd * w.y, v[i].z * rstd * w.z, v[i].w * rstd * w.w);
      }
    }
  }
}

extern "C" void kernel_launch(void* const* d_in, const int* in_sizes, int n_in, void* d_out, int out_size, void* d_ws, size_t ws_size,
                              hipStream_t stream) {
  static int grid_blocks = 0;
  if (!grid_blocks) {
    int dev = 0, cus = 0, per_cu = 0;
    hipGetDevice(&dev);
    hipDeviceGetAttribute(&cus, hipDeviceAttributeMultiprocessorCount, dev);
    hipOccupancyMaxActiveBlocksPerMultiprocessor(&per_cu, (const void*)fwd_megakernel, NT, 0);
    if (per_cu > 1) per_cu = 1;
    if (per_cu < 1) per_cu = 1;
    grid_blocks = cus * per_cu;
  }
  Params p{};
  const float** pp = (const float**)&p;
  for (int i = 0; i < 26; ++i) pp[i] = (const float*)d_in[i];
  p.out = (float*)d_out; p.ws = (char*)d_ws;
  if (ws_size < WS_NEED) { fprintf(stderr, "workspace too small: %zu < %zu\n", ws_size, (size_t)WS_NEED); return; }
  hipMemsetAsync(d_ws, 0, XCD_BAR_WORDS * 4, stream);
  void* args[] = {&p};
  hipError_t e = hipLaunchCooperativeKernel((const void*)fwd_megakernel, dim3(grid_blocks), dim3(NT), args, 0, stream);
  if (e != hipSuccess) fprintf(stderr, "cooperative launch failed: %s (grid %d)\n", hipGetErrorString(e), grid_blocks);
}
```

```cpp
#include <hip/hip_runtime.h>
#include <stdint.h>
#include <cstdio>

#define DI __device__ __forceinline__
typedef unsigned short u16;
typedef __bf16 bf2_t __attribute__((ext_vector_type(2)));
typedef float f2_t __attribute__((ext_vector_type(2)));
using bf16x8 = __attribute__((ext_vector_type(8))) short;
using f32x16 = __attribute__((ext_vector_type(16))) float;
using f32x4 = __attribute__((ext_vector_type(4))) float;
using u32x4 = __attribute__((ext_vector_type(4))) unsigned;
#define MFMA(a, b, c) __builtin_amdgcn_mfma_f32_32x32x16_bf16((a), (b), (c), 0, 0, 0)

constexpr int R = 16512, RP = 16384, D = 1024, DC = 512, QKV = 3072, NIN = 4096, DFF = 4096;
constexpr float EPS = 1e-6f;
constexpr int LDF = 4160;
constexpr float QSCALE = 0.08838834764831845f;

constexpr size_t OFF_BAR   = 0;
constexpr size_t OFF_MOD   = 16384;
constexpr size_t OFF_GB    = OFF_MOD + 3342336;
constexpr size_t OFF_EGL   = OFF_GB + 1056768;
constexpr size_t OFF_SSQ   = OFF_EGL + 8192;
constexpr size_t OFF_WIN   = OFF_SSQ + 2113536;
constexpr size_t OFF_WZ    = OFF_WIN + 8650752;
constexpr size_t OFF_WGA   = OFF_WZ + 2097152;
constexpr size_t OFF_WGB   = OFF_WGA + 2097152;
constexpr size_t OFF_WCONF = OFF_WGB + 2097152;
constexpr size_t OFF_WGDN  = OFF_WCONF + 1048576;
constexpr size_t OFF_WO    = OFF_WGDN + 2097152;
constexpr size_t OFF_W1    = OFF_WO + 2097152;
constexpr size_t OFF_W2    = OFF_W1 + 8388608;
constexpr size_t OFF_GLU   = OFF_W2 + 8650752;
constexpr size_t OFF_AACT  = OFF_GLU + 16908288;
constexpr size_t OFF_QKV   = OFF_AACT + 16908288;
constexpr size_t OFF_HALO  = OFF_QKV + 101449728;
constexpr size_t OFF_EXTRA = OFF_HALO + 4718592;
constexpr size_t OFF_WADA  = OFF_EXTRA;
constexpr size_t OFF_AC    = OFF_EXTRA + 12582912;
constexpr size_t OFF_MERGED= OFF_EXTRA;
constexpr size_t OFF_H2    = OFF_GLU;
constexpr size_t OFF_F     = OFF_QKV;
constexpr size_t OFF_TMP2  = OFF_QKV;
constexpr size_t WS_NEED   = OFF_EXTRA + 50331648;
constexpr size_t OUT_Y = 0, OUT_CONFP = 16908288, OUT_QKVP = 17031168, OUT_DELTAP = 17104896,
                 OUT_CONFS = 18153472, OUT_QKVS = 20119552, OUT_DELTAS = 21299200;

constexpr int HALF_SMEM = 73728;
constexpr int SMEM_BYTES = 2 * HALF_SMEM + 1024;
constexpr int NT = 512;
#ifndef PHASE_MASK
#define PHASE_MASK 0xFFFF
#endif
#define PH(k) if constexpr ((PHASE_MASK >> (k)) & 1)

struct Params {
  const float *x_prompt, *x_sample, *c_prompt, *c_sample, *st_conf, *st_qkv, *st_delta;
  const float *w_ada, *b_ada, *norm1_w, *w_in, *conf_dw_w, *conf_dw_b, *conf_ln_w, *conf_ln_b, *w_conf_out,
              *gdn_conv_w, *a_log, *dt_bias, *gdn_norm_w, *w_gdn_out, *w_o, *norm2_w, *w_ff1, *w_ff2, *final_norm_w;
  float* out; char* ws;
};

DI unsigned pk2(float a, float b) { f2_t v = {a, b}; bf2_t r = __builtin_convertvector(v, bf2_t); return __builtin_bit_cast(unsigned, r); }
DI float bf_lo(unsigned u) { return __uint_as_float(u << 16); }
DI float bf_hi(unsigned u) { return __uint_as_float(u & 0xffff0000u); }
DI float bf1(u16 u) { return __uint_as_float(((unsigned)u) << 16); }
DI u16 f2bf(float a) { return (u16)(pk2(a, 0.f) & 0xffffu); }
DI float sigmoidf_(float x) { return __builtin_amdgcn_rcpf(1.f + __expf(-x)); }
DI float siluf_(float x) { return x * __builtin_amdgcn_rcpf(1.f + __expf(-x)); }
DI float softplusf_(float x) { return fmaxf(x, 0.f) + log1pf(__expf(-fabsf(x))); }
DI float wsum(float v) {
#pragma unroll
  for (int m = 32; m >= 1; m >>= 1) v += __shfl_xor(v, m, 64);
  return v;
}
DI int crow(int reg, int hh) { return (reg & 3) + 8 * (reg >> 2) + 4 * hh; }
DI int mrow_of(int r) { return r < RP ? (r >> 11) : (8 + r - RP); }
DI bf16x8 pack8(const f32x16& x, int s) {
  uint4 p;
  p.x = pk2(x[8 * s + 0], x[8 * s + 1]); p.y = pk2(x[8 * s + 2], x[8 * s + 3]);
  p.z = pk2(x[8 * s + 4], x[8 * s + 5]); p.w = pk2(x[8 * s + 6], x[8 * s + 7]);
  return __builtin_bit_cast(bf16x8, p);
}
DI f32x16 zero16() { f32x16 z; for (int i = 0; i < 16; ++i) z[i] = 0.f; return z; }

#define XB_TMO      128
#define XB_XCNT(j)  (256  + 64 * (j))
#define XB_XSUB(j)  (1280 + 64 * (j))
#define XB_XGEN(j)  (2304 + 64 * (j))
#define XB_TOP      3328
#define XB_TOPGEN   3392
#define XCD_BAR_WORDS 3456
#define XB_SPIN_CAP (1u << 24)
#define LAS __attribute__((address_space(3)))
DI unsigned xb_ld(unsigned* p) { return __hip_atomic_load(p, __ATOMIC_RELAXED, __HIP_MEMORY_SCOPE_AGENT); }
DI unsigned xb_add(unsigned* p, unsigned v) { return __hip_atomic_fetch_add(p, v, __ATOMIC_RELAXED, __HIP_MEMORY_SCOPE_AGENT); }
DI unsigned xb_xcc_id() { return (unsigned)__builtin_amdgcn_s_getreg((3 << 11) | 20) & 0xFu; }
#define XB_SPIN(cond, bar) do { unsigned _sp = 0; while (cond) { __builtin_amdgcn_s_sleep(1); \
    if ((++_sp & 255u) == 0u) { if (xb_ld(&(bar)[XB_TMO])) break; if (_sp > XB_SPIN_CAP) { atomicAdd(&(bar)[XB_TMO], 1u); break; } } } } while (0)
struct XcdBarrier { unsigned* bar; unsigned x; volatile LAS unsigned* st; };
DI XcdBarrier xcd_barrier_post(unsigned* bar, volatile LAS unsigned* st) {
  XcdBarrier b; b.bar = bar; b.x = xb_xcc_id(); b.st = st;
  if (threadIdx.x == 0) (void)xb_add(&bar[XB_XCNT(b.x)], 1u);
  return b;
}
DI void xcd_barrier_complete(unsigned* bar, unsigned x, unsigned& nloc, unsigned& nx) {
  const unsigned G = gridDim.x * gridDim.y * gridDim.z;
  unsigned sum, cnt, mine, sp = 0u;
  for (;;) {
    sum = 0u; cnt = 0u; mine = 0u;
#pragma unroll
    for (unsigned j = 0; j < 16; ++j) { const unsigned c = xb_ld(&bar[XB_XCNT(j)]); sum += c; cnt += (c > 0u) ? 1u : 0u; mine = (j == x) ? c : mine; }
    if (sum == G) break;
    __builtin_amdgcn_s_sleep(1);
    if ((++sp & 255u) == 0u) { if (xb_ld(&bar[XB_TMO])) break; if (sp > XB_SPIN_CAP) { atomicAdd(&bar[XB_TMO], 1u); break; } }
  }
  nloc = mine > 0u ? mine : 1u; nx = cnt > 0u ? cnt : 1u;
}
DI void xcd_barrier(const XcdBarrier& b) {
  asm volatile("s_waitcnt vmcnt(0)" ::: "memory");
  __syncthreads();
  if (threadIdx.x == 0) {
    unsigned* bar = b.bar;
    __builtin_amdgcn_s_waitcnt(0);
    unsigned nloc = b.st[0], nx = b.st[1];
    if (nloc == 0u) { xcd_barrier_complete(bar, b.x, nloc, nx); b.st[0] = nloc; b.st[1] = nx; }
    const unsigned old = xb_add(&bar[XB_XSUB(b.x)], 1u);
    const unsigned gen = old / nloc;
    if (old + 1u == (gen + 1u) * nloc) {
      __builtin_amdgcn_fence(__ATOMIC_RELEASE, "agent");
      asm volatile("s_waitcnt vmcnt(0)" ::: "memory");
      const unsigned og = xb_add(&bar[XB_TOP], 1u);
      const unsigned tg = og / nx;
      if (og + 1u == (tg + 1u) * nx) xb_add(&bar[XB_TOPGEN], 1u);
      else XB_SPIN(xb_ld(&bar[XB_TOPGEN]) == tg, bar);
      __builtin_amdgcn_fence(__ATOMIC_ACQUIRE, "agent");
      xb_add(&bar[XB_XGEN(b.x)], 1u);
      asm volatile("s_waitcnt vmcnt(0)" ::: "memory");
    } else {
      XB_SPIN(xb_ld(&bar[XB_XGEN(b.x)]) == gen, bar);
      __builtin_amdgcn_fence(__ATOMIC_ACQUIRE, "agent");
      asm volatile("s_waitcnt vmcnt(0)" ::: "memory");
    }
  }
  __syncthreads();
}

constexpr int HTB = 128 * 64 * 2;
DI int lds_byte(int r, int c) { const int st = (r >> 4) * 2 + (c >> 5), rr = r & 15, cc = c & 31, ob = rr * 64 + cc * 2; return st * 1024 + (ob ^ (((ob >> 9) & 1) << 5)); }
DI void stage_rc(int b, int& Rr, int& Cc) { const int st = b / 1024, sb = b % 1024, swz = sb ^ (((sb >> 9) & 1) << 5); Rr = (st >> 1) * 16 + swz / 64; Cc = (st & 1) * 32 + (swz % 64) / 2; }
DI void gemm256(f32x4 (&acc)[2][2][4][2], const u16* __restrict__ A, const int lda, const u16* __restrict__ Bt, const int ldb,
                const int brow, const int bcol, const int K, char* shm) {
#define SA(b, h) (shm + ((b) * 2 + (h)) * HTB)
#define SB(b, h) (shm + (4 + (b) * 2 + (h)) * HTB)
#define STAGE_A(P, br, kt) do { const char* _u = (const char*)A + ((size_t)(br) * lda + (size_t)(kt) * 64) * 2; \
    __builtin_amdgcn_global_load_lds((const unsigned*)(_u + voA0), (unsigned*)((char*)(P) + sb0), 16, 0, 0); \
    __builtin_amdgcn_global_load_lds((const unsigned*)(_u + voA1), (unsigned*)((char*)(P) + sb1), 16, 0, 0); } while (0)
#define STAGE_B(P, br, kt) do { const char* _u = (const char*)Bt + ((size_t)(br) * ldb + (size_t)(kt) * 64) * 2; \
    __builtin_amdgcn_global_load_lds((const unsigned*)(_u + voB0), (unsigned*)((char*)(P) + sb0), 16, 0, 0); \
    __builtin_amdgcn_global_load_lds((const unsigned*)(_u + voB1), (unsigned*)((char*)(P) + sb1), 16, 0, 0); } while (0)
#define LDA(dst, b, h) _Pragma("unroll") for (int m = 0; m < 4; ++m) _Pragma("unroll") for (int k = 0; k < 2; ++k) \
    dst[m][k] = *reinterpret_cast<const bf16x8*>((char*)SA(b, h) + lds_byte(wr * 64 + m * 16 + fr, k * 32 + fq * 8))
#define LDB(dst, b, h) _Pragma("unroll") for (int n = 0; n < 2; ++n) _Pragma("unroll") for (int k = 0; k < 2; ++k) \
    dst[n][k] = *reinterpret_cast<const bf16x8*>((char*)SB(b, h) + lds_byte(wc * 32 + n * 16 + fr, k * 32 + fq * 8))
#define MMA(ai, bj, At_, Bt_) do { __builtin_amdgcn_s_setprio(1); \
    _Pragma("unroll") for (int m = 0; m < 4; ++m) _Pragma("unroll") for (int n = 0; n < 2; ++n) _Pragma("unroll") for (int k = 0; k < 2; ++k) \
      acc[ai][bj][m][n] = __builtin_amdgcn_mfma_f32_16x16x32_bf16(Bt_[n][k], At_[m][k], acc[ai][bj][m][n], 0, 0, 0); \
    __builtin_amdgcn_s_setprio(0); } while (0)
#define WAIT_V(n) asm volatile("s_waitcnt vmcnt(" #n ")" ::: "memory")
#define WAIT_L(n) asm volatile("s_waitcnt lgkmcnt(" #n ")" ::: "memory")
#define BAR __builtin_amdgcn_s_barrier()
#define SCHED __builtin_amdgcn_sched_barrier(0)
  int t_ = threadIdx.x;
  asm volatile("" : "+v"(t_));
  const int wid = __builtin_amdgcn_readfirstlane(t_ >> 6), lane = t_ & 63, wr = wid >> 2, wc = wid & 3, fr = lane & 15, fq = lane >> 4;
  const int sb0 = t_ * 16, sb1 = sb0 + 8192;
  int sr0, sc0, sr1, sc1; stage_rc(sb0, sr0, sc0); stage_rc(sb1, sr1, sc1);
  const unsigned voA0 = (unsigned)(sr0 * lda + sc0) * 2u, voA1 = (unsigned)(sr1 * lda + sc1) * 2u;
  const unsigned voB0 = (unsigned)(sr0 * ldb + sc0) * 2u, voB1 = (unsigned)(sr1 * ldb + sc1) * 2u;
  bf16x8 At[4][2], B0[2][2], B1[2][2];
  const int nt = K / 64;
  STAGE_B(SB(0, 0), bcol, 0); STAGE_A(SA(0, 0), brow, 0);
  STAGE_B(SB(0, 1), bcol + 128, 0); STAGE_A(SA(0, 1), brow + 128, 0);
  if (wr == 1) BAR;
  WAIT_V(4); BAR;
  STAGE_B(SB(1, 0), bcol, 1); STAGE_A(SA(1, 0), brow, 1); STAGE_B(SB(1, 1), bcol + 128, 1);
  WAIT_V(6); BAR;
  for (int t = 0; t < nt - 2; t += 2) {
    LDB(B0, 0, 0); SCHED; LDA(At, 0, 0); STAGE_A(SA(1, 1), brow + 128, t + 1);
    WAIT_L(8); BAR; WAIT_L(0); MMA(0, 0, At, B0); BAR; SCHED;
    LDB(B1, 0, 1); STAGE_B(SB(0, 0), bcol, t + 2);
    BAR; WAIT_L(0); MMA(0, 1, At, B1); BAR;
    LDA(At, 0, 1); STAGE_A(SA(0, 0), brow, t + 2);
    BAR; WAIT_L(0); MMA(1, 0, At, B0); BAR; SCHED;
    STAGE_B(SB(0, 1), bcol + 128, t + 2);
    WAIT_V(6); BAR; MMA(1, 1, At, B1); BAR;
    LDB(B0, 1, 0); SCHED; LDA(At, 1, 0); STAGE_A(SA(0, 1), brow + 128, t + 2);
    WAIT_L(8); BAR; WAIT_L(0); MMA(0, 0, At, B0); BAR; SCHED;
    LDB(B1, 1, 1); STAGE_B(SB(1, 0), bcol, t + 3);
    BAR; WAIT_L(0); MMA(0, 1, At, B1); BAR;
    LDA(At, 1, 1); STAGE_A(SA(1, 0), brow, t + 3);
    BAR; WAIT_L(0); MMA(1, 0, At, B0); BAR; SCHED;
    STAGE_B(SB(1, 1), bcol + 128, t + 3);
    WAIT_V(6); BAR; MMA(1, 1, At, B1); BAR;
  }
  { LDB(B0, 0, 0); LDA(At, 0, 0); STAGE_A(SA(1, 1), brow + 128, nt - 1);
    BAR; WAIT_L(0); MMA(0, 0, At, B0); BAR;
    LDB(B1, 0, 1); BAR; WAIT_L(0); MMA(0, 1, At, B1); BAR;
    LDA(At, 0, 1); WAIT_V(4); BAR; WAIT_L(0); MMA(1, 0, At, B0); MMA(1, 1, At, B1); BAR; }
  { LDB(B0, 1, 0); LDA(At, 1, 0); WAIT_V(2); BAR; WAIT_L(0); MMA(0, 0, At, B0); BAR;
    LDB(B1, 1, 1); WAIT_V(0); BAR; WAIT_L(0); MMA(0, 1, At, B1); BAR;
    LDA(At, 1, 1); BAR; WAIT_L(0); MMA(1, 0, At, B0); MMA(1, 1, At, B1); BAR; }
  if (wr == 0) BAR;
#undef SA
#undef SB
#undef STAGE_A
#undef STAGE_B
#undef LDA
#undef LDB
#undef MMA
}
DI void zero_acc(f32x4 (&acc)[2][2][4][2]) {
#pragma unroll
  for (int a = 0; a < 2; ++a)
#pragma unroll
    for (int b = 0; b < 2; ++b)
#pragma unroll
      for (int m = 0; m < 4; ++m)
#pragma unroll
        for (int n = 0; n < 2; ++n) acc[a][b][m][n] = (f32x4){0.f, 0.f, 0.f, 0.f};
}
template <class F> DI void tile_apply(const f32x4 (&acc)[2][2][4][2], int brow, int bcol, F f) {
  int t_ = threadIdx.x;
  asm volatile("" : "+v"(t_));
  const int wid = t_ >> 6, lane = t_ & 63, wr = wid >> 2, wc = wid & 3, fr = lane & 15, fq = lane >> 4;
#pragma unroll
  for (int ai = 0; ai < 2; ++ai)
#pragma unroll
    for (int m = 0; m < 4; ++m) {
      const int row = brow + ai * 128 + wr * 64 + m * 16 + fr;
#pragma unroll
      for (int bj = 0; bj < 2; ++bj)
#pragma unroll
        for (int n = 0; n < 2; ++n) f(row, bcol + bj * 128 + wc * 32 + n * 16 + 4 * fq, acc[ai][bj][m][n]);
      __builtin_amdgcn_sched_barrier(0);
    }
}
constexpr int TLD = 132;
template <class F> DI void tile_epilogue(const f32x4 (&acc)[2][2][4][2], int brow, int bcol, char* shm, F f) {
  int t_ = threadIdx.x;
  asm volatile("" : "+v"(t_));
  const int wid = t_ >> 6, lane = t_ & 63, wr = wid >> 2, wc = wid & 3, fr = lane & 15, fq = lane >> 4;
  float* T = (float*)shm;
#pragma unroll
  for (int bj = 0; bj < 2; ++bj) {
#pragma unroll
    for (int ai = 0; ai < 2; ++ai)
#pragma unroll
      for (int m = 0; m < 4; ++m)
#pragma unroll
        for (int n = 0; n < 2; ++n)
          *(f32x4*)(T + (ai * 128 + wr * 64 + m * 16 + fr) * TLD + wc * 32 + n * 16 + 4 * fq) = acc[ai][bj][m][n];
    __syncthreads();
    const int cg = (t_ & 31) * 4, r0 = t_ >> 5;
#pragma unroll 4
    for (int i = 0; i < 16; ++i) {
      const int rl = r0 + 16 * i;
      const f32x4 v = *(const f32x4*)(T + rl * TLD + cg);
      f(brow + rl, bcol + bj * 128 + cg, v);
    }
    __syncthreads();
  }
}
template <class F> DI void gemm_pass(const u16* A, int lda, const u16* Bt, int ldb, int N, int K, char* shm, F f) {
  const int nN = N >> 8, nunits = 64 * nN;
  for (int u = blockIdx.x; u < nunits; u += gridDim.x) {
    const int pm = u % 64, pn = u / 64;
    f32x4 acc[2][2][4][2];
    zero_acc(acc);
    gemm256(acc, A, lda, Bt, ldb, pm * 256, pn * 256, K, shm);
    tile_epilogue(acc, pm * 256, pn * 256, shm, f);
  }
}
template <int NTL, class CM, class E> DI void skinny(const u16* __restrict__ A, int lda, int row0, int nrows, const u16* __restrict__ Bt, int ldb, int K, CM cm, E epi) {
  int t_ = threadIdx.x;
  asm volatile("" : "+v"(t_));
  const int wid = t_ >> 6, lane = t_ & 63, fr = lane & 15, fq = lane >> 4;
  for (int mt = wid; mt * 16 < nrows; mt += 8) {
    int rr = mt * 16 + fr; const bool valid = rr < nrows; if (!valid) rr = nrows - 1;
    const u16* ap = A + (size_t)(row0 + rr) * lda + 8 * fq;
#pragma unroll
    for (int ntl = 0; ntl < NTL; ++ntl) {
      const u16* bp = Bt + (size_t)cm(ntl * 16 + fr) * ldb + 8 * fq;
      f32x4 acc = {0.f, 0.f, 0.f, 0.f};
#pragma unroll 16
      for (int ks = 0; ks < (K >> 5); ++ks) {
        const bf16x8 a = *(const bf16x8*)(ap + ks * 32);
        const bf16x8 b = *(const bf16x8*)(bp + ks * 32);
        acc = __builtin_amdgcn_mfma_f32_16x16x32_bf16(b, a, acc, 0, 0, 0);
      }
      if (valid) epi(row0 + rr, ntl, fq, acc, lane);
    }
  }
}
DI int map_in(int n) {
  if (n < 1024) { const int pn = n >> 8, c = n & 255; return c < 128 ? (pn * 128 + c) : (512 + pn * 128 + c - 128); }
  return n;
}
DI void phase_convert(const Params& p, char* smem) {
  float* tile = (float*)smem;
  const int tid = threadIdx.x;
  constexpr int NJ = 10;
  constexpr int pre[NJ + 1] = {0, 1024, 1280, 1536, 1792, 1920, 2176, 2432, 3456, 4480, 6016};
  for (int t = blockIdx.x; t < 6016; t += gridDim.x) {
    int j = 0, base = 0;
#pragma unroll
    for (int q = 1; q < NJ; ++q) if (t >= pre[q]) { j = q; base = pre[q]; }
    const int lt = t - base;
    const float* src; int ld, K; u16* dst; int moff = 0; int ldd = 0;
    switch (j) {
      case 0: src = p.w_in; ld = 7184; K = 1024; dst = (u16*)(p.ws + OFF_WIN); break;
      case 1: src = p.w_in; ld = 7184; K = 1024; dst = (u16*)(p.ws + OFF_WZ); moff = 4096; break;
      case 2: src = p.w_in; ld = 7184; K = 1024; dst = (u16*)(p.ws + OFF_WGA); moff = 5136; break;
      case 3: src = p.w_in; ld = 7184; K = 1024; dst = (u16*)(p.ws + OFF_WGB); moff = 6160; break;
      case 4: src = p.w_conf_out; ld = 1024; K = 512; dst = (u16*)(p.ws + OFF_WCONF); break;
      case 5: src = p.w_gdn_out; ld = 1024; K = 1024; dst = (u16*)(p.ws + OFF_WGDN); break;
      case 6: src = p.w_o; ld = 1024; K = 1024; dst = (u16*)(p.ws + OFF_WO); break;
      case 7: src = p.w_ff1; ld = 4096; K = 1024; dst = (u16*)(p.ws + OFF_W1); break;
      case 8: src = p.w_ff2; ld = 1024; K = 4096; dst = (u16*)(p.ws + OFF_W2); ldd = LDF; break;
      default: src = p.w_ada; ld = 6144; K = 1024; dst = (u16*)(p.ws + OFF_WADA); break;
    }
    const int nkt = K >> 6;
    const int n0 = (lt / nkt) * 64, k0 = (lt % nkt) * 64;
    {
      const int nn = tid & 63, ty = tid >> 6;
      const int sc = (j == 0) ? map_in(n0 + nn) : (n0 + nn + moff);
#pragma unroll
      for (int i = 0; i < 8; ++i) {
        const int kk = ty + 8 * i;
        tile[kk * 65 + nn] = src[(size_t)(k0 + kk) * ld + sc];
      }
    }
    __syncthreads();
    {
      const int nn = tid >> 3, kq = (tid & 7) * 8;
      uint4 o0;
      const float* tp = tile + kq * 65 + nn;
      o0.x = pk2(tp[0 * 65], tp[1 * 65]);  o0.y = pk2(tp[2 * 65], tp[3 * 65]);
      o0.z = pk2(tp[4 * 65], tp[5 * 65]);  o0.w = pk2(tp[6 * 65], tp[7 * 65]);
      *(uint4*)(dst + (size_t)(n0 + nn) * (ldd ? ldd : K) + k0 + kq) = o0;
    }
    __syncthreads();
  }
  u16* Ac = (u16*)(p.ws + OFF_AC);
  for (int e = blockIdx.x * NT + tid; e < 256 * 256; e += gridDim.x * NT) {
    const int row = e >> 8, c4 = (e & 255) * 4;
    float4 v = make_float4(0.f, 0.f, 0.f, 0.f);
    if (row < 8) v = *(const float4*)(p.c_prompt + row * 1024 + c4);
    else if (row < 136) v = *(const float4*)(p.c_sample + (row - 8) * 1024 + c4);
    uint2 o; o.x = pk2(siluf_(v.x), siluf_(v.y)); o.y = pk2(siluf_(v.z), siluf_(v.w));
    *(uint2*)(Ac + row * 1024 + c4) = o;
  }
}

constexpr int WBA_LD = 1028;
template <bool BA> DI void phase_modnorm(const Params& p, const float* xa, const float* xb, const float* nw, int shift_off, int scale_off, u16* dst, char* smem) {
  int tmn = threadIdx.x;
  asm volatile("" : "+v"(tmn));
  const int lane = tmn & 63;
  const int gw = blockIdx.x * 8 + (tmn >> 6), nw_ = gridDim.x * 8;
  const float* mod = (const float*)(p.ws + OFF_MOD);
  float* wba = (float*)smem;
  if (BA) {
    for (int e = threadIdx.x; e < 16384; e += NT) { const int c = e >> 4, j = e & 15; wba[j * WBA_LD + c] = p.w_in[(size_t)c * 7184 + 5120 + j]; }
    __syncthreads();
  }
  float* gb = (float*)(p.ws + OFF_GB);
  for (int row = gw; row < R; row += nw_) {
    const float* xr = row < RP ? xa + (size_t)row * 1024 : xb + (size_t)(row - RP) * 1024;
    float4 v[4]; float ss = 0.f;
#pragma unroll
    for (int i = 0; i < 4; ++i) { v[i] = *(const float4*)(xr + (lane + 64 * i) * 4); ss += v[i].x * v[i].x + v[i].y * v[i].y + v[i].z * v[i].z + v[i].w * v[i].w; }
    ss = wsum(ss);
    const float rstd = rsqrtf(ss * (1.f / 1024.f) + EPS);
    const float* mr = mod + (size_t)mrow_of(row) * 6144;
    float ba[16];
    if (BA) {
#pragma unroll
      for (int j = 0; j < 16; ++j) ba[j] = 0.f;
    }
#pragma unroll
    for (int i = 0; i < 4; ++i) {
      const int c = (lane + 64 * i) * 4;
      const float4 w = *(const float4*)(nw + c), sc = *(const float4*)(mr + scale_off + c), sh = *(const float4*)(mr + shift_off + c);
      const float h0 = v[i].x * rstd * w.x * (1.f + sc.x) + sh.x, h1 = v[i].y * rstd * w.y * (1.f + sc.y) + sh.y;
      const float h2 = v[i].z * rstd * w.z * (1.f + sc.z) + sh.z, h3 = v[i].w * rstd * w.w * (1.f + sc.w) + sh.w;
      uint2 o; o.x = pk2(h0, h1); o.y = pk2(h2, h3);
      *(uint2*)(dst + (size_t)row * 1024 + c) = o;
      if (BA) {
#pragma unroll
        for (int j = 0; j < 16; ++j) { const float4 ww = *(const float4*)(wba + j * WBA_LD + c); ba[j] += h0 * ww.x + h1 * ww.y + h2 * ww.z + h3 * ww.w; }
        __builtin_amdgcn_sched_barrier(0);
      }
    }
    if (BA) {
#pragma unroll
      for (int w = 8; w >= 1; w >>= 1) {
        const bool up = (lane & w) != 0;
#pragma unroll
        for (int j = 0; j < w; ++j) {
          const float keep = up ? ba[j + w] : ba[j];
          const float send = up ? ba[j] : ba[j + w];
          ba[j] = keep + __shfl_xor(send, w, 64);
        }
      }
      float tot = ba[0];
      tot += __shfl_xor(tot, 16, 64); tot += __shfl_xor(tot, 32, 64);
      if (lane < 8) gb[(size_t)row * 16 + lane] = sigmoidf_(tot);
      else if (lane < 16) gb[(size_t)row * 16 + lane] = -__expf(p.a_log[lane - 8]) * softplusf_(tot + p.dt_bias[lane - 8]);
    }
  }
  if (BA) __syncthreads();
}

constexpr int LKN = 136, LKT = 72;
DI void d1_item(const Params& p, int item, char* smem) {
  int tid = threadIdx.x & 255;
  asm volatile("" : "+v"(tid));
  const int lane = tid & 63, wave = __builtin_amdgcn_readfirstlane(tid >> 6);
  const int r = lane & 31, hh = lane >> 5;
  const int h = item & 7, n = (item >> 3) & 31, b = item >> 8;
  const int rowbase = b * 2048 + n * 64;
  u16* kn  = (u16*)smem;
  u16* qn  = (u16*)(smem + 17408);
  u16* knT = (u16*)(smem + 34816);
  u16* vT  = (u16*)(smem + 53248);
  float* Gs = (float*)(smem + 71680);
  float* Bs = Gs + 64;
  float* Amat = (float*)(smem + 17408);
  u16* Tb = (u16*)smem;
  u16* Tg = (u16*)(smem + 17408);
  u16* qkv = (u16*)(p.ws + OFF_QKV);
  const u16* halo = (const u16*)(p.ws + OFF_HALO);
  const float* gb = (const float*)(p.ws + OFF_GB);

  if (wave == 0) {
    float g = gb[(size_t)(rowbase + lane) * 16 + 8 + h];
    const float be = gb[(size_t)(rowbase + lane) * 16 + h];
#pragma unroll
    for (int m = 1; m < 64; m <<= 1) { float t = __shfl_up(g, m, 64); if (lane >= m) g += t; }
    Gs[lane] = g; Bs[lane] = be;
  }
  {
    const int cp = lane;
#pragma unroll
    for (int X = 0; X < 3; ++X) {
      const int cb = X * 1024 + h * 128 + 2 * cp;
      float w[4][2];
#pragma unroll
      for (int j = 0; j < 4; ++j) { float2 t = *(const float2*)(p.gdn_conv_w + j * 3072 + cb); w[j][0] = t.x; w[j][1] = t.y; }
      float xw[3][2];
#pragma unroll
      for (int j = 0; j < 3; ++j) {
        const int rr = wave * 16 - 3 + j;
        unsigned u = 0u;
        if (rr >= 0) u = *(const unsigned*)(qkv + (size_t)(rowbase + rr) * 3072 + cb);
        else if (n > 0) u = *(const unsigned*)(halo + ((size_t)((b * 32 + n - 1) * 3 + (rr + 3))) * 3072 + cb);
        xw[j][0] = bf_lo(u); xw[j][1] = bf_hi(u);
      }
      float o[16][2];
#pragma unroll
      for (int t = 0; t < 16; ++t) {
        const unsigned u = *(const unsigned*)(qkv + (size_t)(rowbase + wave * 16 + t) * 3072 + cb);
        const float x0 = bf_lo(u), x1 = bf_hi(u);
        const float a0 = w[0][0] * xw[0][0] + w[1][0] * xw[1][0] + w[2][0] * xw[2][0] + w[3][0] * x0;
        const float a1 = w[0][1] * xw[0][1] + w[1][1] * xw[1][1] + w[2][1] * xw[2][1] + w[3][1] * x1;
        o[t][0] = siluf_(a0); o[t][1] = siluf_(a1);
        xw[0][0] = xw[1][0]; xw[0][1] = xw[1][1]; xw[1][0] = xw[2][0]; xw[1][1] = xw[2][1]; xw[2][0] = x0; xw[2][1] = x1;
      }
      if (X < 2) {
#pragma unroll
        for (int t = 0; t < 16; ++t) {
          const float ss = wsum(o[t][0] * o[t][0] + o[t][1] * o[t][1]);
          const float rs = rsqrtf(ss + EPS);
          o[t][0] *= rs; o[t][1] *= rs;
        }
      }
#pragma unroll
      for (int t = 0; t < 16; ++t) {
        const int row = wave * 16 + t;
        const unsigned pk = pk2(o[t][0], o[t][1]);
        if (X == 0) { *(unsigned*)(qn + row * LKN + 2 * cp) = pk; }
        else if (X == 1) {
          *(unsigned*)(kn + row * LKN + 2 * cp) = pk;
          knT[(2 * cp) * LKT + row] = (u16)(pk & 0xffffu); knT[(2 * cp + 1) * LKT + row] = (u16)(pk >> 16);
        } else {
          vT[(2 * cp) * LKT + row] = (u16)(pk & 0xffffu); vT[(2 * cp + 1) * LKT + row] = (u16)(pk >> 16);
        }
      }
    }
  }
  __syncthreads();
  const float Glast = Gs[63];
#pragma unroll
  for (int ff = 0; ff < 4; ++ff) {
    const int f = wave * 4 + ff;
    const int it = f >> 3, kb = (f >> 1) & 3, s = f & 1;
    const int i = it * 32 + r;
    const float sc = QSCALE * __expf(Gs[i]);
    const uint2 a = *(const uint2*)(qn + i * LKN + kb * 32 + 16 * s + 4 * hh);
    const uint2 c = *(const uint2*)(qn + i * LKN + kb * 32 + 16 * s + 4 * hh + 8);
    uint4 o;
    o.x = pk2(bf_lo(a.x) * sc, bf_hi(a.x) * sc); o.y = pk2(bf_lo(a.y) * sc, bf_hi(a.y) * sc);
    o.z = pk2(bf_lo(c.x) * sc, bf_hi(c.x) * sc); o.w = pk2(bf_lo(c.y) * sc, bf_hi(c.y) * sc);
    *(uint4*)((char*)qkv + (size_t)(rowbase + 4 * f + (lane >> 4)) * 6144 + h * 256 + (lane & 15) * 16) = o;
  }
  char* ext = p.ws + OFF_EXTRA + (size_t)item * 24576;
#pragma unroll
  for (int ff = 0; ff < 4; ++ff) {
    const int f = wave * 4 + ff;
    const int kt = f >> 2, pb = (f >> 1) & 1, s = f & 1;
    const int k = kt * 32 + r;
    const int p0 = pb * 32 + 16 * s + 4 * hh;
    const uint2 a = *(const uint2*)(knT + k * LKT + p0);
    const uint2 c = *(const uint2*)(knT + k * LKT + p0 + 8);
    const float4 g0 = *(const float4*)(Gs + p0), g1 = *(const float4*)(Gs + p0 + 8);
    uint4 o;
    o.x = pk2(bf_lo(a.x) * __expf(Glast - g0.x), bf_hi(a.x) * __expf(Glast - g0.y));
    o.y = pk2(bf_lo(a.y) * __expf(Glast - g0.z), bf_hi(a.y) * __expf(Glast - g0.w));
    o.z = pk2(bf_lo(c.x) * __expf(Glast - g1.x), bf_hi(c.x) * __expf(Glast - g1.y));
    o.w = pk2(bf_lo(c.y) * __expf(Glast - g1.z), bf_hi(c.y) * __expf(Glast - g1.w));
    *(uint4*)(ext + f * 1024 + lane * 16) = o;
  }
  f32x16 akk = zero16(), aqk = zero16();
  const int ta = (wave == 0) ? 0 : 1, tb = (wave == 2) ? 1 : 0;
  if (wave < 3) {
#pragma unroll
    for (int ks = 0; ks < 8; ++ks) {
      const bf16x8 fa = *(const bf16x8*)(kn + (ta * 32 + r) * LKN + ks * 16 + 8 * hh);
      const bf16x8 fb = *(const bf16x8*)(kn + (tb * 32 + r) * LKN + ks * 16 + 8 * hh);
      const bf16x8 fq = *(const bf16x8*)(qn + (ta * 32 + r) * LKN + ks * 16 + 8 * hh);
      akk = MFMA(fa, fb, akk);
      aqk = MFMA(fb, fq, aqk);
    }
  }
  __syncthreads();
  if (wave < 3) {
    const int m = tb * 32 + r; const float Gm = Gs[m];
#pragma unroll
    for (int reg = 0; reg < 16; ++reg) {
      const int i = ta * 32 + crow(reg, hh);
      const float v = (m < i) ? Bs[i] * akk[reg] * __expf(Gs[i] - Gm) : 0.f;
      Amat[i * 64 + m] = v;
    }
    const int i = ta * 32 + r; const float Gi = Gs[i];
    f32x16 av;
#pragma unroll
    for (int reg = 0; reg < 16; ++reg) {
      const int j = tb * 32 + crow(reg, hh);
      av[reg] = (j <= i) ? aqk[reg] * QSCALE * __expf(Gi - Gs[j]) : 0.f;
    }
    const int fbase = 16 + (wave * 2);
#pragma unroll
    for (int s = 0; s < 2; ++s) {
      bf16x8 fr8 = pack8(av, s);
      *(bf16x8*)(ext + (fbase + s) * 1024 + lane * 16) = fr8;
    }
  } else {
    for (int e = lane; e < 32 * 32; e += 64) Amat[(e >> 5) * 64 + 32 + (e & 31)] = 0.f;
    if (lane == 0) *(float*)(ext + 22 * 1024) = __expf(Glast);
  }
  __syncthreads();
  float* Tq = (float*)(smem + 9216);
  if (wave == 0) {
    float x[32];
    const int c = lane & 31, hb = lane >> 5;
    const float* Ab = Amat + (hb * 32) * 64 + hb * 32;
#pragma unroll
    for (int i = 0; i < 32; ++i) {
      float s0 = (c == i) ? 1.f : 0.f, s1 = 0.f;
#pragma unroll
      for (int m4 = 0; m4 < (i + 3) / 4; ++m4) {
        const float4 a4 = *(const float4*)(Ab + i * 64 + m4 * 4);
        if (m4 * 4 + 0 < i) s0 -= a4.x * x[m4 * 4 + 0];
        if (m4 * 4 + 1 < i) s1 -= a4.y * x[m4 * 4 + 1];
        if (m4 * 4 + 2 < i) s0 -= a4.z * x[m4 * 4 + 2];
        if (m4 * 4 + 3 < i) s1 -= a4.w * x[m4 * 4 + 3];
      }
      x[i] = s0 + s1;
      __builtin_amdgcn_sched_barrier(0);
    }
#pragma unroll
    for (int i = 0; i < 32; ++i) Tq[hb * 1024 + i * 32 + c] = x[i];
  }
  __syncthreads();
  const int c32 = tid & 31, g8 = tid >> 5;
  {
    float bm[4] = {0.f, 0.f, 0.f, 0.f};
#pragma unroll
    for (int j4 = 0; j4 < 8; ++j4) {
      float t[4];
#pragma unroll
      for (int e = 0; e < 4; ++e) t[e] = Tq[(j4 * 4 + e) * 32 + c32];
#pragma unroll
      for (int e = 0; e < 4; ++e) {
        const float4 a4 = *(const float4*)(Amat + (32 + g8 * 4 + e) * 64 + j4 * 4);
        bm[e] += a4.x * t[0] + a4.y * t[1] + a4.z * t[2] + a4.w * t[3];
      }
    }
#pragma unroll
    for (int e = 0; e < 4; ++e) Amat[(g8 * 4 + e) * 64 + 32 + c32] = bm[e];
  }
  __syncthreads();
  float t21[4] = {0.f, 0.f, 0.f, 0.f};
  {
#pragma unroll
    for (int m4 = 0; m4 < 8; ++m4) {
      float bv[4];
#pragma unroll
      for (int e = 0; e < 4; ++e) bv[e] = Amat[(m4 * 4 + e) * 64 + 32 + c32];
#pragma unroll
      for (int e = 0; e < 4; ++e) {
        const float4 a4 = *(const float4*)(Tq + 1024 + (g8 * 4 + e) * 32 + m4 * 4);
        t21[e] -= a4.x * bv[0] + a4.y * bv[1] + a4.z * bv[2] + a4.w * bv[3];
      }
    }
  }
  float t11[4], t22[4];
#pragma unroll
  for (int e = 0; e < 4; ++e) { t11[e] = Tq[(g8 * 4 + e) * 32 + c32]; t22[e] = Tq[1024 + (g8 * 4 + e) * 32 + c32]; }
  const float bcl = Bs[c32], bgl = bcl * __expf(Gs[c32]);
  const float bch = Bs[32 + c32], bgh = bch * __expf(Gs[32 + c32]);
  __syncthreads();
#pragma unroll
  for (int e = 0; e < 4; ++e) {
    const int i = g8 * 4 + e;
    Tb[i * LKT + c32] = f2bf(t11[e] * bcl);               Tg[i * LKT + c32] = f2bf(t11[e] * bgl);
    Tb[i * LKT + 32 + c32] = (u16)0;                      Tg[i * LKT + 32 + c32] = (u16)0;
    Tb[(32 + i) * LKT + c32] = f2bf(t21[e] * bcl);        Tg[(32 + i) * LKT + c32] = f2bf(t21[e] * bgl);
    Tb[(32 + i) * LKT + 32 + c32] = f2bf(t22[e] * bch);   Tg[(32 + i) * LKT + 32 + c32] = f2bf(t22[e] * bgh);
  }
  __syncthreads();
#pragma unroll
  for (int it = 0; it < 2; ++it) {
    f32x16 av = zero16(), ak = zero16();
#pragma unroll
    for (int ks = 0; ks < 4; ++ks) {
      const bf16x8 fT = *(const bf16x8*)(Tb + (it * 32 + r) * LKT + ks * 16 + 8 * hh);
      const bf16x8 fV = *(const bf16x8*)(vT + (wave * 32 + r) * LKT + ks * 16 + 8 * hh);
      const bf16x8 fK = *(const bf16x8*)(knT + (wave * 32 + r) * LKT + ks * 16 + 8 * hh);
      const bf16x8 fG = *(const bf16x8*)(Tg + (it * 32 + r) * LKT + ks * 16 + 8 * hh);
      av = MFMA(fT, fV, av);
      ak = MFMA(fK, fG, ak);
    }
    {
      const int fv = wave * 2 + it;
      char* d = (char*)qkv + (size_t)(rowbase + 8 * fv + (lane >> 3)) * 6144 + 4096 + h * 256 + (lane & 7) * 32;
      *(bf16x8*)d = pack8(av, 0); *(bf16x8*)(d + 16) = pack8(av, 1);
    }
#pragma unroll
    for (int s = 0; s < 2; ++s) {
      const int f = it * 8 + wave * 2 + s;
      *(bf16x8*)((char*)qkv + (size_t)(rowbase + 4 * f + (lane >> 4)) * 6144 + 2048 + h * 256 + (lane & 15) * 16) = pack8(ak, s);
    }
  }
  __syncthreads();
}

DI void d2_issue(u32x4 (&rg)[18], const Params& p, int b, int h, int lt, int n) {
  const char* qseg = p.ws + OFF_QKV + (size_t)(b * 2048 + n * 64) * 6144 + h * 256;
  const char* ext = p.ws + OFF_EXTRA + (size_t)((b * 32 + n) * 8 + h) * 24576;
#pragma unroll
  for (int sg = 0; sg < 3; ++sg)
#pragma unroll
    for (int i = 0; i < 4; ++i) rg[sg * 4 + i] = *(const u32x4*)(qseg + (size_t)((lt >> 4) + 16 * i) * 6144 + sg * 2048 + (lt & 15) * 16);
#pragma unroll
  for (int i = 0; i < 6; ++i) rg[12 + i] = *(const u32x4*)(ext + lt * 16 + i * 4096);
}
DI void d2_put(const u32x4 (&rg)[18], char* buf, int lt) {
#pragma unroll
  for (int sg = 0; sg < 3; ++sg)
#pragma unroll
    for (int i = 0; i < 4; ++i) *(u32x4*)(buf + sg * 16384 + ((lt >> 4) + 16 * i) * 256 + (lt & 15) * 16) = rg[sg * 4 + i];
#pragma unroll
  for (int i = 0; i < 6; ++i) *(u32x4*)(buf + 49152 + lt * 16 + i * 4096) = rg[12 + i];
}
DI void d2_block(const Params& p, int unit, char* smem) {
  const int tid = threadIdx.x, half = tid >> 8, lt = tid & 255, lane = tid & 63, wave = (tid >> 6) & 3;
  const int r = lane & 31, hh = lane >> 5;
  const int b = unit >> 3, h = unit & 7;
  const char* qkv = p.ws + OFF_QKV;
  const float* egl = (const float*)(p.ws + OFF_EGL);
  u16* obuf = (u16*)((char*)p.out + (size_t)R * 1024 * 2);
  if (half == 1) {
    u32x4 rg0[18], rg1[18];
    u32x4 og[4], sg4;
    u16* obuf_ = (u16*)((char*)p.out + (size_t)R * 1024 * 2);
    float* ssq_ = (float*)(p.ws + OFF_SSQ);
    const int orow = lt >> 2, opos = lt & 3, ocol = 8 * (opos ^ ((orow >> 1) & 3));
    d2_issue(rg0, p, b, h, lt, 0); d2_put(rg0, smem, lt); d2_issue(rg1, p, b, h, lt, 1); d2_issue(rg0, p, b, h, lt, 2);
    __syncthreads();
#define D2_LOADER_STEP(n_, RG)                                                                                              \
    {                                                                                                                        \
      const int n = (n_);                                                                                                    \
      char* ob = smem + ((n + 1) & 1) * HALF_SMEM;                                                                           \
      if (n >= 1) {                                                                                                          \
        _Pragma("unroll") for (int i = 0; i < 4; ++i) og[i] = *(const u32x4*)(ob + 32768 + (lt + 256 * i) * 16);            \
        if (lt >= 192) sg4 = *(const u32x4*)(ob + 49152 + 20480 + lt * 16);                                                  \
      }                                                                                                                      \
      if (n + 1 < 32) { d2_put(RG, ob, lt); if (n + 3 < 32) d2_issue(RG, p, b, h, lt, n + 3); }                              \
      if (n >= 1) {                                                                                                          \
        const int rowbase = b * 2048 + (n - 1) * 64;                                                                         \
        _Pragma("unroll") for (int i = 0; i < 4; ++i)                                                                        \
          *(u32x4*)(obuf_ + (size_t)(rowbase + orow) * 1024 + h * 128 + 32 * i + ocol) = og[i];                              \
        if (lt >= 192) *(u32x4*)(ssq_ + ((size_t)(rowbase + lt - 192) * 8 + h) * 4) = sg4;                                   \
      }                                                                                                                      \
      if (n < 32) { asm volatile("s_waitcnt lgkmcnt(0)" ::: "memory"); __builtin_amdgcn_s_barrier(); asm volatile("" ::: "memory"); } \
    }
#pragma unroll 1
    for (int n2 = 0; n2 <= 32; n2 += 2) {
      D2_LOADER_STEP(n2, rg1)
      if (n2 + 1 <= 32) D2_LOADER_STEP(n2 + 1, rg0)
    }
#undef D2_LOADER_STEP
    return;
  }
  f32x16 S[4];
#pragma unroll
  for (int k = 0; k < 4; ++k) S[k] = zero16();
  const unsigned voff_l = (unsigned)(lane * 16);
  bf16x8 If0, If1;
#pragma unroll
  for (int j = 0; j < 8; ++j) {
    const int k0 = 8 * (j >> 2) + 4 * hh + (j & 3);
    If0[j] = (short)((k0 == r) ? 0x3F80 : 0); If1[j] = (short)((16 + k0 == r) ? 0x3F80 : 0);
  }
  const unsigned voff_v = (unsigned)((16 * wave + (lane >> 3)) * 256 + (lane & 7) * 32);
  __syncthreads();
#pragma unroll 1
  for (int n = 0; n < 32; ++n) {
    const int item = (b * 32 + n) * 8 + h;
    const int rowbase = b * 2048 + n * 64;
    const char* buf = smem + (n & 1) * HALF_SMEM;
    const char* ext = buf + 49152;
    const float eg = *(const float*)(ext + 22 * 1024);
    bf16x8 fk[16];
#pragma unroll
    for (int f = 0; f < 16; ++f) fk[f] = *(const bf16x8*)(buf + 16384 + f * 1024 + voff_l);
    uint4 vv[2][2];
#pragma unroll
    for (int it = 0; it < 2; ++it) { const char* d = buf + 32768 + it * 2048 + voff_v; vv[it][0] = *(const uint4*)d; vv[it][1] = *(const uint4*)(d + 16); }
    bf16x8 Sf[4][2];
#pragma unroll
    for (int kb = 0; kb < 4; ++kb) { Sf[kb][0] = pack8(S[kb], 0); Sf[kb][1] = pack8(S[kb], 1); }
    __builtin_amdgcn_sched_barrier(0);
    f32x16 P1[2];
    P1[0] = zero16(); P1[1] = zero16();
#pragma unroll
    for (int kb = 0; kb < 4; ++kb)
#pragma unroll
      for (int s = 0; s < 2; ++s) {
        P1[0] = MFMA(fk[kb * 2 + s], Sf[kb][s], P1[0]);
        P1[1] = MFMA(fk[8 + kb * 2 + s], Sf[kb][s], P1[1]);
      }
    bf16x8 fq[8];
#pragma unroll
    for (int f = 0; f < 8; ++f) fq[f] = *(const bf16x8*)(buf + f * 1024 + voff_l);
    bf16x8 Vf[2][2];
#pragma unroll
    for (int it = 0; it < 2; ++it) {
      const uint4 v0 = vv[it][0], v1 = vv[it][1];
      f32x16 vn;
      vn[0] = bf_lo(v0.x) - P1[it][0];  vn[1] = bf_hi(v0.x) - P1[it][1];
      vn[2] = bf_lo(v0.y) - P1[it][2];  vn[3] = bf_hi(v0.y) - P1[it][3];
      vn[4] = bf_lo(v0.z) - P1[it][4];  vn[5] = bf_hi(v0.z) - P1[it][5];
      vn[6] = bf_lo(v0.w) - P1[it][6];  vn[7] = bf_hi(v0.w) - P1[it][7];
      vn[8] = bf_lo(v1.x) - P1[it][8];  vn[9] = bf_hi(v1.x) - P1[it][9];
      vn[10] = bf_lo(v1.y) - P1[it][10]; vn[11] = bf_hi(v1.y) - P1[it][11];
      vn[12] = bf_lo(v1.z) - P1[it][12]; vn[13] = bf_hi(v1.z) - P1[it][13];
      vn[14] = bf_lo(v1.w) - P1[it][14]; vn[15] = bf_hi(v1.w) - P1[it][15];
      Vf[it][0] = pack8(vn, 0); Vf[it][1] = pack8(vn, 1);
    }
    bf16x8 fa[6];
#pragma unroll
    for (int i = 0; i < 6; ++i) fa[i] = *(const bf16x8*)(ext + (16 + i) * 1024 + voff_l);
    f32x16 P2[2];
    P2[0] = zero16(); P2[1] = zero16();
#pragma unroll
    for (int kb = 0; kb < 4; ++kb)
#pragma unroll
      for (int s = 0; s < 2; ++s) {
        P2[0] = MFMA(fq[kb * 2 + s], Sf[kb][s], P2[0]);
        const bf16x8 fq1 = *(const bf16x8*)(buf + (8 + kb * 2 + s) * 1024 + voff_l);
        P2[1] = MFMA(fq1, Sf[kb][s], P2[1]);
      }
    __builtin_amdgcn_sched_barrier(0);
    bf16x8 fkd[16];
#pragma unroll
    for (int i = 0; i < 16; ++i) fkd[i] = *(const bf16x8*)(ext + i * 1024 + voff_l);
#pragma unroll
    for (int s = 0; s < 2; ++s) {
      P2[0] = MFMA(fa[0 + s], Vf[0][s], P2[0]);
      P2[1] = MFMA(fa[2 + s], Vf[0][s], P2[1]);
      P2[1] = MFMA(fa[4 + s], Vf[1][s], P2[1]);
    }
    {
      char* ow = (char*)buf + 32768 + wave * 4096;
      float* sqw = (float*)((char*)buf + 49152 + 23 * 1024);
      const int xs = (r >> 1) & 3;
#pragma unroll
      for (int it = 0; it < 2; ++it) {
        f32x16 Z = MFMA(pack8(P2[it], 0), If0, zero16());
        Z = MFMA(pack8(P2[it], 1), If1, Z);
        float ssl = 0.f;
#pragma unroll
        for (int reg = 0; reg < 16; ++reg) ssl += Z[reg] * Z[reg];
        ssl += __shfl_xor(ssl, 32, 64);
        if (hh == 0) sqw[(it * 32 + r) * 4 + wave] = ssl;
#pragma unroll
        for (int g = 0; g < 4; ++g) {
          uint2 pv; pv.x = pk2(Z[4 * g], Z[4 * g + 1]); pv.y = pk2(Z[4 * g + 2], Z[4 * g + 3]);
          *(uint2*)(ow + (it * 32 + r) * 64 + ((g ^ xs) * 16) + hh * 8) = pv;
        }
      }
    }
#pragma unroll
    for (int kt = 0; kt < 4; ++kt) {
#pragma unroll
      for (int reg = 0; reg < 16; ++reg) S[kt][reg] *= eg;
#pragma unroll
      for (int pb = 0; pb < 2; ++pb)
#pragma unroll
        for (int s = 0; s < 2; ++s) {
          S[kt] = MFMA(fkd[kt * 4 + pb * 2 + s], Vf[pb][s], S[kt]);
        }
    }
    asm volatile("s_waitcnt lgkmcnt(0)" ::: "memory"); __builtin_amdgcn_s_barrier(); asm volatile("" ::: "memory");
  }
  float* od = p.out + OUT_DELTAP + (size_t)(b * 8 + h) * 16384;
#pragma unroll
  for (int kt = 0; kt < 4; ++kt)
#pragma unroll
    for (int reg = 0; reg < 16; ++reg) od[(kt * 32 + crow(reg, hh)) * 128 + wave * 32 + r] = S[kt][reg];
}

DI void conf_prompt_item(const Params& p, int item, char* smem) {
  const int tid = threadIdx.x & 255, lane = tid & 63, wave = tid >> 6;
  const int b = item >> 6, t0 = (item & 63) * 32;
  unsigned* tile = (unsigned*)smem;
  float* red = (float*)(smem + 63488);
  const u16* glu = (const u16*)(p.ws + OFF_GLU);
  u16* aact = (u16*)(p.ws + OFF_AACT);
#pragma unroll 1
  for (int hb = 0; hb < 2; ++hb) {
    u32x4 fv[8];
#pragma unroll
    for (int i = 0; i < 8; ++i) {
      const int e = tid + 256 * (hb * 8 + i), rr = e >> 6, c8 = (e & 63) * 8;
      const int t = t0 - 30 + rr;
      fv[i] = (u32x4){0u, 0u, 0u, 0u};
      if (rr < 62 && t >= 0) fv[i] = *(const u32x4*)(glu + (size_t)(b * 2048 + t) * 512 + c8);
    }
#pragma unroll
    for (int i = 0; i < 8; ++i) {
      const int e = tid + 256 * (hb * 8 + i), rr = e >> 6, c8 = (e & 63) * 8;
      if (rr < 62) *(u32x4*)(tile + rr * 256 + (c8 >> 1)) = fv[i];
    }
  }
  float w[31][2];
#pragma unroll
  for (int j = 0; j < 31; ++j) { const float2 t = *(const float2*)(p.conf_dw_w + j * 512 + 2 * tid); w[j][0] = t.x; w[j][1] = t.y; }
  const float2 bias = *(const float2*)(p.conf_dw_b + 2 * tid);
  const float2 lw = *(const float2*)(p.conf_ln_w + 2 * tid), lb = *(const float2*)(p.conf_ln_b + 2 * tid);
  __syncthreads();
#pragma unroll 1
  for (int tg = 0; tg < 4; ++tg) {
    float a[8][2];
#pragma unroll
    for (int t = 0; t < 8; ++t) { a[t][0] = bias.x; a[t][1] = bias.y; }
#pragma unroll
    for (int i = 0; i < 38; ++i) {
      const unsigned u = tile[(tg * 8 + i) * 256 + tid];
      const float x0 = bf_lo(u), x1 = bf_hi(u);
#pragma unroll
      for (int t = 0; t < 8; ++t) {
        const int j = i - t;
        if (j >= 0 && j < 31) { a[t][0] += w[j][0] * x0; a[t][1] += w[j][1] * x1; }
      }
    }
#pragma unroll
    for (int t = 0; t < 8; ++t) {
      const float s1 = wsum(a[t][0] + a[t][1]);
      const float s2 = wsum(a[t][0] * a[t][0] + a[t][1] * a[t][1]);
      if (lane == 0) { red[(wave * 8 + t) * 2] = s1; red[(wave * 8 + t) * 2 + 1] = s2; }
    }
    __syncthreads();
#pragma unroll
    for (int t = 0; t < 8; ++t) {
      const float s1 = red[t * 2] + red[(8 + t) * 2] + red[(16 + t) * 2] + red[(24 + t) * 2];
      const float s2 = red[t * 2 + 1] + red[(8 + t) * 2 + 1] + red[(16 + t) * 2 + 1] + red[(24 + t) * 2 + 1];
      const float mu = s1 * (1.f / 512.f);
      const float var = fmaxf(s2 * (1.f / 512.f) - mu * mu, 0.f);
      const float rs = rsqrtf(var + EPS);
      const float y0 = (a[t][0] - mu) * rs * lw.x + lb.x, y1 = (a[t][1] - mu) * rs * lw.y + lb.y;
      *(unsigned*)(aact + (size_t)(b * 2048 + t0 + tg * 8 + t) * 512 + 2 * tid) = pk2(siluf_(y0), siluf_(y1));
    }
    __syncthreads();
  }
}
DI void conf_sample_item(const Params& p, int item) {
  const int lane = threadIdx.x & 63, wave = (threadIdx.x >> 6) & 3;
  const int s = item * 4 + wave;
  const int c = lane * 8;
  const u16* glu = (const u16*)(p.ws + OFF_GLU);
  u16* aact = (u16*)(p.ws + OFF_AACT);
  float a[8];
  {
    const float4 b0 = *(const float4*)(p.conf_dw_b + c), b1 = *(const float4*)(p.conf_dw_b + c + 4);
    a[0] = b0.x; a[1] = b0.y; a[2] = b0.z; a[3] = b0.w; a[4] = b1.x; a[5] = b1.y; a[6] = b1.z; a[7] = b1.w;
  }
  const float* st = p.st_conf + (size_t)s * 30 * 512;
  float* oc = p.out + OUT_CONFS + (size_t)s * 30 * 512;
#pragma unroll 1
  for (int j = 0; j < 30; ++j) {
    const float4 x0 = *(const float4*)(st + j * 512 + c), x1 = *(const float4*)(st + j * 512 + c + 4);
    const float4 w0 = *(const float4*)(p.conf_dw_w + j * 512 + c), w1 = *(const float4*)(p.conf_dw_w + j * 512 + c + 4);
    a[0] += w0.x * x0.x; a[1] += w0.y * x0.y; a[2] += w0.z * x0.z; a[3] += w0.w * x0.w;
    a[4] += w1.x * x1.x; a[5] += w1.y * x1.y; a[6] += w1.z * x1.z; a[7] += w1.w * x1.w;
    if (j >= 1) { *(float4*)(oc + (j - 1) * 512 + c) = x0; *(float4*)(oc + (j - 1) * 512 + c + 4) = x1; }
  }
  {
    const uint4 g = *(const uint4*)(glu + (size_t)(RP + s) * 512 + c);
    const float4 w0 = *(const float4*)(p.conf_dw_w + 30 * 512 + c), w1 = *(const float4*)(p.conf_dw_w + 30 * 512 + c + 4);
    a[0] += w0.x * bf_lo(g.x); a[1] += w0.y * bf_hi(g.x); a[2] += w0.z * bf_lo(g.y); a[3] += w0.w * bf_hi(g.y);
    a[4] += w1.x * bf_lo(g.z); a[5] += w1.y * bf_hi(g.z); a[6] += w1.z * bf_lo(g.w); a[7] += w1.w * bf_hi(g.w);
  }
  float s1 = 0.f, s2 = 0.f;
#pragma unroll
  for (int i = 0; i < 8; ++i) { s1 += a[i]; s2 += a[i] * a[i]; }
  s1 = wsum(s1); s2 = wsum(s2);
  const float mu = s1 * (1.f / 512.f);
  const float rs = rsqrtf(fmaxf(s2 * (1.f / 512.f) - mu * mu, 0.f) + EPS);
  float y[8];
#pragma unroll
  for (int i = 0; i < 8; ++i) y[i] = siluf_((a[i] - mu) * rs * p.conf_ln_w[c + i] + p.conf_ln_b[c + i]);
  uint4 o; o.x = pk2(y[0], y[1]); o.y = pk2(y[2], y[3]); o.z = pk2(y[4], y[5]); o.w = pk2(y[6], y[7]);
  *(uint4*)(aact + (size_t)(RP + s) * 512 + c) = o;
}
DI void delta_sample_item(const Params& p, int item, char* smem) {
  const int tid = threadIdx.x & 255, lane = tid & 63, wave = tid >> 6;
  const int s = item >> 3, h = item & 7;
  float* qs = (float*)smem; float* ks = qs + 128; float* vs = ks + 128; float* part = vs + 128;
  float* red = part + 768;
  const u16* qkv = (const u16*)(p.ws + OFF_QKV);
  const float* gb = (const float*)(p.ws + OFF_GB);
  const int row = RP + s;
  const int v = tid & 127, kh = tid >> 7;
  const float* S0 = p.st_delta + (size_t)(s * 8 + h) * 16384 + (size_t)(kh * 64) * 128 + v;
  float Sr[64];
#pragma unroll
  for (int kk = 0; kk < 64; ++kk) Sr[kk] = S0[kk * 128];
  const float g = gb[(size_t)row * 16 + 8 + h], beta = gb[(size_t)row * 16 + h];
  float cq = 0.f, ck = 0.f, cv = 0.f;
  if (tid < 128) {
    float cx[3];
#pragma unroll
    for (int X = 0; X < 3; ++X) {
      const int cg = X * 1024 + h * 128 + tid;
      const float s0 = p.st_qkv[(size_t)(s * 3 + 0) * 3072 + cg], s1 = p.st_qkv[(size_t)(s * 3 + 1) * 3072 + cg], s2 = p.st_qkv[(size_t)(s * 3 + 2) * 3072 + cg];
      const float x = bf1(qkv[(size_t)row * 3072 + cg]);
      const float a = p.gdn_conv_w[cg] * s0 + p.gdn_conv_w[3072 + cg] * s1 + p.gdn_conv_w[2 * 3072 + cg] * s2 + p.gdn_conv_w[3 * 3072 + cg] * x;
      cx[X] = siluf_(a);
      p.out[OUT_QKVS + (size_t)(s * 3 + 0) * 3072 + cg] = s1;
      p.out[OUT_QKVS + (size_t)(s * 3 + 1) * 3072 + cg] = s2;
    }
    cq = cx[0]; ck = cx[1]; cv = cx[2];
  }
  {
    const float sq = wsum(cq * cq), sk = wsum(ck * ck);
    if (lane == 0) { red[wave * 2] = sq; red[wave * 2 + 1] = sk; }
  }
  __syncthreads();
  if (tid < 128) {
    const float rq = rsqrtf(red[0] + red[2] + EPS), rk = rsqrtf(red[1] + red[3] + EPS);
    qs[tid] = cq * rq * QSCALE; ks[tid] = ck * rk; vs[tid] = cv;
  }
  __syncthreads();
  const float eg = __expf(g);
  float kS = 0.f, qS = 0.f, qk = 0.f;
#pragma unroll
  for (int k4 = 0; k4 < 16; ++k4) {
    const float4 kv = *(const float4*)(ks + kh * 64 + k4 * 4), qv = *(const float4*)(qs + kh * 64 + k4 * 4);
    kS += kv.x * Sr[4 * k4] + kv.y * Sr[4 * k4 + 1] + kv.z * Sr[4 * k4 + 2] + kv.w * Sr[4 * k4 + 3];
    qS += qv.x * Sr[4 * k4] + qv.y * Sr[4 * k4 + 1] + qv.z * Sr[4 * k4 + 2] + qv.w * Sr[4 * k4 + 3];
    qk += kv.x * qv.x + kv.y * qv.y + kv.z * qv.z + kv.w * qv.w;
  }
  part[(kh * 3 + 0) * 128 + v] = kS; part[(kh * 3 + 1) * 128 + v] = qS; part[(kh * 3 + 2) * 128 + v] = qk;
  __syncthreads();
  kS = part[0 * 128 + v] + part[3 * 128 + v];
  qS = part[1 * 128 + v] + part[4 * 128 + v];
  qk = part[2 * 128 + v] + part[5 * 128 + v];
  const float vnew = vs[v] * beta - beta * eg * kS;
  const float o = eg * qS + qk * vnew;
  float* Sd = p.out + OUT_DELTAS + (size_t)(s * 8 + h) * 16384 + (size_t)(kh * 64) * 128 + v;
#pragma unroll
  for (int k4 = 0; k4 < 16; ++k4) {
    const float4 kv = *(const float4*)(ks + kh * 64 + k4 * 4);
    Sd[(4 * k4 + 0) * 128] = Sr[4 * k4 + 0] * eg + kv.x * vnew;
    Sd[(4 * k4 + 1) * 128] = Sr[4 * k4 + 1] * eg + kv.y * vnew;
    Sd[(4 * k4 + 2) * 128] = Sr[4 * k4 + 2] * eg + kv.z * vnew;
    Sd[(4 * k4 + 3) * 128] = Sr[4 * k4 + 3] * eg + kv.w * vnew;
  }
  if (kh == 0) {
    ((u16*)((char*)p.out + (size_t)R * 1024 * 2))[(size_t)row * 1024 + h * 128 + v] = f2bf(o);
    const float so = wsum(o * o);
    if (lane == 0) { float* sq = (float*)(p.ws + OFF_SSQ) + ((size_t)row * 8 + h) * 4; sq[wave] = so; sq[wave + 2] = 0.f; }
  }
  __syncthreads();
}

__global__ void __launch_bounds__(512, 2) fwd_megakernel(Params p) {
  __shared__ __attribute__((aligned(1024))) char smem[SMEM_BYTES];
  const int tid = threadIdx.x, lane = tid & 63, wave = tid >> 6;
  const int fr = lane & 15, fq = lane >> 4;
  uint4* xb_words = (uint4*)(smem + 2 * HALF_SMEM);
  if (tid == 0) *xb_words = make_uint4(0u, 0u, 0u, 0u);
  __syncthreads();
  XcdBarrier xb = xcd_barrier_post((unsigned*)(p.ws + OFF_BAR), (volatile LAS unsigned*)xb_words);
  const int G = gridDim.x, bid = blockIdx.x;
  float* mod = (float*)(p.ws + OFF_MOD);
  u16* hbuf = (u16*)p.out;
  u16* obuf = (u16*)((char*)p.out + (size_t)R * 1024 * 2);
  const float* ssq = (const float*)(p.ws + OFF_SSQ);
  u16* merged = (u16*)(p.ws + OFF_MERGED);
  u16* tmp2 = (u16*)(p.ws + OFF_TMP2);

  PH(0) phase_convert(p, smem);
  xcd_barrier(xb);

  PH(1) for (int sb = bid; sb < 256; sb += G) {
    skinny<2>((const u16*)(p.ws + OFF_AC), 1024, 0, 136, (const u16*)(p.ws + OFF_WADA), 1024, 1024,
      [&](int j) { return sb * 24 + (j < 24 ? j : 23); },
      [&](int row, int ntl, int q, f32x4 v, int ln) {
        const int j = ntl * 16 + 4 * q;
        if (j < 24) {
          const int col = sb * 24 + j;
          const float4 bb = *(const float4*)(p.b_ada + col);
          *(float4*)(mod + (size_t)row * 6144 + col) = make_float4(v[0] + bb.x, v[1] + bb.y, v[2] + bb.z, v[3] + bb.w);
        }
      });
  }
  xcd_barrier(xb);

  PH(2) phase_modnorm<true>(p, p.x_prompt, p.x_sample, p.norm1_w, 0, 1024, hbuf, smem);
  xcd_barrier(xb);

  PH(3) {
    u16* glu = (u16*)(p.ws + OFF_GLU);
    u16* qkv = (u16*)(p.ws + OFF_QKV);
    u16* halo = (u16*)(p.ws + OFF_HALO);
    auto f_glu_st = [&](int row, int ch, f32x4 gl) {
      uint2 o; o.x = pk2(gl[0], gl[1]); o.y = pk2(gl[2], gl[3]);
      *(uint2*)(glu + (size_t)row * 512 + ch) = o;
      if (row < RP) { const int b = row >> 11, tt = row & 2047; if (tt >= 2018) *(float4*)(p.out + OUT_CONFP + (size_t)(b * 30 + tt - 2018) * 512 + ch) = make_float4(gl[0], gl[1], gl[2], gl[3]); }
      else *(float4*)(p.out + OUT_CONFS + (size_t)((row - RP) * 30 + 29) * 512 + ch) = make_float4(gl[0], gl[1], gl[2], gl[3]);
    };
    auto f_glu = [&](int row, int ch, f32x4 a, f32x4 g) {
      f32x4 gl;
#pragma unroll
      for (int j = 0; j < 4; ++j) gl[j] = a[j] * sigmoidf_(g[j]);
      f_glu_st(row, ch, gl);
    };
    auto f_qkv = [&](int row, int col, f32x4 a) {
      const float4 v = make_float4(a[0], a[1], a[2], a[3]);
      uint2 o; o.x = pk2(v.x, v.y); o.y = pk2(v.z, v.w);
      *(uint2*)(qkv + (size_t)row * 3072 + col) = o;
      if (row < RP) {
        const int b = row >> 11, tt = row & 2047;
        if ((tt & 63) >= 61) *(uint2*)(halo + (size_t)((b * 32 + (tt >> 6)) * 3 + (tt & 63) - 61) * 3072 + col) = o;
        if (tt >= 2045) *(float4*)(p.out + OUT_QKVP + (size_t)(b * 3 + tt - 2045) * 3072 + col) = v;
      } else *(float4*)(p.out + OUT_QKVS + (size_t)((row - RP) * 3 + 2) * 3072 + col) = v;
    };
    int u = bid;
    for (; u < 64 * 4; u += G) {
      const int pm = u % 64, pn = u / 64;
      f32x4 acc[2][2][4][2];
      zero_acc(acc);
      gemm256(acc, hbuf, 1024, (const u16*)(p.ws + OFF_WIN), 1024, pm * 256, pn * 256, 1024, smem);
      {
        int t_ = threadIdx.x;
        asm volatile("" : "+v"(t_));
        const int wr = t_ >> 8, wc = (t_ >> 6) & 3, fr_ = t_ & 15, fq_ = (t_ >> 4) & 3;
        float* T = (float*)smem;
#pragma unroll
        for (int ai = 0; ai < 2; ++ai)
#pragma unroll
          for (int m = 0; m < 4; ++m)
#pragma unroll
            for (int n = 0; n < 2; ++n) {
              f32x4 gl;
#pragma unroll
              for (int j = 0; j < 4; ++j) gl[j] = acc[ai][0][m][n][j] * sigmoidf_(acc[ai][1][m][n][j]);
              *(f32x4*)(T + (ai * 128 + wr * 64 + m * 16 + fr_) * TLD + wc * 32 + n * 16 + 4 * fq_) = gl;
            }
        __syncthreads();
        const int cg = (t_ & 31) * 4, r0 = t_ >> 5;
#pragma unroll 4
        for (int i = 0; i < 16; ++i) {
          const int rl = r0 + 16 * i;
          const f32x4 v = *(const f32x4*)(T + rl * TLD + cg);
          f_glu_st(pm * 256 + rl, pn * 128 + cg, v);
        }
        __syncthreads();
      }
    }
    for (; u < 64 * 16; u += G) {
      const int pm = u % 64, pn = u / 64;
      f32x4 acc[2][2][4][2];
      zero_acc(acc);
      gemm256(acc, hbuf, 1024, (const u16*)(p.ws + OFF_WIN), 1024, pm * 256, pn * 256, 1024, smem);
      tile_epilogue(acc, pm * 256, pn * 256 - 1024, smem, f_qkv);
    }
    for (int sb = bid; sb < 256; sb += G) {
      if (sb < 64) {
        skinny<1>(hbuf, 1024, RP, 128, (const u16*)(p.ws + OFF_WIN), 1024, 1024,
          [&](int j) { const int ch = sb * 8 + (j & 7); return (ch >> 7) * 256 + (ch & 127) + ((j >> 3) << 7); },
          [&](int row, int ntl, int q, f32x4 v, int ln) {
            f32x4 g;
#pragma unroll
            for (int j = 0; j < 4; ++j) g[j] = __shfl(v[j], (ln + 32) & 63, 64);
            if (q < 2) f_glu(row, sb * 8 + 4 * q, v, g);
          });
      } else {
        skinny<1>(hbuf, 1024, RP, 128, (const u16*)(p.ws + OFF_WIN), 1024, 1024,
          [&](int j) { return 1024 + (sb - 64) * 16 + j; },
          [&](int row, int ntl, int q, f32x4 v, int ln) { f_qkv(row, (sb - 64) * 16 + 4 * q, v); });
      }
    }
  }
  xcd_barrier(xb);

  PH(4) for (int base = bid * 2; base < 2048; base += 2 * G) d1_item(p, base + (tid >> 8), smem + (tid >> 8) * HALF_SMEM);
  xcd_barrier(xb);

  PH(5) {
    const int half = tid >> 8;
    char* hs = smem + half * HALF_SMEM;
    for (int u = bid; u < 64; u += G) { d2_block(p, u, smem); __syncthreads(); }
    unsigned* qhead = (unsigned*)(p.ws + OFF_BAR) + 64;
    volatile unsigned* qslot = (volatile unsigned*)(smem + 2 * HALF_SMEM + 32);
    auto deq = [&]() -> int {
      if (tid == 0) *qslot = __hip_atomic_fetch_add(qhead, 1u, __ATOMIC_RELAXED, __HIP_MEMORY_SCOPE_AGENT);
      __syncthreads();
      const int v = __builtin_amdgcn_readfirstlane((int)*qslot);
      __syncthreads();
      return v;
    };
    int idx = deq();
    for (; idx < 256; idx = deq()) conf_prompt_item(p, 2 * idx + half, hs);
    for (; idx < 272; idx = deq()) conf_sample_item(p, 2 * (idx - 256) + half);
    for (; idx < 784; idx = deq()) delta_sample_item(p, 2 * (idx - 272) + half, hs);
  }
  xcd_barrier(xb);

  PH(6) {
    auto f_z = [&](int row, int col, f32x4 a) {
      const float4 sq4 = *(const float4*)(ssq + ((size_t)row * 8 + (col >> 7)) * 4);
      const float rstd = rsqrtf((sq4.x + sq4.y + sq4.z + sq4.w) * (1.f / 128.f) + EPS);
      const float4 gw = *(const float4*)(p.gdn_norm_w + (col & 127));
      u16* op = obuf + (size_t)row * 1024 + col;
      const uint2 u = *(const uint2*)op;
      uint2 o;
      o.x = pk2(bf_lo(u.x) * rstd * gw.x * siluf_(a[0]), bf_hi(u.x) * rstd * gw.y * siluf_(a[1]));
      o.y = pk2(bf_lo(u.y) * rstd * gw.z * siluf_(a[2]), bf_hi(u.y) * rstd * gw.w * siluf_(a[3]));
      *(uint2*)op = o;
    };
    gemm_pass(hbuf, 1024, (const u16*)(p.ws + OFF_WZ), 1024, 1024, 1024, smem, f_z);
    for (int sb = bid; sb < 256; sb += G)
      skinny<1>(hbuf, 1024, RP, 128, (const u16*)(p.ws + OFF_WZ), 1024, 1024, [&](int j) { return sb * 4 + (j & 3); },
                [&](int row, int ntl, int q, f32x4 v, int ln) { if (q == 0) f_z(row, sb * 4, v); });
  }
  xcd_barrier(xb);

  PH(7) {
    auto f_ga = [&](int row, int col, f32x4 a) {
      uint2 o; o.x = pk2(sigmoidf_(a[0]), sigmoidf_(a[1])); o.y = pk2(sigmoidf_(a[2]), sigmoidf_(a[3]));
      *(uint2*)(merged + (size_t)row * 1024 + col) = o;
    };
    auto f_ya = [&](int row, int col, f32x4 a) {
      u16* mp = merged + (size_t)row * 1024 + col;
      const uint2 u = *(const uint2*)mp;
      uint2 o; o.x = pk2(bf_lo(u.x) * a[0], bf_hi(u.x) * a[1]); o.y = pk2(bf_lo(u.y) * a[2], bf_hi(u.y) * a[3]);
      *(uint2*)mp = o;
    };
    auto f_gb = [&](int row, int col, f32x4 a) {
      uint2 o; o.x = pk2(sigmoidf_(a[0]), sigmoidf_(a[1])); o.y = pk2(sigmoidf_(a[2]), sigmoidf_(a[3]));
      *(uint2*)(tmp2 + (size_t)row * 1024 + col) = o;
    };
    auto f_yb = [&](int row, int col, f32x4 a) {
      u16* mp = merged + (size_t)row * 1024 + col;
      const uint2 u = *(const uint2*)mp, s2 = *(const uint2*)(tmp2 + (size_t)row * 1024 + col);
      uint2 o; o.x = pk2(bf_lo(u.x) + bf_lo(s2.x) * a[0], bf_hi(u.x) + bf_hi(s2.x) * a[1]); o.y = pk2(bf_lo(u.y) + bf_lo(s2.y) * a[2], bf_hi(u.y) + bf_hi(s2.y) * a[3]);
      *(uint2*)mp = o;
    };
    auto cm4 = [&](int sb) { return [sb](int j) { return sb * 4 + (j & 3); }; };
    gemm_pass(hbuf, 1024, (const u16*)(p.ws + OFF_WGA), 1024, 1024, 1024, smem, f_ga);
    gemm_pass((const u16*)(p.ws + OFF_AACT), 512, (const u16*)(p.ws + OFF_WCONF), 512, 1024, 512, smem, f_ya);
    gemm_pass(hbuf, 1024, (const u16*)(p.ws + OFF_WGB), 1024, 1024, 1024, smem, f_gb);
    gemm_pass(obuf, 1024, (const u16*)(p.ws + OFF_WGDN), 1024, 1024, 1024, smem, f_yb);
    for (int sb = bid; sb < 256; sb += G) {
      skinny<1>(hbuf, 1024, RP, 128, (const u16*)(p.ws + OFF_WGA), 1024, 1024, cm4(sb), [&](int row, int ntl, int q, f32x4 v, int ln) { if (q == 0) f_ga(row, sb * 4, v); });
      skinny<1>((const u16*)(p.ws + OFF_AACT), 512, RP, 128, (const u16*)(p.ws + OFF_WCONF), 512, 512, cm4(sb), [&](int row, int ntl, int q, f32x4 v, int ln) { if (q == 0) f_ya(row, sb * 4, v); });
      skinny<1>(hbuf, 1024, RP, 128, (const u16*)(p.ws + OFF_WGB), 1024, 1024, cm4(sb), [&](int row, int ntl, int q, f32x4 v, int ln) { if (q == 0) f_gb(row, sb * 4, v); });
      skinny<1>(obuf, 1024, RP, 128, (const u16*)(p.ws + OFF_WGDN), 1024, 1024, cm4(sb), [&](int row, int ntl, int q, f32x4 v, int ln) { if (q == 0) f_yb(row, sb * 4, v); });
    }
  }
  xcd_barrier(xb);

  PH(8) {
    auto f_o = [&](int row, int col, f32x4 a) {
      const float* xr = row < RP ? p.x_prompt + (size_t)row * 1024 : p.x_sample + (size_t)(row - RP) * 1024;
      const float4 xv = *(const float4*)(xr + col), gv = *(const float4*)(mod + (size_t)mrow_of(row) * 6144 + 2048 + col);
      *(float4*)(p.out + (size_t)row * 1024 + col) = make_float4(xv.x + gv.x * a[0], xv.y + gv.y * a[1], xv.z + gv.z * a[2], xv.w + gv.w * a[3]);
    };
    gemm_pass(merged, 1024, (const u16*)(p.ws + OFF_WO), 1024, 1024, 1024, smem, f_o);
    for (int sb = bid; sb < 256; sb += G)
      skinny<1>(merged, 1024, RP, 128, (const u16*)(p.ws + OFF_WO), 1024, 1024, [&](int j) { return sb * 4 + (j & 3); },
                [&](int row, int ntl, int q, f32x4 v, int ln) { if (q == 0) f_o(row, sb * 4, v); });
  }
  xcd_barrier(xb);

  PH(9) phase_modnorm<false>(p, p.out, p.out + (size_t)RP * 1024, p.norm2_w, 3072, 4096, (u16*)(p.ws + OFF_H2), smem);
  xcd_barrier(xb);

  PH(10) {
    u16* f = (u16*)(p.ws + OFF_F);
    auto f_ff1 = [&](int row, int col, f32x4 a) {
      float v[4];
#pragma unroll
      for (int j = 0; j < 4; ++j) { const float t = fmaxf(a[j], 0.f); v[j] = t * t; }
      uint2 o; o.x = pk2(v[0], v[1]); o.y = pk2(v[2], v[3]);
      *(uint2*)(f + (size_t)row * LDF + col) = o;
    };
    gemm_pass((const u16*)(p.ws + OFF_H2), 1024, (const u16*)(p.ws + OFF_W1), 1024, 4096, 1024, smem, f_ff1);
    for (int sb = bid; sb < 256; sb += G)
      skinny<1>((const u16*)(p.ws + OFF_H2), 1024, RP, 128, (const u16*)(p.ws + OFF_W1), 1024, 1024, [&](int j) { return sb * 16 + j; },
                [&](int row, int ntl, int q, f32x4 v, int ln) { f_ff1(row, sb * 16 + 4 * q, v); });
  }
  xcd_barrier(xb);

  PH(11) {
    auto f_ff2 = [&](int row, int col, f32x4 a) {
      float* xp = p.out + (size_t)row * 1024 + col;
      const float4 xv = *(const float4*)xp, gv = *(const float4*)(mod + (size_t)mrow_of(row) * 6144 + 5120 + col);
      *(float4*)xp = make_float4(xv.x + gv.x * a[0], xv.y + gv.y * a[1], xv.z + gv.z * a[2], xv.w + gv.w * a[3]);
    };
    gemm_pass((const u16*)(p.ws + OFF_F), LDF, (const u16*)(p.ws + OFF_W2), LDF, 1024, 4096, smem, f_ff2);
    for (int sb = bid; sb < 256; sb += G)
      skinny<1>((const u16*)(p.ws + OFF_F), LDF, RP, 128, (const u16*)(p.ws + OFF_W2), LDF, 4096, [&](int j) { return sb * 4 + (j & 3); },
                [&](int row, int ntl, int q, f32x4 v, int ln) { if (q == 0) f_ff2(row, sb * 4, v); });
  }
  xcd_barrier(xb);

  PH(12) {
    int t12 = threadIdx.x;
    asm volatile("" : "+v"(t12));
    const int lane = t12 & 63, wave = t12 >> 6;
    const int gw = bid * 8 + wave, nw_ = G * 8;
    for (int row = gw; row < R; row += nw_) {
      float* xr = p.out + (size_t)row * 1024;
      float4 v[4]; float ss = 0.f;
#pragma unroll
      for (int i = 0; i < 4; ++i) { v[i] = *(const float4*)(xr + (lane + 64 * i) * 4); ss += v[i].x * v[i].x + v[i].y * v[i].y + v[i].z * v[i].z + v[i].w * v[i].w; }
      ss = wsum(ss);
      const float rstd = rsqrtf(ss * (1.f / 1024.f) + EPS);
#pragma unroll
      for (int i = 0; i < 4; ++i) {
        const int c = (lane + 64 * i) * 4;
        const float4 w = *(const float4*)(p.final_norm_w + c);
        *(float4*)(xr + c) = make_float4(v[i].x * rstd * w.x, v[i].y * rstd * w.y, v[i].z * rstd * w.z, v[i].w * rstd * w.w);
      }
    }
  }
}

extern "C" void kernel_launch(void* const* d_in, const int* in_sizes, int n_in, void* d_out, int out_size, void* d_ws, size_t ws_size,
                              hipStream_t stream) {
  static int grid_blocks = 0;
  if (!grid_blocks) {
    int dev = 0, cus = 0, per_cu = 0;
    hipGetDevice(&dev);
    hipDeviceGetAttribute(&cus, hipDeviceAttributeMultiprocessorCount, dev);
    hipOccupancyMaxActiveBlocksPerMultiprocessor(&per_cu, (const void*)fwd_megakernel, NT, 0);
    if (per_cu > 1) per_cu = 1;
    if (per_cu < 1) per_cu = 1;
    grid_blocks = cus * per_cu;
  }
  Params p{};
  const float** pp = (const float**)&p;
  for (int i = 0; i < 26; ++i) pp[i] = (const float*)d_in[i];
  p.out = (float*)d_out; p.ws = (char*)d_ws;
  if (ws_size < WS_NEED) { fprintf(stderr, "workspace too small: %zu < %zu\n", ws_size, (size_t)WS_NEED); return; }
  hipMemsetAsync(d_ws, 0, XCD_BAR_WORDS * 4, stream);
  void* args[] = {&p};
  hipError_t e = hipLaunchCooperativeKernel((const void*)fwd_megakernel, dim3(grid_blocks), dim3(NT), args, 0, stream);
  if (e != hipSuccess) fprintf(stderr, "cooperative launch failed: %s (grid %d)\n", hipGetErrorString(e), grid_blocks);
}
```

```cpp
#include <hip/hip_runtime.h>
#include <stdint.h>
#include <cstdio>

#define DI __device__ __forceinline__
typedef unsigned short u16;
typedef __bf16 bf2_t __attribute__((ext_vector_type(2)));
typedef float f2_t __attribute__((ext_vector_type(2)));
using bf16x8 = __attribute__((ext_vector_type(8))) short;
using f32x16 = __attribute__((ext_vector_type(16))) float;
using f32x4 = __attribute__((ext_vector_type(4))) float;
using u32x4 = __attribute__((ext_vector_type(4))) unsigned;
#define MFMA(a, b, c) __builtin_amdgcn_mfma_f32_32x32x16_bf16((a), (b), (c), 0, 0, 0)

constexpr int R = 16512, RP = 16384, D = 1024, DC = 512, QKV = 3072, NIN = 4096, DFF = 4096;
constexpr float EPS = 1e-6f;
constexpr int LDF = 4160;
constexpr float QSCALE = 0.08838834764831845f;

constexpr size_t OFF_BAR   = 0;
constexpr size_t OFF_MOD   = 16384;
constexpr size_t OFF_GB    = OFF_MOD + 3342336;
constexpr size_t OFF_EGL   = OFF_GB + 1056768;
constexpr size_t OFF_SSQ   = OFF_EGL + 8192;
constexpr size_t OFF_WIN   = OFF_SSQ + 2113536;
constexpr size_t OFF_WZ    = OFF_WIN + 8650752;
constexpr size_t OFF_WGA   = OFF_WZ + 2097152;
constexpr size_t OFF_WGB   = OFF_WGA + 2097152;
constexpr size_t OFF_WCONF = OFF_WGB + 2097152;
constexpr size_t OFF_WGDN  = OFF_WCONF + 1048576;
constexpr size_t OFF_WO    = OFF_WGDN + 2097152;
constexpr size_t OFF_W1    = OFF_WO + 2097152;
constexpr size_t OFF_W2    = OFF_W1 + 8388608;
constexpr size_t OFF_GLU   = OFF_W2 + 8650752;
constexpr size_t OFF_AACT  = OFF_GLU + 16908288;
constexpr size_t OFF_QKV   = OFF_AACT + 16908288;
constexpr size_t OFF_HALO  = OFF_QKV + 101449728;
constexpr size_t OFF_EXTRA = OFF_HALO + 4718592;
constexpr size_t OFF_WADA  = OFF_EXTRA;
constexpr size_t OFF_AC    = OFF_EXTRA + 12582912;
constexpr size_t OFF_MERGED= OFF_EXTRA;
constexpr size_t OFF_H2    = OFF_GLU;
constexpr size_t OFF_F     = OFF_QKV;
constexpr size_t OFF_TMP2  = OFF_QKV;
constexpr size_t WS_NEED   = OFF_EXTRA + 50331648;
constexpr size_t OUT_Y = 0, OUT_CONFP = 16908288, OUT_QKVP = 17031168, OUT_DELTAP = 17104896,
                 OUT_CONFS = 18153472, OUT_QKVS = 20119552, OUT_DELTAS = 21299200;

constexpr int HALF_SMEM = 73728;
constexpr int SMEM_BYTES = 2 * HALF_SMEM + 1024;
constexpr int NT = 512;
#ifndef PHASE_MASK
#define PHASE_MASK 0xFFFF
#endif
#define PH(k) if constexpr ((PHASE_MASK >> (k)) & 1)

struct Params {
  const float *x_prompt, *x_sample, *c_prompt, *c_sample, *st_conf, *st_qkv, *st_delta;
  const float *w_ada, *b_ada, *norm1_w, *w_in, *conf_dw_w, *conf_dw_b, *conf_ln_w, *conf_ln_b, *w_conf_out,
              *gdn_conv_w, *a_log, *dt_bias, *gdn_norm_w, *w_gdn_out, *w_o, *norm2_w, *w_ff1, *w_ff2, *final_norm_w;
  float* out; char* ws;
};

DI unsigned pk2(float a, float b) { f2_t v = {a, b}; bf2_t r = __builtin_convertvector(v, bf2_t); return __builtin_bit_cast(unsigned, r); }
DI float bf_lo(unsigned u) { return __uint_as_float(u << 16); }
DI float bf_hi(unsigned u) { return __uint_as_float(u & 0xffff0000u); }
DI float bf1(u16 u) { return __uint_as_float(((unsigned)u) << 16); }
DI u16 f2bf(float a) { return (u16)(pk2(a, 0.f) & 0xffffu); }
DI float sigmoidf_(float x) { return __builtin_amdgcn_rcpf(1.f + __expf(-x)); }
DI float siluf_(float x) { return x * __builtin_amdgcn_rcpf(1.f + __expf(-x)); }
DI float softplusf_(float x) { return fmaxf(x, 0.f) + log1pf(__expf(-fabsf(x))); }
DI float wsum(float v) {
#pragma unroll
  for (int m = 32; m >= 1; m >>= 1) v += __shfl_xor(v, m, 64);
  return v;
}
DI int crow(int reg, int hh) { return (reg & 3) + 8 * (reg >> 2) + 4 * hh; }
DI int mrow_of(int r) { return r < RP ? (r >> 11) : (8 + r - RP); }
DI bf16x8 pack8(const f32x16& x, int s) {
  uint4 p;
  p.x = pk2(x[8 * s + 0], x[8 * s + 1]); p.y = pk2(x[8 * s + 2], x[8 * s + 3]);
  p.z = pk2(x[8 * s + 4], x[8 * s + 5]); p.w = pk2(x[8 * s + 6], x[8 * s + 7]);
  return __builtin_bit_cast(bf16x8, p);
}
DI f32x16 zero16() { f32x16 z; for (int i = 0; i < 16; ++i) z[i] = 0.f; return z; }

#define XB_TMO      128
#define XB_XCNT(j)  (256  + 64 * (j))
#define XB_XSUB(j)  (1280 + 64 * (j))
#define XB_XGEN(j)  (2304 + 64 * (j))
#define XB_TOP      3328
#define XB_TOPGEN   3392
#define XCD_BAR_WORDS 3456
#define XB_SPIN_CAP (1u << 24)
#define LAS __attribute__((address_space(3)))
DI unsigned xb_ld(unsigned* p) { return __hip_atomic_load(p, __ATOMIC_RELAXED, __HIP_MEMORY_SCOPE_AGENT); }
DI unsigned xb_add(unsigned* p, unsigned v) { return __hip_atomic_fetch_add(p, v, __ATOMIC_RELAXED, __HIP_MEMORY_SCOPE_AGENT); }
DI unsigned xb_xcc_id() { return (unsigned)__builtin_amdgcn_s_getreg((3 << 11) | 20) & 0xFu; }
#define XB_SPIN(cond, bar) do { unsigned _sp = 0; while (cond) { __builtin_amdgcn_s_sleep(1); \
    if ((++_sp & 255u) == 0u) { if (xb_ld(&(bar)[XB_TMO])) break; if (_sp > XB_SPIN_CAP) { atomicAdd(&(bar)[XB_TMO], 1u); break; } } } } while (0)
struct XcdBarrier { unsigned* bar; unsigned x; volatile LAS unsigned* st; };
DI XcdBarrier xcd_barrier_post(unsigned* bar, volatile LAS unsigned* st) {
  XcdBarrier b; b.bar = bar; b.x = xb_xcc_id(); b.st = st;
  if (threadIdx.x == 0) (void)xb_add(&bar[XB_XCNT(b.x)], 1u);
  return b;
}
DI void xcd_barrier_complete(unsigned* bar, unsigned x, unsigned& nloc, unsigned& nx) {
  const unsigned G = gridDim.x * gridDim.y * gridDim.z;
  unsigned sum, cnt, mine, sp = 0u;
  for (;;) {
    sum = 0u; cnt = 0u; mine = 0u;
#pragma unroll
    for (unsigned j = 0; j < 16; ++j) { const unsigned c = xb_ld(&bar[XB_XCNT(j)]); sum += c; cnt += (c > 0u) ? 1u : 0u; mine = (j == x) ? c : mine; }
    if (sum == G) break;
    __builtin_amdgcn_s_sleep(1);
    if ((++sp & 255u) == 0u) { if (xb_ld(&bar[XB_TMO])) break; if (sp > XB_SPIN_CAP) { atomicAdd(&bar[XB_TMO], 1u); break; } }
  }
  nloc = mine > 0u ? mine : 1u; nx = cnt > 0u ? cnt : 1u;
}
DI void xcd_barrier(const XcdBarrier& b) {
  asm volatile("s_waitcnt vmcnt(0)" ::: "memory");
  __syncthreads();
  if (threadIdx.x == 0) {
    unsigned* bar = b.bar;
    __builtin_amdgcn_s_waitcnt(0);
    unsigned nloc = b.st[0], nx = b.st[1];
    if (nloc == 0u) { xcd_barrier_complete(bar, b.x, nloc, nx); b.st[0] = nloc; b.st[1] = nx; }
    const unsigned old = xb_add(&bar[XB_XSUB(b.x)], 1u);
    const unsigned gen = old / nloc;
    if (old + 1u == (gen + 1u) * nloc) {
      __builtin_amdgcn_fence(__ATOMIC_RELEASE, "agent");
      asm volatile("s_waitcnt vmcnt(0)" ::: "memory");
      const unsigned og = xb_add(&bar[XB_TOP], 1u);
      const unsigned tg = og / nx;
      if (og + 1u == (tg + 1u) * nx) xb_add(&bar[XB_TOPGEN], 1u);
      else XB_SPIN(xb_ld(&bar[XB_TOPGEN]) == tg, bar);
      __builtin_amdgcn_fence(__ATOMIC_ACQUIRE, "agent");
      xb_add(&bar[XB_XGEN(b.x)], 1u);
      asm volatile("s_waitcnt vmcnt(0)" ::: "memory");
    } else {
      XB_SPIN(xb_ld(&bar[XB_XGEN(b.x)]) == gen, bar);
      __builtin_amdgcn_fence(__ATOMIC_ACQUIRE, "agent");
      asm volatile("s_waitcnt vmcnt(0)" ::: "memory");
    }
  }
  __syncthreads();
}

constexpr int HTB = 128 * 64 * 2;
DI int lds_byte(int r, int c) { const int st = (r >> 4) * 2 + (c >> 5), rr = r & 15, cc = c & 31, ob = rr * 64 + cc * 2; return st * 1024 + (ob ^ (((ob >> 9) & 1) << 5)); }
DI void stage_rc(int b, int& Rr, int& Cc) { const int st = b / 1024, sb = b % 1024, swz = sb ^ (((sb >> 9) & 1) << 5); Rr = (st >> 1) * 16 + swz / 64; Cc = (st & 1) * 32 + (swz % 64) / 2; }
DI void gemm256(f32x4 (&acc)[2][2][4][2], const u16* __restrict__ A, const int lda, const u16* __restrict__ Bt, const int ldb,
                const int brow, const int bcol, const int K, char* shm) {
#define SA(b, h) (shm + ((b) * 2 + (h)) * HTB)
#define SB(b, h) (shm + (4 + (b) * 2 + (h)) * HTB)
#define STAGE_A(P, br, kt) do { const char* _u = (const char*)A + ((size_t)(br) * lda + (size_t)(kt) * 64) * 2; \
    __builtin_amdgcn_global_load_lds((const unsigned*)(_u + voA0), (unsigned*)((char*)(P) + sb0), 16, 0, 0); \
    __builtin_amdgcn_global_load_lds((const unsigned*)(_u + voA1), (unsigned*)((char*)(P) + sb1), 16, 0, 0); } while (0)
#define STAGE_B(P, br, kt) do { const char* _u = (const char*)Bt + ((size_t)(br) * ldb + (size_t)(kt) * 64) * 2; \
    __builtin_amdgcn_global_load_lds((const unsigned*)(_u + voB0), (unsigned*)((char*)(P) + sb0), 16, 0, 0); \
    __builtin_amdgcn_global_load_lds((const unsigned*)(_u + voB1), (unsigned*)((char*)(P) + sb1), 16, 0, 0); } while (0)
#define LDA(dst, b, h) _Pragma("unroll") for (int m = 0; m < 4; ++m) _Pragma("unroll") for (int k = 0; k < 2; ++k) \
    dst[m][k] = *reinterpret_cast<const bf16x8*>((char*)SA(b, h) + lds_byte(wr * 64 + m * 16 + fr, k * 32 + fq * 8))
#define LDB(dst, b, h) _Pragma("unroll") for (int n = 0; n < 2; ++n) _Pragma("unroll") for (int k = 0; k < 2; ++k) \
    dst[n][k] = *reinterpret_cast<const bf16x8*>((char*)SB(b, h) + lds_byte(wc * 32 + n * 16 + fr, k * 32 + fq * 8))
#define MMA(ai, bj, At_, Bt_) do { __builtin_amdgcn_s_setprio(1); \
    _Pragma("unroll") for (int m = 0; m < 4; ++m) _Pragma("unroll") for (int n = 0; n < 2; ++n) _Pragma("unroll") for (int k = 0; k < 2; ++k) \
      acc[ai][bj][m][n] = __builtin_amdgcn_mfma_f32_16x16x32_bf16(Bt_[n][k], At_[m][k], acc[ai][bj][m][n], 0, 0, 0); \
    __builtin_amdgcn_s_setprio(0); } while (0)
#define WAIT_V(n) asm volatile("s_waitcnt vmcnt(" #n ")" ::: "memory")
#define WAIT_L(n) asm volatile("s_waitcnt lgkmcnt(" #n ")" ::: "memory")
#define BAR __builtin_amdgcn_s_barrier()
#define SCHED __builtin_amdgcn_sched_barrier(0)
  int t_ = threadIdx.x;
  asm volatile("" : "+v"(t_));
  const int wid = __builtin_amdgcn_readfirstlane(t_ >> 6), lane = t_ & 63, wr = wid >> 2, wc = wid & 3, fr = lane & 15, fq = lane >> 4;
  const int sb0 = t_ * 16, sb1 = sb0 + 8192;
  int sr0, sc0, sr1, sc1; stage_rc(sb0, sr0, sc0); stage_rc(sb1, sr1, sc1);
  const unsigned voA0 = (unsigned)(sr0 * lda + sc0) * 2u, voA1 = (unsigned)(sr1 * lda + sc1) * 2u;
  const unsigned voB0 = (unsigned)(sr0 * ldb + sc0) * 2u, voB1 = (unsigned)(sr1 * ldb + sc1) * 2u;
  bf16x8 At[4][2], B0[2][2], B1[2][2];
  const int nt = K / 64;
  STAGE_B(SB(0, 0), bcol, 0); STAGE_A(SA(0, 0), brow, 0);
  STAGE_B(SB(0, 1), bcol + 128, 0); STAGE_A(SA(0, 1), brow + 128, 0);
  if (wr == 1) BAR;
  WAIT_V(4); BAR;
  STAGE_B(SB(1, 0), bcol, 1); STAGE_A(SA(1, 0), brow, 1); STAGE_B(SB(1, 1), bcol + 128, 1);
  WAIT_V(6); BAR;
  for (int t = 0; t < nt - 2; t += 2) {
    LDB(B0, 0, 0); SCHED; LDA(At, 0, 0); STAGE_A(SA(1, 1), brow + 128, t + 1);
    WAIT_L(8); BAR; WAIT_L(0); MMA(0, 0, At, B0); BAR; SCHED;
    LDB(B1, 0, 1); STAGE_B(SB(0, 0), bcol, t + 2);
    BAR; WAIT_L(0); MMA(0, 1, At, B1); BAR;
    LDA(At, 0, 1); STAGE_A(SA(0, 0), brow, t + 2);
    BAR; WAIT_L(0); MMA(1, 0, At, B0); BAR; SCHED;
    STAGE_B(SB(0, 1), bcol + 128, t + 2);
    WAIT_V(6); BAR; MMA(1, 1, At, B1); BAR;
    LDB(B0, 1, 0); SCHED; LDA(At, 1, 0); STAGE_A(SA(0, 1), brow + 128, t + 2);
    WAIT_L(8); BAR; WAIT_L(0); MMA(0, 0, At, B0); BAR; SCHED;
    LDB(B1, 1, 1); STAGE_B(SB(1, 0), bcol, t + 3);
    BAR; WAIT_L(0); MMA(0, 1, At, B1); BAR;
    LDA(At, 1, 1); STAGE_A(SA(1, 0), brow, t + 3);
    BAR; WAIT_L(0); MMA(1, 0, At, B0); BAR; SCHED;
    STAGE_B(SB(1, 1), bcol + 128, t + 3);
    WAIT_V(6); BAR; MMA(1, 1, At, B1); BAR;
  }
  { LDB(B0, 0, 0); LDA(At, 0, 0); STAGE_A(SA(1, 1), brow + 128, nt - 1);
    BAR; WAIT_L(0); MMA(0, 0, At, B0); BAR;
    LDB(B1, 0, 1); BAR; WAIT_L(0); MMA(0, 1, At, B1); BAR;
    LDA(At, 0, 1); WAIT_V(4); BAR; WAIT_L(0); MMA(1, 0, At, B0); MMA(1, 1, At, B1); BAR; }
  { LDB(B0, 1, 0); LDA(At, 1, 0); WAIT_V(2); BAR; WAIT_L(0); MMA(0, 0, At, B0); BAR;
    LDB(B1, 1, 1); WAIT_V(0); BAR; WAIT_L(0); MMA(0, 1, At, B1); BAR;
    LDA(At, 1, 1); BAR; WAIT_L(0); MMA(1, 0, At, B0); MMA(1, 1, At, B1); BAR; }
  if (wr == 0) BAR;
#undef SA
#undef SB
#undef STAGE_A
#undef STAGE_B
#undef LDA
#undef LDB
#undef MMA
}
DI void zero_acc(f32x4 (&acc)[2][2][4][2]) {
#pragma unroll
  for (int a = 0; a < 2; ++a)
#pragma unroll
    for (int b = 0; b < 2; ++b)
#pragma unroll
      for (int m = 0; m < 4; ++m)
#pragma unroll
        for (int n = 0; n < 2; ++n) acc[a][b][m][n] = (f32x4){0.f, 0.f, 0.f, 0.f};
}
template <class F> DI void tile_apply(const f32x4 (&acc)[2][2][4][2], int brow, int bcol, F f) {
  int t_ = threadIdx.x;
  asm volatile("" : "+v"(t_));
  const int wid = t_ >> 6, lane = t_ & 63, wr = wid >> 2, wc = wid & 3, fr = lane & 15, fq = lane >> 4;
#pragma unroll
  for (int ai = 0; ai < 2; ++ai)
#pragma unroll
    for (int m = 0; m < 4; ++m) {
      const int row = brow + ai * 128 + wr * 64 + m * 16 + fr;
#pragma unroll
      for (int bj = 0; bj < 2; ++bj)
#pragma unroll
        for (int n = 0; n < 2; ++n) f(row, bcol + bj * 128 + wc * 32 + n * 16 + 4 * fq, acc[ai][bj][m][n]);
      __builtin_amdgcn_sched_barrier(0);
    }
}
constexpr int TLD = 132;
template <class F> DI void tile_epilogue(const f32x4 (&acc)[2][2][4][2], int brow, int bcol, char* shm, F f) {
  int t_ = threadIdx.x;
  asm volatile("" : "+v"(t_));
  const int wid = t_ >> 6, lane = t_ & 63, wr = wid >> 2, wc = wid & 3, fr = lane & 15, fq = lane >> 4;
  float* T = (float*)shm;
#pragma unroll
  for (int bj = 0; bj < 2; ++bj) {
#pragma unroll
    for (int ai = 0; ai < 2; ++ai)
#pragma unroll
      for (int m = 0; m < 4; ++m)
#pragma unroll
        for (int n = 0; n < 2; ++n)
          *(f32x4*)(T + (ai * 128 + wr * 64 + m * 16 + fr) * TLD + wc * 32 + n * 16 + 4 * fq) = acc[ai][bj][m][n];
    __syncthreads();
    const int cg = (t_ & 31) * 4, r0 = t_ >> 5;
#pragma unroll 4
    for (int i = 0; i < 16; ++i) {
      const int rl = r0 + 16 * i;
      const f32x4 v = *(const f32x4*)(T + rl * TLD + cg);
      f(brow + rl, bcol + bj * 128 + cg, v);
    }
    __syncthreads();
  }
}
template <class F> DI void gemm_pass(const u16* A, int lda, const u16* Bt, int ldb, int N, int K, char* shm, F f) {
  const int nN = N >> 8, nunits = 64 * nN;
  for (int u = blockIdx.x; u < nunits; u += gridDim.x) {
    const int pm = u % 64, pn = u / 64;
    f32x4 acc[2][2][4][2];
    zero_acc(acc);
    gemm256(acc, A, lda, Bt, ldb, pm * 256, pn * 256, K, shm);
    tile_epilogue(acc, pm * 256, pn * 256, shm, f);
  }
}
template <int NTL, class CM, class E> DI void skinny(const u16* __restrict__ A, int lda, int row0, int nrows, const u16* __restrict__ Bt, int ldb, int K, CM cm, E epi) {
  int t_ = threadIdx.x;
  asm volatile("" : "+v"(t_));
  const int wid = t_ >> 6, lane = t_ & 63, fr = lane & 15, fq = lane >> 4;
  for (int mt = wid; mt * 16 < nrows; mt += 8) {
    int rr = mt * 16 + fr; const bool valid = rr < nrows; if (!valid) rr = nrows - 1;
    const u16* ap = A + (size_t)(row0 + rr) * lda + 8 * fq;
#pragma unroll
    for (int ntl = 0; ntl < NTL; ++ntl) {
      const u16* bp = Bt + (size_t)cm(ntl * 16 + fr) * ldb + 8 * fq;
      f32x4 acc = {0.f, 0.f, 0.f, 0.f};
#pragma unroll 16
      for (int ks = 0; ks < (K >> 5); ++ks) {
        const bf16x8 a = *(const bf16x8*)(ap + ks * 32);
        const bf16x8 b = *(const bf16x8*)(bp + ks * 32);
        acc = __builtin_amdgcn_mfma_f32_16x16x32_bf16(b, a, acc, 0, 0, 0);
      }
      if (valid) epi(row0 + rr, ntl, fq, acc, lane);
    }
  }
}
DI int map_in(int n) {
  if (n < 1024) { const int pn = n >> 8, c = n & 255; return c < 128 ? (pn * 128 + c) : (512 + pn * 128 + c - 128); }
  return n;
}
DI void phase_convert(const Params& p, char* smem) {
  float* tile = (float*)smem;
  const int tid = threadIdx.x;
  constexpr int NJ = 10;
  constexpr int pre[NJ + 1] = {0, 1024, 1280, 1536, 1792, 1920, 2176, 2432, 3456, 4480, 6016};
  for (int t = blockIdx.x; t < 6016; t += gridDim.x) {
    int j = 0, base = 0;
#pragma unroll
    for (int q = 1; q < NJ; ++q) if (t >= pre[q]) { j = q; base = pre[q]; }
    const int lt = t - base;
    const float* src; int ld, K; u16* dst; int moff = 0; int ldd = 0;
    switch (j) {
      case 0: src = p.w_in; ld = 7184; K = 1024; dst = (u16*)(p.ws + OFF_WIN); break;
      case 1: src = p.w_in; ld = 7184; K = 1024; dst = (u16*)(p.ws + OFF_WZ); moff = 4096; break;
      case 2: src = p.w_in; ld = 7184; K = 1024; dst = (u16*)(p.ws + OFF_WGA); moff = 5136; break;
      case 3: src = p.w_in; ld = 7184; K = 1024; dst = (u16*)(p.ws + OFF_WGB); moff = 6160; break;
      case 4: src = p.w_conf_out; ld = 1024; K = 512; dst = (u16*)(p.ws + OFF_WCONF); break;
      case 5: src = p.w_gdn_out; ld = 1024; K = 1024; dst = (u16*)(p.ws + OFF_WGDN); break;
      case 6: src = p.w_o; ld = 1024; K = 1024; dst = (u16*)(p.ws + OFF_WO); break;
      case 7: src = p.w_ff1; ld = 4096; K = 1024; dst = (u16*)(p.ws + OFF_W1); break;
      case 8: src = p.w_ff2; ld = 1024; K = 4096; dst = (u16*)(p.ws + OFF_W2); ldd = LDF; break;
      default: src = p.w_ada; ld = 6144; K = 1024; dst = (u16*)(p.ws + OFF_WADA); break;
    }
    const int nkt = K >> 6;
    const int n0 = (lt / nkt) * 64, k0 = (lt % nkt) * 64;
    {
      const int nn = tid & 63, ty = tid >> 6;
      const int sc = (j == 0) ? map_in(n0 + nn) : (n0 + nn + moff);
#pragma unroll
      for (int i = 0; i < 8; ++i) {
        const int kk = ty + 8 * i;
        tile[kk * 65 + nn] = __builtin_nontemporal_load(src + (size_t)(k0 + kk) * ld + sc);
      }
    }
    __syncthreads();
    {
      const int nn = tid >> 3, kq = (tid & 7) * 8;
      uint4 o0;
      const float* tp = tile + kq * 65 + nn;
      o0.x = pk2(tp[0 * 65], tp[1 * 65]);  o0.y = pk2(tp[2 * 65], tp[3 * 65]);
      o0.z = pk2(tp[4 * 65], tp[5 * 65]);  o0.w = pk2(tp[6 * 65], tp[7 * 65]);
      *(uint4*)(dst + (size_t)(n0 + nn) * (ldd ? ldd : K) + k0 + kq) = o0;
    }
    __syncthreads();
  }
  u16* Ac = (u16*)(p.ws + OFF_AC);
  for (int e = blockIdx.x * NT + tid; e < 256 * 256; e += gridDim.x * NT) {
    const int row = e >> 8, c4 = (e & 255) * 4;
    float4 v = make_float4(0.f, 0.f, 0.f, 0.f);
    if (row < 8) v = *(const float4*)(p.c_prompt + row * 1024 + c4);
    else if (row < 136) v = *(const float4*)(p.c_sample + (row - 8) * 1024 + c4);
    uint2 o; o.x = pk2(siluf_(v.x), siluf_(v.y)); o.y = pk2(siluf_(v.z), siluf_(v.w));
    *(uint2*)(Ac + row * 1024 + c4) = o;
  }
}

constexpr int WBA_LD = 1028;
template <bool BA> DI void phase_modnorm(const Params& p, const float* xa, const float* xb, const float* nw, int shift_off, int scale_off, u16* dst, char* smem) {
  int tmn = threadIdx.x;
  asm volatile("" : "+v"(tmn));
  const int lane = tmn & 63;
  const int gw = blockIdx.x * 8 + (tmn >> 6), nw_ = gridDim.x * 8;
  const float* mod = (const float*)(p.ws + OFF_MOD);
  float* wba = (float*)smem;
  if (BA) {
    for (int e = threadIdx.x; e < 16384; e += NT) { const int c = e >> 4, j = e & 15; wba[j * WBA_LD + c] = p.w_in[(size_t)c * 7184 + 5120 + j]; }
    __syncthreads();
  }
  float* gb = (float*)(p.ws + OFF_GB);
  for (int row = gw; row < R; row += nw_) {
    const float* xr = row < RP ? xa + (size_t)row * 1024 : xb + (size_t)(row - RP) * 1024;
    float4 v[4]; float ss = 0.f;
#pragma unroll
    for (int i = 0; i < 4; ++i) { v[i] = *(const float4*)(xr + (lane + 64 * i) * 4); ss += v[i].x * v[i].x + v[i].y * v[i].y + v[i].z * v[i].z + v[i].w * v[i].w; }
    ss = wsum(ss);
    const float rstd = rsqrtf(ss * (1.f / 1024.f) + EPS);
    const float* mr = mod + (size_t)mrow_of(row) * 6144;
    float ba[16];
    if (BA) {
#pragma unroll
      for (int j = 0; j < 16; ++j) ba[j] = 0.f;
    }
#pragma unroll
    for (int i = 0; i < 4; ++i) {
      const int c = (lane + 64 * i) * 4;
      const float4 w = *(const float4*)(nw + c), sc = *(const float4*)(mr + scale_off + c), sh = *(const float4*)(mr + shift_off + c);
      const float h0 = v[i].x * rstd * w.x * (1.f + sc.x) + sh.x, h1 = v[i].y * rstd * w.y * (1.f + sc.y) + sh.y;
      const float h2 = v[i].z * rstd * w.z * (1.f + sc.z) + sh.z, h3 = v[i].w * rstd * w.w * (1.f + sc.w) + sh.w;
      uint2 o; o.x = pk2(h0, h1); o.y = pk2(h2, h3);
      *(uint2*)(dst + (size_t)row * 1024 + c) = o;
      if (BA) {
#pragma unroll
        for (int j = 0; j < 16; ++j) { const float4 ww = *(const float4*)(wba + j * WBA_LD + c); ba[j] += h0 * ww.x + h1 * ww.y + h2 * ww.z + h3 * ww.w; }
        __builtin_amdgcn_sched_barrier(0);
      }
    }
    if (BA) {
#pragma unroll
      for (int w = 8; w >= 1; w >>= 1) {
        const bool up = (lane & w) != 0;
#pragma unroll
        for (int j = 0; j < w; ++j) {
          const float keep = up ? ba[j + w] : ba[j];
          const float send = up ? ba[j] : ba[j + w];
          ba[j] = keep + __shfl_xor(send, w, 64);
        }
      }
      float tot = ba[0];
      tot += __shfl_xor(tot, 16, 64); tot += __shfl_xor(tot, 32, 64);
      if (lane < 8) gb[(size_t)row * 16 + lane] = sigmoidf_(tot);
      else if (lane < 16) gb[(size_t)row * 16 + lane] = -__expf(p.a_log[lane - 8]) * softplusf_(tot + p.dt_bias[lane - 8]);
    }
  }
  if (BA) __syncthreads();
}

constexpr int LKN = 136, LKT = 72;
DI void d1_item(const Params& p, int item, char* smem) {
  int tid = threadIdx.x & 255;
  asm volatile("" : "+v"(tid));
  const int lane = tid & 63, wave = __builtin_amdgcn_readfirstlane(tid >> 6);
  const int r = lane & 31, hh = lane >> 5;
  const int h = item & 7, n = (item >> 3) & 31, b = item >> 8;
  const int rowbase = b * 2048 + n * 64;
  u16* kn  = (u16*)smem;
  u16* qn  = (u16*)(smem + 17408);
  u16* knT = (u16*)(smem + 34816);
  u16* vT  = (u16*)(smem + 53248);
  float* Gs = (float*)(smem + 71680);
  float* Bs = Gs + 64;
  float* Amat = (float*)(smem + 17408);
  u16* Tb = (u16*)smem;
  u16* Tg = (u16*)(smem + 17408);
  u16* qkv = (u16*)(p.ws + OFF_QKV);
  const u16* halo = (const u16*)(p.ws + OFF_HALO);
  const float* gb = (const float*)(p.ws + OFF_GB);

  if (wave == 0) {
    float g = gb[(size_t)(rowbase + lane) * 16 + 8 + h];
    const float be = gb[(size_t)(rowbase + lane) * 16 + h];
#pragma unroll
    for (int m = 1; m < 64; m <<= 1) { float t = __shfl_up(g, m, 64); if (lane >= m) g += t; }
    Gs[lane] = g; Bs[lane] = be;
  }
  {
    const int cp = lane;
#pragma unroll
    for (int X = 0; X < 3; ++X) {
      const int cb = X * 1024 + h * 128 + 2 * cp;
      float w[4][2];
#pragma unroll
      for (int j = 0; j < 4; ++j) { float2 t = *(const float2*)(p.gdn_conv_w + j * 3072 + cb); w[j][0] = t.x; w[j][1] = t.y; }
      float xw[3][2];
#pragma unroll
      for (int j = 0; j < 3; ++j) {
        const int rr = wave * 16 - 3 + j;
        unsigned u = 0u;
        if (rr >= 0) u = *(const unsigned*)(qkv + (size_t)(rowbase + rr) * 3072 + cb);
        else if (n > 0) u = *(const unsigned*)(halo + ((size_t)((b * 32 + n - 1) * 3 + (rr + 3))) * 3072 + cb);
        xw[j][0] = bf_lo(u); xw[j][1] = bf_hi(u);
      }
      float o[16][2];
#pragma unroll
      for (int t = 0; t < 16; ++t) {
        const unsigned u = *(const unsigned*)(qkv + (size_t)(rowbase + wave * 16 + t) * 3072 + cb);
        const float x0 = bf_lo(u), x1 = bf_hi(u);
        const float a0 = w[0][0] * xw[0][0] + w[1][0] * xw[1][0] + w[2][0] * xw[2][0] + w[3][0] * x0;
        const float a1 = w[0][1] * xw[0][1] + w[1][1] * xw[1][1] + w[2][1] * xw[2][1] + w[3][1] * x1;
        o[t][0] = siluf_(a0); o[t][1] = siluf_(a1);
        xw[0][0] = xw[1][0]; xw[0][1] = xw[1][1]; xw[1][0] = xw[2][0]; xw[1][1] = xw[2][1]; xw[2][0] = x0; xw[2][1] = x1;
      }
      if (X < 2) {
#pragma unroll
        for (int t = 0; t < 16; ++t) {
          const float ss = wsum(o[t][0] * o[t][0] + o[t][1] * o[t][1]);
          const float rs = rsqrtf(ss + EPS);
          o[t][0] *= rs; o[t][1] *= rs;
        }
      }
#pragma unroll
      for (int t = 0; t < 16; ++t) {
        const int row = wave * 16 + t;
        const unsigned pk = pk2(o[t][0], o[t][1]);
        if (X == 0) { *(unsigned*)(qn + row * LKN + 2 * cp) = pk; }
        else if (X == 1) {
          *(unsigned*)(kn + row * LKN + 2 * cp) = pk;
          knT[(2 * cp) * LKT + row] = (u16)(pk & 0xffffu); knT[(2 * cp + 1) * LKT + row] = (u16)(pk >> 16);
        } else {
          vT[(2 * cp) * LKT + row] = (u16)(pk & 0xffffu); vT[(2 * cp + 1) * LKT + row] = (u16)(pk >> 16);
        }
      }
    }
  }
  __syncthreads();
  const float Glast = Gs[63];
#pragma unroll
  for (int ff = 0; ff < 4; ++ff) {
    const int f = wave * 4 + ff;
    const int it = f >> 3, kb = (f >> 1) & 3, s = f & 1;
    const int i = it * 32 + r;
    const float sc = QSCALE * __expf(Gs[i]);
    const uint2 a = *(const uint2*)(qn + i * LKN + kb * 32 + 16 * s + 4 * hh);
    const uint2 c = *(const uint2*)(qn + i * LKN + kb * 32 + 16 * s + 4 * hh + 8);
    uint4 o;
    o.x = pk2(bf_lo(a.x) * sc, bf_hi(a.x) * sc); o.y = pk2(bf_lo(a.y) * sc, bf_hi(a.y) * sc);
    o.z = pk2(bf_lo(c.x) * sc, bf_hi(c.x) * sc); o.w = pk2(bf_lo(c.y) * sc, bf_hi(c.y) * sc);
    *(uint4*)((char*)qkv + (size_t)(rowbase + 4 * f + (lane >> 4)) * 6144 + h * 256 + (lane & 15) * 16) = o;
  }
  char* ext = p.ws + OFF_EXTRA + (size_t)item * 24576;
#pragma unroll
  for (int ff = 0; ff < 4; ++ff) {
    const int f = wave * 4 + ff;
    const int kt = f >> 2, pb = (f >> 1) & 1, s = f & 1;
    const int k = kt * 32 + r;
    const int p0 = pb * 32 + 16 * s + 4 * hh;
    const uint2 a = *(const uint2*)(knT + k * LKT + p0);
    const uint2 c = *(const uint2*)(knT + k * LKT + p0 + 8);
    const float4 g0 = *(const float4*)(Gs + p0), g1 = *(const float4*)(Gs + p0 + 8);
    uint4 o;
    o.x = pk2(bf_lo(a.x) * __expf(Glast - g0.x), bf_hi(a.x) * __expf(Glast - g0.y));
    o.y = pk2(bf_lo(a.y) * __expf(Glast - g0.z), bf_hi(a.y) * __expf(Glast - g0.w));
    o.z = pk2(bf_lo(c.x) * __expf(Glast - g1.x), bf_hi(c.x) * __expf(Glast - g1.y));
    o.w = pk2(bf_lo(c.y) * __expf(Glast - g1.z), bf_hi(c.y) * __expf(Glast - g1.w));
    *(uint4*)(ext + f * 1024 + lane * 16) = o;
  }
  f32x16 akk = zero16(), aqk = zero16();
  const int ta = (wave == 0) ? 0 : 1, tb = (wave == 2) ? 1 : 0;
  if (wave < 3) {
#pragma unroll
    for (int ks = 0; ks < 8; ++ks) {
      const bf16x8 fa = *(const bf16x8*)(kn + (ta * 32 + r) * LKN + ks * 16 + 8 * hh);
      const bf16x8 fb = *(const bf16x8*)(kn + (tb * 32 + r) * LKN + ks * 16 + 8 * hh);
      const bf16x8 fq = *(const bf16x8*)(qn + (ta * 32 + r) * LKN + ks * 16 + 8 * hh);
      akk = MFMA(fa, fb, akk);
      aqk = MFMA(fb, fq, aqk);
    }
  }
  __syncthreads();
  if (wave < 3) {
    const int m = tb * 32 + r; const float Gm = Gs[m];
#pragma unroll
    for (int reg = 0; reg < 16; ++reg) {
      const int i = ta * 32 + crow(reg, hh);
      const float v = (m < i) ? Bs[i] * akk[reg] * __expf(Gs[i] - Gm) : 0.f;
      Amat[i * 64 + m] = v;
    }
    const int i = ta * 32 + r; const float Gi = Gs[i];
    f32x16 av;
#pragma unroll
    for (int reg = 0; reg < 16; ++reg) {
      const int j = tb * 32 + crow(reg, hh);
      av[reg] = (j <= i) ? aqk[reg] * QSCALE * __expf(Gi - Gs[j]) : 0.f;
    }
    const int fbase = 16 + (wave * 2);
#pragma unroll
    for (int s = 0; s < 2; ++s) {
      bf16x8 fr8 = pack8(av, s);
      *(bf16x8*)(ext + (fbase + s) * 1024 + lane * 16) = fr8;
    }
  } else {
    for (int e = lane; e < 32 * 32; e += 64) Amat[(e >> 5) * 64 + 32 + (e & 31)] = 0.f;
    if (lane == 0) *(float*)(ext + 22 * 1024) = __expf(Glast);
  }
  __syncthreads();
  float* Tq = (float*)(smem + 9216);
  if (wave == 0) {
    float x[32];
    const int c = lane & 31, hb = lane >> 5;
    const float* Ab = Amat + (hb * 32) * 64 + hb * 32;
#pragma unroll
    for (int i = 0; i < 32; ++i) {
      float s0 = (c == i) ? 1.f : 0.f, s1 = 0.f;
#pragma unroll
      for (int m4 = 0; m4 < (i + 3) / 4; ++m4) {
        const float4 a4 = *(const float4*)(Ab + i * 64 + m4 * 4);
        if (m4 * 4 + 0 < i) s0 -= a4.x * x[m4 * 4 + 0];
        if (m4 * 4 + 1 < i) s1 -= a4.y * x[m4 * 4 + 1];
        if (m4 * 4 + 2 < i) s0 -= a4.z * x[m4 * 4 + 2];
        if (m4 * 4 + 3 < i) s1 -= a4.w * x[m4 * 4 + 3];
      }
      x[i] = s0 + s1;
      __builtin_amdgcn_sched_barrier(0);
    }
#pragma unroll
    for (int i = 0; i < 32; ++i) Tq[hb * 1024 + i * 32 + c] = x[i];
  }
  __syncthreads();
  const int c32 = tid & 31, g8 = tid >> 5;
  {
    float bm[4] = {0.f, 0.f, 0.f, 0.f};
#pragma unroll
    for (int j4 = 0; j4 < 8; ++j4) {
      float t[4];
#pragma unroll
      for (int e = 0; e < 4; ++e) t[e] = Tq[(j4 * 4 + e) * 32 + c32];
#pragma unroll
      for (int e = 0; e < 4; ++e) {
        const float4 a4 = *(const float4*)(Amat + (32 + g8 * 4 + e) * 64 + j4 * 4);
        bm[e] += a4.x * t[0] + a4.y * t[1] + a4.z * t[2] + a4.w * t[3];
      }
    }
#pragma unroll
    for (int e = 0; e < 4; ++e) Amat[(g8 * 4 + e) * 64 + 32 + c32] = bm[e];
  }
  __syncthreads();
  float t21[4] = {0.f, 0.f, 0.f, 0.f};
  {
#pragma unroll
    for (int m4 = 0; m4 < 8; ++m4) {
      float bv[4];
#pragma unroll
      for (int e = 0; e < 4; ++e) bv[e] = Amat[(m4 * 4 + e) * 64 + 32 + c32];
#pragma unroll
      for (int e = 0; e < 4; ++e) {
        const float4 a4 = *(const float4*)(Tq + 1024 + (g8 * 4 + e) * 32 + m4 * 4);
        t21[e] -= a4.x * bv[0] + a4.y * bv[1] + a4.z * bv[2] + a4.w * bv[3];
      }
    }
  }
  float t11[4], t22[4];
#pragma unroll
  for (int e = 0; e < 4; ++e) { t11[e] = Tq[(g8 * 4 + e) * 32 + c32]; t22[e] = Tq[1024 + (g8 * 4 + e) * 32 + c32]; }
  const float bcl = Bs[c32], bgl = bcl * __expf(Gs[c32]);
  const float bch = Bs[32 + c32], bgh = bch * __expf(Gs[32 + c32]);
  __syncthreads();
#pragma unroll
  for (int e = 0; e < 4; ++e) {
    const int i = g8 * 4 + e;
    Tb[i * LKT + c32] = f2bf(t11[e] * bcl);               Tg[i * LKT + c32] = f2bf(t11[e] * bgl);
    Tb[i * LKT + 32 + c32] = (u16)0;                      Tg[i * LKT + 32 + c32] = (u16)0;
    Tb[(32 + i) * LKT + c32] = f2bf(t21[e] * bcl);        Tg[(32 + i) * LKT + c32] = f2bf(t21[e] * bgl);
    Tb[(32 + i) * LKT + 32 + c32] = f2bf(t22[e] * bch);   Tg[(32 + i) * LKT + 32 + c32] = f2bf(t22[e] * bgh);
  }
  __syncthreads();
#pragma unroll
  for (int it = 0; it < 2; ++it) {
    f32x16 av = zero16(), ak = zero16();
#pragma unroll
    for (int ks = 0; ks < 4; ++ks) {
      const bf16x8 fT = *(const bf16x8*)(Tb + (it * 32 + r) * LKT + ks * 16 + 8 * hh);
      const bf16x8 fV = *(const bf16x8*)(vT + (wave * 32 + r) * LKT + ks * 16 + 8 * hh);
      const bf16x8 fK = *(const bf16x8*)(knT + (wave * 32 + r) * LKT + ks * 16 + 8 * hh);
      const bf16x8 fG = *(const bf16x8*)(Tg + (it * 32 + r) * LKT + ks * 16 + 8 * hh);
      av = MFMA(fT, fV, av);
      ak = MFMA(fK, fG, ak);
    }
    {
      const int fv = wave * 2 + it;
      char* d = (char*)qkv + (size_t)(rowbase + 8 * fv + (lane >> 3)) * 6144 + 4096 + h * 256 + (lane & 7) * 32;
      *(bf16x8*)d = pack8(av, 0); *(bf16x8*)(d + 16) = pack8(av, 1);
    }
#pragma unroll
    for (int s = 0; s < 2; ++s) {
      const int f = it * 8 + wave * 2 + s;
      *(bf16x8*)((char*)qkv + (size_t)(rowbase + 4 * f + (lane >> 4)) * 6144 + 2048 + h * 256 + (lane & 15) * 16) = pack8(ak, s);
    }
  }
  __syncthreads();
}

DI void d2_issue(u32x4 (&rg)[18], const Params& p, int b, int h, int lt, int n) {
  const char* qseg = p.ws + OFF_QKV + (size_t)(b * 2048 + n * 64) * 6144 + h * 256;
  const char* ext = p.ws + OFF_EXTRA + (size_t)((b * 32 + n) * 8 + h) * 24576;
#pragma unroll
  for (int sg = 0; sg < 3; ++sg)
#pragma unroll
    for (int i = 0; i < 4; ++i) rg[sg * 4 + i] = *(const u32x4*)(qseg + (size_t)((lt >> 4) + 16 * i) * 6144 + sg * 2048 + (lt & 15) * 16);
#pragma unroll
  for (int i = 0; i < 6; ++i) rg[12 + i] = *(const u32x4*)(ext + lt * 16 + i * 4096);
}
DI void d2_put(const u32x4 (&rg)[18], char* buf, int lt) {
#pragma unroll
  for (int sg = 0; sg < 3; ++sg)
#pragma unroll
    for (int i = 0; i < 4; ++i) *(u32x4*)(buf + sg * 16384 + ((lt >> 4) + 16 * i) * 256 + (lt & 15) * 16) = rg[sg * 4 + i];
#pragma unroll
  for (int i = 0; i < 6; ++i) *(u32x4*)(buf + 49152 + lt * 16 + i * 4096) = rg[12 + i];
}
DI void d2_block(const Params& p, int unit, char* smem) {
  const int tid = threadIdx.x, half = tid >> 8, lt = tid & 255, lane = tid & 63, wave = (tid >> 6) & 3;
  const int r = lane & 31, hh = lane >> 5;
  const int b = unit >> 3, h = unit & 7;
  const char* qkv = p.ws + OFF_QKV;
  const float* egl = (const float*)(p.ws + OFF_EGL);
  u16* obuf = (u16*)((char*)p.out + (size_t)R * 1024 * 2);
  if (half == 1) {
    u32x4 rg0[18], rg1[18];
    u32x4 og[4], sg4;
    u16* obuf_ = (u16*)((char*)p.out + (size_t)R * 1024 * 2);
    float* ssq_ = (float*)(p.ws + OFF_SSQ);
    const int orow = lt >> 2, opos = lt & 3, ocol = 8 * (opos ^ ((orow >> 1) & 3));
    d2_issue(rg0, p, b, h, lt, 0); d2_put(rg0, smem, lt); d2_issue(rg1, p, b, h, lt, 1); d2_issue(rg0, p, b, h, lt, 2);
    __syncthreads();
#define D2_LOADER_STEP(n_, RG)                                                                                              \
    {                                                                                                                        \
      const int n = (n_);                                                                                                    \
      char* ob = smem + ((n + 1) & 1) * HALF_SMEM;                                                                           \
      if (n >= 1) {                                                                                                          \
        _Pragma("unroll") for (int i = 0; i < 4; ++i) og[i] = *(const u32x4*)(ob + 32768 + (lt + 256 * i) * 16);            \
        if (lt >= 192) sg4 = *(const u32x4*)(ob + 49152 + 20480 + lt * 16);                                                  \
      }                                                                                                                      \
      if (n + 1 < 32) { d2_put(RG, ob, lt); if (n + 3 < 32) d2_issue(RG, p, b, h, lt, n + 3); }                              \
      if (n >= 1) {                                                                                                          \
        const int rowbase = b * 2048 + (n - 1) * 64;                                                                         \
        _Pragma("unroll") for (int i = 0; i < 4; ++i)                                                                        \
          *(u32x4*)(obuf_ + (size_t)(rowbase + orow) * 1024 + h * 128 + 32 * i + ocol) = og[i];                              \
        if (lt >= 192) *(u32x4*)(ssq_ + ((size_t)(rowbase + lt - 192) * 8 + h) * 4) = sg4;                                   \
      }                                                                                                                      \
      if (n < 32) { asm volatile("s_waitcnt lgkmcnt(0)" ::: "memory"); __builtin_amdgcn_s_barrier(); asm volatile("" ::: "memory"); } \
    }
#pragma unroll 1
    for (int n2 = 0; n2 <= 32; n2 += 2) {
      D2_LOADER_STEP(n2, rg1)
      if (n2 + 1 <= 32) D2_LOADER_STEP(n2 + 1, rg0)
    }
#undef D2_LOADER_STEP
    return;
  }
  f32x16 S[4];
#pragma unroll
  for (int k = 0; k < 4; ++k) S[k] = zero16();
  const unsigned voff_l = (unsigned)(lane * 16);
  bf16x8 If0, If1;
#pragma unroll
  for (int j = 0; j < 8; ++j) {
    const int k0 = 8 * (j >> 2) + 4 * hh + (j & 3);
    If0[j] = (short)((k0 == r) ? 0x3F80 : 0); If1[j] = (short)((16 + k0 == r) ? 0x3F80 : 0);
  }
  const unsigned voff_v = (unsigned)((16 * wave + (lane >> 3)) * 256 + (lane & 7) * 32);
  __syncthreads();
#pragma unroll 1
  for (int n = 0; n < 32; ++n) {
    const int item = (b * 32 + n) * 8 + h;
    const int rowbase = b * 2048 + n * 64;
    const char* buf = smem + (n & 1) * HALF_SMEM;
    const char* ext = buf + 49152;
    const float eg = *(const float*)(ext + 22 * 1024);
    bf16x8 fk[16];
#pragma unroll
    for (int f = 0; f < 16; ++f) fk[f] = *(const bf16x8*)(buf + 16384 + f * 1024 + voff_l);
    uint4 vv[2][2];
#pragma unroll
    for (int it = 0; it < 2; ++it) { const char* d = buf + 32768 + it * 2048 + voff_v; vv[it][0] = *(const uint4*)d; vv[it][1] = *(const uint4*)(d + 16); }
    bf16x8 Sf[4][2];
#pragma unroll
    for (int kb = 0; kb < 4; ++kb) { Sf[kb][0] = pack8(S[kb], 0); Sf[kb][1] = pack8(S[kb], 1); }
    __builtin_amdgcn_sched_barrier(0);
    f32x16 P1[2];
    P1[0] = zero16(); P1[1] = zero16();
#pragma unroll
    for (int kb = 0; kb < 4; ++kb)
#pragma unroll
      for (int s = 0; s < 2; ++s) {
        P1[0] = MFMA(fk[kb * 2 + s], Sf[kb][s], P1[0]);
        P1[1] = MFMA(fk[8 + kb * 2 + s], Sf[kb][s], P1[1]);
      }
    bf16x8 fq[8];
#pragma unroll
    for (int f = 0; f < 8; ++f) fq[f] = *(const bf16x8*)(buf + f * 1024 + voff_l);
    bf16x8 Vf[2][2];
#pragma unroll
    for (int it = 0; it < 2; ++it) {
      const uint4 v0 = vv[it][0], v1 = vv[it][1];
      f32x16 vn;
      vn[0] = bf_lo(v0.x) - P1[it][0];  vn[1] = bf_hi(v0.x) - P1[it][1];
      vn[2] = bf_lo(v0.y) - P1[it][2];  vn[3] = bf_hi(v0.y) - P1[it][3];
      vn[4] = bf_lo(v0.z) - P1[it][4];  vn[5] = bf_hi(v0.z) - P1[it][5];
      vn[6] = bf_lo(v0.w) - P1[it][6];  vn[7] = bf_hi(v0.w) - P1[it][7];
      vn[8] = bf_lo(v1.x) - P1[it][8];  vn[9] = bf_hi(v1.x) - P1[it][9];
      vn[10] = bf_lo(v1.y) - P1[it][10]; vn[11] = bf_hi(v1.y) - P1[it][11];
      vn[12] = bf_lo(v1.z) - P1[it][12]; vn[13] = bf_hi(v1.z) - P1[it][13];
      vn[14] = bf_lo(v1.w) - P1[it][14]; vn[15] = bf_hi(v1.w) - P1[it][15];
      Vf[it][0] = pack8(vn, 0); Vf[it][1] = pack8(vn, 1);
    }
    bf16x8 fa[6];
#pragma unroll
    for (int i = 0; i < 6; ++i) fa[i] = *(const bf16x8*)(ext + (16 + i) * 1024 + voff_l);
    f32x16 P2[2];
    P2[0] = zero16(); P2[1] = zero16();
#pragma unroll
    for (int kb = 0; kb < 4; ++kb)
#pragma unroll
      for (int s = 0; s < 2; ++s) {
        P2[0] = MFMA(fq[kb * 2 + s], Sf[kb][s], P2[0]);
        const bf16x8 fq1 = *(const bf16x8*)(buf + (8 + kb * 2 + s) * 1024 + voff_l);
        P2[1] = MFMA(fq1, Sf[kb][s], P2[1]);
      }
    __builtin_amdgcn_sched_barrier(0);
    bf16x8 fkd[16];
#pragma unroll
    for (int i = 0; i < 16; ++i) fkd[i] = *(const bf16x8*)(ext + i * 1024 + voff_l);
#pragma unroll
    for (int s = 0; s < 2; ++s) {
      P2[0] = MFMA(fa[0 + s], Vf[0][s], P2[0]);
      P2[1] = MFMA(fa[2 + s], Vf[0][s], P2[1]);
      P2[1] = MFMA(fa[4 + s], Vf[1][s], P2[1]);
    }
    {
      char* ow = (char*)buf + 32768 + wave * 4096;
      float* sqw = (float*)((char*)buf + 49152 + 23 * 1024);
      const int xs = (r >> 1) & 3;
#pragma unroll
      for (int it = 0; it < 2; ++it) {
        f32x16 Z = MFMA(pack8(P2[it], 0), If0, zero16());
        Z = MFMA(pack8(P2[it], 1), If1, Z);
        float ssl = 0.f;
#pragma unroll
        for (int reg = 0; reg < 16; ++reg) ssl += Z[reg] * Z[reg];
        ssl += __shfl_xor(ssl, 32, 64);
        if (hh == 0) sqw[(it * 32 + r) * 4 + wave] = ssl;
#pragma unroll
        for (int g = 0; g < 4; ++g) {
          uint2 pv; pv.x = pk2(Z[4 * g], Z[4 * g + 1]); pv.y = pk2(Z[4 * g + 2], Z[4 * g + 3]);
          *(uint2*)(ow + (it * 32 + r) * 64 + ((g ^ xs) * 16) + hh * 8) = pv;
        }
      }
    }
#pragma unroll
    for (int kt = 0; kt < 4; ++kt) {
#pragma unroll
      for (int reg = 0; reg < 16; ++reg) S[kt][reg] *= eg;
#pragma unroll
      for (int pb = 0; pb < 2; ++pb)
#pragma unroll
        for (int s = 0; s < 2; ++s) {
          S[kt] = MFMA(fkd[kt * 4 + pb * 2 + s], Vf[pb][s], S[kt]);
        }
    }
    asm volatile("s_waitcnt lgkmcnt(0)" ::: "memory"); __builtin_amdgcn_s_barrier(); asm volatile("" ::: "memory");
  }
  float* od = p.out + OUT_DELTAP + (size_t)(b * 8 + h) * 16384;
#pragma unroll
  for (int kt = 0; kt < 4; ++kt)
#pragma unroll
    for (int reg = 0; reg < 16; ++reg) od[(kt * 32 + crow(reg, hh)) * 128 + wave * 32 + r] = S[kt][reg];
}

DI void conf_prompt_item(const Params& p, int item, char* smem) {
  const int tid = threadIdx.x & 255, lane = tid & 63, wave = tid >> 6;
  const int b = item >> 6, t0 = (item & 63) * 32;
  unsigned* tile = (unsigned*)smem;
  float* red = (float*)(smem + 63488);
  const u16* glu = (const u16*)(p.ws + OFF_GLU);
  u16* aact = (u16*)(p.ws + OFF_AACT);
#pragma unroll 1
  for (int hb = 0; hb < 2; ++hb) {
    u32x4 fv[8];
#pragma unroll
    for (int i = 0; i < 8; ++i) {
      const int e = tid + 256 * (hb * 8 + i), rr = e >> 6, c8 = (e & 63) * 8;
      const int t = t0 - 30 + rr;
      fv[i] = (u32x4){0u, 0u, 0u, 0u};
      if (rr < 62 && t >= 0) fv[i] = *(const u32x4*)(glu + (size_t)(b * 2048 + t) * 512 + c8);
    }
#pragma unroll
    for (int i = 0; i < 8; ++i) {
      const int e = tid + 256 * (hb * 8 + i), rr = e >> 6, c8 = (e & 63) * 8;
      if (rr < 62) *(u32x4*)(tile + rr * 256 + (c8 >> 1)) = fv[i];
    }
  }
  float w[31][2];
#pragma unroll
  for (int j = 0; j < 31; ++j) { const float2 t = *(const float2*)(p.conf_dw_w + j * 512 + 2 * tid); w[j][0] = t.x; w[j][1] = t.y; }
  const float2 bias = *(const float2*)(p.conf_dw_b + 2 * tid);
  const float2 lw = *(const float2*)(p.conf_ln_w + 2 * tid), lb = *(const float2*)(p.conf_ln_b + 2 * tid);
  __syncthreads();
#pragma unroll 1
  for (int tg = 0; tg < 4; ++tg) {
    float a[8][2];
#pragma unroll
    for (int t = 0; t < 8; ++t) { a[t][0] = bias.x; a[t][1] = bias.y; }
#pragma unroll
    for (int i = 0; i < 38; ++i) {
      const unsigned u = tile[(tg * 8 + i) * 256 + tid];
      const float x0 = bf_lo(u), x1 = bf_hi(u);
#pragma unroll
      for (int t = 0; t < 8; ++t) {
        const int j = i - t;
        if (j >= 0 && j < 31) { a[t][0] += w[j][0] * x0; a[t][1] += w[j][1] * x1; }
      }
    }
#pragma unroll
    for (int t = 0; t < 8; ++t) {
      const float s1 = wsum(a[t][0] + a[t][1]);
      const float s2 = wsum(a[t][0] * a[t][0] + a[t][1] * a[t][1]);
      if (lane == 0) { red[(wave * 8 + t) * 2] = s1; red[(wave * 8 + t) * 2 + 1] = s2; }
    }
    __syncthreads();
#pragma unroll
    for (int t = 0; t < 8; ++t) {
      const float s1 = red[t * 2] + red[(8 + t) * 2] + red[(16 + t) * 2] + red[(24 + t) * 2];
      const float s2 = red[t * 2 + 1] + red[(8 + t) * 2 + 1] + red[(16 + t) * 2 + 1] + red[(24 + t) * 2 + 1];
      const float mu = s1 * (1.f / 512.f);
      const float var = fmaxf(s2 * (1.f / 512.f) - mu * mu, 0.f);
      const float rs = rsqrtf(var + EPS);
      const float y0 = (a[t][0] - mu) * rs * lw.x + lb.x, y1 = (a[t][1] - mu) * rs * lw.y + lb.y;
      *(unsigned*)(aact + (size_t)(b * 2048 + t0 + tg * 8 + t) * 512 + 2 * tid) = pk2(siluf_(y0), siluf_(y1));
    }
    __syncthreads();
  }
}
DI void conf_sample_item(const Params& p, int item) {
  const int lane = threadIdx.x & 63, wave = (threadIdx.x >> 6) & 3;
  const int s = item * 4 + wave;
  const int c = lane * 8;
  const u16* glu = (const u16*)(p.ws + OFF_GLU);
  u16* aact = (u16*)(p.ws + OFF_AACT);
  float a[8];
  {
    const float4 b0 = *(const float4*)(p.conf_dw_b + c), b1 = *(const float4*)(p.conf_dw_b + c + 4);
    a[0] = b0.x; a[1] = b0.y; a[2] = b0.z; a[3] = b0.w; a[4] = b1.x; a[5] = b1.y; a[6] = b1.z; a[7] = b1.w;
  }
  const float* st = p.st_conf + (size_t)s * 30 * 512;
  float* oc = p.out + OUT_CONFS + (size_t)s * 30 * 512;
#pragma unroll 1
  for (int j = 0; j < 30; ++j) {
    const float4 x0 = *(const float4*)(st + j * 512 + c), x1 = *(const float4*)(st + j * 512 + c + 4);
    const float4 w0 = *(const float4*)(p.conf_dw_w + j * 512 + c), w1 = *(const float4*)(p.conf_dw_w + j * 512 + c + 4);
    a[0] += w0.x * x0.x; a[1] += w0.y * x0.y; a[2] += w0.z * x0.z; a[3] += w0.w * x0.w;
    a[4] += w1.x * x1.x; a[5] += w1.y * x1.y; a[6] += w1.z * x1.z; a[7] += w1.w * x1.w;
    if (j >= 1) { *(float4*)(oc + (j - 1) * 512 + c) = x0; *(float4*)(oc + (j - 1) * 512 + c + 4) = x1; }
  }
  {
    const uint4 g = *(const uint4*)(glu + (size_t)(RP + s) * 512 + c);
    const float4 w0 = *(const float4*)(p.conf_dw_w + 30 * 512 + c), w1 = *(const float4*)(p.conf_dw_w + 30 * 512 + c + 4);
    a[0] += w0.x * bf_lo(g.x); a[1] += w0.y * bf_hi(g.x); a[2] += w0.z * bf_lo(g.y); a[3] += w0.w * bf_hi(g.y);
    a[4] += w1.x * bf_lo(g.z); a[5] += w1.y * bf_hi(g.z); a[6] += w1.z * bf_lo(g.w); a[7] += w1.w * bf_hi(g.w);
  }
  float s1 = 0.f, s2 = 0.f;
#pragma unroll
  for (int i = 0; i < 8; ++i) { s1 += a[i]; s2 += a[i] * a[i]; }
  s1 = wsum(s1); s2 = wsum(s2);
  const float mu = s1 * (1.f / 512.f);
  const float rs = rsqrtf(fmaxf(s2 * (1.f / 512.f) - mu * mu, 0.f) + EPS);
  float y[8];
#pragma unroll
  for (int i = 0; i < 8; ++i) y[i] = siluf_((a[i] - mu) * rs * p.conf_ln_w[c + i] + p.conf_ln_b[c + i]);
  uint4 o; o.x = pk2(y[0], y[1]); o.y = pk2(y[2], y[3]); o.z = pk2(y[4], y[5]); o.w = pk2(y[6], y[7]);
  *(uint4*)(aact + (size_t)(RP + s) * 512 + c) = o;
}
DI void delta_sample_item(const Params& p, int item, char* smem) {
  const int tid = threadIdx.x & 255, lane = tid & 63, wave = tid >> 6;
  const int s = item >> 3, h = item & 7;
  float* qs = (float*)smem; float* ks = qs + 128; float* vs = ks + 128; float* part = vs + 128;
  float* red = part + 768;
  const u16* qkv = (const u16*)(p.ws + OFF_QKV);
  const float* gb = (const float*)(p.ws + OFF_GB);
  const int row = RP + s;
  const int v = tid & 127, kh = tid >> 7;
  const float* S0 = p.st_delta + (size_t)(s * 8 + h) * 16384 + (size_t)(kh * 64) * 128 + v;
  float Sr[64];
#pragma unroll
  for (int kk = 0; kk < 64; ++kk) Sr[kk] = __builtin_nontemporal_load(S0 + kk * 128);
  const float g = gb[(size_t)row * 16 + 8 + h], beta = gb[(size_t)row * 16 + h];
  float cq = 0.f, ck = 0.f, cv = 0.f;
  if (tid < 128) {
    float cx[3];
#pragma unroll
    for (int X = 0; X < 3; ++X) {
      const int cg = X * 1024 + h * 128 + tid;
      const float s0 = p.st_qkv[(size_t)(s * 3 + 0) * 3072 + cg], s1 = p.st_qkv[(size_t)(s * 3 + 1) * 3072 + cg], s2 = p.st_qkv[(size_t)(s * 3 + 2) * 3072 + cg];
      const float x = bf1(qkv[(size_t)row * 3072 + cg]);
      const float a = p.gdn_conv_w[cg] * s0 + p.gdn_conv_w[3072 + cg] * s1 + p.gdn_conv_w[2 * 3072 + cg] * s2 + p.gdn_conv_w[3 * 3072 + cg] * x;
      cx[X] = siluf_(a);
      p.out[OUT_QKVS + (size_t)(s * 3 + 0) * 3072 + cg] = s1;
      p.out[OUT_QKVS + (size_t)(s * 3 + 1) * 3072 + cg] = s2;
    }
    cq = cx[0]; ck = cx[1]; cv = cx[2];
  }
  {
    const float sq = wsum(cq * cq), sk = wsum(ck * ck);
    if (lane == 0) { red[wave * 2] = sq; red[wave * 2 + 1] = sk; }
  }
  __syncthreads();
  if (tid < 128) {
    const float rq = rsqrtf(red[0] + red[2] + EPS), rk = rsqrtf(red[1] + red[3] + EPS);
    qs[tid] = cq * rq * QSCALE; ks[tid] = ck * rk; vs[tid] = cv;
  }
  __syncthreads();
  const float eg = __expf(g);
  float kS = 0.f, qS = 0.f, qk = 0.f;
#pragma unroll
  for (int k4 = 0; k4 < 16; ++k4) {
    const float4 kv = *(const float4*)(ks + kh * 64 + k4 * 4), qv = *(const float4*)(qs + kh * 64 + k4 * 4);
    kS += kv.x * Sr[4 * k4] + kv.y * Sr[4 * k4 + 1] + kv.z * Sr[4 * k4 + 2] + kv.w * Sr[4 * k4 + 3];
    qS += qv.x * Sr[4 * k4] + qv.y * Sr[4 * k4 + 1] + qv.z * Sr[4 * k4 + 2] + qv.w * Sr[4 * k4 + 3];
    qk += kv.x * qv.x + kv.y * qv.y + kv.z * qv.z + kv.w * qv.w;
  }
  part[(kh * 3 + 0) * 128 + v] = kS; part[(kh * 3 + 1) * 128 + v] = qS; part[(kh * 3 + 2) * 128 + v] = qk;
  __syncthreads();
  kS = part[0 * 128 + v] + part[3 * 128 + v];
  qS = part[1 * 128 + v] + part[4 * 128 + v];
  qk = part[2 * 128 + v] + part[5 * 128 + v];
  const float vnew = vs[v] * beta - beta * eg * kS;
  const float o = eg * qS + qk * vnew;
  float* Sd = p.out + OUT_DELTAS + (size_t)(s * 8 + h) * 16384 + (size_t)(kh * 64) * 128 + v;
#pragma unroll
  for (int k4 = 0; k4 < 16; ++k4) {
    const float4 kv = *(const float4*)(ks + kh * 64 + k4 * 4);
    __builtin_nontemporal_store(Sr[4 * k4 + 0] * eg + kv.x * vnew, Sd + (4 * k4 + 0) * 128);
    __builtin_nontemporal_store(Sr[4 * k4 + 1] * eg + kv.y * vnew, Sd + (4 * k4 + 1) * 128);
    __builtin_nontemporal_store(Sr[4 * k4 + 2] * eg + kv.z * vnew, Sd + (4 * k4 + 2) * 128);
    __builtin_nontemporal_store(Sr[4 * k4 + 3] * eg + kv.w * vnew, Sd + (4 * k4 + 3) * 128);
  }
  if (kh == 0) {
    ((u16*)((char*)p.out + (size_t)R * 1024 * 2))[(size_t)row * 1024 + h * 128 + v] = f2bf(o);
    const float so = wsum(o * o);
    if (lane == 0) { float* sq = (float*)(p.ws + OFF_SSQ) + ((size_t)row * 8 + h) * 4; sq[wave] = so; sq[wave + 2] = 0.f; }
  }
  __syncthreads();
}

__global__ void __launch_bounds__(512, 2) fwd_megakernel(Params p) {
  __shared__ __attribute__((aligned(1024))) char smem[SMEM_BYTES];
  const int tid = threadIdx.x, lane = tid & 63, wave = tid >> 6;
  const int fr = lane & 15, fq = lane >> 4;
  uint4* xb_words = (uint4*)(smem + 2 * HALF_SMEM);
  if (tid == 0) *xb_words = make_uint4(0u, 0u, 0u, 0u);
  __syncthreads();
  XcdBarrier xb = xcd_barrier_post((unsigned*)(p.ws + OFF_BAR), (volatile LAS unsigned*)xb_words);
  const int G = gridDim.x, bid = blockIdx.x;
  float* mod = (float*)(p.ws + OFF_MOD);
  u16* hbuf = (u16*)p.out;
  u16* obuf = (u16*)((char*)p.out + (size_t)R * 1024 * 2);
  const float* ssq = (const float*)(p.ws + OFF_SSQ);
  u16* merged = (u16*)(p.ws + OFF_MERGED);
  u16* tmp2 = (u16*)(p.ws + OFF_TMP2);

  PH(0) phase_convert(p, smem);
  xcd_barrier(xb);

  PH(1) for (int sb = bid; sb < 256; sb += G) {
    skinny<2>((const u16*)(p.ws + OFF_AC), 1024, 0, 136, (const u16*)(p.ws + OFF_WADA), 1024, 1024,
      [&](int j) { return sb * 24 + (j < 24 ? j : 23); },
      [&](int row, int ntl, int q, f32x4 v, int ln) {
        const int j = ntl * 16 + 4 * q;
        if (j < 24) {
          const int col = sb * 24 + j;
          const float4 bb = *(const float4*)(p.b_ada + col);
          *(float4*)(mod + (size_t)row * 6144 + col) = make_float4(v[0] + bb.x, v[1] + bb.y, v[2] + bb.z, v[3] + bb.w);
        }
      });
  }
  xcd_barrier(xb);

  PH(2) phase_modnorm<true>(p, p.x_prompt, p.x_sample, p.norm1_w, 0, 1024, hbuf, smem);
  xcd_barrier(xb);

  PH(3) {
    u16* glu = (u16*)(p.ws + OFF_GLU);
    u16* qkv = (u16*)(p.ws + OFF_QKV);
    u16* halo = (u16*)(p.ws + OFF_HALO);
    auto f_glu_st = [&](int row, int ch, f32x4 gl) {
      uint2 o; o.x = pk2(gl[0], gl[1]); o.y = pk2(gl[2], gl[3]);
      *(uint2*)(glu + (size_t)row * 512 + ch) = o;
      if (row < RP) { const int b = row >> 11, tt = row & 2047; if (tt >= 2018) *(float4*)(p.out + OUT_CONFP + (size_t)(b * 30 + tt - 2018) * 512 + ch) = make_float4(gl[0], gl[1], gl[2], gl[3]); }
      else *(float4*)(p.out + OUT_CONFS + (size_t)((row - RP) * 30 + 29) * 512 + ch) = make_float4(gl[0], gl[1], gl[2], gl[3]);
    };
    auto f_glu = [&](int row, int ch, f32x4 a, f32x4 g) {
      f32x4 gl;
#pragma unroll
      for (int j = 0; j < 4; ++j) gl[j] = a[j] * sigmoidf_(g[j]);
      f_glu_st(row, ch, gl);
    };
    auto f_qkv = [&](int row, int col, f32x4 a) {
      const float4 v = make_float4(a[0], a[1], a[2], a[3]);
      uint2 o; o.x = pk2(v.x, v.y); o.y = pk2(v.z, v.w);
      *(uint2*)(qkv + (size_t)row * 3072 + col) = o;
      if (row < RP) {
        const int b = row >> 11, tt = row & 2047;
        if ((tt & 63) >= 61) *(uint2*)(halo + (size_t)((b * 32 + (tt >> 6)) * 3 + (tt & 63) - 61) * 3072 + col) = o;
        if (tt >= 2045) *(float4*)(p.out + OUT_QKVP + (size_t)(b * 3 + tt - 2045) * 3072 + col) = v;
      } else *(float4*)(p.out + OUT_QKVS + (size_t)((row - RP) * 3 + 2) * 3072 + col) = v;
    };
    int u = bid;
    for (; u < 64 * 4; u += G) {
      const int pm = u % 64, pn = u / 64;
      f32x4 acc[2][2][4][2];
      zero_acc(acc);
      gemm256(acc, hbuf, 1024, (const u16*)(p.ws + OFF_WIN), 1024, pm * 256, pn * 256, 1024, smem);
      {
        int t_ = threadIdx.x;
        asm volatile("" : "+v"(t_));
        const int wr = t_ >> 8, wc = (t_ >> 6) & 3, fr_ = t_ & 15, fq_ = (t_ >> 4) & 3;
        float* T = (float*)smem;
#pragma unroll
        for (int ai = 0; ai < 2; ++ai)
#pragma unroll
          for (int m = 0; m < 4; ++m)
#pragma unroll
            for (int n = 0; n < 2; ++n) {
              f32x4 gl;
#pragma unroll
              for (int j = 0; j < 4; ++j) gl[j] = acc[ai][0][m][n][j] * sigmoidf_(acc[ai][1][m][n][j]);
              *(f32x4*)(T + (ai * 128 + wr * 64 + m * 16 + fr_) * TLD + wc * 32 + n * 16 + 4 * fq_) = gl;
            }
        __syncthreads();
        const int cg = (t_ & 31) * 4, r0 = t_ >> 5;
#pragma unroll 4
        for (int i = 0; i < 16; ++i) {
          const int rl = r0 + 16 * i;
          const f32x4 v = *(const f32x4*)(T + rl * TLD + cg);
          f_glu_st(pm * 256 + rl, pn * 128 + cg, v);
        }
        __syncthreads();
      }
    }
    for (; u < 64 * 16; u += G) {
      const int pm = u % 64, pn = u / 64;
      f32x4 acc[2][2][4][2];
      zero_acc(acc);
      gemm256(acc, hbuf, 1024, (const u16*)(p.ws + OFF_WIN), 1024, pm * 256, pn * 256, 1024, smem);
      tile_epilogue(acc, pm * 256, pn * 256 - 1024, smem, f_qkv);
    }
    for (int sb = bid; sb < 256; sb += G) {
      if (sb < 64) {
        skinny<1>(hbuf, 1024, RP, 128, (const u16*)(p.ws + OFF_WIN), 1024, 1024,
          [&](int j) { const int ch = sb * 8 + (j & 7); return (ch >> 7) * 256 + (ch & 127) + ((j >> 3) << 7); },
          [&](int row, int ntl, int q, f32x4 v, int ln) {
            f32x4 g;
#pragma unroll
            for (int j = 0; j < 4; ++j) g[j] = __shfl(v[j], (ln + 32) & 63, 64);
            if (q < 2) f_glu(row, sb * 8 + 4 * q, v, g);
          });
      } else {
        skinny<1>(hbuf, 1024, RP, 128, (const u16*)(p.ws + OFF_WIN), 1024, 1024,
          [&](int j) { return 1024 + (sb - 64) * 16 + j; },
          [&](int row, int ntl, int q, f32x4 v, int ln) { f_qkv(row, (sb - 64) * 16 + 4 * q, v); });
      }
    }
  }
  xcd_barrier(xb);

  PH(4) for (int base = bid * 2; base < 2048; base += 2 * G) d1_item(p, base + (tid >> 8), smem + (tid >> 8) * HALF_SMEM);
  xcd_barrier(xb);

  PH(5) {
    const int half = tid >> 8;
    char* hs = smem + half * HALF_SMEM;
    for (int u = bid; u < 64; u += G) { d2_block(p, u, smem); __syncthreads(); }
    unsigned* qhead = (unsigned*)(p.ws + OFF_BAR) + 64;
    volatile unsigned* qslot = (volatile unsigned*)(smem + 2 * HALF_SMEM + 32);
    auto deq = [&]() -> int {
      if (tid == 0) *qslot = __hip_atomic_fetch_add(qhead, 1u, __ATOMIC_RELAXED, __HIP_MEMORY_SCOPE_AGENT);
      __syncthreads();
      const int v = __builtin_amdgcn_readfirstlane((int)*qslot);
      __syncthreads();
      return v;
    };
    int idx = deq();
    for (; idx < 256; idx = deq()) conf_prompt_item(p, 2 * idx + half, hs);
    for (; idx < 272; idx = deq()) conf_sample_item(p, 2 * (idx - 256) + half);
    for (; idx < 784; idx = deq()) delta_sample_item(p, 2 * (idx - 272) + half, hs);
  }
  xcd_barrier(xb);

  PH(6) {
    auto f_z = [&](int row, int col, f32x4 a) {
      const float4 sq4 = *(const float4*)(ssq + ((size_t)row * 8 + (col >> 7)) * 4);
      const float rstd = rsqrtf((sq4.x + sq4.y + sq4.z + sq4.w) * (1.f / 128.f) + EPS);
      const float4 gw = *(const float4*)(p.gdn_norm_w + (col & 127));
      u16* op = obuf + (size_t)row * 1024 + col;
      const uint2 u = *(const uint2*)op;
      uint2 o;
      o.x = pk2(bf_lo(u.x) * rstd * gw.x * siluf_(a[0]), bf_hi(u.x) * rstd * gw.y * siluf_(a[1]));
      o.y = pk2(bf_lo(u.y) * rstd * gw.z * siluf_(a[2]), bf_hi(u.y) * rstd * gw.w * siluf_(a[3]));
      *(uint2*)op = o;
    };
    gemm_pass(hbuf, 1024, (const u16*)(p.ws + OFF_WZ), 1024, 1024, 1024, smem, f_z);
    for (int sb = bid; sb < 256; sb += G)
      skinny<1>(hbuf, 1024, RP, 128, (const u16*)(p.ws + OFF_WZ), 1024, 1024, [&](int j) { return sb * 4 + (j & 3); },
                [&](int row, int ntl, int q, f32x4 v, int ln) { if (q == 0) f_z(row, sb * 4, v); });
  }
  xcd_barrier(xb);

  PH(7) {
    auto f_ga = [&](int row, int col, f32x4 a) {
      uint2 o; o.x = pk2(sigmoidf_(a[0]), sigmoidf_(a[1])); o.y = pk2(sigmoidf_(a[2]), sigmoidf_(a[3]));
      *(uint2*)(merged + (size_t)row * 1024 + col) = o;
    };
    auto f_ya = [&](int row, int col, f32x4 a) {
      u16* mp = merged + (size_t)row * 1024 + col;
      const uint2 u = *(const uint2*)mp;
      uint2 o; o.x = pk2(bf_lo(u.x) * a[0], bf_hi(u.x) * a[1]); o.y = pk2(bf_lo(u.y) * a[2], bf_hi(u.y) * a[3]);
      *(uint2*)mp = o;
    };
    auto f_gb = [&](int row, int col, f32x4 a) {
      uint2 o; o.x = pk2(sigmoidf_(a[0]), sigmoidf_(a[1])); o.y = pk2(sigmoidf_(a[2]), sigmoidf_(a[3]));
      *(uint2*)(tmp2 + (size_t)row * 1024 + col) = o;
    };
    auto f_yb = [&](int row, int col, f32x4 a) {
      u16* mp = merged + (size_t)row * 1024 + col;
      const uint2 u = *(const uint2*)mp, s2 = *(const uint2*)(tmp2 + (size_t)row * 1024 + col);
      uint2 o; o.x = pk2(bf_lo(u.x) + bf_lo(s2.x) * a[0], bf_hi(u.x) + bf_hi(s2.x) * a[1]); o.y = pk2(bf_lo(u.y) + bf_lo(s2.y) * a[2], bf_hi(u.y) + bf_hi(s2.y) * a[3]);
      *(uint2*)mp = o;
    };
    auto cm4 = [&](int sb) { return [sb](int j) { return sb * 4 + (j & 3); }; };
    gemm_pass(hbuf, 1024, (const u16*)(p.ws + OFF_WGA), 1024, 1024, 1024, smem, f_ga);
    gemm_pass((const u16*)(p.ws + OFF_AACT), 512, (const u16*)(p.ws + OFF_WCONF), 512, 1024, 512, smem, f_ya);
    gemm_pass(hbuf, 1024, (const u16*)(p.ws + OFF_WGB), 1024, 1024, 1024, smem, f_gb);
    gemm_pass(obuf, 1024, (const u16*)(p.ws + OFF_WGDN), 1024, 1024, 1024, smem, f_yb);
    for (int sb = bid; sb < 256; sb += G) {
      skinny<1>(hbuf, 1024, RP, 128, (const u16*)(p.ws + OFF_WGA), 1024, 1024, cm4(sb), [&](int row, int ntl, int q, f32x4 v, int ln) { if (q == 0) f_ga(row, sb * 4, v); });
      skinny<1>((const u16*)(p.ws + OFF_AACT), 512, RP, 128, (const u16*)(p.ws + OFF_WCONF), 512, 512, cm4(sb), [&](int row, int ntl, int q, f32x4 v, int ln) { if (q == 0) f_ya(row, sb * 4, v); });
      skinny<1>(hbuf, 1024, RP, 128, (const u16*)(p.ws + OFF_WGB), 1024, 1024, cm4(sb), [&](int row, int ntl, int q, f32x4 v, int ln) { if (q == 0) f_gb(row, sb * 4, v); });
      skinny<1>(obuf, 1024, RP, 128, (const u16*)(p.ws + OFF_WGDN), 1024, 1024, cm4(sb), [&](int row, int ntl, int q, f32x4 v, int ln) { if (q == 0) f_yb(row, sb * 4, v); });
    }
  }
  xcd_barrier(xb);

  PH(8) {
    auto f_o = [&](int row, int col, f32x4 a) {
      const float* xr = row < RP ? p.x_prompt + (size_t)row * 1024 : p.x_sample + (size_t)(row - RP) * 1024;
      const float4 xv = *(const float4*)(xr + col), gv = *(const float4*)(mod + (size_t)mrow_of(row) * 6144 + 2048 + col);
      *(float4*)(p.out + (size_t)row * 1024 + col) = make_float4(xv.x + gv.x * a[0], xv.y + gv.y * a[1], xv.z + gv.z * a[2], xv.w + gv.w * a[3]);
    };
    gemm_pass(merged, 1024, (const u16*)(p.ws + OFF_WO), 1024, 1024, 1024, smem, f_o);
    for (int sb = bid; sb < 256; sb += G)
      skinny<1>(merged, 1024, RP, 128, (const u16*)(p.ws + OFF_WO), 1024, 1024, [&](int j) { return sb * 4 + (j & 3); },
                [&](int row, int ntl, int q, f32x4 v, int ln) { if (q == 0) f_o(row, sb * 4, v); });
  }
  xcd_barrier(xb);

  PH(9) phase_modnorm<false>(p, p.out, p.out + (size_t)RP * 1024, p.norm2_w, 3072, 4096, (u16*)(p.ws + OFF_H2), smem);
  xcd_barrier(xb);

  PH(10) {
    u16* f = (u16*)(p.ws + OFF_F);
    auto f_ff1 = [&](int row, int col, f32x4 a) {
      float v[4];
#pragma unroll
      for (int j = 0; j < 4; ++j) { const float t = fmaxf(a[j], 0.f); v[j] = t * t; }
      uint2 o; o.x = pk2(v[0], v[1]); o.y = pk2(v[2], v[3]);
      *(uint2*)(f + (size_t)row * LDF + col) = o;
    };
    gemm_pass((const u16*)(p.ws + OFF_H2), 1024, (const u16*)(p.ws + OFF_W1), 1024, 4096, 1024, smem, f_ff1);
    for (int sb = bid; sb < 256; sb += G)
      skinny<1>((const u16*)(p.ws + OFF_H2), 1024, RP, 128, (const u16*)(p.ws + OFF_W1), 1024, 1024, [&](int j) { return sb * 16 + j; },
                [&](int row, int ntl, int q, f32x4 v, int ln) { f_ff1(row, sb * 16 + 4 * q, v); });
  }
  xcd_barrier(xb);

  PH(11) {
    auto f_ff2 = [&](int row, int col, f32x4 a) {
      float* xp = p.out + (size_t)row * 1024 + col;
      const float4 xv = *(const float4*)xp, gv = *(const float4*)(mod + (size_t)mrow_of(row) * 6144 + 5120 + col);
      *(float4*)xp = make_float4(xv.x + gv.x * a[0], xv.y + gv.y * a[1], xv.z + gv.z * a[2], xv.w + gv.w * a[3]);
    };
    gemm_pass((const u16*)(p.ws + OFF_F), LDF, (const u16*)(p.ws + OFF_W2), LDF, 1024, 4096, smem, f_ff2);
    for (int sb = bid; sb < 256; sb += G)
      skinny<1>((const u16*)(p.ws + OFF_F), LDF, RP, 128, (const u16*)(p.ws + OFF_W2), LDF, 4096, [&](int j) { return sb * 4 + (j & 3); },
                [&](int row, int ntl, int q, f32x4 v, int ln) { if (q == 0) f_ff2(row, sb * 4, v); });
  }
  xcd_barrier(xb);

  PH(12) {
    int t12 = threadIdx.x;
    asm volatile("" : "+v"(t12));
    const int lane = t12 & 63, wave = t12 >> 6;
    const int gw = bid * 8 + wave, nw_ = G * 8;
    for (int row = gw; row < R; row += nw_) {
      float* xr = p.out + (size_t)row * 1024;
      float4 v[4]; float ss = 0.f;
#pragma unroll
      for (int i = 0; i < 4; ++i) { v[i] = *(const float4*)(xr + (lane + 64 * i) * 4); ss += v[i].x * v[i].x + v[i].y * v[i].y + v[i].z * v[i].z + v[i].w * v[i].w; }
      ss = wsum(ss);
      const float rstd = rsqrtf(ss * (1.f / 1024.f) + EPS);
#pragma unroll
      for (int i = 0; i < 4; ++i) {
        const int c = (lane + 64 * i) * 4;
        const float4 w = *(const float4*)(p.final_norm_w + c);
        f32x4 yv = {v[i].x * rstd * w.x, v[i].y * rstd * w.y, v[i].z * rstd * w.z, v[i].w * rstd * w.w};
        __builtin_nontemporal_store(yv, (f32x4*)(xr + c));
      }
    }
  }
}

extern "C" void kernel_launch(void* const* d_in, const int* in_sizes, int n_in, void* d_out, int out_size, void* d_ws, size_t ws_size,
                              hipStream_t stream) {
  static int grid_blocks = 0;
  if (!grid_blocks) {
    int dev = 0, cus = 0, per_cu = 0;
    hipGetDevice(&dev);
    hipDeviceGetAttribute(&cus, hipDeviceAttributeMultiprocessorCount, dev);
    hipOccupancyMaxActiveBlocksPerMultiprocessor(&per_cu, (const void*)fwd_megakernel, NT, 0);
    if (per_cu > 1) per_cu = 1;
    if (per_cu < 1) per_cu = 1;
    grid_blocks = cus * per_cu;
  }
  Params p{};
  const float** pp = (const float**)&p;
  for (int i = 0; i < 26; ++i) pp[i] = (const float*)d_in[i];
  p.out = (float*)d_out; p.ws = (char*)d_ws;
  if (ws_size < WS_NEED) { fprintf(stderr, "workspace too small: %zu < %zu\n", ws_size, (size_t)WS_NEED); return; }
  hipMemsetAsync(d_ws, 0, XCD_BAR_WORDS * 4, stream);
  void* args[] = {&p};
  hipError_t e = hipLaunchCooperativeKernel((const void*)fwd_megakernel, dim3(grid_blocks), dim3(NT), args, 0, stream);
  if (e != hipSuccess) fprintf(stderr, "cooperative launch failed: %s (grid %d)\n", hipGetErrorString(e), grid_blocks);
}
```

```cpp
#include <hip/hip_runtime.h>
#include <stdint.h>
#include <cstdio>

#define DI __device__ __forceinline__
typedef unsigned short u16;
typedef __bf16 bf2_t __attribute__((ext_vector_type(2)));
typedef float f2_t __attribute__((ext_vector_type(2)));
using bf16x8 = __attribute__((ext_vector_type(8))) short;
using f32x16 = __attribute__((ext_vector_type(16))) float;
using f32x4 = __attribute__((ext_vector_type(4))) float;
using u32x4 = __attribute__((ext_vector_type(4))) unsigned;
#define MFMA(a, b, c) __builtin_amdgcn_mfma_f32_32x32x16_bf16((a), (b), (c), 0, 0, 0)

constexpr int R = 16512, RP = 16384, D = 1024, DC = 512, QKV = 3072, NIN = 4096, DFF = 4096;
constexpr float EPS = 1e-6f;
constexpr int LDF = 4160;
constexpr float QSCALE = 0.08838834764831845f;

constexpr size_t OFF_BAR   = 0;
constexpr size_t OFF_MOD   = 16384;
constexpr size_t OFF_GB    = OFF_MOD + 3342336;
constexpr size_t OFF_EGL   = OFF_GB + 1056768;
constexpr size_t OFF_SSQ   = OFF_EGL + 8192;
constexpr size_t OFF_WIN   = OFF_SSQ + 2113536;
constexpr size_t OFF_WZ    = OFF_WIN + 8650752;
constexpr size_t OFF_WGA   = OFF_WZ + 2097152;
constexpr size_t OFF_WGB   = OFF_WGA + 2097152;
constexpr size_t OFF_WCONF = OFF_WGB + 2097152;
constexpr size_t OFF_WGDN  = OFF_WCONF + 1048576;
constexpr size_t OFF_WO    = OFF_WGDN + 2097152;
constexpr size_t OFF_W1    = OFF_WO + 2097152;
constexpr size_t OFF_W2    = OFF_W1 + 8388608;
constexpr size_t OFF_GLU   = OFF_W2 + 8650752;
constexpr size_t OFF_AACT  = OFF_GLU + 16908288;
constexpr size_t OFF_QKV   = OFF_AACT + 16908288;
constexpr size_t OFF_HALO  = OFF_QKV + 101449728;
constexpr size_t OFF_EXTRA = OFF_HALO + 4718592;
constexpr size_t OFF_WADA  = OFF_EXTRA;
constexpr size_t OFF_AC    = OFF_EXTRA + 12582912;
constexpr size_t OFF_MERGED= OFF_EXTRA;
constexpr size_t OFF_H2    = OFF_GLU;
constexpr size_t OFF_F     = OFF_QKV;
constexpr size_t OFF_TMP2  = OFF_QKV;
constexpr size_t WS_NEED   = OFF_EXTRA + 50331648;
constexpr size_t OUT_Y = 0, OUT_CONFP = 16908288, OUT_QKVP = 17031168, OUT_DELTAP = 17104896,
                 OUT_CONFS = 18153472, OUT_QKVS = 20119552, OUT_DELTAS = 21299200;

constexpr int HALF_SMEM = 73728;
constexpr int SMEM_BYTES = 2 * HALF_SMEM + 1024;
constexpr int NT = 512;
#ifndef PHASE_MASK
#define PHASE_MASK 0xFFFF
#endif
#define PH(k) if constexpr ((PHASE_MASK >> (k)) & 1)

struct Params {
  const float *x_prompt, *x_sample, *c_prompt, *c_sample, *st_conf, *st_qkv, *st_delta;
  const float *w_ada, *b_ada, *norm1_w, *w_in, *conf_dw_w, *conf_dw_b, *conf_ln_w, *conf_ln_b, *w_conf_out,
              *gdn_conv_w, *a_log, *dt_bias, *gdn_norm_w, *w_gdn_out, *w_o, *norm2_w, *w_ff1, *w_ff2, *final_norm_w;
  float* out; char* ws;
};

DI unsigned pk2(float a, float b) { f2_t v = {a, b}; bf2_t r = __builtin_convertvector(v, bf2_t); return __builtin_bit_cast(unsigned, r); }
DI float bf_lo(unsigned u) { return __uint_as_float(u << 16); }
DI float bf_hi(unsigned u) { return __uint_as_float(u & 0xffff0000u); }
DI float bf1(u16 u) { return __uint_as_float(((unsigned)u) << 16); }
DI u16 f2bf(float a) { return (u16)(pk2(a, 0.f) & 0xffffu); }
DI float sigmoidf_(float x) { return __builtin_amdgcn_rcpf(1.f + __expf(-x)); }
DI float siluf_(float x) { return x * __builtin_amdgcn_rcpf(1.f + __expf(-x)); }
DI float softplusf_(float x) { return fmaxf(x, 0.f) + log1pf(__expf(-fabsf(x))); }
DI float wsum(float v) {
#pragma unroll
  for (int m = 32; m >= 1; m >>= 1) v += __shfl_xor(v, m, 64);
  return v;
}
DI int crow(int reg, int hh) { return (reg & 3) + 8 * (reg >> 2) + 4 * hh; }
DI int mrow_of(int r) { return r < RP ? (r >> 11) : (8 + r - RP); }
DI bf16x8 pack8(const f32x16& x, int s) {
  uint4 p;
  p.x = pk2(x[8 * s + 0], x[8 * s + 1]); p.y = pk2(x[8 * s + 2], x[8 * s + 3]);
  p.z = pk2(x[8 * s + 4], x[8 * s + 5]); p.w = pk2(x[8 * s + 6], x[8 * s + 7]);
  return __builtin_bit_cast(bf16x8, p);
}
DI f32x16 zero16() { f32x16 z; for (int i = 0; i < 16; ++i) z[i] = 0.f; return z; }

#define XB_TMO      128
#define XB_XCNT(j)  (256  + 64 * (j))
#define XB_XSUB(j)  (1280 + 64 * (j))
#define XB_XGEN(j)  (2304 + 64 * (j))
#define XB_TOP      3328
#define XB_TOPGEN   3392
#define XCD_BAR_WORDS 3456
#define XB_SPIN_CAP (1u << 24)
#define LAS __attribute__((address_space(3)))
DI unsigned xb_ld(unsigned* p) { return __hip_atomic_load(p, __ATOMIC_RELAXED, __HIP_MEMORY_SCOPE_AGENT); }
DI unsigned xb_add(unsigned* p, unsigned v) { return __hip_atomic_fetch_add(p, v, __ATOMIC_RELAXED, __HIP_MEMORY_SCOPE_AGENT); }
DI unsigned xb_xcc_id() { return (unsigned)__builtin_amdgcn_s_getreg((3 << 11) | 20) & 0xFu; }
#define XB_SPIN(cond, bar) do { unsigned _sp = 0; while (cond) { __builtin_amdgcn_s_sleep(1); \
    if ((++_sp & 255u) == 0u) { if (xb_ld(&(bar)[XB_TMO])) break; if (_sp > XB_SPIN_CAP) { atomicAdd(&(bar)[XB_TMO], 1u); break; } } } } while (0)
struct XcdBarrier { unsigned* bar; unsigned x; volatile LAS unsigned* st; };
DI XcdBarrier xcd_barrier_post(unsigned* bar, volatile LAS unsigned* st) {
  XcdBarrier b; b.bar = bar; b.x = xb_xcc_id(); b.st = st;
  if (threadIdx.x == 0) (void)xb_add(&bar[XB_XCNT(b.x)], 1u);
  return b;
}
DI void xcd_barrier_complete(unsigned* bar, unsigned x, unsigned& nloc, unsigned& nx) {
  const unsigned G = gridDim.x * gridDim.y * gridDim.z;
  unsigned sum, cnt, mine, sp = 0u;
  for (;;) {
    sum = 0u; cnt = 0u; mine = 0u;
#pragma unroll
    for (unsigned j = 0; j < 16; ++j) { const unsigned c = xb_ld(&bar[XB_XCNT(j)]); sum += c; cnt += (c > 0u) ? 1u : 0u; mine = (j == x) ? c : mine; }
    if (sum == G) break;
    __builtin_amdgcn_s_sleep(1);
    if ((++sp & 255u) == 0u) { if (xb_ld(&bar[XB_TMO])) break; if (sp > XB_SPIN_CAP) { atomicAdd(&bar[XB_TMO], 1u); break; } }
  }
  nloc = mine > 0u ? mine : 1u; nx = cnt > 0u ? cnt : 1u;
}
DI void xcd_barrier(const XcdBarrier& b) {
  asm volatile("s_waitcnt vmcnt(0)" ::: "memory");
  __syncthreads();
  if (threadIdx.x == 0) {
    unsigned* bar = b.bar;
    __builtin_amdgcn_s_waitcnt(0);
    unsigned nloc = b.st[0], nx = b.st[1];
    if (nloc == 0u) { xcd_barrier_complete(bar, b.x, nloc, nx); b.st[0] = nloc; b.st[1] = nx; }
    const unsigned old = xb_add(&bar[XB_XSUB(b.x)], 1u);
    const unsigned gen = old / nloc;
    if (old + 1u == (gen + 1u) * nloc) {
      __builtin_amdgcn_fence(__ATOMIC_RELEASE, "agent");
      asm volatile("s_waitcnt vmcnt(0)" ::: "memory");
      const unsigned og = xb_add(&bar[XB_TOP], 1u);
      const unsigned tg = og / nx;
      if (og + 1u == (tg + 1u) * nx) xb_add(&bar[XB_TOPGEN], 1u);
      else XB_SPIN(xb_ld(&bar[XB_TOPGEN]) == tg, bar);
      __builtin_amdgcn_fence(__ATOMIC_ACQUIRE, "agent");
      xb_add(&bar[XB_XGEN(b.x)], 1u);
      asm volatile("s_waitcnt vmcnt(0)" ::: "memory");
    } else {
      XB_SPIN(xb_ld(&bar[XB_XGEN(b.x)]) == gen, bar);
      __builtin_amdgcn_fence(__ATOMIC_ACQUIRE, "agent");
      asm volatile("s_waitcnt vmcnt(0)" ::: "memory");
    }
  }
  __syncthreads();
}

constexpr int HTB = 128 * 64 * 2;
DI int lds_byte(int r, int c) { const int st = (r >> 4) * 2 + (c >> 5), rr = r & 15, cc = c & 31, ob = rr * 64 + cc * 2; return st * 1024 + (ob ^ (((ob >> 9) & 1) << 5)); }
DI void stage_rc(int b, int& Rr, int& Cc) { const int st = b / 1024, sb = b % 1024, swz = sb ^ (((sb >> 9) & 1) << 5); Rr = (st >> 1) * 16 + swz / 64; Cc = (st & 1) * 32 + (swz % 64) / 2; }
DI void gemm256(f32x4 (&acc)[2][2][4][2], const u16* __restrict__ A, const int lda, const u16* __restrict__ Bt, const int ldb,
                const int brow, const int bcol, const int K, char* shm) {
#define SA(b, h) (shm + ((b) * 2 + (h)) * HTB)
#define SB(b, h) (shm + (4 + (b) * 2 + (h)) * HTB)
#define STAGE_A(P, br, kt) do { const char* _u = (const char*)A + ((size_t)(br) * lda + (size_t)(kt) * 64) * 2; \
    __builtin_amdgcn_global_load_lds((const unsigned*)(_u + voA0), (unsigned*)((char*)(P) + sb0), 16, 0, 0); \
    __builtin_amdgcn_global_load_lds((const unsigned*)(_u + voA1), (unsigned*)((char*)(P) + sb1), 16, 0, 0); } while (0)
#define STAGE_B(P, br, kt) do { const char* _u = (const char*)Bt + ((size_t)(br) * ldb + (size_t)(kt) * 64) * 2; \
    __builtin_amdgcn_global_load_lds((const unsigned*)(_u + voB0), (unsigned*)((char*)(P) + sb0), 16, 0, 0); \
    __builtin_amdgcn_global_load_lds((const unsigned*)(_u + voB1), (unsigned*)((char*)(P) + sb1), 16, 0, 0); } while (0)
#define LDA(dst, b, h) _Pragma("unroll") for (int m = 0; m < 4; ++m) _Pragma("unroll") for (int k = 0; k < 2; ++k) \
    dst[m][k] = *reinterpret_cast<const bf16x8*>((char*)SA(b, h) + lds_byte(wr * 64 + m * 16 + fr, k * 32 + fq * 8))
#define LDB(dst, b, h) _Pragma("unroll") for (int n = 0; n < 2; ++n) _Pragma("unroll") for (int k = 0; k < 2; ++k) \
    dst[n][k] = *reinterpret_cast<const bf16x8*>((char*)SB(b, h) + lds_byte(wc * 32 + n * 16 + fr, k * 32 + fq * 8))
#define MMA(ai, bj, At_, Bt_) do { __builtin_amdgcn_s_setprio(1); \
    _Pragma("unroll") for (int m = 0; m < 4; ++m) _Pragma("unroll") for (int n = 0; n < 2; ++n) _Pragma("unroll") for (int k = 0; k < 2; ++k) \
      acc[ai][bj][m][n] = __builtin_amdgcn_mfma_f32_16x16x32_bf16(Bt_[n][k], At_[m][k], acc[ai][bj][m][n], 0, 0, 0); \
    __builtin_amdgcn_s_setprio(0); } while (0)
#define WAIT_V(n) asm volatile("s_waitcnt vmcnt(" #n ")" ::: "memory")
#define WAIT_L(n) asm volatile("s_waitcnt lgkmcnt(" #n ")" ::: "memory")
#define BAR __builtin_amdgcn_s_barrier()
#define SCHED __builtin_amdgcn_sched_barrier(0)
  int t_ = threadIdx.x;
  asm volatile("" : "+v"(t_));
  const int wid = __builtin_amdgcn_readfirstlane(t_ >> 6), lane = t_ & 63, wr = wid >> 2, wc = wid & 3, fr = lane & 15, fq = lane >> 4;
  const int sb0 = t_ * 16, sb1 = sb0 + 8192;
  int sr0, sc0, sr1, sc1; stage_rc(sb0, sr0, sc0); stage_rc(sb1, sr1, sc1);
  const unsigned voA0 = (unsigned)(sr0 * lda + sc0) * 2u, voA1 = (unsigned)(sr1 * lda + sc1) * 2u;
  const unsigned voB0 = (unsigned)(sr0 * ldb + sc0) * 2u, voB1 = (unsigned)(sr1 * ldb + sc1) * 2u;
  bf16x8 At[4][2], B0[2][2], B1[2][2];
  const int nt = K / 64;
  STAGE_B(SB(0, 0), bcol, 0); STAGE_A(SA(0, 0), brow, 0);
  STAGE_B(SB(0, 1), bcol + 128, 0); STAGE_A(SA(0, 1), brow + 128, 0);
  if (wr == 1) BAR;
  WAIT_V(4); BAR;
  STAGE_B(SB(1, 0), bcol, 1); STAGE_A(SA(1, 0), brow, 1); STAGE_B(SB(1, 1), bcol + 128, 1);
  WAIT_V(6); BAR;
  for (int t = 0; t < nt - 2; t += 2) {
    LDB(B0, 0, 0); SCHED; LDA(At, 0, 0); STAGE_A(SA(1, 1), brow + 128, t + 1);
    WAIT_L(8); BAR; WAIT_L(0); MMA(0, 0, At, B0); BAR; SCHED;
    LDB(B1, 0, 1); STAGE_B(SB(0, 0), bcol, t + 2);
    BAR; WAIT_L(0); MMA(0, 1, At, B1); BAR;
    LDA(At, 0, 1); STAGE_A(SA(0, 0), brow, t + 2);
    BAR; WAIT_L(0); MMA(1, 0, At, B0); BAR; SCHED;
    STAGE_B(SB(0, 1), bcol + 128, t + 2);
    WAIT_V(6); BAR; MMA(1, 1, At, B1); BAR;
    LDB(B0, 1, 0); SCHED; LDA(At, 1, 0); STAGE_A(SA(0, 1), brow + 128, t + 2);
    WAIT_L(8); BAR; WAIT_L(0); MMA(0, 0, At, B0); BAR; SCHED;
    LDB(B1, 1, 1); STAGE_B(SB(1, 0), bcol, t + 3);
    BAR; WAIT_L(0); MMA(0, 1, At, B1); BAR;
    LDA(At, 1, 1); STAGE_A(SA(1, 0), brow, t + 3);
    BAR; WAIT_L(0); MMA(1, 0, At, B0); BAR; SCHED;
    STAGE_B(SB(1, 1), bcol + 128, t + 3);
    WAIT_V(6); BAR; MMA(1, 1, At, B1); BAR;
  }
  { LDB(B0, 0, 0); LDA(At, 0, 0); STAGE_A(SA(1, 1), brow + 128, nt - 1);
    BAR; WAIT_L(0); MMA(0, 0, At, B0); BAR;
    LDB(B1, 0, 1); BAR; WAIT_L(0); MMA(0, 1, At, B1); BAR;
    LDA(At, 0, 1); WAIT_V(4); BAR; WAIT_L(0); MMA(1, 0, At, B0); MMA(1, 1, At, B1); BAR; }
  { LDB(B0, 1, 0); LDA(At, 1, 0); WAIT_V(2); BAR; WAIT_L(0); MMA(0, 0, At, B0); BAR;
    LDB(B1, 1, 1); WAIT_V(0); BAR; WAIT_L(0); MMA(0, 1, At, B1); BAR;
    LDA(At, 1, 1); BAR; WAIT_L(0); MMA(1, 0, At, B0); MMA(1, 1, At, B1); BAR; }
  if (wr == 0) BAR;
#undef SA
#undef SB
#undef STAGE_A
#undef STAGE_B
#undef LDA
#undef LDB
#undef MMA
}
DI void zero_acc(f32x4 (&acc)[2][2][4][2]) {
#pragma unroll
  for (int a = 0; a < 2; ++a)
#pragma unroll
    for (int b = 0; b < 2; ++b)
#pragma unroll
      for (int m = 0; m < 4; ++m)
#pragma unroll
        for (int n = 0; n < 2; ++n) acc[a][b][m][n] = (f32x4){0.f, 0.f, 0.f, 0.f};
}
template <class F> DI void tile_apply(const f32x4 (&acc)[2][2][4][2], int brow, int bcol, F f) {
  int t_ = threadIdx.x;
  asm volatile("" : "+v"(t_));
  const int wid = t_ >> 6, lane = t_ & 63, wr = wid >> 2, wc = wid & 3, fr = lane & 15, fq = lane >> 4;
#pragma unroll
  for (int ai = 0; ai < 2; ++ai)
#pragma unroll
    for (int m = 0; m < 4; ++m) {
      const int row = brow + ai * 128 + wr * 64 + m * 16 + fr;
#pragma unroll
      for (int bj = 0; bj < 2; ++bj)
#pragma unroll
        for (int n = 0; n < 2; ++n) f(row, bcol + bj * 128 + wc * 32 + n * 16 + 4 * fq, acc[ai][bj][m][n]);
      __builtin_amdgcn_sched_barrier(0);
    }
}
constexpr int TLD = 132;
template <class F> DI void tile_epilogue(const f32x4 (&acc)[2][2][4][2], int brow, int bcol, char* shm, F f) {
  int t_ = threadIdx.x;
  asm volatile("" : "+v"(t_));
  const int wid = t_ >> 6, lane = t_ & 63, wr = wid >> 2, wc = wid & 3, fr = lane & 15, fq = lane >> 4;
  float* T = (float*)shm;
#pragma unroll
  for (int bj = 0; bj < 2; ++bj) {
#pragma unroll
    for (int ai = 0; ai < 2; ++ai)
#pragma unroll
      for (int m = 0; m < 4; ++m)
#pragma unroll
        for (int n = 0; n < 2; ++n)
          *(f32x4*)(T + (ai * 128 + wr * 64 + m * 16 + fr) * TLD + wc * 32 + n * 16 + 4 * fq) = acc[ai][bj][m][n];
    __syncthreads();
    const int cg = (t_ & 31) * 4, r0 = t_ >> 5;
#pragma unroll 4
    for (int i = 0; i < 16; ++i) {
      const int rl = r0 + 16 * i;
      const f32x4 v = *(const f32x4*)(T + rl * TLD + cg);
      f(brow + rl, bcol + bj * 128 + cg, v);
    }
    __syncthreads();
  }
}
template <class F> DI void gemm_pass(const u16* A, int lda, const u16* Bt, int ldb, int N, int K, char* shm, F f) {
  const int nN = N >> 8, nunits = 64 * nN;
  for (int u = blockIdx.x; u < nunits; u += gridDim.x) {
    const int pm = u % 64, pn = u / 64;
    f32x4 acc[2][2][4][2];
    zero_acc(acc);
    gemm256(acc, A, lda, Bt, ldb, pm * 256, pn * 256, K, shm);
    tile_epilogue(acc, pm * 256, pn * 256, shm, f);
  }
}
template <int NTL, class CM, class E> DI void skinny(const u16* __restrict__ A, int lda, int row0, int nrows, const u16* __restrict__ Bt, int ldb, int K, CM cm, E epi) {
  int t_ = threadIdx.x;
  asm volatile("" : "+v"(t_));
  const int wid = t_ >> 6, lane = t_ & 63, fr = lane & 15, fq = lane >> 4;
  for (int mt = wid; mt * 16 < nrows; mt += 8) {
    int rr = mt * 16 + fr; const bool valid = rr < nrows; if (!valid) rr = nrows - 1;
    const u16* ap = A + (size_t)(row0 + rr) * lda + 8 * fq;
#pragma unroll
    for (int ntl = 0; ntl < NTL; ++ntl) {
      const u16* bp = Bt + (size_t)cm(ntl * 16 + fr) * ldb + 8 * fq;
      f32x4 acc = {0.f, 0.f, 0.f, 0.f};
#pragma unroll 16
      for (int ks = 0; ks < (K >> 5); ++ks) {
        const bf16x8 a = *(const bf16x8*)(ap + ks * 32);
        const bf16x8 b = *(const bf16x8*)(bp + ks * 32);
        acc = __builtin_amdgcn_mfma_f32_16x16x32_bf16(b, a, acc, 0, 0, 0);
      }
      if (valid) epi(row0 + rr, ntl, fq, acc, lane);
    }
  }
}
DI int map_in(int n) {
  if (n < 1024) { const int pn = n >> 8, c = n & 255; return c < 128 ? (pn * 128 + c) : (512 + pn * 128 + c - 128); }
  return n;
}
DI void phase_convert(const Params& p, char* smem) {
  float* tile = (float*)smem;
  const int tid = threadIdx.x;
  constexpr int NJ = 10;
  constexpr int pre[NJ + 1] = {0, 1024, 1280, 1536, 1792, 1920, 2176, 2432, 3456, 4480, 6016};
  for (int t = blockIdx.x; t < 6016; t += gridDim.x) {
    int j = 0, base = 0;
#pragma unroll
    for (int q = 1; q < NJ; ++q) if (t >= pre[q]) { j = q; base = pre[q]; }
    const int lt = t - base;
    const float* src; int ld, K; u16* dst; int moff = 0; int ldd = 0;
    switch (j) {
      case 0: src = p.w_in; ld = 7184; K = 1024; dst = (u16*)(p.ws + OFF_WIN); break;
      case 1: src = p.w_in; ld = 7184; K = 1024; dst = (u16*)(p.ws + OFF_WZ); moff = 4096; break;
      case 2: src = p.w_in; ld = 7184; K = 1024; dst = (u16*)(p.ws + OFF_WGA); moff = 5136; break;
      case 3: src = p.w_in; ld = 7184; K = 1024; dst = (u16*)(p.ws + OFF_WGB); moff = 6160; break;
      case 4: src = p.w_conf_out; ld = 1024; K = 512; dst = (u16*)(p.ws + OFF_WCONF); break;
      case 5: src = p.w_gdn_out; ld = 1024; K = 1024; dst = (u16*)(p.ws + OFF_WGDN); break;
      case 6: src = p.w_o; ld = 1024; K = 1024; dst = (u16*)(p.ws + OFF_WO); break;
      case 7: src = p.w_ff1; ld = 4096; K = 1024; dst = (u16*)(p.ws + OFF_W1); break;
      case 8: src = p.w_ff2; ld = 1024; K = 4096; dst = (u16*)(p.ws + OFF_W2); ldd = LDF; break;
      default: src = p.w_ada; ld = 6144; K = 1024; dst = (u16*)(p.ws + OFF_WADA); break;
    }
    const int nkt = K >> 6;
    const int n0 = (lt / nkt) * 64, k0 = (lt % nkt) * 64;
    {
      const int nn = tid & 63, ty = tid >> 6;
      const int sc = (j == 0) ? map_in(n0 + nn) : (n0 + nn + moff);
#pragma unroll
      for (int i = 0; i < 8; ++i) {
        const int kk = ty + 8 * i;
        tile[kk * 65 + nn] = __builtin_nontemporal_load(src + (size_t)(k0 + kk) * ld + sc);
      }
    }
    __syncthreads();
    {
      const int nn = tid >> 3, kq = (tid & 7) * 8;
      uint4 o0;
      const float* tp = tile + kq * 65 + nn;
      o0.x = pk2(tp[0 * 65], tp[1 * 65]);  o0.y = pk2(tp[2 * 65], tp[3 * 65]);
      o0.z = pk2(tp[4 * 65], tp[5 * 65]);  o0.w = pk2(tp[6 * 65], tp[7 * 65]);
      *(uint4*)(dst + (size_t)(n0 + nn) * (ldd ? ldd : K) + k0 + kq) = o0;
    }
    __syncthreads();
  }
  u16* Ac = (u16*)(p.ws + OFF_AC);
  for (int e = blockIdx.x * NT + tid; e < 256 * 256; e += gridDim.x * NT) {
    const int row = e >> 8, c4 = (e & 255) * 4;
    float4 v = make_float4(0.f, 0.f, 0.f, 0.f);
    if (row < 8) v = *(const float4*)(p.c_prompt + row * 1024 + c4);
    else if (row < 136) v = *(const float4*)(p.c_sample + (row - 8) * 1024 + c4);
    uint2 o; o.x = pk2(siluf_(v.x), siluf_(v.y)); o.y = pk2(siluf_(v.z), siluf_(v.w));
    *(uint2*)(Ac + row * 1024 + c4) = o;
  }
}

constexpr int WBA_LD = 1028;
template <bool BA> DI void phase_modnorm(const Params& p, const float* xa, const float* xb, const float* nw, int shift_off, int scale_off, u16* dst, char* smem) {
  int tmn = threadIdx.x;
  asm volatile("" : "+v"(tmn));
  const int lane = tmn & 63;
  const int gw = blockIdx.x * 8 + (tmn >> 6), nw_ = gridDim.x * 8;
  const float* mod = (const float*)(p.ws + OFF_MOD);
  float* wba = (float*)smem;
  if (BA) {
    for (int e = threadIdx.x; e < 16384; e += NT) { const int c = e >> 4, j = e & 15; wba[j * WBA_LD + c] = p.w_in[(size_t)c * 7184 + 5120 + j]; }
    __syncthreads();
  }
  float* gb = (float*)(p.ws + OFF_GB);
  for (int row = gw; row < R; row += nw_) {
    const float* xr = row < RP ? xa + (size_t)row * 1024 : xb + (size_t)(row - RP) * 1024;
    float4 v[4]; float ss = 0.f;
#pragma unroll
    for (int i = 0; i < 4; ++i) {
      if (BA) { const f32x4 t4 = __builtin_nontemporal_load((const f32x4*)(xr + (lane + 64 * i) * 4)); v[i] = make_float4(t4[0], t4[1], t4[2], t4[3]); }
      else v[i] = *(const float4*)(xr + (lane + 64 * i) * 4);
      ss += v[i].x * v[i].x + v[i].y * v[i].y + v[i].z * v[i].z + v[i].w * v[i].w; }
    ss = wsum(ss);
    const float rstd = rsqrtf(ss * (1.f / 1024.f) + EPS);
    const float* mr = mod + (size_t)mrow_of(row) * 6144;
    float ba[16];
    if (BA) {
#pragma unroll
      for (int j = 0; j < 16; ++j) ba[j] = 0.f;
    }
#pragma unroll
    for (int i = 0; i < 4; ++i) {
      const int c = (lane + 64 * i) * 4;
      const float4 w = *(const float4*)(nw + c), sc = *(const float4*)(mr + scale_off + c), sh = *(const float4*)(mr + shift_off + c);
      const float h0 = v[i].x * rstd * w.x * (1.f + sc.x) + sh.x, h1 = v[i].y * rstd * w.y * (1.f + sc.y) + sh.y;
      const float h2 = v[i].z * rstd * w.z * (1.f + sc.z) + sh.z, h3 = v[i].w * rstd * w.w * (1.f + sc.w) + sh.w;
      uint2 o; o.x = pk2(h0, h1); o.y = pk2(h2, h3);
      *(uint2*)(dst + (size_t)row * 1024 + c) = o;
      if (BA) {
#pragma unroll
        for (int j = 0; j < 16; ++j) { const float4 ww = *(const float4*)(wba + j * WBA_LD + c); ba[j] += h0 * ww.x + h1 * ww.y + h2 * ww.z + h3 * ww.w; }
        __builtin_amdgcn_sched_barrier(0);
      }
    }
    if (BA) {
#pragma unroll
      for (int w = 8; w >= 1; w >>= 1) {
        const bool up = (lane & w) != 0;
#pragma unroll
        for (int j = 0; j < w; ++j) {
          const float keep = up ? ba[j + w] : ba[j];
          const float send = up ? ba[j] : ba[j + w];
          ba[j] = keep + __shfl_xor(send, w, 64);
        }
      }
      float tot = ba[0];
      tot += __shfl_xor(tot, 16, 64); tot += __shfl_xor(tot, 32, 64);
      if (lane < 8) gb[(size_t)row * 16 + lane] = sigmoidf_(tot);
      else if (lane < 16) gb[(size_t)row * 16 + lane] = -__expf(p.a_log[lane - 8]) * softplusf_(tot + p.dt_bias[lane - 8]);
    }
  }
  if (BA) __syncthreads();
}

constexpr int LKN = 136, LKT = 72;
DI void d1_item(const Params& p, int item, char* smem) {
  int tid = threadIdx.x & 255;
  asm volatile("" : "+v"(tid));
  const int lane = tid & 63, wave = __builtin_amdgcn_readfirstlane(tid >> 6);
  const int r = lane & 31, hh = lane >> 5;
  const int h = item & 7, n = (item >> 3) & 31, b = item >> 8;
  const int rowbase = b * 2048 + n * 64;
  u16* kn  = (u16*)smem;
  u16* qn  = (u16*)(smem + 17408);
  u16* knT = (u16*)(smem + 34816);
  u16* vT  = (u16*)(smem + 53248);
  float* Gs = (float*)(smem + 71680);
  float* Bs = Gs + 64;
  float* Amat = (float*)(smem + 17408);
  u16* Tb = (u16*)smem;
  u16* Tg = (u16*)(smem + 17408);
  u16* qkv = (u16*)(p.ws + OFF_QKV);
  const u16* halo = (const u16*)(p.ws + OFF_HALO);
  const float* gb = (const float*)(p.ws + OFF_GB);

  if (wave == 0) {
    float g = gb[(size_t)(rowbase + lane) * 16 + 8 + h];
    const float be = gb[(size_t)(rowbase + lane) * 16 + h];
#pragma unroll
    for (int m = 1; m < 64; m <<= 1) { float t = __shfl_up(g, m, 64); if (lane >= m) g += t; }
    Gs[lane] = g; Bs[lane] = be;
  }
  {
    const int cp = lane;
#pragma unroll
    for (int X = 0; X < 3; ++X) {
      const int cb = X * 1024 + h * 128 + 2 * cp;
      float w[4][2];
#pragma unroll
      for (int j = 0; j < 4; ++j) { float2 t = *(const float2*)(p.gdn_conv_w + j * 3072 + cb); w[j][0] = t.x; w[j][1] = t.y; }
      float xw[3][2];
#pragma unroll
      for (int j = 0; j < 3; ++j) {
        const int rr = wave * 16 - 3 + j;
        unsigned u = 0u;
        if (rr >= 0) u = *(const unsigned*)(qkv + (size_t)(rowbase + rr) * 3072 + cb);
        else if (n > 0) u = *(const unsigned*)(halo + ((size_t)((b * 32 + n - 1) * 3 + (rr + 3))) * 3072 + cb);
        xw[j][0] = bf_lo(u); xw[j][1] = bf_hi(u);
      }
      float o[16][2];
#pragma unroll
      for (int t = 0; t < 16; ++t) {
        const unsigned u = *(const unsigned*)(qkv + (size_t)(rowbase + wave * 16 + t) * 3072 + cb);
        const float x0 = bf_lo(u), x1 = bf_hi(u);
        const float a0 = w[0][0] * xw[0][0] + w[1][0] * xw[1][0] + w[2][0] * xw[2][0] + w[3][0] * x0;
        const float a1 = w[0][1] * xw[0][1] + w[1][1] * xw[1][1] + w[2][1] * xw[2][1] + w[3][1] * x1;
        o[t][0] = siluf_(a0); o[t][1] = siluf_(a1);
        xw[0][0] = xw[1][0]; xw[0][1] = xw[1][1]; xw[1][0] = xw[2][0]; xw[1][1] = xw[2][1]; xw[2][0] = x0; xw[2][1] = x1;
      }
      if (X < 2) {
#pragma unroll
        for (int t = 0; t < 16; ++t) {
          const float ss = wsum(o[t][0] * o[t][0] + o[t][1] * o[t][1]);
          const float rs = rsqrtf(ss + EPS);
          o[t][0] *= rs; o[t][1] *= rs;
        }
      }
#pragma unroll
      for (int t = 0; t < 16; ++t) {
        const int row = wave * 16 + t;
        const unsigned pk = pk2(o[t][0], o[t][1]);
        if (X == 0) { *(unsigned*)(qn + row * LKN + 2 * cp) = pk; }
        else if (X == 1) {
          *(unsigned*)(kn + row * LKN + 2 * cp) = pk;
          knT[(2 * cp) * LKT + row] = (u16)(pk & 0xffffu); knT[(2 * cp + 1) * LKT + row] = (u16)(pk >> 16);
        } else {
          vT[(2 * cp) * LKT + row] = (u16)(pk & 0xffffu); vT[(2 * cp + 1) * LKT + row] = (u16)(pk >> 16);
        }
      }
    }
  }
  __syncthreads();
  const float Glast = Gs[63];
#pragma unroll
  for (int ff = 0; ff < 4; ++ff) {
    const int f = wave * 4 + ff;
    const int it = f >> 3, kb = (f >> 1) & 3, s = f & 1;
    const int i = it * 32 + r;
    const float sc = QSCALE * __expf(Gs[i]);
    const uint2 a = *(const uint2*)(qn + i * LKN + kb * 32 + 16 * s + 4 * hh);
    const uint2 c = *(const uint2*)(qn + i * LKN + kb * 32 + 16 * s + 4 * hh + 8);
    uint4 o;
    o.x = pk2(bf_lo(a.x) * sc, bf_hi(a.x) * sc); o.y = pk2(bf_lo(a.y) * sc, bf_hi(a.y) * sc);
    o.z = pk2(bf_lo(c.x) * sc, bf_hi(c.x) * sc); o.w = pk2(bf_lo(c.y) * sc, bf_hi(c.y) * sc);
    *(uint4*)((char*)qkv + (size_t)(rowbase + 4 * f + (lane >> 4)) * 6144 + h * 256 + (lane & 15) * 16) = o;
  }
  char* ext = p.ws + OFF_EXTRA + (size_t)item * 24576;
#pragma unroll
  for (int ff = 0; ff < 4; ++ff) {
    const int f = wave * 4 + ff;
    const int kt = f >> 2, pb = (f >> 1) & 1, s = f & 1;
    const int k = kt * 32 + r;
    const int p0 = pb * 32 + 16 * s + 4 * hh;
    const uint2 a = *(const uint2*)(knT + k * LKT + p0);
    const uint2 c = *(const uint2*)(knT + k * LKT + p0 + 8);
    const float4 g0 = *(const float4*)(Gs + p0), g1 = *(const float4*)(Gs + p0 + 8);
    uint4 o;
    o.x = pk2(bf_lo(a.x) * __expf(Glast - g0.x), bf_hi(a.x) * __expf(Glast - g0.y));
    o.y = pk2(bf_lo(a.y) * __expf(Glast - g0.z), bf_hi(a.y) * __expf(Glast - g0.w));
    o.z = pk2(bf_lo(c.x) * __expf(Glast - g1.x), bf_hi(c.x) * __expf(Glast - g1.y));
    o.w = pk2(bf_lo(c.y) * __expf(Glast - g1.z), bf_hi(c.y) * __expf(Glast - g1.w));
    *(uint4*)(ext + f * 1024 + lane * 16) = o;
  }
  f32x16 akk = zero16(), aqk = zero16();
  const int ta = (wave == 0) ? 0 : 1, tb = (wave == 2) ? 1 : 0;
  if (wave < 3) {
#pragma unroll
    for (int ks = 0; ks < 8; ++ks) {
      const bf16x8 fa = *(const bf16x8*)(kn + (ta * 32 + r) * LKN + ks * 16 + 8 * hh);
      const bf16x8 fb = *(const bf16x8*)(kn + (tb * 32 + r) * LKN + ks * 16 + 8 * hh);
      const bf16x8 fq = *(const bf16x8*)(qn + (ta * 32 + r) * LKN + ks * 16 + 8 * hh);
      akk = MFMA(fa, fb, akk);
      aqk = MFMA(fb, fq, aqk);
    }
  }
  __syncthreads();
  if (wave < 3) {
    const int m = tb * 32 + r; const float Gm = Gs[m];
#pragma unroll
    for (int reg = 0; reg < 16; ++reg) {
      const int i = ta * 32 + crow(reg, hh);
      const float v = (m < i) ? Bs[i] * akk[reg] * __expf(Gs[i] - Gm) : 0.f;
      Amat[i * 64 + m] = v;
    }
    const int i = ta * 32 + r; const float Gi = Gs[i];
    f32x16 av;
#pragma unroll
    for (int reg = 0; reg < 16; ++reg) {
      const int j = tb * 32 + crow(reg, hh);
      av[reg] = (j <= i) ? aqk[reg] * QSCALE * __expf(Gi - Gs[j]) : 0.f;
    }
    const int fbase = 16 + (wave * 2);
#pragma unroll
    for (int s = 0; s < 2; ++s) {
      bf16x8 fr8 = pack8(av, s);
      *(bf16x8*)(ext + (fbase + s) * 1024 + lane * 16) = fr8;
    }
  } else {
    for (int e = lane; e < 32 * 32; e += 64) Amat[(e >> 5) * 64 + 32 + (e & 31)] = 0.f;
    if (lane == 0) *(float*)(ext + 22 * 1024) = __expf(Glast);
  }
  __syncthreads();
  float* Tq = (float*)(smem + 9216);
  if (wave == 0) {
    float x[32];
    const int c = lane & 31, hb = lane >> 5;
    const float* Ab = Amat + (hb * 32) * 64 + hb * 32;
#pragma unroll
    for (int i = 0; i < 32; ++i) {
      float s0 = (c == i) ? 1.f : 0.f, s1 = 0.f;
#pragma unroll
      for (int m4 = 0; m4 < (i + 3) / 4; ++m4) {
        const float4 a4 = *(const float4*)(Ab + i * 64 + m4 * 4);
        if (m4 * 4 + 0 < i) s0 -= a4.x * x[m4 * 4 + 0];
        if (m4 * 4 + 1 < i) s1 -= a4.y * x[m4 * 4 + 1];
        if (m4 * 4 + 2 < i) s0 -= a4.z * x[m4 * 4 + 2];
        if (m4 * 4 + 3 < i) s1 -= a4.w * x[m4 * 4 + 3];
      }
      x[i] = s0 + s1;
      __builtin_amdgcn_sched_barrier(0);
    }
#pragma unroll
    for (int i = 0; i < 32; ++i) Tq[hb * 1024 + i * 32 + c] = x[i];
  }
  __syncthreads();
  const int c32 = tid & 31, g8 = tid >> 5;
  {
    float bm[4] = {0.f, 0.f, 0.f, 0.f};
#pragma unroll
    for (int j4 = 0; j4 < 8; ++j4) {
      float t[4];
#pragma unroll
      for (int e = 0; e < 4; ++e) t[e] = Tq[(j4 * 4 + e) * 32 + c32];
#pragma unroll
      for (int e = 0; e < 4; ++e) {
        const float4 a4 = *(const float4*)(Amat + (32 + g8 * 4 + e) * 64 + j4 * 4);
        bm[e] += a4.x * t[0] + a4.y * t[1] + a4.z * t[2] + a4.w * t[3];
      }
    }
#pragma unroll
    for (int e = 0; e < 4; ++e) Amat[(g8 * 4 + e) * 64 + 32 + c32] = bm[e];
  }
  __syncthreads();
  float t21[4] = {0.f, 0.f, 0.f, 0.f};
  {
#pragma unroll
    for (int m4 = 0; m4 < 8; ++m4) {
      float bv[4];
#pragma unroll
      for (int e = 0; e < 4; ++e) bv[e] = Amat[(m4 * 4 + e) * 64 + 32 + c32];
#pragma unroll
      for (int e = 0; e < 4; ++e) {
        const float4 a4 = *(const float4*)(Tq + 1024 + (g8 * 4 + e) * 32 + m4 * 4);
        t21[e] -= a4.x * bv[0] + a4.y * bv[1] + a4.z * bv[2] + a4.w * bv[3];
      }
    }
  }
  float t11[4], t22[4];
#pragma unroll
  for (int e = 0; e < 4; ++e) { t11[e] = Tq[(g8 * 4 + e) * 32 + c32]; t22[e] = Tq[1024 + (g8 * 4 + e) * 32 + c32]; }
  const float bcl = Bs[c32], bgl = bcl * __expf(Gs[c32]);
  const float bch = Bs[32 + c32], bgh = bch * __expf(Gs[32 + c32]);
  __syncthreads();
#pragma unroll
  for (int e = 0; e < 4; ++e) {
    const int i = g8 * 4 + e;
    Tb[i * LKT + c32] = f2bf(t11[e] * bcl);               Tg[i * LKT + c32] = f2bf(t11[e] * bgl);
    Tb[i * LKT + 32 + c32] = (u16)0;                      Tg[i * LKT + 32 + c32] = (u16)0;
    Tb[(32 + i) * LKT + c32] = f2bf(t21[e] * bcl);        Tg[(32 + i) * LKT + c32] = f2bf(t21[e] * bgl);
    Tb[(32 + i) * LKT + 32 + c32] = f2bf(t22[e] * bch);   Tg[(32 + i) * LKT + 32 + c32] = f2bf(t22[e] * bgh);
  }
  __syncthreads();
#pragma unroll
  for (int it = 0; it < 2; ++it) {
    f32x16 av = zero16(), ak = zero16();
#pragma unroll
    for (int ks = 0; ks < 4; ++ks) {
      const bf16x8 fT = *(const bf16x8*)(Tb + (it * 32 + r) * LKT + ks * 16 + 8 * hh);
      const bf16x8 fV = *(const bf16x8*)(vT + (wave * 32 + r) * LKT + ks * 16 + 8 * hh);
      const bf16x8 fK = *(const bf16x8*)(knT + (wave * 32 + r) * LKT + ks * 16 + 8 * hh);
      const bf16x8 fG = *(const bf16x8*)(Tg + (it * 32 + r) * LKT + ks * 16 + 8 * hh);
      av = MFMA(fT, fV, av);
      ak = MFMA(fK, fG, ak);
    }
    {
      const int fv = wave * 2 + it;
      char* d = (char*)qkv + (size_t)(rowbase + 8 * fv + (lane >> 3)) * 6144 + 4096 + h * 256 + (lane & 7) * 32;
      *(bf16x8*)d = pack8(av, 0); *(bf16x8*)(d + 16) = pack8(av, 1);
    }
#pragma unroll
    for (int s = 0; s < 2; ++s) {
      const int f = it * 8 + wave * 2 + s;
      *(bf16x8*)((char*)qkv + (size_t)(rowbase + 4 * f + (lane >> 4)) * 6144 + 2048 + h * 256 + (lane & 15) * 16) = pack8(ak, s);
    }
  }
  __syncthreads();
}

DI void d2_issue(u32x4 (&rg)[18], const Params& p, int b, int h, int lt, int n) {
  const char* qseg = p.ws + OFF_QKV + (size_t)(b * 2048 + n * 64) * 6144 + h * 256;
  const char* ext = p.ws + OFF_EXTRA + (size_t)((b * 32 + n) * 8 + h) * 24576;
#pragma unroll
  for (int sg = 0; sg < 3; ++sg)
#pragma unroll
    for (int i = 0; i < 4; ++i) rg[sg * 4 + i] = __builtin_nontemporal_load((const u32x4*)(qseg + (size_t)((lt >> 4) + 16 * i) * 6144 + sg * 2048 + (lt & 15) * 16));
#pragma unroll
  for (int i = 0; i < 6; ++i) rg[12 + i] = __builtin_nontemporal_load((const u32x4*)(ext + lt * 16 + i * 4096));
}
DI void d2_put(const u32x4 (&rg)[18], char* buf, int lt) {
#pragma unroll
  for (int sg = 0; sg < 3; ++sg)
#pragma unroll
    for (int i = 0; i < 4; ++i) *(u32x4*)(buf + sg * 16384 + ((lt >> 4) + 16 * i) * 256 + (lt & 15) * 16) = rg[sg * 4 + i];
#pragma unroll
  for (int i = 0; i < 6; ++i) *(u32x4*)(buf + 49152 + lt * 16 + i * 4096) = rg[12 + i];
}
DI void d2_block(const Params& p, int unit, char* smem) {
  const int tid = threadIdx.x, half = tid >> 8, lt = tid & 255, lane = tid & 63, wave = (tid >> 6) & 3;
  const int r = lane & 31, hh = lane >> 5;
  const int b = unit >> 3, h = unit & 7;
  const char* qkv = p.ws + OFF_QKV;
  const float* egl = (const float*)(p.ws + OFF_EGL);
  u16* obuf = (u16*)((char*)p.out + (size_t)R * 1024 * 2);
  if (half == 1) {
    u32x4 rg0[18], rg1[18];
    u32x4 og[4], sg4;
    u16* obuf_ = (u16*)((char*)p.out + (size_t)R * 1024 * 2);
    float* ssq_ = (float*)(p.ws + OFF_SSQ);
    const int orow = lt >> 2, opos = lt & 3, ocol = 8 * (opos ^ ((orow >> 1) & 3));
    d2_issue(rg0, p, b, h, lt, 0); d2_put(rg0, smem, lt); d2_issue(rg1, p, b, h, lt, 1); d2_issue(rg0, p, b, h, lt, 2);
    __syncthreads();
#define D2_LOADER_STEP(n_, RG)                                                                                              \
    {                                                                                                                        \
      const int n = (n_);                                                                                                    \
      char* ob = smem + ((n + 1) & 1) * HALF_SMEM;                                                                           \
      if (n >= 1) {                                                                                                          \
        _Pragma("unroll") for (int i = 0; i < 4; ++i) og[i] = *(const u32x4*)(ob + 32768 + (lt + 256 * i) * 16);            \
        if (lt >= 192) sg4 = *(const u32x4*)(ob + 49152 + 20480 + lt * 16);                                                  \
      }                                                                                                                      \
      if (n + 1 < 32) { d2_put(RG, ob, lt); if (n + 3 < 32) d2_issue(RG, p, b, h, lt, n + 3); }                              \
      if (n >= 1) {                                                                                                          \
        const int rowbase = b * 2048 + (n - 1) * 64;                                                                         \
        _Pragma("unroll") for (int i = 0; i < 4; ++i)                                                                        \
          *(u32x4*)(obuf_ + (size_t)(rowbase + orow) * 1024 + h * 128 + 32 * i + ocol) = og[i];                              \
        if (lt >= 192) *(u32x4*)(ssq_ + ((size_t)(rowbase + lt - 192) * 8 + h) * 4) = sg4;                                   \
      }                                                                                                                      \
      if (n < 32) { asm volatile("s_waitcnt lgkmcnt(0)" ::: "memory"); __builtin_amdgcn_s_barrier(); asm volatile("" ::: "memory"); } \
    }
#pragma unroll 1
    for (int n2 = 0; n2 <= 32; n2 += 2) {
      D2_LOADER_STEP(n2, rg1)
      if (n2 + 1 <= 32) D2_LOADER_STEP(n2 + 1, rg0)
    }
#undef D2_LOADER_STEP
    return;
  }
  f32x16 S[4];
#pragma unroll
  for (int k = 0; k < 4; ++k) S[k] = zero16();
  const unsigned voff_l = (unsigned)(lane * 16);
  bf16x8 If0, If1;
#pragma unroll
  for (int j = 0; j < 8; ++j) {
    const int k0 = 8 * (j >> 2) + 4 * hh + (j & 3);
    If0[j] = (short)((k0 == r) ? 0x3F80 : 0); If1[j] = (short)((16 + k0 == r) ? 0x3F80 : 0);
  }
  const unsigned voff_v = (unsigned)((16 * wave + (lane >> 3)) * 256 + (lane & 7) * 32);
  __syncthreads();
#pragma unroll 1
  for (int n = 0; n < 32; ++n) {
    const int item = (b * 32 + n) * 8 + h;
    const int rowbase = b * 2048 + n * 64;
    const char* buf = smem + (n & 1) * HALF_SMEM;
    const char* ext = buf + 49152;
    const float eg = *(const float*)(ext + 22 * 1024);
    bf16x8 fk[16];
#pragma unroll
    for (int f = 0; f < 16; ++f) fk[f] = *(const bf16x8*)(buf + 16384 + f * 1024 + voff_l);
    uint4 vv[2][2];
#pragma unroll
    for (int it = 0; it < 2; ++it) { const char* d = buf + 32768 + it * 2048 + voff_v; vv[it][0] = *(const uint4*)d; vv[it][1] = *(const uint4*)(d + 16); }
    bf16x8 Sf[4][2];
#pragma unroll
    for (int kb = 0; kb < 4; ++kb) { Sf[kb][0] = pack8(S[kb], 0); Sf[kb][1] = pack8(S[kb], 1); }
    __builtin_amdgcn_sched_barrier(0);
    f32x16 P1[2];
    P1[0] = zero16(); P1[1] = zero16();
#pragma unroll
    for (int kb = 0; kb < 4; ++kb)
#pragma unroll
      for (int s = 0; s < 2; ++s) {
        P1[0] = MFMA(fk[kb * 2 + s], Sf[kb][s], P1[0]);
        P1[1] = MFMA(fk[8 + kb * 2 + s], Sf[kb][s], P1[1]);
      }
    bf16x8 fq[8];
#pragma unroll
    for (int f = 0; f < 8; ++f) fq[f] = *(const bf16x8*)(buf + f * 1024 + voff_l);
    bf16x8 Vf[2][2];
#pragma unroll
    for (int it = 0; it < 2; ++it) {
      const uint4 v0 = vv[it][0], v1 = vv[it][1];
      f32x16 vn;
      vn[0] = bf_lo(v0.x) - P1[it][0];  vn[1] = bf_hi(v0.x) - P1[it][1];
      vn[2] = bf_lo(v0.y) - P1[it][2];  vn[3] = bf_hi(v0.y) - P1[it][3];
      vn[4] = bf_lo(v0.z) - P1[it][4];  vn[5] = bf_hi(v0.z) - P1[it][5];
      vn[6] = bf_lo(v0.w) - P1[it][6];  vn[7] = bf_hi(v0.w) - P1[it][7];
      vn[8] = bf_lo(v1.x) - P1[it][8];  vn[9] = bf_hi(v1.x) - P1[it][9];
      vn[10] = bf_lo(v1.y) - P1[it][10]; vn[11] = bf_hi(v1.y) - P1[it][11];
      vn[12] = bf_lo(v1.z) - P1[it][12]; vn[13] = bf_hi(v1.z) - P1[it][13];
      vn[14] = bf_lo(v1.w) - P1[it][14]; vn[15] = bf_hi(v1.w) - P1[it][15];
      Vf[it][0] = pack8(vn, 0); Vf[it][1] = pack8(vn, 1);
    }
    bf16x8 fa[6];
#pragma unroll
    for (int i = 0; i < 6; ++i) fa[i] = *(const bf16x8*)(ext + (16 + i) * 1024 + voff_l);
    f32x16 P2[2];
    P2[0] = zero16(); P2[1] = zero16();
#pragma unroll
    for (int kb = 0; kb < 4; ++kb)
#pragma unroll
      for (int s = 0; s < 2; ++s) {
        P2[0] = MFMA(fq[kb * 2 + s], Sf[kb][s], P2[0]);
        const bf16x8 fq1 = *(const bf16x8*)(buf + (8 + kb * 2 + s) * 1024 + voff_l);
        P2[1] = MFMA(fq1, Sf[kb][s], P2[1]);
      }
    __builtin_amdgcn_sched_barrier(0);
    bf16x8 fkd[16];
#pragma unroll
    for (int i = 0; i < 16; ++i) fkd[i] = *(const bf16x8*)(ext + i * 1024 + voff_l);
#pragma unroll
    for (int s = 0; s < 2; ++s) {
      P2[0] = MFMA(fa[0 + s], Vf[0][s], P2[0]);
      P2[1] = MFMA(fa[2 + s], Vf[0][s], P2[1]);
      P2[1] = MFMA(fa[4 + s], Vf[1][s], P2[1]);
    }
    {
      char* ow = (char*)buf + 32768 + wave * 4096;
      float* sqw = (float*)((char*)buf + 49152 + 23 * 1024);
      const int xs = (r >> 1) & 3;
#pragma unroll
      for (int it = 0; it < 2; ++it) {
        f32x16 Z = MFMA(pack8(P2[it], 0), If0, zero16());
        Z = MFMA(pack8(P2[it], 1), If1, Z);
        float ssl = 0.f;
#pragma unroll
        for (int reg = 0; reg < 16; ++reg) ssl += Z[reg] * Z[reg];
        ssl += __shfl_xor(ssl, 32, 64);
        if (hh == 0) sqw[(it * 32 + r) * 4 + wave] = ssl;
#pragma unroll
        for (int g = 0; g < 4; ++g) {
          uint2 pv; pv.x = pk2(Z[4 * g], Z[4 * g + 1]); pv.y = pk2(Z[4 * g + 2], Z[4 * g + 3]);
          *(uint2*)(ow + (it * 32 + r) * 64 + ((g ^ xs) * 16) + hh * 8) = pv;
        }
      }
    }
#pragma unroll
    for (int kt = 0; kt < 4; ++kt) {
#pragma unroll
      for (int reg = 0; reg < 16; ++reg) S[kt][reg] *= eg;
#pragma unroll
      for (int pb = 0; pb < 2; ++pb)
#pragma unroll
        for (int s = 0; s < 2; ++s) {
          S[kt] = MFMA(fkd[kt * 4 + pb * 2 + s], Vf[pb][s], S[kt]);
        }
    }
    asm volatile("s_waitcnt lgkmcnt(0)" ::: "memory"); __builtin_amdgcn_s_barrier(); asm volatile("" ::: "memory");
  }
  float* od = p.out + OUT_DELTAP + (size_t)(b * 8 + h) * 16384;
#pragma unroll
  for (int kt = 0; kt < 4; ++kt)
#pragma unroll
    for (int reg = 0; reg < 16; ++reg) od[(kt * 32 + crow(reg, hh)) * 128 + wave * 32 + r] = S[kt][reg];
}

DI void conf_prompt_item(const Params& p, int item, char* smem) {
  const int tid = threadIdx.x & 255, lane = tid & 63, wave = tid >> 6;
  const int b = item >> 6, t0 = (item & 63) * 32;
  unsigned* tile = (unsigned*)smem;
  float* red = (float*)(smem + 63488);
  const u16* glu = (const u16*)(p.ws + OFF_GLU);
  u16* aact = (u16*)(p.ws + OFF_AACT);
#pragma unroll 1
  for (int hb = 0; hb < 2; ++hb) {
    u32x4 fv[8];
#pragma unroll
    for (int i = 0; i < 8; ++i) {
      const int e = tid + 256 * (hb * 8 + i), rr = e >> 6, c8 = (e & 63) * 8;
      const int t = t0 - 30 + rr;
      fv[i] = (u32x4){0u, 0u, 0u, 0u};
      if (rr < 62 && t >= 0) fv[i] = *(const u32x4*)(glu + (size_t)(b * 2048 + t) * 512 + c8);
    }
#pragma unroll
    for (int i = 0; i < 8; ++i) {
      const int e = tid + 256 * (hb * 8 + i), rr = e >> 6, c8 = (e & 63) * 8;
      if (rr < 62) *(u32x4*)(tile + rr * 256 + (c8 >> 1)) = fv[i];
    }
  }
  float w[31][2];
#pragma unroll
  for (int j = 0; j < 31; ++j) { const float2 t = *(const float2*)(p.conf_dw_w + j * 512 + 2 * tid); w[j][0] = t.x; w[j][1] = t.y; }
  const float2 bias = *(const float2*)(p.conf_dw_b + 2 * tid);
  const float2 lw = *(const float2*)(p.conf_ln_w + 2 * tid), lb = *(const float2*)(p.conf_ln_b + 2 * tid);
  __syncthreads();
#pragma unroll 1
  for (int tg = 0; tg < 4; ++tg) {
    float a[8][2];
#pragma unroll
    for (int t = 0; t < 8; ++t) { a[t][0] = bias.x; a[t][1] = bias.y; }
#pragma unroll
    for (int i = 0; i < 38; ++i) {
      const unsigned u = tile[(tg * 8 + i) * 256 + tid];
      const float x0 = bf_lo(u), x1 = bf_hi(u);
#pragma unroll
      for (int t = 0; t < 8; ++t) {
        const int j = i - t;
        if (j >= 0 && j < 31) { a[t][0] += w[j][0] * x0; a[t][1] += w[j][1] * x1; }
      }
    }
#pragma unroll
    for (int t = 0; t < 8; ++t) {
      const float s1 = wsum(a[t][0] + a[t][1]);
      const float s2 = wsum(a[t][0] * a[t][0] + a[t][1] * a[t][1]);
      if (lane == 0) { red[(wave * 8 + t) * 2] = s1; red[(wave * 8 + t) * 2 + 1] = s2; }
    }
    __syncthreads();
#pragma unroll
    for (int t = 0; t < 8; ++t) {
      const float s1 = red[t * 2] + red[(8 + t) * 2] + red[(16 + t) * 2] + red[(24 + t) * 2];
      const float s2 = red[t * 2 + 1] + red[(8 + t) * 2 + 1] + red[(16 + t) * 2 + 1] + red[(24 + t) * 2 + 1];
      const float mu = s1 * (1.f / 512.f);
      const float var = fmaxf(s2 * (1.f / 512.f) - mu * mu, 0.f);
      const float rs = rsqrtf(var + EPS);
      const float y0 = (a[t][0] - mu) * rs * lw.x + lb.x, y1 = (a[t][1] - mu) * rs * lw.y + lb.y;
      *(unsigned*)(aact + (size_t)(b * 2048 + t0 + tg * 8 + t) * 512 + 2 * tid) = pk2(siluf_(y0), siluf_(y1));
    }
    __syncthreads();
  }
}
DI void conf_sample_item(const Params& p, int item) {
  const int lane = threadIdx.x & 63, wave = (threadIdx.x >> 6) & 3;
  const int s = item * 4 + wave;
  const int c = lane * 8;
  const u16* glu = (const u16*)(p.ws + OFF_GLU);
  u16* aact = (u16*)(p.ws + OFF_AACT);
  float a[8];
  {
    const float4 b0 = *(const float4*)(p.conf_dw_b + c), b1 = *(const float4*)(p.conf_dw_b + c + 4);
    a[0] = b0.x; a[1] = b0.y; a[2] = b0.z; a[3] = b0.w; a[4] = b1.x; a[5] = b1.y; a[6] = b1.z; a[7] = b1.w;
  }
  const float* st = p.st_conf + (size_t)s * 30 * 512;
  float* oc = p.out + OUT_CONFS + (size_t)s * 30 * 512;
#pragma unroll 1
  for (int j = 0; j < 30; ++j) {
    const f32x4 n0 = __builtin_nontemporal_load((const f32x4*)(st + j * 512 + c)), n1 = __builtin_nontemporal_load((const f32x4*)(st + j * 512 + c + 4));
    const float4 x0 = make_float4(n0[0], n0[1], n0[2], n0[3]), x1 = make_float4(n1[0], n1[1], n1[2], n1[3]);
    const float4 w0 = *(const float4*)(p.conf_dw_w + j * 512 + c), w1 = *(const float4*)(p.conf_dw_w + j * 512 + c + 4);
    a[0] += w0.x * x0.x; a[1] += w0.y * x0.y; a[2] += w0.z * x0.z; a[3] += w0.w * x0.w;
    a[4] += w1.x * x1.x; a[5] += w1.y * x1.y; a[6] += w1.z * x1.z; a[7] += w1.w * x1.w;
    if (j >= 1) { __builtin_nontemporal_store(n0, (f32x4*)(oc + (j - 1) * 512 + c)); __builtin_nontemporal_store(n1, (f32x4*)(oc + (j - 1) * 512 + c + 4)); }
  }
  {
    const uint4 g = *(const uint4*)(glu + (size_t)(RP + s) * 512 + c);
    const float4 w0 = *(const float4*)(p.conf_dw_w + 30 * 512 + c), w1 = *(const float4*)(p.conf_dw_w + 30 * 512 + c + 4);
    a[0] += w0.x * bf_lo(g.x); a[1] += w0.y * bf_hi(g.x); a[2] += w0.z * bf_lo(g.y); a[3] += w0.w * bf_hi(g.y);
    a[4] += w1.x * bf_lo(g.z); a[5] += w1.y * bf_hi(g.z); a[6] += w1.z * bf_lo(g.w); a[7] += w1.w * bf_hi(g.w);
  }
  float s1 = 0.f, s2 = 0.f;
#pragma unroll
  for (int i = 0; i < 8; ++i) { s1 += a[i]; s2 += a[i] * a[i]; }
  s1 = wsum(s1); s2 = wsum(s2);
  const float mu = s1 * (1.f / 512.f);
  const float rs = rsqrtf(fmaxf(s2 * (1.f / 512.f) - mu * mu, 0.f) + EPS);
  float y[8];
#pragma unroll
  for (int i = 0; i < 8; ++i) y[i] = siluf_((a[i] - mu) * rs * p.conf_ln_w[c + i] + p.conf_ln_b[c + i]);
  uint4 o; o.x = pk2(y[0], y[1]); o.y = pk2(y[2], y[3]); o.z = pk2(y[4], y[5]); o.w = pk2(y[6], y[7]);
  *(uint4*)(aact + (size_t)(RP + s) * 512 + c) = o;
}
DI void delta_sample_item(const Params& p, int item, char* smem) {
  const int tid = threadIdx.x & 255, lane = tid & 63, wave = tid >> 6;
  const int s = item >> 3, h = item & 7;
  float* qs = (float*)smem; float* ks = qs + 128; float* vs = ks + 128; float* part = vs + 128;
  float* red = part + 768;
  const u16* qkv = (const u16*)(p.ws + OFF_QKV);
  const float* gb = (const float*)(p.ws + OFF_GB);
  const int row = RP + s;
  const int v = tid & 127, kh = tid >> 7;
  const float* S0 = p.st_delta + (size_t)(s * 8 + h) * 16384 + (size_t)(kh * 64) * 128 + v;
  float Sr[64];
#pragma unroll
  for (int kk = 0; kk < 64; ++kk) Sr[kk] = __builtin_nontemporal_load(S0 + kk * 128);
  const float g = gb[(size_t)row * 16 + 8 + h], beta = gb[(size_t)row * 16 + h];
  float cq = 0.f, ck = 0.f, cv = 0.f;
  if (tid < 128) {
    float cx[3];
#pragma unroll
    for (int X = 0; X < 3; ++X) {
      const int cg = X * 1024 + h * 128 + tid;
      const float s0 = p.st_qkv[(size_t)(s * 3 + 0) * 3072 + cg], s1 = p.st_qkv[(size_t)(s * 3 + 1) * 3072 + cg], s2 = p.st_qkv[(size_t)(s * 3 + 2) * 3072 + cg];
      const float x = bf1(qkv[(size_t)row * 3072 + cg]);
      const float a = p.gdn_conv_w[cg] * s0 + p.gdn_conv_w[3072 + cg] * s1 + p.gdn_conv_w[2 * 3072 + cg] * s2 + p.gdn_conv_w[3 * 3072 + cg] * x;
      cx[X] = siluf_(a);
      p.out[OUT_QKVS + (size_t)(s * 3 + 0) * 3072 + cg] = s1;
      p.out[OUT_QKVS + (size_t)(s * 3 + 1) * 3072 + cg] = s2;
    }
    cq = cx[0]; ck = cx[1]; cv = cx[2];
  }
  {
    const float sq = wsum(cq * cq), sk = wsum(ck * ck);
    if (lane == 0) { red[wave * 2] = sq; red[wave * 2 + 1] = sk; }
  }
  __syncthreads();
  if (tid < 128) {
    const float rq = rsqrtf(red[0] + red[2] + EPS), rk = rsqrtf(red[1] + red[3] + EPS);
    qs[tid] = cq * rq * QSCALE; ks[tid] = ck * rk; vs[tid] = cv;
  }
  __syncthreads();
  const float eg = __expf(g);
  float kS = 0.f, qS = 0.f, qk = 0.f;
#pragma unroll
  for (int k4 = 0; k4 < 16; ++k4) {
    const float4 kv = *(const float4*)(ks + kh * 64 + k4 * 4), qv = *(const float4*)(qs + kh * 64 + k4 * 4);
    kS += kv.x * Sr[4 * k4] + kv.y * Sr[4 * k4 + 1] + kv.z * Sr[4 * k4 + 2] + kv.w * Sr[4 * k4 + 3];
    qS += qv.x * Sr[4 * k4] + qv.y * Sr[4 * k4 + 1] + qv.z * Sr[4 * k4 + 2] + qv.w * Sr[4 * k4 + 3];
    qk += kv.x * qv.x + kv.y * qv.y + kv.z * qv.z + kv.w * qv.w;
  }
  part[(kh * 3 + 0) * 128 + v] = kS; part[(kh * 3 + 1) * 128 + v] = qS; part[(kh * 3 + 2) * 128 + v] = qk;
  __syncthreads();
  kS = part[0 * 128 + v] + part[3 * 128 + v];
  qS = part[1 * 128 + v] + part[4 * 128 + v];
  qk = part[2 * 128 + v] + part[5 * 128 + v];
  const float vnew = vs[v] * beta - beta * eg * kS;
  const float o = eg * qS + qk * vnew;
  float* Sd = p.out + OUT_DELTAS + (size_t)(s * 8 + h) * 16384 + (size_t)(kh * 64) * 128 + v;
#pragma unroll
  for (int k4 = 0; k4 < 16; ++k4) {
    const float4 kv = *(const float4*)(ks + kh * 64 + k4 * 4);
    __builtin_nontemporal_store(Sr[4 * k4 + 0] * eg + kv.x * vnew, Sd + (4 * k4 + 0) * 128);
    __builtin_nontemporal_store(Sr[4 * k4 + 1] * eg + kv.y * vnew, Sd + (4 * k4 + 1) * 128);
    __builtin_nontemporal_store(Sr[4 * k4 + 2] * eg + kv.z * vnew, Sd + (4 * k4 + 2) * 128);
    __builtin_nontemporal_store(Sr[4 * k4 + 3] * eg + kv.w * vnew, Sd + (4 * k4 + 3) * 128);
  }
  if (kh == 0) {
    ((u16*)((char*)p.out + (size_t)R * 1024 * 2))[(size_t)row * 1024 + h * 128 + v] = f2bf(o);
    const float so = wsum(o * o);
    if (lane == 0) { float* sq = (float*)(p.ws + OFF_SSQ) + ((size_t)row * 8 + h) * 4; sq[wave] = so; sq[wave + 2] = 0.f; }
  }
  __syncthreads();
}

__global__ void __launch_bounds__(512, 2) fwd_megakernel(Params p) {
  __shared__ __attribute__((aligned(1024))) char smem[SMEM_BYTES];
  const int tid = threadIdx.x, lane = tid & 63, wave = tid >> 6;
  const int fr = lane & 15, fq = lane >> 4;
  uint4* xb_words = (uint4*)(smem + 2 * HALF_SMEM);
  if (tid == 0) *xb_words = make_uint4(0u, 0u, 0u, 0u);
  __syncthreads();
  XcdBarrier xb = xcd_barrier_post((unsigned*)(p.ws + OFF_BAR), (volatile LAS unsigned*)xb_words);
  const int G = gridDim.x, bid = blockIdx.x;
  float* mod = (float*)(p.ws + OFF_MOD);
  u16* hbuf = (u16*)p.out;
  u16* obuf = (u16*)((char*)p.out + (size_t)R * 1024 * 2);
  const float* ssq = (const float*)(p.ws + OFF_SSQ);
  u16* merged = (u16*)(p.ws + OFF_MERGED);
  u16* tmp2 = (u16*)(p.ws + OFF_TMP2);

  PH(0) phase_convert(p, smem);
  xcd_barrier(xb);

  PH(1) for (int sb = bid; sb < 256; sb += G) {
    skinny<2>((const u16*)(p.ws + OFF_AC), 1024, 0, 136, (const u16*)(p.ws + OFF_WADA), 1024, 1024,
      [&](int j) { return sb * 24 + (j < 24 ? j : 23); },
      [&](int row, int ntl, int q, f32x4 v, int ln) {
        const int j = ntl * 16 + 4 * q;
        if (j < 24) {
          const int col = sb * 24 + j;
          const float4 bb = *(const float4*)(p.b_ada + col);
          *(float4*)(mod + (size_t)row * 6144 + col) = make_float4(v[0] + bb.x, v[1] + bb.y, v[2] + bb.z, v[3] + bb.w);
        }
      });
  }
  xcd_barrier(xb);

  PH(2) phase_modnorm<true>(p, p.x_prompt, p.x_sample, p.norm1_w, 0, 1024, hbuf, smem);
  xcd_barrier(xb);

  PH(3) {
    u16* glu = (u16*)(p.ws + OFF_GLU);
    u16* qkv = (u16*)(p.ws + OFF_QKV);
    u16* halo = (u16*)(p.ws + OFF_HALO);
    auto f_glu_st = [&](int row, int ch, f32x4 gl) {
      uint2 o; o.x = pk2(gl[0], gl[1]); o.y = pk2(gl[2], gl[3]);
      *(uint2*)(glu + (size_t)row * 512 + ch) = o;
      if (row < RP) { const int b = row >> 11, tt = row & 2047; if (tt >= 2018) *(float4*)(p.out + OUT_CONFP + (size_t)(b * 30 + tt - 2018) * 512 + ch) = make_float4(gl[0], gl[1], gl[2], gl[3]); }
      else *(float4*)(p.out + OUT_CONFS + (size_t)((row - RP) * 30 + 29) * 512 + ch) = make_float4(gl[0], gl[1], gl[2], gl[3]);
    };
    auto f_glu = [&](int row, int ch, f32x4 a, f32x4 g) {
      f32x4 gl;
#pragma unroll
      for (int j = 0; j < 4; ++j) gl[j] = a[j] * sigmoidf_(g[j]);
      f_glu_st(row, ch, gl);
    };
    auto f_qkv = [&](int row, int col, f32x4 a) {
      const float4 v = make_float4(a[0], a[1], a[2], a[3]);
      uint2 o; o.x = pk2(v.x, v.y); o.y = pk2(v.z, v.w);
      *(uint2*)(qkv + (size_t)row * 3072 + col) = o;
      if (row < RP) {
        const int b = row >> 11, tt = row & 2047;
        if ((tt & 63) >= 61) *(uint2*)(halo + (size_t)((b * 32 + (tt >> 6)) * 3 + (tt & 63) - 61) * 3072 + col) = o;
        if (tt >= 2045) *(float4*)(p.out + OUT_QKVP + (size_t)(b * 3 + tt - 2045) * 3072 + col) = v;
      } else *(float4*)(p.out + OUT_QKVS + (size_t)((row - RP) * 3 + 2) * 3072 + col) = v;
    };
    int u = bid;
    for (; u < 64 * 4; u += G) {
      const int pm = u % 64, pn = u / 64;
      f32x4 acc[2][2][4][2];
      zero_acc(acc);
      gemm256(acc, hbuf, 1024, (const u16*)(p.ws + OFF_WIN), 1024, pm * 256, pn * 256, 1024, smem);
      {
        int t_ = threadIdx.x;
        asm volatile("" : "+v"(t_));
        const int wr = t_ >> 8, wc = (t_ >> 6) & 3, fr_ = t_ & 15, fq_ = (t_ >> 4) & 3;
        float* T = (float*)smem;
#pragma unroll
        for (int ai = 0; ai < 2; ++ai)
#pragma unroll
          for (int m = 0; m < 4; ++m)
#pragma unroll
            for (int n = 0; n < 2; ++n) {
              f32x4 gl;
#pragma unroll
              for (int j = 0; j < 4; ++j) gl[j] = acc[ai][0][m][n][j] * sigmoidf_(acc[ai][1][m][n][j]);
              *(f32x4*)(T + (ai * 128 + wr * 64 + m * 16 + fr_) * TLD + wc * 32 + n * 16 + 4 * fq_) = gl;
            }
        __syncthreads();
        const int cg = (t_ & 31) * 4, r0 = t_ >> 5;
#pragma unroll 4
        for (int i = 0; i < 16; ++i) {
          const int rl = r0 + 16 * i;
          const f32x4 v = *(const f32x4*)(T + rl * TLD + cg);
          f_glu_st(pm * 256 + rl, pn * 128 + cg, v);
        }
        __syncthreads();
      }
    }
    for (; u < 64 * 16; u += G) {
      const int pm = u % 64, pn = u / 64;
      f32x4 acc[2][2][4][2];
      zero_acc(acc);
      gemm256(acc, hbuf, 1024, (const u16*)(p.ws + OFF_WIN), 1024, pm * 256, pn * 256, 1024, smem);
      tile_epilogue(acc, pm * 256, pn * 256 - 1024, smem, f_qkv);
    }
    for (int sb = bid; sb < 256; sb += G) {
      if (sb < 64) {
        skinny<1>(hbuf, 1024, RP, 128, (const u16*)(p.ws + OFF_WIN), 1024, 1024,
          [&](int j) { const int ch = sb * 8 + (j & 7); return (ch >> 7) * 256 + (ch & 127) + ((j >> 3) << 7); },
          [&](int row, int ntl, int q, f32x4 v, int ln) {
            f32x4 g;
#pragma unroll
            for (int j = 0; j < 4; ++j) g[j] = __shfl(v[j], (ln + 32) & 63, 64);
            if (q < 2) f_glu(row, sb * 8 + 4 * q, v, g);
          });
      } else {
        skinny<1>(hbuf, 1024, RP, 128, (const u16*)(p.ws + OFF_WIN), 1024, 1024,
          [&](int j) { return 1024 + (sb - 64) * 16 + j; },
          [&](int row, int ntl, int q, f32x4 v, int ln) { f_qkv(row, (sb - 64) * 16 + 4 * q, v); });
      }
    }
  }
  xcd_barrier(xb);

  PH(4) for (int base = bid * 2; base < 2048; base += 2 * G) d1_item(p, base + (tid >> 8), smem + (tid >> 8) * HALF_SMEM);
  xcd_barrier(xb);

  PH(5) {
    const int half = tid >> 8;
    char* hs = smem + half * HALF_SMEM;
    for (int u = bid; u < 64; u += G) { d2_block(p, u, smem); __syncthreads(); }
    unsigned* qhead = (unsigned*)(p.ws + OFF_BAR) + 64;
    volatile unsigned* qslot = (volatile unsigned*)(smem + 2 * HALF_SMEM + 32);
    auto deq = [&]() -> int {
      if (tid == 0) *qslot = __hip_atomic_fetch_add(qhead, 1u, __ATOMIC_RELAXED, __HIP_MEMORY_SCOPE_AGENT);
      __syncthreads();
      const int v = __builtin_amdgcn_readfirstlane((int)*qslot);
      __syncthreads();
      return v;
    };
    int idx = deq();
    for (; idx < 256; idx = deq()) conf_prompt_item(p, 2 * idx + half, hs);
    for (; idx < 272; idx = deq()) conf_sample_item(p, 2 * (idx - 256) + half);
    for (; idx < 784; idx = deq()) delta_sample_item(p, 2 * (idx - 272) + half, hs);
  }
  xcd_barrier(xb);

  PH(6) {
    auto f_z = [&](int row, int col, f32x4 a) {
      const float4 sq4 = *(const float4*)(ssq + ((size_t)row * 8 + (col >> 7)) * 4);
      const float rstd = rsqrtf((sq4.x + sq4.y + sq4.z + sq4.w) * (1.f / 128.f) + EPS);
      const float4 gw = *(const float4*)(p.gdn_norm_w + (col & 127));
      u16* op = obuf + (size_t)row * 1024 + col;
      const uint2 u = *(const uint2*)op;
      uint2 o;
      o.x = pk2(bf_lo(u.x) * rstd * gw.x * siluf_(a[0]), bf_hi(u.x) * rstd * gw.y * siluf_(a[1]));
      o.y = pk2(bf_lo(u.y) * rstd * gw.z * siluf_(a[2]), bf_hi(u.y) * rstd * gw.w * siluf_(a[3]));
      *(uint2*)op = o;
    };
    gemm_pass(hbuf, 1024, (const u16*)(p.ws + OFF_WZ), 1024, 1024, 1024, smem, f_z);
    for (int sb = bid; sb < 256; sb += G)
      skinny<1>(hbuf, 1024, RP, 128, (const u16*)(p.ws + OFF_WZ), 1024, 1024, [&](int j) { return sb * 4 + (j & 3); },
                [&](int row, int ntl, int q, f32x4 v, int ln) { if (q == 0) f_z(row, sb * 4, v); });
  }
  xcd_barrier(xb);

  PH(7) {
    auto f_ga = [&](int row, int col, f32x4 a) {
      uint2 o; o.x = pk2(sigmoidf_(a[0]), sigmoidf_(a[1])); o.y = pk2(sigmoidf_(a[2]), sigmoidf_(a[3]));
      *(uint2*)(merged + (size_t)row * 1024 + col) = o;
    };
    auto f_ya = [&](int row, int col, f32x4 a) {
      u16* mp = merged + (size_t)row * 1024 + col;
      const uint2 u = *(const uint2*)mp;
      uint2 o; o.x = pk2(bf_lo(u.x) * a[0], bf_hi(u.x) * a[1]); o.y = pk2(bf_lo(u.y) * a[2], bf_hi(u.y) * a[3]);
      *(uint2*)mp = o;
    };
    auto f_gb = [&](int row, int col, f32x4 a) {
      uint2 o; o.x = pk2(sigmoidf_(a[0]), sigmoidf_(a[1])); o.y = pk2(sigmoidf_(a[2]), sigmoidf_(a[3]));
      *(uint2*)(tmp2 + (size_t)row * 1024 + col) = o;
    };
    auto f_yb = [&](int row, int col, f32x4 a) {
      u16* mp = merged + (size_t)row * 1024 + col;
      const uint2 u = *(const uint2*)mp, s2 = *(const uint2*)(tmp2 + (size_t)row * 1024 + col);
      uint2 o; o.x = pk2(bf_lo(u.x) + bf_lo(s2.x) * a[0], bf_hi(u.x) + bf_hi(s2.x) * a[1]); o.y = pk2(bf_lo(u.y) + bf_lo(s2.y) * a[2], bf_hi(u.y) + bf_hi(s2.y) * a[3]);
      *(uint2*)mp = o;
    };
    auto cm4 = [&](int sb) { return [sb](int j) { return sb * 4 + (j & 3); }; };
    gemm_pass(hbuf, 1024, (const u16*)(p.ws + OFF_WGA), 1024, 1024, 1024, smem, f_ga);
    gemm_pass((const u16*)(p.ws + OFF_AACT), 512, (const u16*)(p.ws + OFF_WCONF), 512, 1024, 512, smem, f_ya);
    gemm_pass(hbuf, 1024, (const u16*)(p.ws + OFF_WGB), 1024, 1024, 1024, smem, f_gb);
    gemm_pass(obuf, 1024, (const u16*)(p.ws + OFF_WGDN), 1024, 1024, 1024, smem, f_yb);
    for (int sb = bid; sb < 256; sb += G) {
      skinny<1>(hbuf, 1024, RP, 128, (const u16*)(p.ws + OFF_WGA), 1024, 1024, cm4(sb), [&](int row, int ntl, int q, f32x4 v, int ln) { if (q == 0) f_ga(row, sb * 4, v); });
      skinny<1>((const u16*)(p.ws + OFF_AACT), 512, RP, 128, (const u16*)(p.ws + OFF_WCONF), 512, 512, cm4(sb), [&](int row, int ntl, int q, f32x4 v, int ln) { if (q == 0) f_ya(row, sb * 4, v); });
      skinny<1>(hbuf, 1024, RP, 128, (const u16*)(p.ws + OFF_WGB), 1024, 1024, cm4(sb), [&](int row, int ntl, int q, f32x4 v, int ln) { if (q == 0) f_gb(row, sb * 4, v); });
      skinny<1>(obuf, 1024, RP, 128, (const u16*)(p.ws + OFF_WGDN), 1024, 1024, cm4(sb), [&](int row, int ntl, int q, f32x4 v, int ln) { if (q == 0) f_yb(row, sb * 4, v); });
    }
  }
  xcd_barrier(xb);

  PH(8) {
    auto f_o = [&](int row, int col, f32x4 a) {
      const float* xr = row < RP ? p.x_prompt + (size_t)row * 1024 : p.x_sample + (size_t)(row - RP) * 1024;
      const f32x4 x4 = __builtin_nontemporal_load((const f32x4*)(xr + col));
      const float4 xv = make_float4(x4[0], x4[1], x4[2], x4[3]), gv = *(const float4*)(mod + (size_t)mrow_of(row) * 6144 + 2048 + col);
      *(float4*)(p.out + (size_t)row * 1024 + col) = make_float4(xv.x + gv.x * a[0], xv.y + gv.y * a[1], xv.z + gv.z * a[2], xv.w + gv.w * a[3]);
    };
    gemm_pass(merged, 1024, (const u16*)(p.ws + OFF_WO), 1024, 1024, 1024, smem, f_o);
    for (int sb = bid; sb < 256; sb += G)
      skinny<1>(merged, 1024, RP, 128, (const u16*)(p.ws + OFF_WO), 1024, 1024, [&](int j) { return sb * 4 + (j & 3); },
                [&](int row, int ntl, int q, f32x4 v, int ln) { if (q == 0) f_o(row, sb * 4, v); });
  }
  xcd_barrier(xb);

  PH(9) phase_modnorm<false>(p, p.out, p.out + (size_t)RP * 1024, p.norm2_w, 3072, 4096, (u16*)(p.ws + OFF_H2), smem);
  xcd_barrier(xb);

  PH(10) {
    u16* f = (u16*)(p.ws + OFF_F);
    auto f_ff1 = [&](int row, int col, f32x4 a) {
      float v[4];
#pragma unroll
      for (int j = 0; j < 4; ++j) { const float t = fmaxf(a[j], 0.f); v[j] = t * t; }
      uint2 o; o.x = pk2(v[0], v[1]); o.y = pk2(v[2], v[3]);
      *(uint2*)(f + (size_t)row * LDF + col) = o;
    };
    gemm_pass((const u16*)(p.ws + OFF_H2), 1024, (const u16*)(p.ws + OFF_W1), 1024, 4096, 1024, smem, f_ff1);
    for (int sb = bid; sb < 256; sb += G)
      skinny<1>((const u16*)(p.ws + OFF_H2), 1024, RP, 128, (const u16*)(p.ws + OFF_W1), 1024, 1024, [&](int j) { return sb * 16 + j; },
                [&](int row, int ntl, int q, f32x4 v, int ln) { f_ff1(row, sb * 16 + 4 * q, v); });
  }
  xcd_barrier(xb);

  PH(11) {
    auto f_ff2 = [&](int row, int col, f32x4 a) {
      float* xp = p.out + (size_t)row * 1024 + col;
      const f32x4 x4 = __builtin_nontemporal_load((const f32x4*)xp);
      const float4 xv = make_float4(x4[0], x4[1], x4[2], x4[3]), gv = *(const float4*)(mod + (size_t)mrow_of(row) * 6144 + 5120 + col);
      *(float4*)xp = make_float4(xv.x + gv.x * a[0], xv.y + gv.y * a[1], xv.z + gv.z * a[2], xv.w + gv.w * a[3]);
    };
    gemm_pass((const u16*)(p.ws + OFF_F), LDF, (const u16*)(p.ws + OFF_W2), LDF, 1024, 4096, smem, f_ff2);
    for (int sb = bid; sb < 256; sb += G)
      skinny<1>((const u16*)(p.ws + OFF_F), LDF, RP, 128, (const u16*)(p.ws + OFF_W2), LDF, 4096, [&](int j) { return sb * 4 + (j & 3); },
                [&](int row, int ntl, int q, f32x4 v, int ln) { if (q == 0) f_ff2(row, sb * 4, v); });
  }
  xcd_barrier(xb);

  PH(12) {
    int t12 = threadIdx.x;
    asm volatile("" : "+v"(t12));
    const int lane = t12 & 63, wave = t12 >> 6;
    const int gw = bid * 8 + wave, nw_ = G * 8;
    for (int row = gw; row < R; row += nw_) {
      float* xr = p.out + (size_t)row * 1024;
      float4 v[4]; float ss = 0.f;
#pragma unroll
      for (int i = 0; i < 4; ++i) { const f32x4 t4 = __builtin_nontemporal_load((const f32x4*)(xr + (lane + 64 * i) * 4)); v[i] = make_float4(t4[0], t4[1], t4[2], t4[3]); ss += v[i].x * v[i].x + v[i].y * v[i].y + v[i].z * v[i].z + v[i].w * v[i].w; }
      ss = wsum(ss);
      const float rstd = rsqrtf(ss * (1.f / 1024.f) + EPS);
#pragma unroll
      for (int i = 0; i < 4; ++i) {
        const int c = (lane + 64 * i) * 4;
        const float4 w = *(const float4*)(p.final_norm_w + c);
        f32x4 yv = {v[i].x * rstd * w.x, v[i].y * rstd * w.y, v[i].z * rstd * w.z, v[i].w * rstd * w.w};
        __builtin_nontemporal_store(yv, (f32x4*)(xr + c));
      }
    }
  }
}

extern "C" void kernel_launch(void* const* d_in, const int* in_sizes, int n_in, void* d_out, int out_size, void* d_ws, size_t ws_size,
                              hipStream_t stream) {
  static int grid_blocks = 0;
  if (!grid_blocks) {
    int dev = 0, cus = 0, per_cu = 0;
    hipGetDevice(&dev);
    hipDeviceGetAttribute(&cus, hipDeviceAttributeMultiprocessorCount, dev);
    hipOccupancyMaxActiveBlocksPerMultiprocessor(&per_cu, (const void*)fwd_megakernel, NT, 0);
    if (per_cu > 1) per_cu = 1;
    if (per_cu < 1) per_cu = 1;
    grid_blocks = cus * per_cu;
  }
  Params p{};
  const float** pp = (const float**)&p;
  for (int i = 0; i < 26; ++i) pp[i] = (const float*)d_in[i];
  p.out = (float*)d_out; p.ws = (char*)d_ws;
  if (ws_size < WS_NEED) { fprintf(stderr, "workspace too small: %zu < %zu\n", ws_size, (size_t)WS_NEED); return; }
  hipMemsetAsync(d_ws, 0, XCD_BAR_WORDS * 4, stream);
  void* args[] = {&p};
  hipError_t e = hipLaunchCooperativeKernel((const void*)fwd_megakernel, dim3(grid_blocks), dim3(NT), args, 0, stream);
  if (e != hipSuccess) fprintf(stderr, "cooperative launch failed: %s (grid %d)\n", hipGetErrorString(e), grid_blocks);
}
```

```cpp
#include <hip/hip_runtime.h>
#include <stdint.h>
#include <cstdio>

#define DI __device__ __forceinline__
typedef unsigned short u16;
typedef __bf16 bf2_t __attribute__((ext_vector_type(2)));
typedef float f2_t __attribute__((ext_vector_type(2)));
using bf16x8 = __attribute__((ext_vector_type(8))) short;
using f32x16 = __attribute__((ext_vector_type(16))) float;
using f32x4 = __attribute__((ext_vector_type(4))) float;
using u32x4 = __attribute__((ext_vector_type(4))) unsigned;
#define MFMA(a, b, c) __builtin_amdgcn_mfma_f32_32x32x16_bf16((a), (b), (c), 0, 0, 0)

constexpr int R = 16512, RP = 16384, D = 1024, DC = 512, QKV = 3072, NIN = 4096, DFF = 4096;
constexpr float EPS = 1e-6f;
constexpr int LDF = 4160;
constexpr float QSCALE = 0.08838834764831845f;

constexpr size_t OFF_BAR   = 0;
constexpr size_t OFF_MOD   = 16384;
constexpr size_t OFF_GB    = OFF_MOD + 3342336;
constexpr size_t OFF_EGL   = OFF_GB + 1056768;
constexpr size_t OFF_SSQ   = OFF_EGL + 8192;
constexpr size_t OFF_WIN   = OFF_SSQ + 2113536;
constexpr size_t OFF_WZ    = OFF_WIN + 8650752;
constexpr size_t OFF_WGA   = OFF_WZ + 2097152;
constexpr size_t OFF_WGB   = OFF_WGA + 2097152;
constexpr size_t OFF_WCONF = OFF_WGB + 2097152;
constexpr size_t OFF_WGDN  = OFF_WCONF + 1048576;
constexpr size_t OFF_WO    = OFF_WGDN + 2097152;
constexpr size_t OFF_W1    = OFF_WO + 2097152;
constexpr size_t OFF_W2    = OFF_W1 + 8388608;
constexpr size_t OFF_GLU   = OFF_W2 + 8650752;
constexpr size_t OFF_AACT  = OFF_GLU + 16908288;
constexpr size_t OFF_QKV   = OFF_AACT + 16908288;
constexpr size_t OFF_HALO  = OFF_QKV + 101449728;
constexpr size_t OFF_EXTRA = OFF_HALO + 4718592;
constexpr size_t OFF_WADA  = OFF_EXTRA;
constexpr size_t OFF_AC    = OFF_EXTRA + 12582912;
constexpr size_t OFF_MERGED= OFF_EXTRA;
constexpr size_t OFF_H2    = OFF_GLU;
constexpr size_t OFF_F     = OFF_QKV;
constexpr size_t OFF_TMP2  = OFF_QKV;
constexpr size_t WS_NEED   = OFF_EXTRA + 50331648;
constexpr size_t OUT_Y = 0, OUT_CONFP = 16908288, OUT_QKVP = 17031168, OUT_DELTAP = 17104896,
                 OUT_CONFS = 18153472, OUT_QKVS = 20119552, OUT_DELTAS = 21299200;

constexpr int HALF_SMEM = 73728;
constexpr int SMEM_BYTES = 2 * HALF_SMEM + 1024;
constexpr int NT = 512;
#ifndef PHASE_MASK
#define PHASE_MASK 0xFFFF
#endif
#define PH(k) if constexpr ((PHASE_MASK >> (k)) & 1)

struct Params {
  const float *x_prompt, *x_sample, *c_prompt, *c_sample, *st_conf, *st_qkv, *st_delta;
  const float *w_ada, *b_ada, *norm1_w, *w_in, *conf_dw_w, *conf_dw_b, *conf_ln_w, *conf_ln_b, *w_conf_out,
              *gdn_conv_w, *a_log, *dt_bias, *gdn_norm_w, *w_gdn_out, *w_o, *norm2_w, *w_ff1, *w_ff2, *final_norm_w;
  float* out; char* ws;
};

DI unsigned pk2(float a, float b) { f2_t v = {a, b}; bf2_t r = __builtin_convertvector(v, bf2_t); return __builtin_bit_cast(unsigned, r); }
DI float bf_lo(unsigned u) { return __uint_as_float(u << 16); }
DI float bf_hi(unsigned u) { return __uint_as_float(u & 0xffff0000u); }
DI float bf1(u16 u) { return __uint_as_float(((unsigned)u) << 16); }
DI u16 f2bf(float a) { return (u16)(pk2(a, 0.f) & 0xffffu); }
DI float sigmoidf_(float x) { return __builtin_amdgcn_rcpf(1.f + __expf(-x)); }
DI float siluf_(float x) { return x * __builtin_amdgcn_rcpf(1.f + __expf(-x)); }
DI float softplusf_(float x) { return fmaxf(x, 0.f) + log1pf(__expf(-fabsf(x))); }
DI float wsum(float v) {
#pragma unroll
  for (int m = 32; m >= 1; m >>= 1) v += __shfl_xor(v, m, 64);
  return v;
}
DI int crow(int reg, int hh) { return (reg & 3) + 8 * (reg >> 2) + 4 * hh; }
DI int mrow_of(int r) { return r < RP ? (r >> 11) : (8 + r - RP); }
DI bf16x8 pack8(const f32x16& x, int s) {
  uint4 p;
  p.x = pk2(x[8 * s + 0], x[8 * s + 1]); p.y = pk2(x[8 * s + 2], x[8 * s + 3]);
  p.z = pk2(x[8 * s + 4], x[8 * s + 5]); p.w = pk2(x[8 * s + 6], x[8 * s + 7]);
  return __builtin_bit_cast(bf16x8, p);
}
DI f32x16 zero16() { f32x16 z; for (int i = 0; i < 16; ++i) z[i] = 0.f; return z; }

#define XB_TMO      128
#define XB_XCNT(j)  (256  + 64 * (j))
#define XB_XSUB(j)  (1280 + 64 * (j))
#define XB_XGEN(j)  (2304 + 64 * (j))
#define XB_TOP      3328
#define XB_TOPGEN   3392
#define XCD_BAR_WORDS 3456
#define XB_SPIN_CAP (1u << 24)
#define LAS __attribute__((address_space(3)))
DI unsigned xb_ld(unsigned* p) { return __hip_atomic_load(p, __ATOMIC_RELAXED, __HIP_MEMORY_SCOPE_AGENT); }
DI unsigned xb_add(unsigned* p, unsigned v) { return __hip_atomic_fetch_add(p, v, __ATOMIC_RELAXED, __HIP_MEMORY_SCOPE_AGENT); }
DI unsigned xb_xcc_id() { return (unsigned)__builtin_amdgcn_s_getreg((3 << 11) | 20) & 0xFu; }
#define XB_SPIN(cond, bar) do { unsigned _sp = 0; while (cond) { __builtin_amdgcn_s_sleep(1); \
    if ((++_sp & 255u) == 0u) { if (xb_ld(&(bar)[XB_TMO])) break; if (_sp > XB_SPIN_CAP) { atomicAdd(&(bar)[XB_TMO], 1u); break; } } } } while (0)
struct XcdBarrier { unsigned* bar; unsigned x; volatile LAS unsigned* st; };
DI XcdBarrier xcd_barrier_post(unsigned* bar, volatile LAS unsigned* st) {
  XcdBarrier b; b.bar = bar; b.x = xb_xcc_id(); b.st = st;
  if (threadIdx.x == 0) (void)xb_add(&bar[XB_XCNT(b.x)], 1u);
  return b;
}
DI void xcd_barrier_complete(unsigned* bar, unsigned x, unsigned& nloc, unsigned& nx) {
  const unsigned G = gridDim.x * gridDim.y * gridDim.z;
  unsigned sum, cnt, mine, sp = 0u;
  for (;;) {
    sum = 0u; cnt = 0u; mine = 0u;
#pragma unroll
    for (unsigned j = 0; j < 16; ++j) { const unsigned c = xb_ld(&bar[XB_XCNT(j)]); sum += c; cnt += (c > 0u) ? 1u : 0u; mine = (j == x) ? c : mine; }
    if (sum == G) break;
    __builtin_amdgcn_s_sleep(1);
    if ((++sp & 255u) == 0u) { if (xb_ld(&bar[XB_TMO])) break; if (sp > XB_SPIN_CAP) { atomicAdd(&bar[XB_TMO], 1u); break; } }
  }
  nloc = mine > 0u ? mine : 1u; nx = cnt > 0u ? cnt : 1u;
}
DI void xcd_barrier(const XcdBarrier& b) {
  asm volatile("s_waitcnt vmcnt(0)" ::: "memory");
  __syncthreads();
  if (threadIdx.x == 0) {
    unsigned* bar = b.bar;
    __builtin_amdgcn_s_waitcnt(0);
    unsigned nloc = b.st[0], nx = b.st[1];
    if (nloc == 0u) { xcd_barrier_complete(bar, b.x, nloc, nx); b.st[0] = nloc; b.st[1] = nx; }
    const unsigned old = xb_add(&bar[XB_XSUB(b.x)], 1u);
    const unsigned gen = old / nloc;
    if (old + 1u == (gen + 1u) * nloc) {
      __builtin_amdgcn_fence(__ATOMIC_RELEASE, "agent");
      asm volatile("s_waitcnt vmcnt(0)" ::: "memory");
      const unsigned og = xb_add(&bar[XB_TOP], 1u);
      const unsigned tg = og / nx;
      if (og + 1u == (tg + 1u) * nx) xb_add(&bar[XB_TOPGEN], 1u);
      else XB_SPIN(xb_ld(&bar[XB_TOPGEN]) == tg, bar);
      __builtin_amdgcn_fence(__ATOMIC_ACQUIRE, "agent");
      xb_add(&bar[XB_XGEN(b.x)], 1u);
      asm volatile("s_waitcnt vmcnt(0)" ::: "memory");
    } else {
      XB_SPIN(xb_ld(&bar[XB_XGEN(b.x)]) == gen, bar);
      __builtin_amdgcn_fence(__ATOMIC_ACQUIRE, "agent");
      asm volatile("s_waitcnt vmcnt(0)" ::: "memory");
    }
  }
  __syncthreads();
}

constexpr int HTB = 128 * 64 * 2;
DI int lds_byte(int r, int c) { const int st = (r >> 4) * 2 + (c >> 5), rr = r & 15, cc = c & 31, ob = rr * 64 + cc * 2; return st * 1024 + (ob ^ (((ob >> 9) & 1) << 5)); }
DI void stage_rc(int b, int& Rr, int& Cc) { const int st = b / 1024, sb = b % 1024, swz = sb ^ (((sb >> 9) & 1) << 5); Rr = (st >> 1) * 16 + swz / 64; Cc = (st & 1) * 32 + (swz % 64) / 2; }
DI void gemm256(f32x4 (&acc)[2][2][4][2], const u16* __restrict__ A, const int lda, const u16* __restrict__ Bt, const int ldb,
                const int brow, const int bcol, const int K, char* shm) {
#define SA(b, h) (shm + ((b) * 2 + (h)) * HTB)
#define SB(b, h) (shm + (4 + (b) * 2 + (h)) * HTB)
#define STAGE_A(P, br, kt) do { const char* _u = (const char*)A + ((size_t)(br) * lda + (size_t)(kt) * 64) * 2; \
    __builtin_amdgcn_global_load_lds((const unsigned*)(_u + voA0), (unsigned*)((char*)(P) + sb0), 16, 0, 0); \
    __builtin_amdgcn_global_load_lds((const unsigned*)(_u + voA1), (unsigned*)((char*)(P) + sb1), 16, 0, 0); } while (0)
#define STAGE_B(P, br, kt) do { const char* _u = (const char*)Bt + ((size_t)(br) * ldb + (size_t)(kt) * 64) * 2; \
    __builtin_amdgcn_global_load_lds((const unsigned*)(_u + voB0), (unsigned*)((char*)(P) + sb0), 16, 0, 0); \
    __builtin_amdgcn_global_load_lds((const unsigned*)(_u + voB1), (unsigned*)((char*)(P) + sb1), 16, 0, 0); } while (0)
#define LDA(dst, b, h) _Pragma("unroll") for (int m = 0; m < 4; ++m) _Pragma("unroll") for (int k = 0; k < 2; ++k) \
    dst[m][k] = *reinterpret_cast<const bf16x8*>((char*)SA(b, h) + lds_byte(wr * 64 + m * 16 + fr, k * 32 + fq * 8))
#define LDB(dst, b, h) _Pragma("unroll") for (int n = 0; n < 2; ++n) _Pragma("unroll") for (int k = 0; k < 2; ++k) \
    dst[n][k] = *reinterpret_cast<const bf16x8*>((char*)SB(b, h) + lds_byte(wc * 32 + n * 16 + fr, k * 32 + fq * 8))
#define MMA(ai, bj, At_, Bt_) do { __builtin_amdgcn_s_setprio(1); \
    _Pragma("unroll") for (int m = 0; m < 4; ++m) _Pragma("unroll") for (int n = 0; n < 2; ++n) _Pragma("unroll") for (int k = 0; k < 2; ++k) \
      acc[ai][bj][m][n] = __builtin_amdgcn_mfma_f32_16x16x32_bf16(Bt_[n][k], At_[m][k], acc[ai][bj][m][n], 0, 0, 0); \
    __builtin_amdgcn_s_setprio(0); } while (0)
#define WAIT_V(n) asm volatile("s_waitcnt vmcnt(" #n ")" ::: "memory")
#define WAIT_L(n) asm volatile("s_waitcnt lgkmcnt(" #n ")" ::: "memory")
#define BAR __builtin_amdgcn_s_barrier()
#define SCHED __builtin_amdgcn_sched_barrier(0)
  int t_ = threadIdx.x;
  asm volatile("" : "+v"(t_));
  const int wid = __builtin_amdgcn_readfirstlane(t_ >> 6), lane = t_ & 63, wr = wid >> 2, wc = wid & 3, fr = lane & 15, fq = lane >> 4;
  const int sb0 = t_ * 16, sb1 = sb0 + 8192;
  int sr0, sc0, sr1, sc1; stage_rc(sb0, sr0, sc0); stage_rc(sb1, sr1, sc1);
  const unsigned voA0 = (unsigned)(sr0 * lda + sc0) * 2u, voA1 = (unsigned)(sr1 * lda + sc1) * 2u;
  const unsigned voB0 = (unsigned)(sr0 * ldb + sc0) * 2u, voB1 = (unsigned)(sr1 * ldb + sc1) * 2u;
  bf16x8 At[4][2], B0[2][2], B1[2][2];
  const int nt = K / 64;
  STAGE_B(SB(0, 0), bcol, 0); STAGE_A(SA(0, 0), brow, 0);
  STAGE_B(SB(0, 1), bcol + 128, 0); STAGE_A(SA(0, 1), brow + 128, 0);
  if (wr == 1) BAR;
  WAIT_V(4); BAR;
  STAGE_B(SB(1, 0), bcol, 1); STAGE_A(SA(1, 0), brow, 1); STAGE_B(SB(1, 1), bcol + 128, 1);
  WAIT_V(6); BAR;
  for (int t = 0; t < nt - 2; t += 2) {
    LDB(B0, 0, 0); SCHED; LDA(At, 0, 0); STAGE_A(SA(1, 1), brow + 128, t + 1);
    WAIT_L(8); BAR; WAIT_L(0); MMA(0, 0, At, B0); BAR; SCHED;
    LDB(B1, 0, 1); STAGE_B(SB(0, 0), bcol, t + 2);
    BAR; WAIT_L(0); MMA(0, 1, At, B1); BAR;
    LDA(At, 0, 1); STAGE_A(SA(0, 0), brow, t + 2);
    BAR; WAIT_L(0); MMA(1, 0, At, B0); BAR; SCHED;
    STAGE_B(SB(0, 1), bcol + 128, t + 2);
    WAIT_V(6); BAR; MMA(1, 1, At, B1); BAR;
    LDB(B0, 1, 0); SCHED; LDA(At, 1, 0); STAGE_A(SA(0, 1), brow + 128, t + 2);
    WAIT_L(8); BAR; WAIT_L(0); MMA(0, 0, At, B0); BAR; SCHED;
    LDB(B1, 1, 1); STAGE_B(SB(1, 0), bcol, t + 3);
    BAR; WAIT_L(0); MMA(0, 1, At, B1); BAR;
    LDA(At, 1, 1); STAGE_A(SA(1, 0), brow, t + 3);
    BAR; WAIT_L(0); MMA(1, 0, At, B0); BAR; SCHED;
    STAGE_B(SB(1, 1), bcol + 128, t + 3);
    WAIT_V(6); BAR; MMA(1, 1, At, B1); BAR;
  }
  { LDB(B0, 0, 0); LDA(At, 0, 0); STAGE_A(SA(1, 1), brow + 128, nt - 1);
    BAR; WAIT_L(0); MMA(0, 0, At, B0); BAR;
    LDB(B1, 0, 1); BAR; WAIT_L(0); MMA(0, 1, At, B1); BAR;
    LDA(At, 0, 1); WAIT_V(4); BAR; WAIT_L(0); MMA(1, 0, At, B0); MMA(1, 1, At, B1); BAR; }
  { LDB(B0, 1, 0); LDA(At, 1, 0); WAIT_V(2); BAR; WAIT_L(0); MMA(0, 0, At, B0); BAR;
    LDB(B1, 1, 1); WAIT_V(0); BAR; WAIT_L(0); MMA(0, 1, At, B1); BAR;
    LDA(At, 1, 1); BAR; WAIT_L(0); MMA(1, 0, At, B0); MMA(1, 1, At, B1); BAR; }
  if (wr == 0) BAR;
#undef SA
#undef SB
#undef STAGE_A
#undef STAGE_B
#undef LDA
#undef LDB
#undef MMA
}
DI void zero_acc(f32x4 (&acc)[2][2][4][2]) {
#pragma unroll
  for (int a = 0; a < 2; ++a)
#pragma unroll
    for (int b = 0; b < 2; ++b)
#pragma unroll
      for (int m = 0; m < 4; ++m)
#pragma unroll
        for (int n = 0; n < 2; ++n) acc[a][b][m][n] = (f32x4){0.f, 0.f, 0.f, 0.f};
}
template <class F> DI void tile_apply(const f32x4 (&acc)[2][2][4][2], int brow, int bcol, F f) {
  int t_ = threadIdx.x;
  asm volatile("" : "+v"(t_));
  const int wid = t_ >> 6, lane = t_ & 63, wr = wid >> 2, wc = wid & 3, fr = lane & 15, fq = lane >> 4;
#pragma unroll
  for (int ai = 0; ai < 2; ++ai)
#pragma unroll
    for (int m = 0; m < 4; ++m) {
      const int row = brow + ai * 128 + wr * 64 + m * 16 + fr;
#pragma unroll
      for (int bj = 0; bj < 2; ++bj)
#pragma unroll
        for (int n = 0; n < 2; ++n) f(row, bcol + bj * 128 + wc * 32 + n * 16 + 4 * fq, acc[ai][bj][m][n]);
      __builtin_amdgcn_sched_barrier(0);
    }
}
constexpr int TLD = 132;
template <class F> DI void tile_epilogue(const f32x4 (&acc)[2][2][4][2], int brow, int bcol, char* shm, F f) {
  int t_ = threadIdx.x;
  asm volatile("" : "+v"(t_));
  const int wid = t_ >> 6, lane = t_ & 63, wr = wid >> 2, wc = wid & 3, fr = lane & 15, fq = lane >> 4;
  float* T = (float*)shm;
#pragma unroll
  for (int bj = 0; bj < 2; ++bj) {
#pragma unroll
    for (int ai = 0; ai < 2; ++ai)
#pragma unroll
      for (int m = 0; m < 4; ++m)
#pragma unroll
        for (int n = 0; n < 2; ++n)
          *(f32x4*)(T + (ai * 128 + wr * 64 + m * 16 + fr) * TLD + wc * 32 + n * 16 + 4 * fq) = acc[ai][bj][m][n];
    __syncthreads();
    const int cg = (t_ & 31) * 4, r0 = t_ >> 5;
#pragma unroll 4
    for (int i = 0; i < 16; ++i) {
      const int rl = r0 + 16 * i;
      const f32x4 v = *(const f32x4*)(T + rl * TLD + cg);
      f(brow + rl, bcol + bj * 128 + cg, v);
    }
    __syncthreads();
  }
}
template <class F> DI void gemm_pass(const u16* A, int lda, const u16* Bt, int ldb, int N, int K, char* shm, F f) {
  const int nN = N >> 8, nunits = 64 * nN;
  for (int u = blockIdx.x; u < nunits; u += gridDim.x) {
    const int pm = u % 64, pn = u / 64;
    f32x4 acc[2][2][4][2];
    zero_acc(acc);
    gemm256(acc, A, lda, Bt, ldb, pm * 256, pn * 256, K, shm);
    tile_epilogue(acc, pm * 256, pn * 256, shm, f);
  }
}
template <int NTL, class CM, class E> DI void skinny(const u16* __restrict__ A, int lda, int row0, int nrows, const u16* __restrict__ Bt, int ldb, int K, CM cm, E epi) {
  int t_ = threadIdx.x;
  asm volatile("" : "+v"(t_));
  const int wid = t_ >> 6, lane = t_ & 63, fr = lane & 15, fq = lane >> 4;
  for (int mt = wid; mt * 16 < nrows; mt += 8) {
    int rr = mt * 16 + fr; const bool valid = rr < nrows; if (!valid) rr = nrows - 1;
    const u16* ap = A + (size_t)(row0 + rr) * lda + 8 * fq;
#pragma unroll
    for (int ntl = 0; ntl < NTL; ++ntl) {
      const u16* bp = Bt + (size_t)cm(ntl * 16 + fr) * ldb + 8 * fq;
      f32x4 acc = {0.f, 0.f, 0.f, 0.f};
#pragma unroll 16
      for (int ks = 0; ks < (K >> 5); ++ks) {
        const bf16x8 a = *(const bf16x8*)(ap + ks * 32);
        const bf16x8 b = *(const bf16x8*)(bp + ks * 32);
        acc = __builtin_amdgcn_mfma_f32_16x16x32_bf16(b, a, acc, 0, 0, 0);
      }
      if (valid) epi(row0 + rr, ntl, fq, acc, lane);
    }
  }
}
DI int map_in(int n) {
  if (n < 1024) { const int pn = n >> 8, c = n & 255; return c < 128 ? (pn * 128 + c) : (512 + pn * 128 + c - 128); }
  return n;
}
DI void phase_convert(const Params& p, char* smem) {
  float* tile = (float*)smem;
  const int tid = threadIdx.x;
  constexpr int NJ = 10;
  constexpr int pre[NJ + 1] = {0, 1024, 1280, 1536, 1792, 1920, 2176, 2432, 3456, 4480, 6016};
  for (int t = blockIdx.x; t < 6016; t += gridDim.x) {
    int j = 0, base = 0;
#pragma unroll
    for (int q = 1; q < NJ; ++q) if (t >= pre[q]) { j = q; base = pre[q]; }
    const int lt = t - base;
    const float* src; int ld, K; u16* dst; int moff = 0; int ldd = 0;
    switch (j) {
      case 0: src = p.w_in; ld = 7184; K = 1024; dst = (u16*)(p.ws + OFF_WIN); break;
      case 1: src = p.w_in; ld = 7184; K = 1024; dst = (u16*)(p.ws + OFF_WZ); moff = 4096; break;
      case 2: src = p.w_in; ld = 7184; K = 1024; dst = (u16*)(p.ws + OFF_WGA); moff = 5136; break;
      case 3: src = p.w_in; ld = 7184; K = 1024; dst = (u16*)(p.ws + OFF_WGB); moff = 6160; break;
      case 4: src = p.w_conf_out; ld = 1024; K = 512; dst = (u16*)(p.ws + OFF_WCONF); break;
      case 5: src = p.w_gdn_out; ld = 1024; K = 1024; dst = (u16*)(p.ws + OFF_WGDN); break;
      case 6: src = p.w_o; ld = 1024; K = 1024; dst = (u16*)(p.ws + OFF_WO); break;
      case 7: src = p.w_ff1; ld = 4096; K = 1024; dst = (u16*)(p.ws + OFF_W1); break;
      case 8: src = p.w_ff2; ld = 1024; K = 4096; dst = (u16*)(p.ws + OFF_W2); ldd = LDF; break;
      default: src = p.w_ada; ld = 6144; K = 1024; dst = (u16*)(p.ws + OFF_WADA); break;
    }
    const int nkt = K >> 6;
    const int n0 = (lt / nkt) * 64, k0 = (lt % nkt) * 64;
    {
      const int nn = tid & 63, ty = tid >> 6;
      const int sc = (j == 0) ? map_in(n0 + nn) : (n0 + nn + moff);
#pragma unroll
      for (int i = 0; i < 8; ++i) {
        const int kk = ty + 8 * i;
        tile[kk * 65 + nn] = __builtin_nontemporal_load(src + (size_t)(k0 + kk) * ld + sc);
      }
    }
    __syncthreads();
    {
      const int nn = tid >> 3, kq = (tid & 7) * 8;
      uint4 o0;
      const float* tp = tile + kq * 65 + nn;
      o0.x = pk2(tp[0 * 65], tp[1 * 65]);  o0.y = pk2(tp[2 * 65], tp[3 * 65]);
      o0.z = pk2(tp[4 * 65], tp[5 * 65]);  o0.w = pk2(tp[6 * 65], tp[7 * 65]);
      *(uint4*)(dst + (size_t)(n0 + nn) * (ldd ? ldd : K) + k0 + kq) = o0;
    }
    __syncthreads();
  }
  u16* Ac = (u16*)(p.ws + OFF_AC);
  for (int e = blockIdx.x * NT + tid; e < 256 * 256; e += gridDim.x * NT) {
    const int row = e >> 8, c4 = (e & 255) * 4;
    float4 v = make_float4(0.f, 0.f, 0.f, 0.f);
    if (row < 8) v = *(const float4*)(p.c_prompt + row * 1024 + c4);
    else if (row < 136) v = *(const float4*)(p.c_sample + (row - 8) * 1024 + c4);
    uint2 o; o.x = pk2(siluf_(v.x), siluf_(v.y)); o.y = pk2(siluf_(v.z), siluf_(v.w));
    *(uint2*)(Ac + row * 1024 + c4) = o;
  }
}

constexpr int WBA_LD = 1028;
template <bool BA> DI void phase_modnorm(const Params& p, const float* xa, const float* xb, const float* nw, int shift_off, int scale_off, u16* dst, char* smem) {
  int tmn = threadIdx.x;
  asm volatile("" : "+v"(tmn));
  const int lane = tmn & 63;
  const int gw = blockIdx.x * 8 + (tmn >> 6), nw_ = gridDim.x * 8;
  const float* mod = (const float*)(p.ws + OFF_MOD);
  float* wba = (float*)smem;
  if (BA) {
    for (int e = threadIdx.x; e < 16384; e += NT) { const int c = e >> 4, j = e & 15; wba[j * WBA_LD + c] = p.w_in[(size_t)c * 7184 + 5120 + j]; }
    __syncthreads();
  }
  float* gb = (float*)(p.ws + OFF_GB);
  for (int row = gw; row < R; row += nw_) {
    const float* xr = row < RP ? xa + (size_t)row * 1024 : xb + (size_t)(row - RP) * 1024;
    float4 v[4]; float ss = 0.f;
#pragma unroll
    for (int i = 0; i < 4; ++i) {
      { const f32x4 t4 = __builtin_nontemporal_load((const f32x4*)(xr + (lane + 64 * i) * 4)); v[i] = make_float4(t4[0], t4[1], t4[2], t4[3]); }
      ss += v[i].x * v[i].x + v[i].y * v[i].y + v[i].z * v[i].z + v[i].w * v[i].w; }
    ss = wsum(ss);
    const float rstd = rsqrtf(ss * (1.f / 1024.f) + EPS);
    const float* mr = mod + (size_t)mrow_of(row) * 6144;
    float ba[16];
    if (BA) {
#pragma unroll
      for (int j = 0; j < 16; ++j) ba[j] = 0.f;
    }
#pragma unroll
    for (int i = 0; i < 4; ++i) {
      const int c = (lane + 64 * i) * 4;
      const float4 w = *(const float4*)(nw + c), sc = *(const float4*)(mr + scale_off + c), sh = *(const float4*)(mr + shift_off + c);
      const float h0 = v[i].x * rstd * w.x * (1.f + sc.x) + sh.x, h1 = v[i].y * rstd * w.y * (1.f + sc.y) + sh.y;
      const float h2 = v[i].z * rstd * w.z * (1.f + sc.z) + sh.z, h3 = v[i].w * rstd * w.w * (1.f + sc.w) + sh.w;
      uint2 o; o.x = pk2(h0, h1); o.y = pk2(h2, h3);
      *(uint2*)(dst + (size_t)row * 1024 + c) = o;
      if (BA) {
#pragma unroll
        for (int j = 0; j < 16; ++j) { const float4 ww = *(const float4*)(wba + j * WBA_LD + c); ba[j] += h0 * ww.x + h1 * ww.y + h2 * ww.z + h3 * ww.w; }
        __builtin_amdgcn_sched_barrier(0);
      }
    }
    if (BA) {
#pragma unroll
      for (int w = 8; w >= 1; w >>= 1) {
        const bool up = (lane & w) != 0;
#pragma unroll
        for (int j = 0; j < w; ++j) {
          const float keep = up ? ba[j + w] : ba[j];
          const float send = up ? ba[j] : ba[j + w];
          ba[j] = keep + __shfl_xor(send, w, 64);
        }
      }
      float tot = ba[0];
      tot += __shfl_xor(tot, 16, 64); tot += __shfl_xor(tot, 32, 64);
      if (lane < 8) gb[(size_t)row * 16 + lane] = sigmoidf_(tot);
      else if (lane < 16) gb[(size_t)row * 16 + lane] = -__expf(p.a_log[lane - 8]) * softplusf_(tot + p.dt_bias[lane - 8]);
    }
  }
  if (BA) __syncthreads();
}

constexpr int LKN = 136, LKT = 72;
DI void d1_item(const Params& p, int item, char* smem) {
  int tid = threadIdx.x & 255;
  asm volatile("" : "+v"(tid));
  const int lane = tid & 63, wave = __builtin_amdgcn_readfirstlane(tid >> 6);
  const int r = lane & 31, hh = lane >> 5;
  const int h = item & 7, n = (item >> 3) & 31, b = item >> 8;
  const int rowbase = b * 2048 + n * 64;
  u16* kn  = (u16*)smem;
  u16* qn  = (u16*)(smem + 17408);
  u16* knT = (u16*)(smem + 34816);
  u16* vT  = (u16*)(smem + 53248);
  float* Gs = (float*)(smem + 71680);
  float* Bs = Gs + 64;
  float* Amat = (float*)(smem + 17408);
  u16* Tb = (u16*)smem;
  u16* Tg = (u16*)(smem + 17408);
  u16* qkv = (u16*)(p.ws + OFF_QKV);
  const u16* halo = (const u16*)(p.ws + OFF_HALO);
  const float* gb = (const float*)(p.ws + OFF_GB);

  if (wave == 0) {
    float g = gb[(size_t)(rowbase + lane) * 16 + 8 + h];
    const float be = gb[(size_t)(rowbase + lane) * 16 + h];
#pragma unroll
    for (int m = 1; m < 64; m <<= 1) { float t = __shfl_up(g, m, 64); if (lane >= m) g += t; }
    Gs[lane] = g; Bs[lane] = be;
  }
  {
    const int cp = lane;
#pragma unroll
    for (int X = 0; X < 3; ++X) {
      const int cb = X * 1024 + h * 128 + 2 * cp;
      float w[4][2];
#pragma unroll
      for (int j = 0; j < 4; ++j) { float2 t = *(const float2*)(p.gdn_conv_w + j * 3072 + cb); w[j][0] = t.x; w[j][1] = t.y; }
      float xw[3][2];
#pragma unroll
      for (int j = 0; j < 3; ++j) {
        const int rr = wave * 16 - 3 + j;
        unsigned u = 0u;
        if (rr >= 0) u = *(const unsigned*)(qkv + (size_t)(rowbase + rr) * 3072 + cb);
        else if (n > 0) u = *(const unsigned*)(halo + ((size_t)((b * 32 + n - 1) * 3 + (rr + 3))) * 3072 + cb);
        xw[j][0] = bf_lo(u); xw[j][1] = bf_hi(u);
      }
      float o[16][2];
#pragma unroll
      for (int t = 0; t < 16; ++t) {
        const unsigned u = *(const unsigned*)(qkv + (size_t)(rowbase + wave * 16 + t) * 3072 + cb);
        const float x0 = bf_lo(u), x1 = bf_hi(u);
        const float a0 = w[0][0] * xw[0][0] + w[1][0] * xw[1][0] + w[2][0] * xw[2][0] + w[3][0] * x0;
        const float a1 = w[0][1] * xw[0][1] + w[1][1] * xw[1][1] + w[2][1] * xw[2][1] + w[3][1] * x1;
        o[t][0] = siluf_(a0); o[t][1] = siluf_(a1);
        xw[0][0] = xw[1][0]; xw[0][1] = xw[1][1]; xw[1][0] = xw[2][0]; xw[1][1] = xw[2][1]; xw[2][0] = x0; xw[2][1] = x1;
      }
      if (X < 2) {
#pragma unroll
        for (int t = 0; t < 16; ++t) {
          const float ss = wsum(o[t][0] * o[t][0] + o[t][1] * o[t][1]);
          const float rs = rsqrtf(ss + EPS);
          o[t][0] *= rs; o[t][1] *= rs;
        }
      }
#pragma unroll
      for (int t = 0; t < 16; ++t) {
        const int row = wave * 16 + t;
        const unsigned pk = pk2(o[t][0], o[t][1]);
        if (X == 0) { *(unsigned*)(qn + row * LKN + 2 * cp) = pk; }
        else if (X == 1) {
          *(unsigned*)(kn + row * LKN + 2 * cp) = pk;
          knT[(2 * cp) * LKT + row] = (u16)(pk & 0xffffu); knT[(2 * cp + 1) * LKT + row] = (u16)(pk >> 16);
        } else {
          vT[(2 * cp) * LKT + row] = (u16)(pk & 0xffffu); vT[(2 * cp + 1) * LKT + row] = (u16)(pk >> 16);
        }
      }
    }
  }
  __syncthreads();
  const float Glast = Gs[63];
#pragma unroll
  for (int ff = 0; ff < 4; ++ff) {
    const int f = wave * 4 + ff;
    const int it = f >> 3, kb = (f >> 1) & 3, s = f & 1;
    const int i = it * 32 + r;
    const float sc = QSCALE * __expf(Gs[i]);
    const uint2 a = *(const uint2*)(qn + i * LKN + kb * 32 + 16 * s + 4 * hh);
    const uint2 c = *(const uint2*)(qn + i * LKN + kb * 32 + 16 * s + 4 * hh + 8);
    uint4 o;
    o.x = pk2(bf_lo(a.x) * sc, bf_hi(a.x) * sc); o.y = pk2(bf_lo(a.y) * sc, bf_hi(a.y) * sc);
    o.z = pk2(bf_lo(c.x) * sc, bf_hi(c.x) * sc); o.w = pk2(bf_lo(c.y) * sc, bf_hi(c.y) * sc);
    *(uint4*)((char*)qkv + (size_t)(rowbase + 4 * f + (lane >> 4)) * 6144 + h * 256 + (lane & 15) * 16) = o;
  }
  char* ext = p.ws + OFF_EXTRA + (size_t)item * 24576;
#pragma unroll
  for (int ff = 0; ff < 4; ++ff) {
    const int f = wave * 4 + ff;
    const int kt = f >> 2, pb = (f >> 1) & 1, s = f & 1;
    const int k = kt * 32 + r;
    const int p0 = pb * 32 + 16 * s + 4 * hh;
    const uint2 a = *(const uint2*)(knT + k * LKT + p0);
    const uint2 c = *(const uint2*)(knT + k * LKT + p0 + 8);
    const float4 g0 = *(const float4*)(Gs + p0), g1 = *(const float4*)(Gs + p0 + 8);
    uint4 o;
    o.x = pk2(bf_lo(a.x) * __expf(Glast - g0.x), bf_hi(a.x) * __expf(Glast - g0.y));
    o.y = pk2(bf_lo(a.y) * __expf(Glast - g0.z), bf_hi(a.y) * __expf(Glast - g0.w));
    o.z = pk2(bf_lo(c.x) * __expf(Glast - g1.x), bf_hi(c.x) * __expf(Glast - g1.y));
    o.w = pk2(bf_lo(c.y) * __expf(Glast - g1.z), bf_hi(c.y) * __expf(Glast - g1.w));
    *(uint4*)(ext + f * 1024 + lane * 16) = o;
  }
  f32x16 akk = zero16(), aqk = zero16();
  const int ta = (wave == 0) ? 0 : 1, tb = (wave == 2) ? 1 : 0;
  if (wave < 3) {
#pragma unroll
    for (int ks = 0; ks < 8; ++ks) {
      const bf16x8 fa = *(const bf16x8*)(kn + (ta * 32 + r) * LKN + ks * 16 + 8 * hh);
      const bf16x8 fb = *(const bf16x8*)(kn + (tb * 32 + r) * LKN + ks * 16 + 8 * hh);
      const bf16x8 fq = *(const bf16x8*)(qn + (ta * 32 + r) * LKN + ks * 16 + 8 * hh);
      akk = MFMA(fa, fb, akk);
      aqk = MFMA(fb, fq, aqk);
    }
  }
  __syncthreads();
  if (wave < 3) {
    const int m = tb * 32 + r; const float Gm = Gs[m];
#pragma unroll
    for (int reg = 0; reg < 16; ++reg) {
      const int i = ta * 32 + crow(reg, hh);
      const float v = (m < i) ? Bs[i] * akk[reg] * __expf(Gs[i] - Gm) : 0.f;
      Amat[i * 64 + m] = v;
    }
    const int i = ta * 32 + r; const float Gi = Gs[i];
    f32x16 av;
#pragma unroll
    for (int reg = 0; reg < 16; ++reg) {
      const int j = tb * 32 + crow(reg, hh);
      av[reg] = (j <= i) ? aqk[reg] * QSCALE * __expf(Gi - Gs[j]) : 0.f;
    }
    const int fbase = 16 + (wave * 2);
#pragma unroll
    for (int s = 0; s < 2; ++s) {
      bf16x8 fr8 = pack8(av, s);
      *(bf16x8*)(ext + (fbase + s) * 1024 + lane * 16) = fr8;
    }
  } else {
    for (int e = lane; e < 32 * 32; e += 64) Amat[(e >> 5) * 64 + 32 + (e & 31)] = 0.f;
    if (lane == 0) *(float*)(ext + 22 * 1024) = __expf(Glast);
  }
  __syncthreads();
  float* Tq = (float*)(smem + 9216);
  if (wave == 0) {
    float x[32];
    const int c = lane & 31, hb = lane >> 5;
    const float* Ab = Amat + (hb * 32) * 64 + hb * 32;
#pragma unroll
    for (int i = 0; i < 32; ++i) {
      float s0 = (c == i) ? 1.f : 0.f, s1 = 0.f;
#pragma unroll
      for (int m4 = 0; m4 < (i + 3) / 4; ++m4) {
        const float4 a4 = *(const float4*)(Ab + i * 64 + m4 * 4);
        if (m4 * 4 + 0 < i) s0 -= a4.x * x[m4 * 4 + 0];
        if (m4 * 4 + 1 < i) s1 -= a4.y * x[m4 * 4 + 1];
        if (m4 * 4 + 2 < i) s0 -= a4.z * x[m4 * 4 + 2];
        if (m4 * 4 + 3 < i) s1 -= a4.w * x[m4 * 4 + 3];
      }
      x[i] = s0 + s1;
      __builtin_amdgcn_sched_barrier(0);
    }
#pragma unroll
    for (int i = 0; i < 32; ++i) Tq[hb * 1024 + i * 32 + c] = x[i];
  }
  __syncthreads();
  const int c32 = tid & 31, g8 = tid >> 5;
  {
    float bm[4] = {0.f, 0.f, 0.f, 0.f};
#pragma unroll
    for (int j4 = 0; j4 < 8; ++j4) {
      float t[4];
#pragma unroll
      for (int e = 0; e < 4; ++e) t[e] = Tq[(j4 * 4 + e) * 32 + c32];
#pragma unroll
      for (int e = 0; e < 4; ++e) {
        const float4 a4 = *(const float4*)(Amat + (32 + g8 * 4 + e) * 64 + j4 * 4);
        bm[e] += a4.x * t[0] + a4.y * t[1] + a4.z * t[2] + a4.w * t[3];
      }
    }
#pragma unroll
    for (int e = 0; e < 4; ++e) Amat[(g8 * 4 + e) * 64 + 32 + c32] = bm[e];
  }
  __syncthreads();
  float t21[4] = {0.f, 0.f, 0.f, 0.f};
  {
#pragma unroll
    for (int m4 = 0; m4 < 8; ++m4) {
      float bv[4];
#pragma unroll
      for (int e = 0; e < 4; ++e) bv[e] = Amat[(m4 * 4 + e) * 64 + 32 + c32];
#pragma unroll
      for (int e = 0; e < 4; ++e) {
        const float4 a4 = *(const float4*)(Tq + 1024 + (g8 * 4 + e) * 32 + m4 * 4);
        t21[e] -= a4.x * bv[0] + a4.y * bv[1] + a4.z * bv[2] + a4.w * bv[3];
      }
    }
  }
  float t11[4], t22[4];
#pragma unroll
  for (int e = 0; e < 4; ++e) { t11[e] = Tq[(g8 * 4 + e) * 32 + c32]; t22[e] = Tq[1024 + (g8 * 4 + e) * 32 + c32]; }
  const float bcl = Bs[c32], bgl = bcl * __expf(Gs[c32]);
  const float bch = Bs[32 + c32], bgh = bch * __expf(Gs[32 + c32]);
  __syncthreads();
#pragma unroll
  for (int e = 0; e < 4; ++e) {
    const int i = g8 * 4 + e;
    Tb[i * LKT + c32] = f2bf(t11[e] * bcl);               Tg[i * LKT + c32] = f2bf(t11[e] * bgl);
    Tb[i * LKT + 32 + c32] = (u16)0;                      Tg[i * LKT + 32 + c32] = (u16)0;
    Tb[(32 + i) * LKT + c32] = f2bf(t21[e] * bcl);        Tg[(32 + i) * LKT + c32] = f2bf(t21[e] * bgl);
    Tb[(32 + i) * LKT + 32 + c32] = f2bf(t22[e] * bch);   Tg[(32 + i) * LKT + 32 + c32] = f2bf(t22[e] * bgh);
  }
  __syncthreads();
#pragma unroll
  for (int it = 0; it < 2; ++it) {
    f32x16 av = zero16(), ak = zero16();
#pragma unroll
    for (int ks = 0; ks < 4; ++ks) {
      const bf16x8 fT = *(const bf16x8*)(Tb + (it * 32 + r) * LKT + ks * 16 + 8 * hh);
      const bf16x8 fV = *(const bf16x8*)(vT + (wave * 32 + r) * LKT + ks * 16 + 8 * hh);
      const bf16x8 fK = *(const bf16x8*)(knT + (wave * 32 + r) * LKT + ks * 16 + 8 * hh);
      const bf16x8 fG = *(const bf16x8*)(Tg + (it * 32 + r) * LKT + ks * 16 + 8 * hh);
      av = MFMA(fT, fV, av);
      ak = MFMA(fK, fG, ak);
    }
    {
      const int fv = wave * 2 + it;
      char* d = (char*)qkv + (size_t)(rowbase + 8 * fv + (lane >> 3)) * 6144 + 4096 + h * 256 + (lane & 7) * 32;
      *(bf16x8*)d = pack8(av, 0); *(bf16x8*)(d + 16) = pack8(av, 1);
    }
#pragma unroll
    for (int s = 0; s < 2; ++s) {
      const int f = it * 8 + wave * 2 + s;
      *(bf16x8*)((char*)qkv + (size_t)(rowbase + 4 * f + (lane >> 4)) * 6144 + 2048 + h * 256 + (lane & 15) * 16) = pack8(ak, s);
    }
  }
  __syncthreads();
}

DI void d2_issue(u32x4 (&rg)[18], const Params& p, int b, int h, int lt, int n) {
  const char* qseg = p.ws + OFF_QKV + (size_t)(b * 2048 + n * 64) * 6144 + h * 256;
  const char* ext = p.ws + OFF_EXTRA + (size_t)((b * 32 + n) * 8 + h) * 24576;
#pragma unroll
  for (int sg = 0; sg < 3; ++sg)
#pragma unroll
    for (int i = 0; i < 4; ++i) rg[sg * 4 + i] = __builtin_nontemporal_load((const u32x4*)(qseg + (size_t)((lt >> 4) + 16 * i) * 6144 + sg * 2048 + (lt & 15) * 16));
#pragma unroll
  for (int i = 0; i < 6; ++i) rg[12 + i] = __builtin_nontemporal_load((const u32x4*)(ext + lt * 16 + i * 4096));
}
DI void d2_put(const u32x4 (&rg)[18], char* buf, int lt) {
#pragma unroll
  for (int sg = 0; sg < 3; ++sg)
#pragma unroll
    for (int i = 0; i < 4; ++i) *(u32x4*)(buf + sg * 16384 + ((lt >> 4) + 16 * i) * 256 + (lt & 15) * 16) = rg[sg * 4 + i];
#pragma unroll
  for (int i = 0; i < 6; ++i) *(u32x4*)(buf + 49152 + lt * 16 + i * 4096) = rg[12 + i];
}
DI void d2_block(const Params& p, int unit, char* smem) {
  const int tid = threadIdx.x, half = tid >> 8, lt = tid & 255, lane = tid & 63, wave = (tid >> 6) & 3;
  const int r = lane & 31, hh = lane >> 5;
  const int b = unit >> 3, h = unit & 7;
  const char* qkv = p.ws + OFF_QKV;
  const float* egl = (const float*)(p.ws + OFF_EGL);
  u16* obuf = (u16*)((char*)p.out + (size_t)R * 1024 * 2);
  if (half == 1) {
    u32x4 rg0[18], rg1[18];
    u32x4 og[4], sg4;
    u16* obuf_ = (u16*)((char*)p.out + (size_t)R * 1024 * 2);
    float* ssq_ = (float*)(p.ws + OFF_SSQ);
    const int orow = lt >> 2, opos = lt & 3, ocol = 8 * (opos ^ ((orow >> 1) & 3));
    d2_issue(rg0, p, b, h, lt, 0); d2_put(rg0, smem, lt); d2_issue(rg1, p, b, h, lt, 1); d2_issue(rg0, p, b, h, lt, 2);
    __syncthreads();
#define D2_LOADER_STEP(n_, RG)                                                                                              \
    {                                                                                                                        \
      const int n = (n_);                                                                                                    \
      char* ob = smem + ((n + 1) & 1) * HALF_SMEM;                                                                           \
      if (n >= 1) {                                                                                                          \
        _Pragma("unroll") for (int i = 0; i < 4; ++i) og[i] = *(const u32x4*)(ob + 32768 + (lt + 256 * i) * 16);            \
        if (lt >= 192) sg4 = *(const u32x4*)(ob + 49152 + 20480 + lt * 16);                                                  \
      }                                                                                                                      \
      if (n + 1 < 32) { d2_put(RG, ob, lt); if (n + 3 < 32) d2_issue(RG, p, b, h, lt, n + 3); }                              \
      if (n >= 1) {                                                                                                          \
        const int rowbase = b * 2048 + (n - 1) * 64;                                                                         \
        _Pragma("unroll") for (int i = 0; i < 4; ++i)                                                                        \
          *(u32x4*)(obuf_ + (size_t)(rowbase + orow) * 1024 + h * 128 + 32 * i + ocol) = og[i];                              \
        if (lt >= 192) *(u32x4*)(ssq_ + ((size_t)(rowbase + lt - 192) * 8 + h) * 4) = sg4;                                   \
      }                                                                                                                      \
      if (n < 32) { asm volatile("s_waitcnt lgkmcnt(0)" ::: "memory"); __builtin_amdgcn_s_barrier(); asm volatile("" ::: "memory"); } \
    }
#pragma unroll 1
    for (int n2 = 0; n2 <= 32; n2 += 2) {
      D2_LOADER_STEP(n2, rg1)
      if (n2 + 1 <= 32) D2_LOADER_STEP(n2 + 1, rg0)
    }
#undef D2_LOADER_STEP
    return;
  }
  f32x16 S[4];
#pragma unroll
  for (int k = 0; k < 4; ++k) S[k] = zero16();
  const unsigned voff_l = (unsigned)(lane * 16);
  bf16x8 If0, If1;
#pragma unroll
  for (int j = 0; j < 8; ++j) {
    const int k0 = 8 * (j >> 2) + 4 * hh + (j & 3);
    If0[j] = (short)((k0 == r) ? 0x3F80 : 0); If1[j] = (short)((16 + k0 == r) ? 0x3F80 : 0);
  }
  const unsigned voff_v = (unsigned)((16 * wave + (lane >> 3)) * 256 + (lane & 7) * 32);
  __syncthreads();
#pragma unroll 1
  for (int n = 0; n < 32; ++n) {
    const int item = (b * 32 + n) * 8 + h;
    const int rowbase = b * 2048 + n * 64;
    const char* buf = smem + (n & 1) * HALF_SMEM;
    const char* ext = buf + 49152;
    const float eg = *(const float*)(ext + 22 * 1024);
    bf16x8 fk[16];
#pragma unroll
    for (int f = 0; f < 16; ++f) fk[f] = *(const bf16x8*)(buf + 16384 + f * 1024 + voff_l);
    uint4 vv[2][2];
#pragma unroll
    for (int it = 0; it < 2; ++it) { const char* d = buf + 32768 + it * 2048 + voff_v; vv[it][0] = *(const uint4*)d; vv[it][1] = *(const uint4*)(d + 16); }
    bf16x8 Sf[4][2];
#pragma unroll
    for (int kb = 0; kb < 4; ++kb) { Sf[kb][0] = pack8(S[kb], 0); Sf[kb][1] = pack8(S[kb], 1); }
    __builtin_amdgcn_sched_barrier(0);
    f32x16 P1[2];
    P1[0] = zero16(); P1[1] = zero16();
#pragma unroll
    for (int kb = 0; kb < 4; ++kb)
#pragma unroll
      for (int s = 0; s < 2; ++s) {
        P1[0] = MFMA(fk[kb * 2 + s], Sf[kb][s], P1[0]);
        P1[1] = MFMA(fk[8 + kb * 2 + s], Sf[kb][s], P1[1]);
      }
    bf16x8 fq[8];
#pragma unroll
    for (int f = 0; f < 8; ++f) fq[f] = *(const bf16x8*)(buf + f * 1024 + voff_l);
    bf16x8 Vf[2][2];
#pragma unroll
    for (int it = 0; it < 2; ++it) {
      const uint4 v0 = vv[it][0], v1 = vv[it][1];
      f32x16 vn;
      vn[0] = bf_lo(v0.x) - P1[it][0];  vn[1] = bf_hi(v0.x) - P1[it][1];
      vn[2] = bf_lo(v0.y) - P1[it][2];  vn[3] = bf_hi(v0.y) - P1[it][3];
      vn[4] = bf_lo(v0.z) - P1[it][4];  vn[5] = bf_hi(v0.z) - P1[it][5];
      vn[6] = bf_lo(v0.w) - P1[it][6];  vn[7] = bf_hi(v0.w) - P1[it][7];
      vn[8] = bf_lo(v1.x) - P1[it][8];  vn[9] = bf_hi(v1.x) - P1[it][9];
      vn[10] = bf_lo(v1.y) - P1[it][10]; vn[11] = bf_hi(v1.y) - P1[it][11];
      vn[12] = bf_lo(v1.z) - P1[it][12]; vn[13] = bf_hi(v1.z) - P1[it][13];
      vn[14] = bf_lo(v1.w) - P1[it][14]; vn[15] = bf_hi(v1.w) - P1[it][15];
      Vf[it][0] = pack8(vn, 0); Vf[it][1] = pack8(vn, 1);
    }
    bf16x8 fa[6];
#pragma unroll
    for (int i = 0; i < 6; ++i) fa[i] = *(const bf16x8*)(ext + (16 + i) * 1024 + voff_l);
    f32x16 P2[2];
    P2[0] = zero16(); P2[1] = zero16();
#pragma unroll
    for (int kb = 0; kb < 4; ++kb)
#pragma unroll
      for (int s = 0; s < 2; ++s) {
        P2[0] = MFMA(fq[kb * 2 + s], Sf[kb][s], P2[0]);
        const bf16x8 fq1 = *(const bf16x8*)(buf + (8 + kb * 2 + s) * 1024 + voff_l);
        P2[1] = MFMA(fq1, Sf[kb][s], P2[1]);
      }
    __builtin_amdgcn_sched_barrier(0);
    bf16x8 fkd[16];
#pragma unroll
    for (int i = 0; i < 16; ++i) fkd[i] = *(const bf16x8*)(ext + i * 1024 + voff_l);
#pragma unroll
    for (int s = 0; s < 2; ++s) {
      P2[0] = MFMA(fa[0 + s], Vf[0][s], P2[0]);
      P2[1] = MFMA(fa[2 + s], Vf[0][s], P2[1]);
      P2[1] = MFMA(fa[4 + s], Vf[1][s], P2[1]);
    }
    {
      char* ow = (char*)buf + 32768 + wave * 4096;
      float* sqw = (float*)((char*)buf + 49152 + 23 * 1024);
      const int xs = (r >> 1) & 3;
#pragma unroll
      for (int it = 0; it < 2; ++it) {
        f32x16 Z = MFMA(pack8(P2[it], 0), If0, zero16());
        Z = MFMA(pack8(P2[it], 1), If1, Z);
        float ssl = 0.f;
#pragma unroll
        for (int reg = 0; reg < 16; ++reg) ssl += Z[reg] * Z[reg];
        ssl += __shfl_xor(ssl, 32, 64);
        if (hh == 0) sqw[(it * 32 + r) * 4 + wave] = ssl;
#pragma unroll
        for (int g = 0; g < 4; ++g) {
          uint2 pv; pv.x = pk2(Z[4 * g], Z[4 * g + 1]); pv.y = pk2(Z[4 * g + 2], Z[4 * g + 3]);
          *(uint2*)(ow + (it * 32 + r) * 64 + ((g ^ xs) * 16) + hh * 8) = pv;
        }
      }
    }
#pragma unroll
    for (int kt = 0; kt < 4; ++kt) {
#pragma unroll
      for (int reg = 0; reg < 16; ++reg) S[kt][reg] *= eg;
#pragma unroll
      for (int pb = 0; pb < 2; ++pb)
#pragma unroll
        for (int s = 0; s < 2; ++s) {
          S[kt] = MFMA(fkd[kt * 4 + pb * 2 + s], Vf[pb][s], S[kt]);
        }
    }
    asm volatile("s_waitcnt lgkmcnt(0)" ::: "memory"); __builtin_amdgcn_s_barrier(); asm volatile("" ::: "memory");
  }
  float* od = p.out + OUT_DELTAP + (size_t)(b * 8 + h) * 16384;
#pragma unroll
  for (int kt = 0; kt < 4; ++kt)
#pragma unroll
    for (int reg = 0; reg < 16; ++reg) od[(kt * 32 + crow(reg, hh)) * 128 + wave * 32 + r] = S[kt][reg];
}

DI void conf_prompt_item(const Params& p, int item, char* smem) {
  const int tid = threadIdx.x & 255, lane = tid & 63, wave = tid >> 6;
  const int b = item >> 6, t0 = (item & 63) * 32;
  unsigned* tile = (unsigned*)smem;
  float* red = (float*)(smem + 63488);
  const u16* glu = (const u16*)(p.ws + OFF_GLU);
  u16* aact = (u16*)(p.ws + OFF_AACT);
#pragma unroll 1
  for (int hb = 0; hb < 2; ++hb) {
    u32x4 fv[8];
#pragma unroll
    for (int i = 0; i < 8; ++i) {
      const int e = tid + 256 * (hb * 8 + i), rr = e >> 6, c8 = (e & 63) * 8;
      const int t = t0 - 30 + rr;
      fv[i] = (u32x4){0u, 0u, 0u, 0u};
      if (rr < 62 && t >= 0) fv[i] = *(const u32x4*)(glu + (size_t)(b * 2048 + t) * 512 + c8);
    }
#pragma unroll
    for (int i = 0; i < 8; ++i) {
      const int e = tid + 256 * (hb * 8 + i), rr = e >> 6, c8 = (e & 63) * 8;
      if (rr < 62) *(u32x4*)(tile + rr * 256 + (c8 >> 1)) = fv[i];
    }
  }
  float w[31][2];
#pragma unroll
  for (int j = 0; j < 31; ++j) { const float2 t = *(const float2*)(p.conf_dw_w + j * 512 + 2 * tid); w[j][0] = t.x; w[j][1] = t.y; }
  const float2 bias = *(const float2*)(p.conf_dw_b + 2 * tid);
  const float2 lw = *(const float2*)(p.conf_ln_w + 2 * tid), lb = *(const float2*)(p.conf_ln_b + 2 * tid);
  __syncthreads();
#pragma unroll 1
  for (int tg = 0; tg < 4; ++tg) {
    float a[8][2];
#pragma unroll
    for (int t = 0; t < 8; ++t) { a[t][0] = bias.x; a[t][1] = bias.y; }
#pragma unroll
    for (int i = 0; i < 38; ++i) {
      const unsigned u = tile[(tg * 8 + i) * 256 + tid];
      const float x0 = bf_lo(u), x1 = bf_hi(u);
#pragma unroll
      for (int t = 0; t < 8; ++t) {
        const int j = i - t;
        if (j >= 0 && j < 31) { a[t][0] += w[j][0] * x0; a[t][1] += w[j][1] * x1; }
      }
    }
#pragma unroll
    for (int t = 0; t < 8; ++t) {
      const float s1 = wsum(a[t][0] + a[t][1]);
      const float s2 = wsum(a[t][0] * a[t][0] + a[t][1] * a[t][1]);
      if (lane == 0) { red[(wave * 8 + t) * 2] = s1; red[(wave * 8 + t) * 2 + 1] = s2; }
    }
    __syncthreads();
#pragma unroll
    for (int t = 0; t < 8; ++t) {
      const float s1 = red[t * 2] + red[(8 + t) * 2] + red[(16 + t) * 2] + red[(24 + t) * 2];
      const float s2 = red[t * 2 + 1] + red[(8 + t) * 2 + 1] + red[(16 + t) * 2 + 1] + red[(24 + t) * 2 + 1];
      const float mu = s1 * (1.f / 512.f);
      const float var = fmaxf(s2 * (1.f / 512.f) - mu * mu, 0.f);
      const float rs = rsqrtf(var + EPS);
      const float y0 = (a[t][0] - mu) * rs * lw.x + lb.x, y1 = (a[t][1] - mu) * rs * lw.y + lb.y;
      *(unsigned*)(aact + (size_t)(b * 2048 + t0 + tg * 8 + t) * 512 + 2 * tid) = pk2(siluf_(y0), siluf_(y1));
    }
    __syncthreads();
  }
}
DI void conf_sample_item(const Params& p, int item) {
  const int lane = threadIdx.x & 63, wave = (threadIdx.x >> 6) & 3;
  const int s = item * 4 + wave;
  const int c = lane * 8;
  const u16* glu = (const u16*)(p.ws + OFF_GLU);
  u16* aact = (u16*)(p.ws + OFF_AACT);
  float a[8];
  {
    const float4 b0 = *(const float4*)(p.conf_dw_b + c), b1 = *(const float4*)(p.conf_dw_b + c + 4);
    a[0] = b0.x; a[1] = b0.y; a[2] = b0.z; a[3] = b0.w; a[4] = b1.x; a[5] = b1.y; a[6] = b1.z; a[7] = b1.w;
  }
  const float* st = p.st_conf + (size_t)s * 30 * 512;
  float* oc = p.out + OUT_CONFS + (size_t)s * 30 * 512;
#pragma unroll 1
  for (int j = 0; j < 30; ++j) {
    const f32x4 n0 = __builtin_nontemporal_load((const f32x4*)(st + j * 512 + c)), n1 = __builtin_nontemporal_load((const f32x4*)(st + j * 512 + c + 4));
    const float4 x0 = make_float4(n0[0], n0[1], n0[2], n0[3]), x1 = make_float4(n1[0], n1[1], n1[2], n1[3]);
    const float4 w0 = *(const float4*)(p.conf_dw_w + j * 512 + c), w1 = *(const float4*)(p.conf_dw_w + j * 512 + c + 4);
    a[0] += w0.x * x0.x; a[1] += w0.y * x0.y; a[2] += w0.z * x0.z; a[3] += w0.w * x0.w;
    a[4] += w1.x * x1.x; a[5] += w1.y * x1.y; a[6] += w1.z * x1.z; a[7] += w1.w * x1.w;
    if (j >= 1) { __builtin_nontemporal_store(n0, (f32x4*)(oc + (j - 1) * 512 + c)); __builtin_nontemporal_store(n1, (f32x4*)(oc + (j - 1) * 512 + c + 4)); }
  }
  {
    const uint4 g = *(const uint4*)(glu + (size_t)(RP + s) * 512 + c);
    const float4 w0 = *(const float4*)(p.conf_dw_w + 30 * 512 + c), w1 = *(const float4*)(p.conf_dw_w + 30 * 512 + c + 4);
    a[0] += w0.x * bf_lo(g.x); a[1] += w0.y * bf_hi(g.x); a[2] += w0.z * bf_lo(g.y); a[3] += w0.w * bf_hi(g.y);
    a[4] += w1.x * bf_lo(g.z); a[5] += w1.y * bf_hi(g.z); a[6] += w1.z * bf_lo(g.w); a[7] += w1.w * bf_hi(g.w);
  }
  float s1 = 0.f, s2 = 0.f;
#pragma unroll
  for (int i = 0; i < 8; ++i) { s1 += a[i]; s2 += a[i] * a[i]; }
  s1 = wsum(s1); s2 = wsum(s2);
  const float mu = s1 * (1.f / 512.f);
  const float rs = rsqrtf(fmaxf(s2 * (1.f / 512.f) - mu * mu, 0.f) + EPS);
  float y[8];
#pragma unroll
  for (int i = 0; i < 8; ++i) y[i] = siluf_((a[i] - mu) * rs * p.conf_ln_w[c + i] + p.conf_ln_b[c + i]);
  uint4 o; o.x = pk2(y[0], y[1]); o.y = pk2(y[2], y[3]); o.z = pk2(y[4], y[5]); o.w = pk2(y[6], y[7]);
  *(uint4*)(aact + (size_t)(RP + s) * 512 + c) = o;
}
DI void delta_sample_item(const Params& p, int item, char* smem) {
  const int tid = threadIdx.x & 255, lane = tid & 63, wave = tid >> 6;
  const int s = item >> 3, h = item & 7;
  float* qs = (float*)smem; float* ks = qs + 128; float* vs = ks + 128; float* part = vs + 128;
  float* red = part + 768;
  const u16* qkv = (const u16*)(p.ws + OFF_QKV);
  const float* gb = (const float*)(p.ws + OFF_GB);
  const int row = RP + s;
  const int v = tid & 127, kh = tid >> 7;
  const float* S0 = p.st_delta + (size_t)(s * 8 + h) * 16384 + (size_t)(kh * 64) * 128 + v;
  float Sr[64];
#pragma unroll
  for (int kk = 0; kk < 64; ++kk) Sr[kk] = __builtin_nontemporal_load(S0 + kk * 128);
  const float g = gb[(size_t)row * 16 + 8 + h], beta = gb[(size_t)row * 16 + h];
  float cq = 0.f, ck = 0.f, cv = 0.f;
  if (tid < 128) {
    float cx[3];
#pragma unroll
    for (int X = 0; X < 3; ++X) {
      const int cg = X * 1024 + h * 128 + tid;
      const float s0 = p.st_qkv[(size_t)(s * 3 + 0) * 3072 + cg], s1 = p.st_qkv[(size_t)(s * 3 + 1) * 3072 + cg], s2 = p.st_qkv[(size_t)(s * 3 + 2) * 3072 + cg];
      const float x = bf1(qkv[(size_t)row * 3072 + cg]);
      const float a = p.gdn_conv_w[cg] * s0 + p.gdn_conv_w[3072 + cg] * s1 + p.gdn_conv_w[2 * 3072 + cg] * s2 + p.gdn_conv_w[3 * 3072 + cg] * x;
      cx[X] = siluf_(a);
      p.out[OUT_QKVS + (size_t)(s * 3 + 0) * 3072 + cg] = s1;
      p.out[OUT_QKVS + (size_t)(s * 3 + 1) * 3072 + cg] = s2;
    }
    cq = cx[0]; ck = cx[1]; cv = cx[2];
  }
  {
    const float sq = wsum(cq * cq), sk = wsum(ck * ck);
    if (lane == 0) { red[wave * 2] = sq; red[wave * 2 + 1] = sk; }
  }
  __syncthreads();
  if (tid < 128) {
    const float rq = rsqrtf(red[0] + red[2] + EPS), rk = rsqrtf(red[1] + red[3] + EPS);
    qs[tid] = cq * rq * QSCALE; ks[tid] = ck * rk; vs[tid] = cv;
  }
  __syncthreads();
  const float eg = __expf(g);
  float kS = 0.f, qS = 0.f, qk = 0.f;
#pragma unroll
  for (int k4 = 0; k4 < 16; ++k4) {
    const float4 kv = *(const float4*)(ks + kh * 64 + k4 * 4), qv = *(const float4*)(qs + kh * 64 + k4 * 4);
    kS += kv.x * Sr[4 * k4] + kv.y * Sr[4 * k4 + 1] + kv.z * Sr[4 * k4 + 2] + kv.w * Sr[4 * k4 + 3];
    qS += qv.x * Sr[4 * k4] + qv.y * Sr[4 * k4 + 1] + qv.z * Sr[4 * k4 + 2] + qv.w * Sr[4 * k4 + 3];
    qk += kv.x * qv.x + kv.y * qv.y + kv.z * qv.z + kv.w * qv.w;
  }
  part[(kh * 3 + 0) * 128 + v] = kS; part[(kh * 3 + 1) * 128 + v] = qS; part[(kh * 3 + 2) * 128 + v] = qk;
  __syncthreads();
  kS = part[0 * 128 + v] + part[3 * 128 + v];
  qS = part[1 * 128 + v] + part[4 * 128 + v];
  qk = part[2 * 128 + v] + part[5 * 128 + v];
  const float vnew = vs[v] * beta - beta * eg * kS;
  const float o = eg * qS + qk * vnew;
  float* Sd = p.out + OUT_DELTAS + (size_t)(s * 8 + h) * 16384 + (size_t)(kh * 64) * 128 + v;
#pragma unroll
  for (int k4 = 0; k4 < 16; ++k4) {
    const float4 kv = *(const float4*)(ks + kh * 64 + k4 * 4);
    __builtin_nontemporal_store(Sr[4 * k4 + 0] * eg + kv.x * vnew, Sd + (4 * k4 + 0) * 128);
    __builtin_nontemporal_store(Sr[4 * k4 + 1] * eg + kv.y * vnew, Sd + (4 * k4 + 1) * 128);
    __builtin_nontemporal_store(Sr[4 * k4 + 2] * eg + kv.z * vnew, Sd + (4 * k4 + 2) * 128);
    __builtin_nontemporal_store(Sr[4 * k4 + 3] * eg + kv.w * vnew, Sd + (4 * k4 + 3) * 128);
  }
  if (kh == 0) {
    ((u16*)((char*)p.out + (size_t)R * 1024 * 2))[(size_t)row * 1024 + h * 128 + v] = f2bf(o);
    const float so = wsum(o * o);
    if (lane == 0) { float* sq = (float*)(p.ws + OFF_SSQ) + ((size_t)row * 8 + h) * 4; sq[wave] = so; sq[wave + 2] = 0.f; }
  }
  __syncthreads();
}

__global__ void __launch_bounds__(512, 2) fwd_megakernel(Params p) {
  __shared__ __attribute__((aligned(1024))) char smem[SMEM_BYTES];
  const int tid = threadIdx.x, lane = tid & 63, wave = tid >> 6;
  const int fr = lane & 15, fq = lane >> 4;
  uint4* xb_words = (uint4*)(smem + 2 * HALF_SMEM);
  if (tid == 0) *xb_words = make_uint4(0u, 0u, 0u, 0u);
  __syncthreads();
  XcdBarrier xb = xcd_barrier_post((unsigned*)(p.ws + OFF_BAR), (volatile LAS unsigned*)xb_words);
  const int G = gridDim.x, bid = blockIdx.x;
  float* mod = (float*)(p.ws + OFF_MOD);
  u16* hbuf = (u16*)p.out;
  u16* obuf = (u16*)((char*)p.out + (size_t)R * 1024 * 2);
  const float* ssq = (const float*)(p.ws + OFF_SSQ);
  u16* merged = (u16*)(p.ws + OFF_MERGED);
  u16* tmp2 = (u16*)(p.ws + OFF_TMP2);

  PH(0) phase_convert(p, smem);
  xcd_barrier(xb);

  PH(1) for (int sb = bid; sb < 256; sb += G) {
    skinny<2>((const u16*)(p.ws + OFF_AC), 1024, 0, 136, (const u16*)(p.ws + OFF_WADA), 1024, 1024,
      [&](int j) { return sb * 24 + (j < 24 ? j : 23); },
      [&](int row, int ntl, int q, f32x4 v, int ln) {
        const int j = ntl * 16 + 4 * q;
        if (j < 24) {
          const int col = sb * 24 + j;
          const float4 bb = *(const float4*)(p.b_ada + col);
          *(float4*)(mod + (size_t)row * 6144 + col) = make_float4(v[0] + bb.x, v[1] + bb.y, v[2] + bb.z, v[3] + bb.w);
        }
      });
  }
  xcd_barrier(xb);

  PH(2) phase_modnorm<true>(p, p.x_prompt, p.x_sample, p.norm1_w, 0, 1024, hbuf, smem);
  xcd_barrier(xb);

  PH(3) {
    u16* glu = (u16*)(p.ws + OFF_GLU);
    u16* qkv = (u16*)(p.ws + OFF_QKV);
    u16* halo = (u16*)(p.ws + OFF_HALO);
    auto f_glu_st = [&](int row, int ch, f32x4 gl) {
      uint2 o; o.x = pk2(gl[0], gl[1]); o.y = pk2(gl[2], gl[3]);
      *(uint2*)(glu + (size_t)row * 512 + ch) = o;
      if (row < RP) { const int b = row >> 11, tt = row & 2047; if (tt >= 2018) *(float4*)(p.out + OUT_CONFP + (size_t)(b * 30 + tt - 2018) * 512 + ch) = make_float4(gl[0], gl[1], gl[2], gl[3]); }
      else *(float4*)(p.out + OUT_CONFS + (size_t)((row - RP) * 30 + 29) * 512 + ch) = make_float4(gl[0], gl[1], gl[2], gl[3]);
    };
    auto f_glu = [&](int row, int ch, f32x4 a, f32x4 g) {
      f32x4 gl;
#pragma unroll
      for (int j = 0; j < 4; ++j) gl[j] = a[j] * sigmoidf_(g[j]);
      f_glu_st(row, ch, gl);
    };
    auto f_qkv = [&](int row, int col, f32x4 a) {
      const float4 v = make_float4(a[0], a[1], a[2], a[3]);
      uint2 o; o.x = pk2(v.x, v.y); o.y = pk2(v.z, v.w);
      *(uint2*)(qkv + (size_t)row * 3072 + col) = o;
      if (row < RP) {
        const int b = row >> 11, tt = row & 2047;
        if ((tt & 63) >= 61) *(uint2*)(halo + (size_t)((b * 32 + (tt >> 6)) * 3 + (tt & 63) - 61) * 3072 + col) = o;
        if (tt >= 2045) *(float4*)(p.out + OUT_QKVP + (size_t)(b * 3 + tt - 2045) * 3072 + col) = v;
      } else *(float4*)(p.out + OUT_QKVS + (size_t)((row - RP) * 3 + 2) * 3072 + col) = v;
    };
    int u = bid;
    for (; u < 64 * 4; u += G) {
      const int pm = u % 64, pn = u / 64;
      f32x4 acc[2][2][4][2];
      zero_acc(acc);
      gemm256(acc, hbuf, 1024, (const u16*)(p.ws + OFF_WIN), 1024, pm * 256, pn * 256, 1024, smem);
      {
        int t_ = threadIdx.x;
        asm volatile("" : "+v"(t_));
        const int wr = t_ >> 8, wc = (t_ >> 6) & 3, fr_ = t_ & 15, fq_ = (t_ >> 4) & 3;
        float* T = (float*)smem;
#pragma unroll
        for (int ai = 0; ai < 2; ++ai)
#pragma unroll
          for (int m = 0; m < 4; ++m)
#pragma unroll
            for (int n = 0; n < 2; ++n) {
              f32x4 gl;
#pragma unroll
              for (int j = 0; j < 4; ++j) gl[j] = acc[ai][0][m][n][j] * sigmoidf_(acc[ai][1][m][n][j]);
              *(f32x4*)(T + (ai * 128 + wr * 64 + m * 16 + fr_) * TLD + wc * 32 + n * 16 + 4 * fq_) = gl;
            }
        __syncthreads();
        const int cg = (t_ & 31) * 4, r0 = t_ >> 5;
#pragma unroll 4
        for (int i = 0; i < 16; ++i) {
          const int rl = r0 + 16 * i;
          const f32x4 v = *(const f32x4*)(T + rl * TLD + cg);
          f_glu_st(pm * 256 + rl, pn * 128 + cg, v);
        }
        __syncthreads();
      }
    }
    for (; u < 64 * 16; u += G) {
      const int pm = u % 64, pn = u / 64;
      f32x4 acc[2][2][4][2];
      zero_acc(acc);
      gemm256(acc, hbuf, 1024, (const u16*)(p.ws + OFF_WIN), 1024, pm * 256, pn * 256, 1024, smem);
      tile_epilogue(acc, pm * 256, pn * 256 - 1024, smem, f_qkv);
    }
    for (int sb = bid; sb < 256; sb += G) {
      if (sb < 64) {
        skinny<1>(hbuf, 1024, RP, 128, (const u16*)(p.ws + OFF_WIN), 1024, 1024,
          [&](int j) { const int ch = sb * 8 + (j & 7); return (ch >> 7) * 256 + (ch & 127) + ((j >> 3) << 7); },
          [&](int row, int ntl, int q, f32x4 v, int ln) {
            f32x4 g;
#pragma unroll
            for (int j = 0; j < 4; ++j) g[j] = __shfl(v[j], (ln + 32) & 63, 64);
            if (q < 2) f_glu(row, sb * 8 + 4 * q, v, g);
          });
      } else {
        skinny<1>(hbuf, 1024, RP, 128, (const u16*)(p.ws + OFF_WIN), 1024, 1024,
          [&](int j) { return 1024 + (sb - 64) * 16 + j; },
          [&](int row, int ntl, int q, f32x4 v, int ln) { f_qkv(row, (sb - 64) * 16 + 4 * q, v); });
      }
    }
  }
  xcd_barrier(xb);

  PH(4) for (int base = bid * 2; base < 2048; base += 2 * G) d1_item(p, base + (tid >> 8), smem + (tid >> 8) * HALF_SMEM);
  xcd_barrier(xb);

  PH(5) {
    const int half = tid >> 8;
    char* hs = smem + half * HALF_SMEM;
    for (int u = bid; u < 64; u += G) { d2_block(p, u, smem); __syncthreads(); }
    unsigned* qhead = (unsigned*)(p.ws + OFF_BAR) + 64;
    volatile unsigned* qslot = (volatile unsigned*)(smem + 2 * HALF_SMEM + 32);
    auto deq = [&]() -> int {
      if (tid == 0) *qslot = __hip_atomic_fetch_add(qhead, 1u, __ATOMIC_RELAXED, __HIP_MEMORY_SCOPE_AGENT);
      __syncthreads();
      const int v = __builtin_amdgcn_readfirstlane((int)*qslot);
      __syncthreads();
      return v;
    };
    int idx = deq();
    for (; idx < 256; idx = deq()) conf_prompt_item(p, 2 * idx + half, hs);
    for (; idx < 272; idx = deq()) conf_sample_item(p, 2 * (idx - 256) + half);
    for (; idx < 784; idx = deq()) delta_sample_item(p, 2 * (idx - 272) + half, hs);
  }
  xcd_barrier(xb);

  PH(6) {
    auto f_z = [&](int row, int col, f32x4 a) {
      const float4 sq4 = *(const float4*)(ssq + ((size_t)row * 8 + (col >> 7)) * 4);
      const float rstd = rsqrtf((sq4.x + sq4.y + sq4.z + sq4.w) * (1.f / 128.f) + EPS);
      const float4 gw = *(const float4*)(p.gdn_norm_w + (col & 127));
      u16* op = obuf + (size_t)row * 1024 + col;
      const uint2 u = *(const uint2*)op;
      uint2 o;
      o.x = pk2(bf_lo(u.x) * rstd * gw.x * siluf_(a[0]), bf_hi(u.x) * rstd * gw.y * siluf_(a[1]));
      o.y = pk2(bf_lo(u.y) * rstd * gw.z * siluf_(a[2]), bf_hi(u.y) * rstd * gw.w * siluf_(a[3]));
      *(uint2*)op = o;
    };
    gemm_pass(hbuf, 1024, (const u16*)(p.ws + OFF_WZ), 1024, 1024, 1024, smem, f_z);
    for (int sb = bid; sb < 256; sb += G)
      skinny<1>(hbuf, 1024, RP, 128, (const u16*)(p.ws + OFF_WZ), 1024, 1024, [&](int j) { return sb * 4 + (j & 3); },
                [&](int row, int ntl, int q, f32x4 v, int ln) { if (q == 0) f_z(row, sb * 4, v); });
  }
  xcd_barrier(xb);

  PH(7) {
    auto f_ga = [&](int row, int col, f32x4 a) {
      uint2 o; o.x = pk2(sigmoidf_(a[0]), sigmoidf_(a[1])); o.y = pk2(sigmoidf_(a[2]), sigmoidf_(a[3]));
      *(uint2*)(merged + (size_t)row * 1024 + col) = o;
    };
    auto f_ya = [&](int row, int col, f32x4 a) {
      u16* mp = merged + (size_t)row * 1024 + col;
      const uint2 u = *(const uint2*)mp;
      uint2 o; o.x = pk2(bf_lo(u.x) * a[0], bf_hi(u.x) * a[1]); o.y = pk2(bf_lo(u.y) * a[2], bf_hi(u.y) * a[3]);
      *(uint2*)mp = o;
    };
    auto f_gb = [&](int row, int col, f32x4 a) {
      uint2 o; o.x = pk2(sigmoidf_(a[0]), sigmoidf_(a[1])); o.y = pk2(sigmoidf_(a[2]), sigmoidf_(a[3]));
      *(uint2*)(tmp2 + (size_t)row * 1024 + col) = o;
    };
    auto f_yb = [&](int row, int col, f32x4 a) {
      u16* mp = merged + (size_t)row * 1024 + col;
      const uint2 u = *(const uint2*)mp, s2 = *(const uint2*)(tmp2 + (size_t)row * 1024 + col);
      uint2 o; o.x = pk2(bf_lo(u.x) + bf_lo(s2.x) * a[0], bf_hi(u.x) + bf_hi(s2.x) * a[1]); o.y = pk2(bf_lo(u.y) + bf_lo(s2.y) * a[2], bf_hi(u.y) + bf_hi(s2.y) * a[3]);
      *(uint2*)mp = o;
    };
    auto cm4 = [&](int sb) { return [sb](int j) { return sb * 4 + (j & 3); }; };
    gemm_pass(hbuf, 1024, (const u16*)(p.ws + OFF_WGA), 1024, 1024, 1024, smem, f_ga);
    gemm_pass((const u16*)(p.ws + OFF_AACT), 512, (const u16*)(p.ws + OFF_WCONF), 512, 1024, 512, smem, f_ya);
    gemm_pass(hbuf, 1024, (const u16*)(p.ws + OFF_WGB), 1024, 1024, 1024, smem, f_gb);
    gemm_pass(obuf, 1024, (const u16*)(p.ws + OFF_WGDN), 1024, 1024, 1024, smem, f_yb);
    for (int sb = bid; sb < 256; sb += G) {
      skinny<1>(hbuf, 1024, RP, 128, (const u16*)(p.ws + OFF_WGA), 1024, 1024, cm4(sb), [&](int row, int ntl, int q, f32x4 v, int ln) { if (q == 0) f_ga(row, sb * 4, v); });
      skinny<1>((const u16*)(p.ws + OFF_AACT), 512, RP, 128, (const u16*)(p.ws + OFF_WCONF), 512, 512, cm4(sb), [&](int row, int ntl, int q, f32x4 v, int ln) { if (q == 0) f_ya(row, sb * 4, v); });
      skinny<1>(hbuf, 1024, RP, 128, (const u16*)(p.ws + OFF_WGB), 1024, 1024, cm4(sb), [&](int row, int ntl, int q, f32x4 v, int ln) { if (q == 0) f_gb(row, sb * 4, v); });
      skinny<1>(obuf, 1024, RP, 128, (const u16*)(p.ws + OFF_WGDN), 1024, 1024, cm4(sb), [&](int row, int ntl, int q, f32x4 v, int ln) { if (q == 0) f_yb(row, sb * 4, v); });
    }
  }
  xcd_barrier(xb);

  PH(8) {
    auto f_o = [&](int row, int col, f32x4 a) {
      const float* xr = row < RP ? p.x_prompt + (size_t)row * 1024 : p.x_sample + (size_t)(row - RP) * 1024;
      const f32x4 x4 = __builtin_nontemporal_load((const f32x4*)(xr + col));
      const float4 xv = make_float4(x4[0], x4[1], x4[2], x4[3]), gv = *(const float4*)(mod + (size_t)mrow_of(row) * 6144 + 2048 + col);
      *(float4*)(p.out + (size_t)row * 1024 + col) = make_float4(xv.x + gv.x * a[0], xv.y + gv.y * a[1], xv.z + gv.z * a[2], xv.w + gv.w * a[3]);
    };
    gemm_pass(merged, 1024, (const u16*)(p.ws + OFF_WO), 1024, 1024, 1024, smem, f_o);
    for (int sb = bid; sb < 256; sb += G)
      skinny<1>(merged, 1024, RP, 128, (const u16*)(p.ws + OFF_WO), 1024, 1024, [&](int j) { return sb * 4 + (j & 3); },
                [&](int row, int ntl, int q, f32x4 v, int ln) { if (q == 0) f_o(row, sb * 4, v); });
  }
  xcd_barrier(xb);

  PH(9) phase_modnorm<false>(p, p.out, p.out + (size_t)RP * 1024, p.norm2_w, 3072, 4096, (u16*)(p.ws + OFF_H2), smem);
  xcd_barrier(xb);

  PH(10) {
    u16* f = (u16*)(p.ws + OFF_F);
    auto f_ff1 = [&](int row, int col, f32x4 a) {
      float v[4];
#pragma unroll
      for (int j = 0; j < 4; ++j) { const float t = fmaxf(a[j], 0.f); v[j] = t * t; }
      uint2 o; o.x = pk2(v[0], v[1]); o.y = pk2(v[2], v[3]);
      *(uint2*)(f + (size_t)row * LDF + col) = o;
    };
    gemm_pass((const u16*)(p.ws + OFF_H2), 1024, (const u16*)(p.ws + OFF_W1), 1024, 4096, 1024, smem, f_ff1);
    for (int sb = bid; sb < 256; sb += G)
      skinny<1>((const u16*)(p.ws + OFF_H2), 1024, RP, 128, (const u16*)(p.ws + OFF_W1), 1024, 1024, [&](int j) { return sb * 16 + j; },
                [&](int row, int ntl, int q, f32x4 v, int ln) { f_ff1(row, sb * 16 + 4 * q, v); });
  }
  xcd_barrier(xb);

  PH(11) {
    auto f_ff2 = [&](int row, int col, f32x4 a) {
      float* xp = p.out + (size_t)row * 1024 + col;
      const f32x4 x4 = __builtin_nontemporal_load((const f32x4*)xp);
      const float4 xv = make_float4(x4[0], x4[1], x4[2], x4[3]), gv = *(const float4*)(mod + (size_t)mrow_of(row) * 6144 + 5120 + col);
      *(float4*)xp = make_float4(xv.x + gv.x * a[0], xv.y + gv.y * a[1], xv.z + gv.z * a[2], xv.w + gv.w * a[3]);
    };
    gemm_pass((const u16*)(p.ws + OFF_F), LDF, (const u16*)(p.ws + OFF_W2), LDF, 1024, 4096, smem, f_ff2);
    for (int sb = bid; sb < 256; sb += G)
      skinny<1>((const u16*)(p.ws + OFF_F), LDF, RP, 128, (const u16*)(p.ws + OFF_W2), LDF, 4096, [&](int j) { return sb * 4 + (j & 3); },
                [&](int row, int ntl, int q, f32x4 v, int ln) { if (q == 0) f_ff2(row, sb * 4, v); });
  }
  xcd_barrier(xb);

  PH(12) {
    int t12 = threadIdx.x;
    asm volatile("" : "+v"(t12));
    const int lane = t12 & 63, wave = t12 >> 6;
    const int gw = bid * 8 + wave, nw_ = G * 8;
    for (int row = gw; row < R; row += nw_) {
      float* xr = p.out + (size_t)row * 1024;
      float4 v[4]; float ss = 0.f;
#pragma unroll
      for (int i = 0; i < 4; ++i) { const f32x4 t4 = __builtin_nontemporal_load((const f32x4*)(xr + (lane + 64 * i) * 4)); v[i] = make_float4(t4[0], t4[1], t4[2], t4[3]); ss += v[i].x * v[i].x + v[i].y * v[i].y + v[i].z * v[i].z + v[i].w * v[i].w; }
      ss = wsum(ss);
      const float rstd = rsqrtf(ss * (1.f / 1024.f) + EPS);
#pragma unroll
      for (int i = 0; i < 4; ++i) {
        const int c = (lane + 64 * i) * 4;
        const float4 w = *(const float4*)(p.final_norm_w + c);
        f32x4 yv = {v[i].x * rstd * w.x, v[i].y * rstd * w.y, v[i].z * rstd * w.z, v[i].w * rstd * w.w};
        __builtin_nontemporal_store(yv, (f32x4*)(xr + c));
      }
    }
  }
}

extern "C" void kernel_launch(void* const* d_in, const int* in_sizes, int n_in, void* d_out, int out_size, void* d_ws, size_t ws_size,
                              hipStream_t stream) {
  static int grid_blocks = 0;
  if (!grid_blocks) {
    int dev = 0, cus = 0, per_cu = 0;
    hipGetDevice(&dev);
    hipDeviceGetAttribute(&cus, hipDeviceAttributeMultiprocessorCount, dev);
    hipOccupancyMaxActiveBlocksPerMultiprocessor(&per_cu, (const void*)fwd_megakernel, NT, 0);
    if (per_cu > 1) per_cu = 1;
    if (per_cu < 1) per_cu = 1;
    grid_blocks = cus * per_cu;
  }
  Params p{};
  const float** pp = (const float**)&p;
  for (int i = 0; i < 26; ++i) pp[i] = (const float*)d_in[i];
  p.out = (float*)d_out; p.ws = (char*)d_ws;
  if (ws_size < WS_NEED) { fprintf(stderr, "workspace too small: %zu < %zu\n", ws_size, (size_t)WS_NEED); return; }
  hipMemsetAsync(d_ws, 0, XCD_BAR_WORDS * 4, stream);
  void* args[] = {&p};
  hipError_t e = hipLaunchCooperativeKernel((const void*)fwd_megakernel, dim3(grid_blocks), dim3(NT), args, 0, stream);
  if (e != hipSuccess) fprintf(stderr, "cooperative launch failed: %s (grid %d)\n", hipGetErrorString(e), grid_blocks);
}
```

```cpp
#include <hip/hip_runtime.h>
#include <stdint.h>
#include <cstdio>

#define DI __device__ __forceinline__
typedef unsigned short u16;
typedef __bf16 bf2_t __attribute__((ext_vector_type(2)));
typedef float f2_t __attribute__((ext_vector_type(2)));
using bf16x8 = __attribute__((ext_vector_type(8))) short;
using f32x16 = __attribute__((ext_vector_type(16))) float;
using f32x4 = __attribute__((ext_vector_type(4))) float;
using u32x4 = __attribute__((ext_vector_type(4))) unsigned;
#define MFMA(a, b, c) __builtin_amdgcn_mfma_f32_32x32x16_bf16((a), (b), (c), 0, 0, 0)

constexpr int R = 16512, RP = 16384, D = 1024, DC = 512, QKV = 3072, NIN = 4096, DFF = 4096;
constexpr float EPS = 1e-6f;
constexpr int LDF = 4160;
constexpr float QSCALE = 0.08838834764831845f;

constexpr size_t OFF_BAR   = 0;
constexpr size_t OFF_MOD   = 16384;
constexpr size_t OFF_GB    = OFF_MOD + 3342336;
constexpr size_t OFF_EGL   = OFF_GB + 1056768;
constexpr size_t OFF_SSQ   = OFF_EGL + 8192;
constexpr size_t OFF_WIN   = OFF_SSQ + 2113536;
constexpr size_t OFF_WZ    = OFF_WIN + 8650752;
constexpr size_t OFF_WGA   = OFF_WZ + 2097152;
constexpr size_t OFF_WGB   = OFF_WGA + 2097152;
constexpr size_t OFF_WCONF = OFF_WGB + 2097152;
constexpr size_t OFF_WGDN  = OFF_WCONF + 1048576;
constexpr size_t OFF_WO    = OFF_WGDN + 2097152;
constexpr size_t OFF_W1    = OFF_WO + 2097152;
constexpr size_t OFF_W2    = OFF_W1 + 8388608;
constexpr size_t OFF_GLU   = OFF_W2 + 8650752;
constexpr size_t OFF_AACT  = OFF_GLU + 16908288;
constexpr size_t OFF_QKV   = OFF_AACT + 16908288;
constexpr size_t OFF_HALO  = OFF_QKV + 101449728;
constexpr size_t OFF_EXTRA = OFF_HALO + 4718592;
constexpr size_t OFF_WADA  = OFF_EXTRA;
constexpr size_t OFF_AC    = OFF_EXTRA + 12582912;
constexpr size_t OFF_MERGED= OFF_EXTRA;
constexpr size_t OFF_H2    = OFF_GLU;
constexpr size_t OFF_F     = OFF_QKV;
constexpr size_t OFF_TMP2  = OFF_QKV;
constexpr size_t WS_NEED   = OFF_EXTRA + 50331648;
constexpr size_t OUT_Y = 0, OUT_CONFP = 16908288, OUT_QKVP = 17031168, OUT_DELTAP = 17104896,
                 OUT_CONFS = 18153472, OUT_QKVS = 20119552, OUT_DELTAS = 21299200;

constexpr int HALF_SMEM = 73728;
constexpr int SMEM_BYTES = 2 * HALF_SMEM + 1024;
constexpr int NT = 512;
#ifndef PHASE_MASK
#define PHASE_MASK 0xFFFF
#endif
#define PH(k) if constexpr ((PHASE_MASK >> (k)) & 1)

struct Params {
  const float *x_prompt, *x_sample, *c_prompt, *c_sample, *st_conf, *st_qkv, *st_delta;
  const float *w_ada, *b_ada, *norm1_w, *w_in, *conf_dw_w, *conf_dw_b, *conf_ln_w, *conf_ln_b, *w_conf_out,
              *gdn_conv_w, *a_log, *dt_bias, *gdn_norm_w, *w_gdn_out, *w_o, *norm2_w, *w_ff1, *w_ff2, *final_norm_w;
  float* out; char* ws;
};

DI unsigned pk2(float a, float b) { f2_t v = {a, b}; bf2_t r = __builtin_convertvector(v, bf2_t); return __builtin_bit_cast(unsigned, r); }
DI float bf_lo(unsigned u) { return __uint_as_float(u << 16); }
DI float bf_hi(unsigned u) { return __uint_as_float(u & 0xffff0000u); }
DI float bf1(u16 u) { return __uint_as_float(((unsigned)u) << 16); }
DI u16 f2bf(float a) { return (u16)(pk2(a, 0.f) & 0xffffu); }
DI float sigmoidf_(float x) { return __builtin_amdgcn_rcpf(1.f + __expf(-x)); }
DI float siluf_(float x) { return x * __builtin_amdgcn_rcpf(1.f + __expf(-x)); }
DI float softplusf_(float x) { return fmaxf(x, 0.f) + log1pf(__expf(-fabsf(x))); }
DI float dpp_f(float x, const int ctrl_sel) {
  const int xi = __builtin_bit_cast(int, x);
  int r;
  if (ctrl_sel == 0) r = __builtin_amdgcn_update_dpp(xi, xi, 0xB1, 0xF, 0xF, false);
  else if (ctrl_sel == 1) r = __builtin_amdgcn_update_dpp(xi, xi, 0x4E, 0xF, 0xF, false);
  else if (ctrl_sel == 2) r = __builtin_amdgcn_update_dpp(xi, xi, 0x141, 0xF, 0xF, false);
  else r = __builtin_amdgcn_update_dpp(xi, xi, 0x140, 0xF, 0xF, false);
  return __builtin_bit_cast(float, r);
}
DI float wsum(float v) {
  v += dpp_f(v, 0); v += dpp_f(v, 1); v += dpp_f(v, 2); v += dpp_f(v, 3);
  v += __shfl_xor(v, 16, 64); v += __shfl_xor(v, 32, 64);
  return v;
}
DI int crow(int reg, int hh) { return (reg & 3) + 8 * (reg >> 2) + 4 * hh; }
DI int mrow_of(int r) { return r < RP ? (r >> 11) : (8 + r - RP); }
DI bf16x8 pack8(const f32x16& x, int s) {
  uint4 p;
  p.x = pk2(x[8 * s + 0], x[8 * s + 1]); p.y = pk2(x[8 * s + 2], x[8 * s + 3]);
  p.z = pk2(x[8 * s + 4], x[8 * s + 5]); p.w = pk2(x[8 * s + 6], x[8 * s + 7]);
  return __builtin_bit_cast(bf16x8, p);
}
DI f32x16 zero16() { f32x16 z; for (int i = 0; i < 16; ++i) z[i] = 0.f; return z; }

#define XB_TMO      128
#define XB_XCNT(j)  (256  + 64 * (j))
#define XB_XSUB(j)  (1280 + 64 * (j))
#define XB_XGEN(j)  (2304 + 64 * (j))
#define XB_TOP      3328
#define XB_TOPGEN   3392
#define XCD_BAR_WORDS 3456
#define XB_SPIN_CAP (1u << 24)
#define LAS __attribute__((address_space(3)))
DI unsigned xb_ld(unsigned* p) { return __hip_atomic_load(p, __ATOMIC_RELAXED, __HIP_MEMORY_SCOPE_AGENT); }
DI unsigned xb_add(unsigned* p, unsigned v) { return __hip_atomic_fetch_add(p, v, __ATOMIC_RELAXED, __HIP_MEMORY_SCOPE_AGENT); }
DI unsigned xb_xcc_id() { return (unsigned)__builtin_amdgcn_s_getreg((3 << 11) | 20) & 0xFu; }
#define XB_SPIN(cond, bar) do { unsigned _sp = 0; while (cond) { __builtin_amdgcn_s_sleep(1); \
    if ((++_sp & 255u) == 0u) { if (xb_ld(&(bar)[XB_TMO])) break; if (_sp > XB_SPIN_CAP) { atomicAdd(&(bar)[XB_TMO], 1u); break; } } } } while (0)
struct XcdBarrier { unsigned* bar; unsigned x; volatile LAS unsigned* st; };
DI XcdBarrier xcd_barrier_post(unsigned* bar, volatile LAS unsigned* st) {
  XcdBarrier b; b.bar = bar; b.x = xb_xcc_id(); b.st = st;
  if (threadIdx.x == 0) (void)xb_add(&bar[XB_XCNT(b.x)], 1u);
  return b;
}
DI void xcd_barrier_complete(unsigned* bar, unsigned x, unsigned& nloc, unsigned& nx) {
  const unsigned G = gridDim.x * gridDim.y * gridDim.z;
  unsigned sum, cnt, mine, sp = 0u;
  for (;;) {
    sum = 0u; cnt = 0u; mine = 0u;
#pragma unroll
    for (unsigned j = 0; j < 16; ++j) { const unsigned c = xb_ld(&bar[XB_XCNT(j)]); sum += c; cnt += (c > 0u) ? 1u : 0u; mine = (j == x) ? c : mine; }
    if (sum == G) break;
    __builtin_amdgcn_s_sleep(1);
    if ((++sp & 255u) == 0u) { if (xb_ld(&bar[XB_TMO])) break; if (sp > XB_SPIN_CAP) { atomicAdd(&bar[XB_TMO], 1u); break; } }
  }
  nloc = mine > 0u ? mine : 1u; nx = cnt > 0u ? cnt : 1u;
}
DI void xcd_barrier(const XcdBarrier& b) {
  asm volatile("s_waitcnt vmcnt(0)" ::: "memory");
  __syncthreads();
  if (threadIdx.x == 0) {
    unsigned* bar = b.bar;
    __builtin_amdgcn_s_waitcnt(0);
    unsigned nloc = b.st[0], nx = b.st[1];
    if (nloc == 0u) { xcd_barrier_complete(bar, b.x, nloc, nx); b.st[0] = nloc; b.st[1] = nx; }
    const unsigned old = xb_add(&bar[XB_XSUB(b.x)], 1u);
    const unsigned gen = old / nloc;
    if (old + 1u == (gen + 1u) * nloc) {
      __builtin_amdgcn_fence(__ATOMIC_RELEASE, "agent");
      asm volatile("s_waitcnt vmcnt(0)" ::: "memory");
      const unsigned og = xb_add(&bar[XB_TOP], 1u);
      const unsigned tg = og / nx;
      if (og + 1u == (tg + 1u) * nx) xb_add(&bar[XB_TOPGEN], 1u);
      else XB_SPIN(xb_ld(&bar[XB_TOPGEN]) == tg, bar);
      __builtin_amdgcn_fence(__ATOMIC_ACQUIRE, "agent");
      xb_add(&bar[XB_XGEN(b.x)], 1u);
      asm volatile("s_waitcnt vmcnt(0)" ::: "memory");
    } else {
      XB_SPIN(xb_ld(&bar[XB_XGEN(b.x)]) == gen, bar);
      __builtin_amdgcn_fence(__ATOMIC_ACQUIRE, "agent");
      asm volatile("s_waitcnt vmcnt(0)" ::: "memory");
    }
  }
  __syncthreads();
}

constexpr int HTB = 128 * 64 * 2;
DI int lds_byte(int r, int c) { const int st = (r >> 4) * 2 + (c >> 5), rr = r & 15, cc = c & 31, ob = rr * 64 + cc * 2; return st * 1024 + (ob ^ (((ob >> 9) & 1) << 5)); }
DI void stage_rc(int b, int& Rr, int& Cc) { const int st = b / 1024, sb = b % 1024, swz = sb ^ (((sb >> 9) & 1) << 5); Rr = (st >> 1) * 16 + swz / 64; Cc = (st & 1) * 32 + (swz % 64) / 2; }
DI void gemm256(f32x4 (&acc)[2][2][4][2], const u16* __restrict__ A, const int lda, const u16* __restrict__ Bt, const int ldb,
                const int brow, const int bcol, const int K, char* shm) {
#define SA(b, h) (shm + ((b) * 2 + (h)) * HTB)
#define SB(b, h) (shm + (4 + (b) * 2 + (h)) * HTB)
#define STAGE_A(P, br, kt) do { const char* _u = (const char*)A + ((size_t)(br) * lda + (size_t)(kt) * 64) * 2; \
    __builtin_amdgcn_global_load_lds((const unsigned*)(_u + voA0), (unsigned*)((char*)(P) + sb0), 16, 0, 0); \
    __builtin_amdgcn_global_load_lds((const unsigned*)(_u + voA1), (unsigned*)((char*)(P) + sb1), 16, 0, 0); } while (0)
#define STAGE_B(P, br, kt) do { const char* _u = (const char*)Bt + ((size_t)(br) * ldb + (size_t)(kt) * 64) * 2; \
    __builtin_amdgcn_global_load_lds((const unsigned*)(_u + voB0), (unsigned*)((char*)(P) + sb0), 16, 0, 0); \
    __builtin_amdgcn_global_load_lds((const unsigned*)(_u + voB1), (unsigned*)((char*)(P) + sb1), 16, 0, 0); } while (0)
#define LDA(dst, b, h) _Pragma("unroll") for (int m = 0; m < 4; ++m) _Pragma("unroll") for (int k = 0; k < 2; ++k) \
    dst[m][k] = *reinterpret_cast<const bf16x8*>((char*)SA(b, h) + lds_byte(wr * 64 + m * 16 + fr, k * 32 + fq * 8))
#define LDB(dst, b, h) _Pragma("unroll") for (int n = 0; n < 2; ++n) _Pragma("unroll") for (int k = 0; k < 2; ++k) \
    dst[n][k] = *reinterpret_cast<const bf16x8*>((char*)SB(b, h) + lds_byte(wc * 32 + n * 16 + fr, k * 32 + fq * 8))
#define MMA(ai, bj, At_, Bt_) do { __builtin_amdgcn_s_setprio(1); \
    _Pragma("unroll") for (int m = 0; m < 4; ++m) _Pragma("unroll") for (int n = 0; n < 2; ++n) _Pragma("unroll") for (int k = 0; k < 2; ++k) \
      acc[ai][bj][m][n] = __builtin_amdgcn_mfma_f32_16x16x32_bf16(Bt_[n][k], At_[m][k], acc[ai][bj][m][n], 0, 0, 0); \
    __builtin_amdgcn_s_setprio(0); } while (0)
#define WAIT_V(n) asm volatile("s_waitcnt vmcnt(" #n ")" ::: "memory")
#define WAIT_L(n) asm volatile("s_waitcnt lgkmcnt(" #n ")" ::: "memory")
#define BAR __builtin_amdgcn_s_barrier()
#define SCHED __builtin_amdgcn_sched_barrier(0)
  int t_ = threadIdx.x;
  asm volatile("" : "+v"(t_));
  const int wid = __builtin_amdgcn_readfirstlane(t_ >> 6), lane = t_ & 63, wr = wid >> 2, wc = wid & 3, fr = lane & 15, fq = lane >> 4;
  const int sb0 = t_ * 16, sb1 = sb0 + 8192;
  int sr0, sc0, sr1, sc1; stage_rc(sb0, sr0, sc0); stage_rc(sb1, sr1, sc1);
  const unsigned voA0 = (unsigned)(sr0 * lda + sc0) * 2u, voA1 = (unsigned)(sr1 * lda + sc1) * 2u;
  const unsigned voB0 = (unsigned)(sr0 * ldb + sc0) * 2u, voB1 = (unsigned)(sr1 * ldb + sc1) * 2u;
  bf16x8 At[4][2], B0[2][2], B1[2][2];
  const int nt = K / 64;
  STAGE_B(SB(0, 0), bcol, 0); STAGE_A(SA(0, 0), brow, 0);
  STAGE_B(SB(0, 1), bcol + 128, 0); STAGE_A(SA(0, 1), brow + 128, 0);
  if (wr == 1) BAR;
  WAIT_V(4); BAR;
  STAGE_B(SB(1, 0), bcol, 1); STAGE_A(SA(1, 0), brow, 1); STAGE_B(SB(1, 1), bcol + 128, 1);
  WAIT_V(6); BAR;
  for (int t = 0; t < nt - 2; t += 2) {
    LDB(B0, 0, 0); SCHED; LDA(At, 0, 0); STAGE_A(SA(1, 1), brow + 128, t + 1);
    WAIT_L(8); BAR; WAIT_L(0); MMA(0, 0, At, B0); BAR; SCHED;
    LDB(B1, 0, 1); STAGE_B(SB(0, 0), bcol, t + 2);
    BAR; WAIT_L(0); MMA(0, 1, At, B1); BAR;
    LDA(At, 0, 1); STAGE_A(SA(0, 0), brow, t + 2);
    BAR; WAIT_L(0); MMA(1, 0, At, B0); BAR; SCHED;
    STAGE_B(SB(0, 1), bcol + 128, t + 2);
    WAIT_V(6); BAR; MMA(1, 1, At, B1); BAR;
    LDB(B0, 1, 0); SCHED; LDA(At, 1, 0); STAGE_A(SA(0, 1), brow + 128, t + 2);
    WAIT_L(8); BAR; WAIT_L(0); MMA(0, 0, At, B0); BAR; SCHED;
    LDB(B1, 1, 1); STAGE_B(SB(1, 0), bcol, t + 3);
    BAR; WAIT_L(0); MMA(0, 1, At, B1); BAR;
    LDA(At, 1, 1); STAGE_A(SA(1, 0), brow, t + 3);
    BAR; WAIT_L(0); MMA(1, 0, At, B0); BAR; SCHED;
    STAGE_B(SB(1, 1), bcol + 128, t + 3);
    WAIT_V(6); BAR; MMA(1, 1, At, B1); BAR;
  }
  { LDB(B0, 0, 0); LDA(At, 0, 0); STAGE_A(SA(1, 1), brow + 128, nt - 1);
    BAR; WAIT_L(0); MMA(0, 0, At, B0); BAR;
    LDB(B1, 0, 1); BAR; WAIT_L(0); MMA(0, 1, At, B1); BAR;
    LDA(At, 0, 1); WAIT_V(4); BAR; WAIT_L(0); MMA(1, 0, At, B0); MMA(1, 1, At, B1); BAR; }
  { LDB(B0, 1, 0); LDA(At, 1, 0); WAIT_V(2); BAR; WAIT_L(0); MMA(0, 0, At, B0); BAR;
    LDB(B1, 1, 1); WAIT_V(0); BAR; WAIT_L(0); MMA(0, 1, At, B1); BAR;
    LDA(At, 1, 1); BAR; WAIT_L(0); MMA(1, 0, At, B0); MMA(1, 1, At, B1); BAR; }
  if (wr == 0) BAR;
#undef SA
#undef SB
#undef STAGE_A
#undef STAGE_B
#undef LDA
#undef LDB
#undef MMA
}
DI void zero_acc(f32x4 (&acc)[2][2][4][2]) {
#pragma unroll
  for (int a = 0; a < 2; ++a)
#pragma unroll
    for (int b = 0; b < 2; ++b)
#pragma unroll
      for (int m = 0; m < 4; ++m)
#pragma unroll
        for (int n = 0; n < 2; ++n) acc[a][b][m][n] = (f32x4){0.f, 0.f, 0.f, 0.f};
}
template <class F> DI void tile_apply(const f32x4 (&acc)[2][2][4][2], int brow, int bcol, F f) {
  int t_ = threadIdx.x;
  asm volatile("" : "+v"(t_));
  const int wid = t_ >> 6, lane = t_ & 63, wr = wid >> 2, wc = wid & 3, fr = lane & 15, fq = lane >> 4;
#pragma unroll
  for (int ai = 0; ai < 2; ++ai)
#pragma unroll
    for (int m = 0; m < 4; ++m) {
      const int row = brow + ai * 128 + wr * 64 + m * 16 + fr;
#pragma unroll
      for (int bj = 0; bj < 2; ++bj)
#pragma unroll
        for (int n = 0; n < 2; ++n) f(row, bcol + bj * 128 + wc * 32 + n * 16 + 4 * fq, acc[ai][bj][m][n]);
      __builtin_amdgcn_sched_barrier(0);
    }
}
constexpr int TLD = 132;
template <class F> DI void tile_epilogue(const f32x4 (&acc)[2][2][4][2], int brow, int bcol, char* shm, F f) {
  int t_ = threadIdx.x;
  asm volatile("" : "+v"(t_));
  const int wid = t_ >> 6, lane = t_ & 63, wr = wid >> 2, wc = wid & 3, fr = lane & 15, fq = lane >> 4;
  float* T = (float*)shm;
#pragma unroll
  for (int bj = 0; bj < 2; ++bj) {
#pragma unroll
    for (int ai = 0; ai < 2; ++ai)
#pragma unroll
      for (int m = 0; m < 4; ++m)
#pragma unroll
        for (int n = 0; n < 2; ++n)
          *(f32x4*)(T + (ai * 128 + wr * 64 + m * 16 + fr) * TLD + wc * 32 + n * 16 + 4 * fq) = acc[ai][bj][m][n];
    __syncthreads();
    const int cg = (t_ & 31) * 4, r0 = t_ >> 5;
#pragma unroll 4
    for (int i = 0; i < 16; ++i) {
      const int rl = r0 + 16 * i;
      const f32x4 v = *(const f32x4*)(T + rl * TLD + cg);
      f(brow + rl, bcol + bj * 128 + cg, v);
    }
    __syncthreads();
  }
}
template <class F> DI void gemm_pass(const u16* A, int lda, const u16* Bt, int ldb, int N, int K, char* shm, F f) {
  const int nN = N >> 8, nunits = 64 * nN;
  for (int u = blockIdx.x; u < nunits; u += gridDim.x) {
    const int pm = u % 64, pn = u / 64;
    f32x4 acc[2][2][4][2];
    zero_acc(acc);
    gemm256(acc, A, lda, Bt, ldb, pm * 256, pn * 256, K, shm);
    tile_epilogue(acc, pm * 256, pn * 256, shm, f);
  }
}
template <int NTL, class CM, class E> DI void skinny(const u16* __restrict__ A, int lda, int row0, int nrows, const u16* __restrict__ Bt, int ldb, int K, CM cm, E epi) {
  int t_ = threadIdx.x;
  asm volatile("" : "+v"(t_));
  const int wid = t_ >> 6, lane = t_ & 63, fr = lane & 15, fq = lane >> 4;
  for (int mt = wid; mt * 16 < nrows; mt += 8) {
    int rr = mt * 16 + fr; const bool valid = rr < nrows; if (!valid) rr = nrows - 1;
    const u16* ap = A + (size_t)(row0 + rr) * lda + 8 * fq;
#pragma unroll
    for (int ntl = 0; ntl < NTL; ++ntl) {
      const u16* bp = Bt + (size_t)cm(ntl * 16 + fr) * ldb + 8 * fq;
      f32x4 acc = {0.f, 0.f, 0.f, 0.f};
#pragma unroll 16
      for (int ks = 0; ks < (K >> 5); ++ks) {
        const bf16x8 a = *(const bf16x8*)(ap + ks * 32);
        const bf16x8 b = *(const bf16x8*)(bp + ks * 32);
        acc = __builtin_amdgcn_mfma_f32_16x16x32_bf16(b, a, acc, 0, 0, 0);
      }
      if (valid) epi(row0 + rr, ntl, fq, acc, lane);
    }
  }
}
DI int map_in(int n) {
  if (n < 1024) { const int pn = n >> 8, c = n & 255; return c < 128 ? (pn * 128 + c) : (512 + pn * 128 + c - 128); }
  return n;
}
DI void phase_convert(const Params& p, char* smem) {
  float* tile = (float*)smem;
  const int tid = threadIdx.x;
  constexpr int NJ = 10;
  constexpr int pre[NJ + 1] = {0, 1024, 1280, 1536, 1792, 1920, 2176, 2432, 3456, 4480, 6016};
  for (int t = blockIdx.x; t < 6016; t += gridDim.x) {
    int j = 0, base = 0;
#pragma unroll
    for (int q = 1; q < NJ; ++q) if (t >= pre[q]) { j = q; base = pre[q]; }
    const int lt = t - base;
    const float* src; int ld, K; u16* dst; int moff = 0; int ldd = 0;
    switch (j) {
      case 0: src = p.w_in; ld = 7184; K = 1024; dst = (u16*)(p.ws + OFF_WIN); break;
      case 1: src = p.w_in; ld = 7184; K = 1024; dst = (u16*)(p.ws + OFF_WZ); moff = 4096; break;
      case 2: src = p.w_in; ld = 7184; K = 1024; dst = (u16*)(p.ws + OFF_WGA); moff = 5136; break;
      case 3: src = p.w_in; ld = 7184; K = 1024; dst = (u16*)(p.ws + OFF_WGB); moff = 6160; break;
      case 4: src = p.w_conf_out; ld = 1024; K = 512; dst = (u16*)(p.ws + OFF_WCONF); break;
      case 5: src = p.w_gdn_out; ld = 1024; K = 1024; dst = (u16*)(p.ws + OFF_WGDN); break;
      case 6: src = p.w_o; ld = 1024; K = 1024; dst = (u16*)(p.ws + OFF_WO); break;
      case 7: src = p.w_ff1; ld = 4096; K = 1024; dst = (u16*)(p.ws + OFF_W1); break;
      case 8: src = p.w_ff2; ld = 1024; K = 4096; dst = (u16*)(p.ws + OFF_W2); ldd = LDF; break;
      default: src = p.w_ada; ld = 6144; K = 1024; dst = (u16*)(p.ws + OFF_WADA); break;
    }
    const int nkt = K >> 6;
    const int n0 = (lt / nkt) * 64, k0 = (lt % nkt) * 64;
    {
      const int nn = tid & 63, ty = tid >> 6;
      const int sc = (j == 0) ? map_in(n0 + nn) : (n0 + nn + moff);
#pragma unroll
      for (int i = 0; i < 8; ++i) {
        const int kk = ty + 8 * i;
        tile[kk * 65 + nn] = __builtin_nontemporal_load(src + (size_t)(k0 + kk) * ld + sc);
      }
    }
    __syncthreads();
    {
      const int nn = tid >> 3, kq = (tid & 7) * 8;
      uint4 o0;
      const float* tp = tile + kq * 65 + nn;
      o0.x = pk2(tp[0 * 65], tp[1 * 65]);  o0.y = pk2(tp[2 * 65], tp[3 * 65]);
      o0.z = pk2(tp[4 * 65], tp[5 * 65]);  o0.w = pk2(tp[6 * 65], tp[7 * 65]);
      *(uint4*)(dst + (size_t)(n0 + nn) * (ldd ? ldd : K) + k0 + kq) = o0;
    }
    __syncthreads();
  }
  u16* Ac = (u16*)(p.ws + OFF_AC);
  for (int e = blockIdx.x * NT + tid; e < 256 * 256; e += gridDim.x * NT) {
    const int row = e >> 8, c4 = (e & 255) * 4;
    float4 v = make_float4(0.f, 0.f, 0.f, 0.f);
    if (row < 8) v = *(const float4*)(p.c_prompt + row * 1024 + c4);
    else if (row < 136) v = *(const float4*)(p.c_sample + (row - 8) * 1024 + c4);
    uint2 o; o.x = pk2(siluf_(v.x), siluf_(v.y)); o.y = pk2(siluf_(v.z), siluf_(v.w));
    *(uint2*)(Ac + row * 1024 + c4) = o;
  }
}

constexpr int WBA_LD = 1028;
template <bool BA> DI void phase_modnorm(const Params& p, const float* xa, const float* xb, const float* nw, int shift_off, int scale_off, u16* dst, char* smem) {
  int tmn = threadIdx.x;
  asm volatile("" : "+v"(tmn));
  const int lane = tmn & 63;
  const int gw = blockIdx.x * 8 + (tmn >> 6), nw_ = gridDim.x * 8;
  const float* mod = (const float*)(p.ws + OFF_MOD);
  float* wba = (float*)smem;
  if (BA) {
    for (int e = threadIdx.x; e < 16384; e += NT) { const int c = e >> 4, j = e & 15; wba[j * WBA_LD + c] = p.w_in[(size_t)c * 7184 + 5120 + j]; }
    __syncthreads();
  }
  float* gb = (float*)(p.ws + OFF_GB);
  for (int row = gw; row < R; row += nw_) {
    const float* xr = row < RP ? xa + (size_t)row * 1024 : xb + (size_t)(row - RP) * 1024;
    float4 v[4]; float ss = 0.f;
#pragma unroll
    for (int i = 0; i < 4; ++i) {
      { const f32x4 t4 = __builtin_nontemporal_load((const f32x4*)(xr + (lane + 64 * i) * 4)); v[i] = make_float4(t4[0], t4[1], t4[2], t4[3]); }
      ss += v[i].x * v[i].x + v[i].y * v[i].y + v[i].z * v[i].z + v[i].w * v[i].w; }
    ss = wsum(ss);
    const float rstd = rsqrtf(ss * (1.f / 1024.f) + EPS);
    const float* mr = mod + (size_t)mrow_of(row) * 6144;
    float ba[16];
    if (BA) {
#pragma unroll
      for (int j = 0; j < 16; ++j) ba[j] = 0.f;
    }
#pragma unroll
    for (int i = 0; i < 4; ++i) {
      const int c = (lane + 64 * i) * 4;
      const float4 w = *(const float4*)(nw + c), sc = *(const float4*)(mr + scale_off + c), sh = *(const float4*)(mr + shift_off + c);
      const float h0 = v[i].x * rstd * w.x * (1.f + sc.x) + sh.x, h1 = v[i].y * rstd * w.y * (1.f + sc.y) + sh.y;
      const float h2 = v[i].z * rstd * w.z * (1.f + sc.z) + sh.z, h3 = v[i].w * rstd * w.w * (1.f + sc.w) + sh.w;
      uint2 o; o.x = pk2(h0, h1); o.y = pk2(h2, h3);
      *(uint2*)(dst + (size_t)row * 1024 + c) = o;
      if (BA) {
#pragma unroll
        for (int j = 0; j < 16; ++j) { const float4 ww = *(const float4*)(wba + j * WBA_LD + c); ba[j] += h0 * ww.x + h1 * ww.y + h2 * ww.z + h3 * ww.w; }
        __builtin_amdgcn_sched_barrier(0);
      }
    }
    if (BA) {
#pragma unroll
      for (int w = 8; w >= 1; w >>= 1) {
        const bool up = (lane & w) != 0;
#pragma unroll
        for (int j = 0; j < w; ++j) {
          const float keep = up ? ba[j + w] : ba[j];
          const float send = up ? ba[j] : ba[j + w];
          ba[j] = keep + __shfl_xor(send, w, 64);
        }
      }
      float tot = ba[0];
      tot += __shfl_xor(tot, 16, 64); tot += __shfl_xor(tot, 32, 64);
      if (lane < 8) gb[(size_t)row * 16 + lane] = sigmoidf_(tot);
      else if (lane < 16) gb[(size_t)row * 16 + lane] = -__expf(p.a_log[lane - 8]) * softplusf_(tot + p.dt_bias[lane - 8]);
    }
  }
  if (BA) __syncthreads();
}

constexpr int LKN = 136, LKT = 72;
DI void d1_item(const Params& p, int item, char* smem) {
  int tid = threadIdx.x & 255;
  asm volatile("" : "+v"(tid));
  const int lane = tid & 63, wave = __builtin_amdgcn_readfirstlane(tid >> 6);
  const int r = lane & 31, hh = lane >> 5;
  const int h = item & 7, n = (item >> 3) & 31, b = item >> 8;
  const int rowbase = b * 2048 + n * 64;
  u16* kn  = (u16*)smem;
  u16* qn  = (u16*)(smem + 17408);
  u16* knT = (u16*)(smem + 34816);
  u16* vT  = (u16*)(smem + 53248);
  float* Gs = (float*)(smem + 71680);
  float* Bs = Gs + 64;
  float* Amat = (float*)(smem + 17408);
  u16* Tb = (u16*)smem;
  u16* Tg = (u16*)(smem + 17408);
  u16* qkv = (u16*)(p.ws + OFF_QKV);
  const u16* halo = (const u16*)(p.ws + OFF_HALO);
  const float* gb = (const float*)(p.ws + OFF_GB);

  if (wave == 0) {
    float g = gb[(size_t)(rowbase + lane) * 16 + 8 + h];
    const float be = gb[(size_t)(rowbase + lane) * 16 + h];
#pragma unroll
    for (int m = 1; m < 64; m <<= 1) { float t = __shfl_up(g, m, 64); if (lane >= m) g += t; }
    Gs[lane] = g; Bs[lane] = be;
  }
  {
    const int cp = lane;
#pragma unroll
    for (int X = 0; X < 3; ++X) {
      const int cb = X * 1024 + h * 128 + 2 * cp;
      float w[4][2];
#pragma unroll
      for (int j = 0; j < 4; ++j) { float2 t = *(const float2*)(p.gdn_conv_w + j * 3072 + cb); w[j][0] = t.x; w[j][1] = t.y; }
      float xw[3][2];
#pragma unroll
      for (int j = 0; j < 3; ++j) {
        const int rr = wave * 16 - 3 + j;
        unsigned u = 0u;
        if (rr >= 0) u = *(const unsigned*)(qkv + (size_t)(rowbase + rr) * 3072 + cb);
        else if (n > 0) u = *(const unsigned*)(halo + ((size_t)((b * 32 + n - 1) * 3 + (rr + 3))) * 3072 + cb);
        xw[j][0] = bf_lo(u); xw[j][1] = bf_hi(u);
      }
      float o[16][2];
#pragma unroll
      for (int t = 0; t < 16; ++t) {
        const unsigned u = *(const unsigned*)(qkv + (size_t)(rowbase + wave * 16 + t) * 3072 + cb);
        const float x0 = bf_lo(u), x1 = bf_hi(u);
        const float a0 = w[0][0] * xw[0][0] + w[1][0] * xw[1][0] + w[2][0] * xw[2][0] + w[3][0] * x0;
        const float a1 = w[0][1] * xw[0][1] + w[1][1] * xw[1][1] + w[2][1] * xw[2][1] + w[3][1] * x1;
        o[t][0] = siluf_(a0); o[t][1] = siluf_(a1);
        xw[0][0] = xw[1][0]; xw[0][1] = xw[1][1]; xw[1][0] = xw[2][0]; xw[1][1] = xw[2][1]; xw[2][0] = x0; xw[2][1] = x1;
      }
      if (X < 2) {
#pragma unroll
        for (int t = 0; t < 16; ++t) {
          const float ss = wsum(o[t][0] * o[t][0] + o[t][1] * o[t][1]);
          const float rs = rsqrtf(ss + EPS);
          o[t][0] *= rs; o[t][1] *= rs;
        }
      }
#pragma unroll
      for (int t = 0; t < 16; ++t) {
        const int row = wave * 16 + t;
        const unsigned pk = pk2(o[t][0], o[t][1]);
        if (X == 0) { *(unsigned*)(qn + row * LKN + 2 * cp) = pk; }
        else if (X == 1) {
          *(unsigned*)(kn + row * LKN + 2 * cp) = pk;
          knT[(2 * cp) * LKT + row] = (u16)(pk & 0xffffu); knT[(2 * cp + 1) * LKT + row] = (u16)(pk >> 16);
        } else {
          vT[(2 * cp) * LKT + row] = (u16)(pk & 0xffffu); vT[(2 * cp + 1) * LKT + row] = (u16)(pk >> 16);
        }
      }
    }
  }
  __syncthreads();
  const float Glast = Gs[63];
#pragma unroll
  for (int ff = 0; ff < 4; ++ff) {
    const int f = wave * 4 + ff;
    const int it = f >> 3, kb = (f >> 1) & 3, s = f & 1;
    const int i = it * 32 + r;
    const float sc = QSCALE * __expf(Gs[i]);
    const uint2 a = *(const uint2*)(qn + i * LKN + kb * 32 + 16 * s + 4 * hh);
    const uint2 c = *(const uint2*)(qn + i * LKN + kb * 32 + 16 * s + 4 * hh + 8);
    uint4 o;
    o.x = pk2(bf_lo(a.x) * sc, bf_hi(a.x) * sc); o.y = pk2(bf_lo(a.y) * sc, bf_hi(a.y) * sc);
    o.z = pk2(bf_lo(c.x) * sc, bf_hi(c.x) * sc); o.w = pk2(bf_lo(c.y) * sc, bf_hi(c.y) * sc);
    *(uint4*)((char*)qkv + (size_t)(rowbase + 4 * f + (lane >> 4)) * 6144 + h * 256 + (lane & 15) * 16) = o;
  }
  char* ext = p.ws + OFF_EXTRA + (size_t)item * 24576;
#pragma unroll
  for (int ff = 0; ff < 4; ++ff) {
    const int f = wave * 4 + ff;
    const int kt = f >> 2, pb = (f >> 1) & 1, s = f & 1;
    const int k = kt * 32 + r;
    const int p0 = pb * 32 + 16 * s + 4 * hh;
    const uint2 a = *(const uint2*)(knT + k * LKT + p0);
    const uint2 c = *(const uint2*)(knT + k * LKT + p0 + 8);
    const float4 g0 = *(const float4*)(Gs + p0), g1 = *(const float4*)(Gs + p0 + 8);
    uint4 o;
    o.x = pk2(bf_lo(a.x) * __expf(Glast - g0.x), bf_hi(a.x) * __expf(Glast - g0.y));
    o.y = pk2(bf_lo(a.y) * __expf(Glast - g0.z), bf_hi(a.y) * __expf(Glast - g0.w));
    o.z = pk2(bf_lo(c.x) * __expf(Glast - g1.x), bf_hi(c.x) * __expf(Glast - g1.y));
    o.w = pk2(bf_lo(c.y) * __expf(Glast - g1.z), bf_hi(c.y) * __expf(Glast - g1.w));
    *(uint4*)(ext + f * 1024 + lane * 16) = o;
  }
  f32x16 akk = zero16(), aqk = zero16();
  const int ta = (wave == 0) ? 0 : 1, tb = (wave == 2) ? 1 : 0;
  if (wave < 3) {
#pragma unroll
    for (int ks = 0; ks < 8; ++ks) {
      const bf16x8 fa = *(const bf16x8*)(kn + (ta * 32 + r) * LKN + ks * 16 + 8 * hh);
      const bf16x8 fb = *(const bf16x8*)(kn + (tb * 32 + r) * LKN + ks * 16 + 8 * hh);
      const bf16x8 fq = *(const bf16x8*)(qn + (ta * 32 + r) * LKN + ks * 16 + 8 * hh);
      akk = MFMA(fa, fb, akk);
      aqk = MFMA(fb, fq, aqk);
    }
  }
  __syncthreads();
  if (wave < 3) {
    const int m = tb * 32 + r; const float Gm = Gs[m];
#pragma unroll
    for (int reg = 0; reg < 16; ++reg) {
      const int i = ta * 32 + crow(reg, hh);
      const float v = (m < i) ? Bs[i] * akk[reg] * __expf(Gs[i] - Gm) : 0.f;
      Amat[i * 64 + m] = v;
    }
    const int i = ta * 32 + r; const float Gi = Gs[i];
    f32x16 av;
#pragma unroll
    for (int reg = 0; reg < 16; ++reg) {
      const int j = tb * 32 + crow(reg, hh);
      av[reg] = (j <= i) ? aqk[reg] * QSCALE * __expf(Gi - Gs[j]) : 0.f;
    }
    const int fbase = 16 + (wave * 2);
#pragma unroll
    for (int s = 0; s < 2; ++s) {
      bf16x8 fr8 = pack8(av, s);
      *(bf16x8*)(ext + (fbase + s) * 1024 + lane * 16) = fr8;
    }
  } else {
    for (int e = lane; e < 32 * 32; e += 64) Amat[(e >> 5) * 64 + 32 + (e & 31)] = 0.f;
    if (lane == 0) *(float*)(ext + 22 * 1024) = __expf(Glast);
  }
  __syncthreads();
  float* Tq = (float*)(smem + 9216);
  if (wave == 0) {
    float x[32];
    const int c = lane & 31, hb = lane >> 5;
    const float* Ab = Amat + (hb * 32) * 64 + hb * 32;
#pragma unroll
    for (int i = 0; i < 32; ++i) {
      float s0 = (c == i) ? 1.f : 0.f, s1 = 0.f;
#pragma unroll
      for (int m4 = 0; m4 < (i + 3) / 4; ++m4) {
        const float4 a4 = *(const float4*)(Ab + i * 64 + m4 * 4);
        if (m4 * 4 + 0 < i) s0 -= a4.x * x[m4 * 4 + 0];
        if (m4 * 4 + 1 < i) s1 -= a4.y * x[m4 * 4 + 1];
        if (m4 * 4 + 2 < i) s0 -= a4.z * x[m4 * 4 + 2];
        if (m4 * 4 + 3 < i) s1 -= a4.w * x[m4 * 4 + 3];
      }
      x[i] = s0 + s1;
      __builtin_amdgcn_sched_barrier(0);
    }
#pragma unroll
    for (int i = 0; i < 32; ++i) Tq[hb * 1024 + i * 32 + c] = x[i];
  }
  __syncthreads();
  const int c32 = tid & 31, g8 = tid >> 5;
  {
    float bm[4] = {0.f, 0.f, 0.f, 0.f};
#pragma unroll
    for (int j4 = 0; j4 < 8; ++j4) {
      float t[4];
#pragma unroll
      for (int e = 0; e < 4; ++e) t[e] = Tq[(j4 * 4 + e) * 32 + c32];
#pragma unroll
      for (int e = 0; e < 4; ++e) {
        const float4 a4 = *(const float4*)(Amat + (32 + g8 * 4 + e) * 64 + j4 * 4);
        bm[e] += a4.x * t[0] + a4.y * t[1] + a4.z * t[2] + a4.w * t[3];
      }
    }
#pragma unroll
    for (int e = 0; e < 4; ++e) Amat[(g8 * 4 + e) * 64 + 32 + c32] = bm[e];
  }
  __syncthreads();
  float t21[4] = {0.f, 0.f, 0.f, 0.f};
  {
#pragma unroll
    for (int m4 = 0; m4 < 8; ++m4) {
      float bv[4];
#pragma unroll
      for (int e = 0; e < 4; ++e) bv[e] = Amat[(m4 * 4 + e) * 64 + 32 + c32];
#pragma unroll
      for (int e = 0; e < 4; ++e) {
        const float4 a4 = *(const float4*)(Tq + 1024 + (g8 * 4 + e) * 32 + m4 * 4);
        t21[e] -= a4.x * bv[0] + a4.y * bv[1] + a4.z * bv[2] + a4.w * bv[3];
      }
    }
  }
  float t11[4], t22[4];
#pragma unroll
  for (int e = 0; e < 4; ++e) { t11[e] = Tq[(g8 * 4 + e) * 32 + c32]; t22[e] = Tq[1024 + (g8 * 4 + e) * 32 + c32]; }
  const float bcl = Bs[c32], bgl = bcl * __expf(Gs[c32]);
  const float bch = Bs[32 + c32], bgh = bch * __expf(Gs[32 + c32]);
  __syncthreads();
#pragma unroll
  for (int e = 0; e < 4; ++e) {
    const int i = g8 * 4 + e;
    Tb[i * LKT + c32] = f2bf(t11[e] * bcl);               Tg[i * LKT + c32] = f2bf(t11[e] * bgl);
    Tb[i * LKT + 32 + c32] = (u16)0;                      Tg[i * LKT + 32 + c32] = (u16)0;
    Tb[(32 + i) * LKT + c32] = f2bf(t21[e] * bcl);        Tg[(32 + i) * LKT + c32] = f2bf(t21[e] * bgl);
    Tb[(32 + i) * LKT + 32 + c32] = f2bf(t22[e] * bch);   Tg[(32 + i) * LKT + 32 + c32] = f2bf(t22[e] * bgh);
  }
  __syncthreads();
#pragma unroll
  for (int it = 0; it < 2; ++it) {
    f32x16 av = zero16(), ak = zero16();
#pragma unroll
    for (int ks = 0; ks < 4; ++ks) {
      const bf16x8 fT = *(const bf16x8*)(Tb + (it * 32 + r) * LKT + ks * 16 + 8 * hh);
      const bf16x8 fV = *(const bf16x8*)(vT + (wave * 32 + r) * LKT + ks * 16 + 8 * hh);
      const bf16x8 fK = *(const bf16x8*)(knT + (wave * 32 + r) * LKT + ks * 16 + 8 * hh);
      const bf16x8 fG = *(const bf16x8*)(Tg + (it * 32 + r) * LKT + ks * 16 + 8 * hh);
      av = MFMA(fT, fV, av);
      ak = MFMA(fK, fG, ak);
    }
    {
      const int fv = wave * 2 + it;
      char* d = (char*)qkv + (size_t)(rowbase + 8 * fv + (lane >> 3)) * 6144 + 4096 + h * 256 + (lane & 7) * 32;
      *(bf16x8*)d = pack8(av, 0); *(bf16x8*)(d + 16) = pack8(av, 1);
    }
#pragma unroll
    for (int s = 0; s < 2; ++s) {
      const int f = it * 8 + wave * 2 + s;
      *(bf16x8*)((char*)qkv + (size_t)(rowbase + 4 * f + (lane >> 4)) * 6144 + 2048 + h * 256 + (lane & 15) * 16) = pack8(ak, s);
    }
  }
  __syncthreads();
}

DI void d2_issue(u32x4 (&rg)[18], const Params& p, int b, int h, int lt, int n) {
  const char* qseg = p.ws + OFF_QKV + (size_t)(b * 2048 + n * 64) * 6144 + h * 256;
  const char* ext = p.ws + OFF_EXTRA + (size_t)((b * 32 + n) * 8 + h) * 24576;
#pragma unroll
  for (int sg = 0; sg < 3; ++sg)
#pragma unroll
    for (int i = 0; i < 4; ++i) rg[sg * 4 + i] = __builtin_nontemporal_load((const u32x4*)(qseg + (size_t)((lt >> 4) + 16 * i) * 6144 + sg * 2048 + (lt & 15) * 16));
#pragma unroll
  for (int i = 0; i < 6; ++i) rg[12 + i] = __builtin_nontemporal_load((const u32x4*)(ext + lt * 16 + i * 4096));
}
DI void d2_put(const u32x4 (&rg)[18], char* buf, int lt) {
#pragma unroll
  for (int sg = 0; sg < 3; ++sg)
#pragma unroll
    for (int i = 0; i < 4; ++i) *(u32x4*)(buf + sg * 16384 + ((lt >> 4) + 16 * i) * 256 + (lt & 15) * 16) = rg[sg * 4 + i];
#pragma unroll
  for (int i = 0; i < 6; ++i) *(u32x4*)(buf + 49152 + lt * 16 + i * 4096) = rg[12 + i];
}
DI void d2_block(const Params& p, int unit, char* smem) {
  const int tid = threadIdx.x, half = tid >> 8, lt = tid & 255, lane = tid & 63, wave = (tid >> 6) & 3;
  const int r = lane & 31, hh = lane >> 5;
  const int b = unit >> 3, h = unit & 7;
  const char* qkv = p.ws + OFF_QKV;
  const float* egl = (const float*)(p.ws + OFF_EGL);
  u16* obuf = (u16*)((char*)p.out + (size_t)R * 1024 * 2);
  if (half == 1) {
    u32x4 rg0[18], rg1[18];
    u32x4 og[4], sg4;
    u16* obuf_ = (u16*)((char*)p.out + (size_t)R * 1024 * 2);
    float* ssq_ = (float*)(p.ws + OFF_SSQ);
    const int orow = lt >> 2, opos = lt & 3, ocol = 8 * (opos ^ ((orow >> 1) & 3));
    d2_issue(rg0, p, b, h, lt, 0); d2_put(rg0, smem, lt); d2_issue(rg1, p, b, h, lt, 1); d2_issue(rg0, p, b, h, lt, 2);
    __syncthreads();
#define D2_LOADER_STEP(n_, RG)                                                                                              \
    {                                                                                                                        \
      const int n = (n_);                                                                                                    \
      char* ob = smem + ((n + 1) & 1) * HALF_SMEM;                                                                           \
      if (n >= 1) {                                                                                                          \
        _Pragma("unroll") for (int i = 0; i < 4; ++i) og[i] = *(const u32x4*)(ob + 32768 + (lt + 256 * i) * 16);            \
        if (lt >= 192) sg4 = *(const u32x4*)(ob + 49152 + 20480 + lt * 16);                                                  \
      }                                                                                                                      \
      if (n + 1 < 32) { d2_put(RG, ob, lt); if (n + 3 < 32) d2_issue(RG, p, b, h, lt, n + 3); }                              \
      if (n >= 1) {                                                                                                          \
        const int rowbase = b * 2048 + (n - 1) * 64;                                                                         \
        _Pragma("unroll") for (int i = 0; i < 4; ++i)                                                                        \
          *(u32x4*)(obuf_ + (size_t)(rowbase + orow) * 1024 + h * 128 + 32 * i + ocol) = og[i];                              \
        if (lt >= 192) *(u32x4*)(ssq_ + ((size_t)(rowbase + lt - 192) * 8 + h) * 4) = sg4;                                   \
      }                                                                                                                      \
      if (n < 32) { asm volatile("s_waitcnt lgkmcnt(0)" ::: "memory"); __builtin_amdgcn_s_barrier(); asm volatile("" ::: "memory"); } \
    }
#pragma unroll 1
    for (int n2 = 0; n2 <= 32; n2 += 2) {
      D2_LOADER_STEP(n2, rg1)
      if (n2 + 1 <= 32) D2_LOADER_STEP(n2 + 1, rg0)
    }
#undef D2_LOADER_STEP
    return;
  }
  f32x16 S[4];
#pragma unroll
  for (int k = 0; k < 4; ++k) S[k] = zero16();
  const unsigned voff_l = (unsigned)(lane * 16);
  bf16x8 If0, If1;
#pragma unroll
  for (int j = 0; j < 8; ++j) {
    const int k0 = 8 * (j >> 2) + 4 * hh + (j & 3);
    If0[j] = (short)((k0 == r) ? 0x3F80 : 0); If1[j] = (short)((16 + k0 == r) ? 0x3F80 : 0);
  }
  const unsigned voff_v = (unsigned)((16 * wave + (lane >> 3)) * 256 + (lane & 7) * 32);
  __syncthreads();
#pragma unroll 1
  for (int n = 0; n < 32; ++n) {
    const int item = (b * 32 + n) * 8 + h;
    const int rowbase = b * 2048 + n * 64;
    const char* buf = smem + (n & 1) * HALF_SMEM;
    const char* ext = buf + 49152;
    const float eg = *(const float*)(ext + 22 * 1024);
    bf16x8 fk[16];
#pragma unroll
    for (int f = 0; f < 16; ++f) fk[f] = *(const bf16x8*)(buf + 16384 + f * 1024 + voff_l);
    uint4 vv[2][2];
#pragma unroll
    for (int it = 0; it < 2; ++it) { const char* d = buf + 32768 + it * 2048 + voff_v; vv[it][0] = *(const uint4*)d; vv[it][1] = *(const uint4*)(d + 16); }
    bf16x8 Sf[4][2];
#pragma unroll
    for (int kb = 0; kb < 4; ++kb) { Sf[kb][0] = pack8(S[kb], 0); Sf[kb][1] = pack8(S[kb], 1); }
    __builtin_amdgcn_sched_barrier(0);
    f32x16 P1[2];
    P1[0] = zero16(); P1[1] = zero16();
#pragma unroll
    for (int kb = 0; kb < 4; ++kb)
#pragma unroll
      for (int s = 0; s < 2; ++s) {
        P1[0] = MFMA(fk[kb * 2 + s], Sf[kb][s], P1[0]);
        P1[1] = MFMA(fk[8 + kb * 2 + s], Sf[kb][s], P1[1]);
      }
    bf16x8 fq[8];
#pragma unroll
    for (int f = 0; f < 8; ++f) fq[f] = *(const bf16x8*)(buf + f * 1024 + voff_l);
    bf16x8 Vf[2][2];
#pragma unroll
    for (int it = 0; it < 2; ++it) {
      const uint4 v0 = vv[it][0], v1 = vv[it][1];
      f32x16 vn;
      vn[0] = bf_lo(v0.x) - P1[it][0];  vn[1] = bf_hi(v0.x) - P1[it][1];
      vn[2] = bf_lo(v0.y) - P1[it][2];  vn[3] = bf_hi(v0.y) - P1[it][3];
      vn[4] = bf_lo(v0.z) - P1[it][4];  vn[5] = bf_hi(v0.z) - P1[it][5];
      vn[6] = bf_lo(v0.w) - P1[it][6];  vn[7] = bf_hi(v0.w) - P1[it][7];
      vn[8] = bf_lo(v1.x) - P1[it][8];  vn[9] = bf_hi(v1.x) - P1[it][9];
      vn[10] = bf_lo(v1.y) - P1[it][10]; vn[11] = bf_hi(v1.y) - P1[it][11];
      vn[12] = bf_lo(v1.z) - P1[it][12]; vn[13] = bf_hi(v1.z) - P1[it][13];
      vn[14] = bf_lo(v1.w) - P1[it][14]; vn[15] = bf_hi(v1.w) - P1[it][15];
      Vf[it][0] = pack8(vn, 0); Vf[it][1] = pack8(vn, 1);
    }
    bf16x8 fa[6];
#pragma unroll
    for (int i = 0; i < 6; ++i) fa[i] = *(const bf16x8*)(ext + (16 + i) * 1024 + voff_l);
    f32x16 P2[2];
    P2[0] = zero16(); P2[1] = zero16();
#pragma unroll
    for (int kb = 0; kb < 4; ++kb)
#pragma unroll
      for (int s = 0; s < 2; ++s) {
        P2[0] = MFMA(fq[kb * 2 + s], Sf[kb][s], P2[0]);
        const bf16x8 fq1 = *(const bf16x8*)(buf + (8 + kb * 2 + s) * 1024 + voff_l);
        P2[1] = MFMA(fq1, Sf[kb][s], P2[1]);
      }
    __builtin_amdgcn_sched_barrier(0);
    bf16x8 fkd[16];
#pragma unroll
    for (int i = 0; i < 16; ++i) fkd[i] = *(const bf16x8*)(ext + i * 1024 + voff_l);
#pragma unroll
    for (int s = 0; s < 2; ++s) {
      P2[0] = MFMA(fa[0 + s], Vf[0][s], P2[0]);
      P2[1] = MFMA(fa[2 + s], Vf[0][s], P2[1]);
      P2[1] = MFMA(fa[4 + s], Vf[1][s], P2[1]);
    }
    {
      char* ow = (char*)buf + 32768 + wave * 4096;
      float* sqw = (float*)((char*)buf + 49152 + 23 * 1024);
      const int xs = (r >> 1) & 3;
#pragma unroll
      for (int it = 0; it < 2; ++it) {
        f32x16 Z = MFMA(pack8(P2[it], 0), If0, zero16());
        Z = MFMA(pack8(P2[it], 1), If1, Z);
        float ssl = 0.f;
#pragma unroll
        for (int reg = 0; reg < 16; ++reg) ssl += Z[reg] * Z[reg];
        ssl += __shfl_xor(ssl, 32, 64);
        if (hh == 0) sqw[(it * 32 + r) * 4 + wave] = ssl;
#pragma unroll
        for (int g = 0; g < 4; ++g) {
          uint2 pv; pv.x = pk2(Z[4 * g], Z[4 * g + 1]); pv.y = pk2(Z[4 * g + 2], Z[4 * g + 3]);
          *(uint2*)(ow + (it * 32 + r) * 64 + ((g ^ xs) * 16) + hh * 8) = pv;
        }
      }
    }
#pragma unroll
    for (int kt = 0; kt < 4; ++kt) {
#pragma unroll
      for (int reg = 0; reg < 16; ++reg) S[kt][reg] *= eg;
#pragma unroll
      for (int pb = 0; pb < 2; ++pb)
#pragma unroll
        for (int s = 0; s < 2; ++s) {
          S[kt] = MFMA(fkd[kt * 4 + pb * 2 + s], Vf[pb][s], S[kt]);
        }
    }
    asm volatile("s_waitcnt lgkmcnt(0)" ::: "memory"); __builtin_amdgcn_s_barrier(); asm volatile("" ::: "memory");
  }
  float* od = p.out + OUT_DELTAP + (size_t)(b * 8 + h) * 16384;
#pragma unroll
  for (int kt = 0; kt < 4; ++kt)
#pragma unroll
    for (int reg = 0; reg < 16; ++reg) od[(kt * 32 + crow(reg, hh)) * 128 + wave * 32 + r] = S[kt][reg];
}

DI void conf_prompt_item(const Params& p, int item, char* smem) {
  const int tid = threadIdx.x & 255, lane = tid & 63, wave = tid >> 6;
  const int b = item >> 6, t0 = (item & 63) * 32;
  unsigned* tile = (unsigned*)smem;
  float* red = (float*)(smem + 63488);
  const u16* glu = (const u16*)(p.ws + OFF_GLU);
  u16* aact = (u16*)(p.ws + OFF_AACT);
#pragma unroll 1
  for (int hb = 0; hb < 2; ++hb) {
    u32x4 fv[8];
#pragma unroll
    for (int i = 0; i < 8; ++i) {
      const int e = tid + 256 * (hb * 8 + i), rr = e >> 6, c8 = (e & 63) * 8;
      const int t = t0 - 30 + rr;
      fv[i] = (u32x4){0u, 0u, 0u, 0u};
      if (rr < 62 && t >= 0) fv[i] = *(const u32x4*)(glu + (size_t)(b * 2048 + t) * 512 + c8);
    }
#pragma unroll
    for (int i = 0; i < 8; ++i) {
      const int e = tid + 256 * (hb * 8 + i), rr = e >> 6, c8 = (e & 63) * 8;
      if (rr < 62) *(u32x4*)(tile + rr * 256 + (c8 >> 1)) = fv[i];
    }
  }
  float w[31][2];
#pragma unroll
  for (int j = 0; j < 31; ++j) { const float2 t = *(const float2*)(p.conf_dw_w + j * 512 + 2 * tid); w[j][0] = t.x; w[j][1] = t.y; }
  const float2 bias = *(const float2*)(p.conf_dw_b + 2 * tid);
  const float2 lw = *(const float2*)(p.conf_ln_w + 2 * tid), lb = *(const float2*)(p.conf_ln_b + 2 * tid);
  __syncthreads();
#pragma unroll 1
  for (int tg = 0; tg < 4; ++tg) {
    float a[8][2];
#pragma unroll
    for (int t = 0; t < 8; ++t) { a[t][0] = bias.x; a[t][1] = bias.y; }
#pragma unroll
    for (int i = 0; i < 38; ++i) {
      const unsigned u = tile[(tg * 8 + i) * 256 + tid];
      const float x0 = bf_lo(u), x1 = bf_hi(u);
#pragma unroll
      for (int t = 0; t < 8; ++t) {
        const int j = i - t;
        if (j >= 0 && j < 31) { a[t][0] += w[j][0] * x0; a[t][1] += w[j][1] * x1; }
      }
    }
#pragma unroll
    for (int t = 0; t < 8; ++t) {
      const float s1 = wsum(a[t][0] + a[t][1]);
      const float s2 = wsum(a[t][0] * a[t][0] + a[t][1] * a[t][1]);
      if (lane == 0) { red[(wave * 8 + t) * 2] = s1; red[(wave * 8 + t) * 2 + 1] = s2; }
    }
    __syncthreads();
#pragma unroll
    for (int t = 0; t < 8; ++t) {
      const float s1 = red[t * 2] + red[(8 + t) * 2] + red[(16 + t) * 2] + red[(24 + t) * 2];
      const float s2 = red[t * 2 + 1] + red[(8 + t) * 2 + 1] + red[(16 + t) * 2 + 1] + red[(24 + t) * 2 + 1];
      const float mu = s1 * (1.f / 512.f);
      const float var = fmaxf(s2 * (1.f / 512.f) - mu * mu, 0.f);
      const float rs = rsqrtf(var + EPS);
      const float y0 = (a[t][0] - mu) * rs * lw.x + lb.x, y1 = (a[t][1] - mu) * rs * lw.y + lb.y;
      *(unsigned*)(aact + (size_t)(b * 2048 + t0 + tg * 8 + t) * 512 + 2 * tid) = pk2(siluf_(y0), siluf_(y1));
    }
    __syncthreads();
  }
}
DI void conf_sample_item(const Params& p, int item) {
  const int lane = threadIdx.x & 63, wave = (threadIdx.x >> 6) & 3;
  const int s = item * 4 + wave;
  const int c = lane * 8;
  const u16* glu = (const u16*)(p.ws + OFF_GLU);
  u16* aact = (u16*)(p.ws + OFF_AACT);
  float a[8];
  {
    const float4 b0 = *(const float4*)(p.conf_dw_b + c), b1 = *(const float4*)(p.conf_dw_b + c + 4);
    a[0] = b0.x; a[1] = b0.y; a[2] = b0.z; a[3] = b0.w; a[4] = b1.x; a[5] = b1.y; a[6] = b1.z; a[7] = b1.w;
  }
  const float* st = p.st_conf + (size_t)s * 30 * 512;
  float* oc = p.out + OUT_CONFS + (size_t)s * 30 * 512;
#pragma unroll 1
  for (int j = 0; j < 30; ++j) {
    const f32x4 n0 = __builtin_nontemporal_load((const f32x4*)(st + j * 512 + c)), n1 = __builtin_nontemporal_load((const f32x4*)(st + j * 512 + c + 4));
    const float4 x0 = make_float4(n0[0], n0[1], n0[2], n0[3]), x1 = make_float4(n1[0], n1[1], n1[2], n1[3]);
    const float4 w0 = *(const float4*)(p.conf_dw_w + j * 512 + c), w1 = *(const float4*)(p.conf_dw_w + j * 512 + c + 4);
    a[0] += w0.x * x0.x; a[1] += w0.y * x0.y; a[2] += w0.z * x0.z; a[3] += w0.w * x0.w;
    a[4] += w1.x * x1.x; a[5] += w1.y * x1.y; a[6] += w1.z * x1.z; a[7] += w1.w * x1.w;
    if (j >= 1) { __builtin_nontemporal_store(n0, (f32x4*)(oc + (j - 1) * 512 + c)); __builtin_nontemporal_store(n1, (f32x4*)(oc + (j - 1) * 512 + c + 4)); }
  }
  {
    const uint4 g = *(const uint4*)(glu + (size_t)(RP + s) * 512 + c);
    const float4 w0 = *(const float4*)(p.conf_dw_w + 30 * 512 + c), w1 = *(const float4*)(p.conf_dw_w + 30 * 512 + c + 4);
    a[0] += w0.x * bf_lo(g.x); a[1] += w0.y * bf_hi(g.x); a[2] += w0.z * bf_lo(g.y); a[3] += w0.w * bf_hi(g.y);
    a[4] += w1.x * bf_lo(g.z); a[5] += w1.y * bf_hi(g.z); a[6] += w1.z * bf_lo(g.w); a[7] += w1.w * bf_hi(g.w);
  }
  float s1 = 0.f, s2 = 0.f;
#pragma unroll
  for (int i = 0; i < 8; ++i) { s1 += a[i]; s2 += a[i] * a[i]; }
  s1 = wsum(s1); s2 = wsum(s2);
  const float mu = s1 * (1.f / 512.f);
  const float rs = rsqrtf(fmaxf(s2 * (1.f / 512.f) - mu * mu, 0.f) + EPS);
  float y[8];
#pragma unroll
  for (int i = 0; i < 8; ++i) y[i] = siluf_((a[i] - mu) * rs * p.conf_ln_w[c + i] + p.conf_ln_b[c + i]);
  uint4 o; o.x = pk2(y[0], y[1]); o.y = pk2(y[2], y[3]); o.z = pk2(y[4], y[5]); o.w = pk2(y[6], y[7]);
  *(uint4*)(aact + (size_t)(RP + s) * 512 + c) = o;
}
DI void delta_sample_item(const Params& p, int item, char* smem) {
  const int tid = threadIdx.x & 255, lane = tid & 63, wave = tid >> 6;
  const int s = item >> 3, h = item & 7;
  float* qs = (float*)smem; float* ks = qs + 128; float* vs = ks + 128; float* part = vs + 128;
  float* red = part + 768;
  const u16* qkv = (const u16*)(p.ws + OFF_QKV);
  const float* gb = (const float*)(p.ws + OFF_GB);
  const int row = RP + s;
  const int v = tid & 127, kh = tid >> 7;
  const float* S0 = p.st_delta + (size_t)(s * 8 + h) * 16384 + (size_t)(kh * 64) * 128 + v;
  float Sr[64];
#pragma unroll
  for (int kk = 0; kk < 64; ++kk) Sr[kk] = __builtin_nontemporal_load(S0 + kk * 128);
  const float g = gb[(size_t)row * 16 + 8 + h], beta = gb[(size_t)row * 16 + h];
  float cq = 0.f, ck = 0.f, cv = 0.f;
  if (tid < 128) {
    float cx[3];
#pragma unroll
    for (int X = 0; X < 3; ++X) {
      const int cg = X * 1024 + h * 128 + tid;
      const float s0 = p.st_qkv[(size_t)(s * 3 + 0) * 3072 + cg], s1 = p.st_qkv[(size_t)(s * 3 + 1) * 3072 + cg], s2 = p.st_qkv[(size_t)(s * 3 + 2) * 3072 + cg];
      const float x = bf1(qkv[(size_t)row * 3072 + cg]);
      const float a = p.gdn_conv_w[cg] * s0 + p.gdn_conv_w[3072 + cg] * s1 + p.gdn_conv_w[2 * 3072 + cg] * s2 + p.gdn_conv_w[3 * 3072 + cg] * x;
      cx[X] = siluf_(a);
      p.out[OUT_QKVS + (size_t)(s * 3 + 0) * 3072 + cg] = s1;
      p.out[OUT_QKVS + (size_t)(s * 3 + 1) * 3072 + cg] = s2;
    }
    cq = cx[0]; ck = cx[1]; cv = cx[2];
  }
  {
    const float sq = wsum(cq * cq), sk = wsum(ck * ck);
    if (lane == 0) { red[wave * 2] = sq; red[wave * 2 + 1] = sk; }
  }
  __syncthreads();
  if (tid < 128) {
    const float rq = rsqrtf(red[0] + red[2] + EPS), rk = rsqrtf(red[1] + red[3] + EPS);
    qs[tid] = cq * rq * QSCALE; ks[tid] = ck * rk; vs[tid] = cv;
  }
  __syncthreads();
  const float eg = __expf(g);
  float kS = 0.f, qS = 0.f, qk = 0.f;
#pragma unroll
  for (int k4 = 0; k4 < 16; ++k4) {
    const float4 kv = *(const float4*)(ks + kh * 64 + k4 * 4), qv = *(const float4*)(qs + kh * 64 + k4 * 4);
    kS += kv.x * Sr[4 * k4] + kv.y * Sr[4 * k4 + 1] + kv.z * Sr[4 * k4 + 2] + kv.w * Sr[4 * k4 + 3];
    qS += qv.x * Sr[4 * k4] + qv.y * Sr[4 * k4 + 1] + qv.z * Sr[4 * k4 + 2] + qv.w * Sr[4 * k4 + 3];
    qk += kv.x * qv.x + kv.y * qv.y + kv.z * qv.z + kv.w * qv.w;
  }
  part[(kh * 3 + 0) * 128 + v] = kS; part[(kh * 3 + 1) * 128 + v] = qS; part[(kh * 3 + 2) * 128 + v] = qk;
  __syncthreads();
  kS = part[0 * 128 + v] + part[3 * 128 + v];
  qS = part[1 * 128 + v] + part[4 * 128 + v];
  qk = part[2 * 128 + v] + part[5 * 128 + v];
  const float vnew = vs[v] * beta - beta * eg * kS;
  const float o = eg * qS + qk * vnew;
  float* Sd = p.out + OUT_DELTAS + (size_t)(s * 8 + h) * 16384 + (size_t)(kh * 64) * 128 + v;
#pragma unroll
  for (int k4 = 0; k4 < 16; ++k4) {
    const float4 kv = *(const float4*)(ks + kh * 64 + k4 * 4);
    __builtin_nontemporal_store(Sr[4 * k4 + 0] * eg + kv.x * vnew, Sd + (4 * k4 + 0) * 128);
    __builtin_nontemporal_store(Sr[4 * k4 + 1] * eg + kv.y * vnew, Sd + (4 * k4 + 1) * 128);
    __builtin_nontemporal_store(Sr[4 * k4 + 2] * eg + kv.z * vnew, Sd + (4 * k4 + 2) * 128);
    __builtin_nontemporal_store(Sr[4 * k4 + 3] * eg + kv.w * vnew, Sd + (4 * k4 + 3) * 128);
  }
  if (kh == 0) {
    ((u16*)((char*)p.out + (size_t)R * 1024 * 2))[(size_t)row * 1024 + h * 128 + v] = f2bf(o);
    const float so = wsum(o * o);
    if (lane == 0) { float* sq = (float*)(p.ws + OFF_SSQ) + ((size_t)row * 8 + h) * 4; sq[wave] = so; sq[wave + 2] = 0.f; }
  }
  __syncthreads();
}

__global__ void __launch_bounds__(512, 2) fwd_megakernel(Params p) {
  __shared__ __attribute__((aligned(1024))) char smem[SMEM_BYTES];
  const int tid = threadIdx.x, lane = tid & 63, wave = tid >> 6;
  const int fr = lane & 15, fq = lane >> 4;
  uint4* xb_words = (uint4*)(smem + 2 * HALF_SMEM);
  if (tid == 0) *xb_words = make_uint4(0u, 0u, 0u, 0u);
  __syncthreads();
  XcdBarrier xb = xcd_barrier_post((unsigned*)(p.ws + OFF_BAR), (volatile LAS unsigned*)xb_words);
  const int G = gridDim.x, bid = blockIdx.x;
  float* mod = (float*)(p.ws + OFF_MOD);
  u16* hbuf = (u16*)p.out;
  u16* obuf = (u16*)((char*)p.out + (size_t)R * 1024 * 2);
  const float* ssq = (const float*)(p.ws + OFF_SSQ);
  u16* merged = (u16*)(p.ws + OFF_MERGED);
  u16* tmp2 = (u16*)(p.ws + OFF_TMP2);

  PH(0) phase_convert(p, smem);
  xcd_barrier(xb);

  PH(1) for (int sb = bid; sb < 256; sb += G) {
    skinny<2>((const u16*)(p.ws + OFF_AC), 1024, 0, 136, (const u16*)(p.ws + OFF_WADA), 1024, 1024,
      [&](int j) { return sb * 24 + (j < 24 ? j : 23); },
      [&](int row, int ntl, int q, f32x4 v, int ln) {
        const int j = ntl * 16 + 4 * q;
        if (j < 24) {
          const int col = sb * 24 + j;
          const float4 bb = *(const float4*)(p.b_ada + col);
          *(float4*)(mod + (size_t)row * 6144 + col) = make_float4(v[0] + bb.x, v[1] + bb.y, v[2] + bb.z, v[3] + bb.w);
        }
      });
  }
  xcd_barrier(xb);

  PH(2) phase_modnorm<true>(p, p.x_prompt, p.x_sample, p.norm1_w, 0, 1024, hbuf, smem);
  xcd_barrier(xb);

  PH(3) {
    u16* glu = (u16*)(p.ws + OFF_GLU);
    u16* qkv = (u16*)(p.ws + OFF_QKV);
    u16* halo = (u16*)(p.ws + OFF_HALO);
    auto f_glu_st = [&](int row, int ch, f32x4 gl) {
      uint2 o; o.x = pk2(gl[0], gl[1]); o.y = pk2(gl[2], gl[3]);
      *(uint2*)(glu + (size_t)row * 512 + ch) = o;
      if (row < RP) { const int b = row >> 11, tt = row & 2047; if (tt >= 2018) *(float4*)(p.out + OUT_CONFP + (size_t)(b * 30 + tt - 2018) * 512 + ch) = make_float4(gl[0], gl[1], gl[2], gl[3]); }
      else *(float4*)(p.out + OUT_CONFS + (size_t)((row - RP) * 30 + 29) * 512 + ch) = make_float4(gl[0], gl[1], gl[2], gl[3]);
    };
    auto f_glu = [&](int row, int ch, f32x4 a, f32x4 g) {
      f32x4 gl;
#pragma unroll
      for (int j = 0; j < 4; ++j) gl[j] = a[j] * sigmoidf_(g[j]);
      f_glu_st(row, ch, gl);
    };
    auto f_qkv = [&](int row, int col, f32x4 a) {
      const float4 v = make_float4(a[0], a[1], a[2], a[3]);
      uint2 o; o.x = pk2(v.x, v.y); o.y = pk2(v.z, v.w);
      *(uint2*)(qkv + (size_t)row * 3072 + col) = o;
      if (row < RP) {
        const int b = row >> 11, tt = row & 2047;
        if ((tt & 63) >= 61) *(uint2*)(halo + (size_t)((b * 32 + (tt >> 6)) * 3 + (tt & 63) - 61) * 3072 + col) = o;
        if (tt >= 2045) *(float4*)(p.out + OUT_QKVP + (size_t)(b * 3 + tt - 2045) * 3072 + col) = v;
      } else *(float4*)(p.out + OUT_QKVS + (size_t)((row - RP) * 3 + 2) * 3072 + col) = v;
    };
    int u = bid;
    for (; u < 64 * 4; u += G) {
      const int pm = u % 64, pn = u / 64;
      f32x4 acc[2][2][4][2];
      zero_acc(acc);
      gemm256(acc, hbuf, 1024, (const u16*)(p.ws + OFF_WIN), 1024, pm * 256, pn * 256, 1024, smem);
      {
        int t_ = threadIdx.x;
        asm volatile("" : "+v"(t_));
        const int wr = t_ >> 8, wc = (t_ >> 6) & 3, fr_ = t_ & 15, fq_ = (t_ >> 4) & 3;
        float* T = (float*)smem;
#pragma unroll
        for (int ai = 0; ai < 2; ++ai)
#pragma unroll
          for (int m = 0; m < 4; ++m)
#pragma unroll
            for (int n = 0; n < 2; ++n) {
              f32x4 gl;
#pragma unroll
              for (int j = 0; j < 4; ++j) gl[j] = acc[ai][0][m][n][j] * sigmoidf_(acc[ai][1][m][n][j]);
              *(f32x4*)(T + (ai * 128 + wr * 64 + m * 16 + fr_) * TLD + wc * 32 + n * 16 + 4 * fq_) = gl;
            }
        __syncthreads();
        const int cg = (t_ & 31) * 4, r0 = t_ >> 5;
#pragma unroll 4
        for (int i = 0; i < 16; ++i) {
          const int rl = r0 + 16 * i;
          const f32x4 v = *(const f32x4*)(T + rl * TLD + cg);
          f_glu_st(pm * 256 + rl, pn * 128 + cg, v);
        }
        __syncthreads();
      }
    }
    for (; u < 64 * 16; u += G) {
      const int pm = u % 64, pn = u / 64;
      f32x4 acc[2][2][4][2];
      zero_acc(acc);
      gemm256(acc, hbuf, 1024, (const u16*)(p.ws + OFF_WIN), 1024, pm * 256, pn * 256, 1024, smem);
      tile_epilogue(acc, pm * 256, pn * 256 - 1024, smem, f_qkv);
    }
    for (int sb = bid; sb < 256; sb += G) {
      if (sb < 64) {
        skinny<1>(hbuf, 1024, RP, 128, (const u16*)(p.ws + OFF_WIN), 1024, 1024,
          [&](int j) { const int ch = sb * 8 + (j & 7); return (ch >> 7) * 256 + (ch & 127) + ((j >> 3) << 7); },
          [&](int row, int ntl, int q, f32x4 v, int ln) {
            f32x4 g;
#pragma unroll
            for (int j = 0; j < 4; ++j) g[j] = __shfl(v[j], (ln + 32) & 63, 64);
            if (q < 2) f_glu(row, sb * 8 + 4 * q, v, g);
          });
      } else {
        skinny<1>(hbuf, 1024, RP, 128, (const u16*)(p.ws + OFF_WIN), 1024, 1024,
          [&](int j) { return 1024 + (sb - 64) * 16 + j; },
          [&](int row, int ntl, int q, f32x4 v, int ln) { f_qkv(row, (sb - 64) * 16 + 4 * q, v); });
      }
    }
  }
  xcd_barrier(xb);

  PH(4) for (int base = bid * 2; base < 2048; base += 2 * G) d1_item(p, base + (tid >> 8), smem + (tid >> 8) * HALF_SMEM);
  xcd_barrier(xb);

  PH(5) {
    const int half = tid >> 8;
    char* hs = smem + half * HALF_SMEM;
    for (int u = bid; u < 64; u += G) { d2_block(p, u, smem); __syncthreads(); }
    unsigned* qhead = (unsigned*)(p.ws + OFF_BAR) + 64;
    volatile unsigned* qslot = (volatile unsigned*)(smem + 2 * HALF_SMEM + 32);
    auto deq = [&]() -> int {
      if (tid == 0) *qslot = __hip_atomic_fetch_add(qhead, 1u, __ATOMIC_RELAXED, __HIP_MEMORY_SCOPE_AGENT);
      __syncthreads();
      const int v = __builtin_amdgcn_readfirstlane((int)*qslot);
      __syncthreads();
      return v;
    };
    int idx = deq();
    for (; idx < 256; idx = deq()) conf_prompt_item(p, 2 * idx + half, hs);
    for (; idx < 272; idx = deq()) conf_sample_item(p, 2 * (idx - 256) + half);
    for (; idx < 784; idx = deq()) delta_sample_item(p, 2 * (idx - 272) + half, hs);
  }
  xcd_barrier(xb);

  PH(6) {
    auto f_z = [&](int row, int col, f32x4 a) {
      const float4 sq4 = *(const float4*)(ssq + ((size_t)row * 8 + (col >> 7)) * 4);
      const float rstd = rsqrtf((sq4.x + sq4.y + sq4.z + sq4.w) * (1.f / 128.f) + EPS);
      const float4 gw = *(const float4*)(p.gdn_norm_w + (col & 127));
      u16* op = obuf + (size_t)row * 1024 + col;
      const uint2 u = *(const uint2*)op;
      uint2 o;
      o.x = pk2(bf_lo(u.x) * rstd * gw.x * siluf_(a[0]), bf_hi(u.x) * rstd * gw.y * siluf_(a[1]));
      o.y = pk2(bf_lo(u.y) * rstd * gw.z * siluf_(a[2]), bf_hi(u.y) * rstd * gw.w * siluf_(a[3]));
      *(uint2*)op = o;
    };
    gemm_pass(hbuf, 1024, (const u16*)(p.ws + OFF_WZ), 1024, 1024, 1024, smem, f_z);
    for (int sb = bid; sb < 256; sb += G)
      skinny<1>(hbuf, 1024, RP, 128, (const u16*)(p.ws + OFF_WZ), 1024, 1024, [&](int j) { return sb * 4 + (j & 3); },
                [&](int row, int ntl, int q, f32x4 v, int ln) { if (q == 0) f_z(row, sb * 4, v); });
  }
  xcd_barrier(xb);

  PH(7) {
    auto f_ga = [&](int row, int col, f32x4 a) {
      uint2 o; o.x = pk2(sigmoidf_(a[0]), sigmoidf_(a[1])); o.y = pk2(sigmoidf_(a[2]), sigmoidf_(a[3]));
      *(uint2*)(merged + (size_t)row * 1024 + col) = o;
    };
    auto f_ya = [&](int row, int col, f32x4 a) {
      u16* mp = merged + (size_t)row * 1024 + col;
      const uint2 u = *(const uint2*)mp;
      uint2 o; o.x = pk2(bf_lo(u.x) * a[0], bf_hi(u.x) * a[1]); o.y = pk2(bf_lo(u.y) * a[2], bf_hi(u.y) * a[3]);
      *(uint2*)mp = o;
    };
    auto f_gb = [&](int row, int col, f32x4 a) {
      uint2 o; o.x = pk2(sigmoidf_(a[0]), sigmoidf_(a[1])); o.y = pk2(sigmoidf_(a[2]), sigmoidf_(a[3]));
      *(uint2*)(tmp2 + (size_t)row * 1024 + col) = o;
    };
    auto f_yb = [&](int row, int col, f32x4 a) {
      u16* mp = merged + (size_t)row * 1024 + col;
      const uint2 u = *(const uint2*)mp, s2 = *(const uint2*)(tmp2 + (size_t)row * 1024 + col);
      uint2 o; o.x = pk2(bf_lo(u.x) + bf_lo(s2.x) * a[0], bf_hi(u.x) + bf_hi(s2.x) * a[1]); o.y = pk2(bf_lo(u.y) + bf_lo(s2.y) * a[2], bf_hi(u.y) + bf_hi(s2.y) * a[3]);
      *(uint2*)mp = o;
    };
    auto cm4 = [&](int sb) { return [sb](int j) { return sb * 4 + (j & 3); }; };
    gemm_pass(hbuf, 1024, (const u16*)(p.ws + OFF_WGA), 1024, 1024, 1024, smem, f_ga);
    gemm_pass((const u16*)(p.ws + OFF_AACT), 512, (const u16*)(p.ws + OFF_WCONF), 512, 1024, 512, smem, f_ya);
    gemm_pass(hbuf, 1024, (const u16*)(p.ws + OFF_WGB), 1024, 1024, 1024, smem, f_gb);
    gemm_pass(obuf, 1024, (const u16*)(p.ws + OFF_WGDN), 1024, 1024, 1024, smem, f_yb);
    for (int sb = bid; sb < 256; sb += G) {
      skinny<1>(hbuf, 1024, RP, 128, (const u16*)(p.ws + OFF_WGA), 1024, 1024, cm4(sb), [&](int row, int ntl, int q, f32x4 v, int ln) { if (q == 0) f_ga(row, sb * 4, v); });
      skinny<1>((const u16*)(p.ws + OFF_AACT), 512, RP, 128, (const u16*)(p.ws + OFF_WCONF), 512, 512, cm4(sb), [&](int row, int ntl, int q, f32x4 v, int ln) { if (q == 0) f_ya(row, sb * 4, v); });
      skinny<1>(hbuf, 1024, RP, 128, (const u16*)(p.ws + OFF_WGB), 1024, 1024, cm4(sb), [&](int row, int ntl, int q, f32x4 v, int ln) { if (q == 0) f_gb(row, sb * 4, v); });
      skinny<1>(obuf, 1024, RP, 128, (const u16*)(p.ws + OFF_WGDN), 1024, 1024, cm4(sb), [&](int row, int ntl, int q, f32x4 v, int ln) { if (q == 0) f_yb(row, sb * 4, v); });
    }
  }
  xcd_barrier(xb);

  PH(8) {
    auto f_o = [&](int row, int col, f32x4 a) {
      const float* xr = row < RP ? p.x_prompt + (size_t)row * 1024 : p.x_sample + (size_t)(row - RP) * 1024;
      const f32x4 x4 = __builtin_nontemporal_load((const f32x4*)(xr + col));
      const float4 xv = make_float4(x4[0], x4[1], x4[2], x4[3]), gv = *(const float4*)(mod + (size_t)mrow_of(row) * 6144 + 2048 + col);
      *(float4*)(p.out + (size_t)row * 1024 + col) = make_float4(xv.x + gv.x * a[0], xv.y + gv.y * a[1], xv.z + gv.z * a[2], xv.w + gv.w * a[3]);
    };
    gemm_pass(merged, 1024, (const u16*)(p.ws + OFF_WO), 1024, 1024, 1024, smem, f_o);
    for (int sb = bid; sb < 256; sb += G)
      skinny<1>(merged, 1024, RP, 128, (const u16*)(p.ws + OFF_WO), 1024, 1024, [&](int j) { return sb * 4 + (j & 3); },
                [&](int row, int ntl, int q, f32x4 v, int ln) { if (q == 0) f_o(row, sb * 4, v); });
  }
  xcd_barrier(xb);

  PH(9) phase_modnorm<false>(p, p.out, p.out + (size_t)RP * 1024, p.norm2_w, 3072, 4096, (u16*)(p.ws + OFF_H2), smem);
  xcd_barrier(xb);

  PH(10) {
    u16* f = (u16*)(p.ws + OFF_F);
    auto f_ff1 = [&](int row, int col, f32x4 a) {
      float v[4];
#pragma unroll
      for (int j = 0; j < 4; ++j) { const float t = fmaxf(a[j], 0.f); v[j] = t * t; }
      uint2 o; o.x = pk2(v[0], v[1]); o.y = pk2(v[2], v[3]);
      *(uint2*)(f + (size_t)row * LDF + col) = o;
    };
    gemm_pass((const u16*)(p.ws + OFF_H2), 1024, (const u16*)(p.ws + OFF_W1), 1024, 4096, 1024, smem, f_ff1);
    for (int sb = bid; sb < 256; sb += G)
      skinny<1>((const u16*)(p.ws + OFF_H2), 1024, RP, 128, (const u16*)(p.ws + OFF_W1), 1024, 1024, [&](int j) { return sb * 16 + j; },
                [&](int row, int ntl, int q, f32x4 v, int ln) { f_ff1(row, sb * 16 + 4 * q, v); });
  }
  xcd_barrier(xb);

  PH(11) {
    auto f_ff2 = [&](int row, int col, f32x4 a) {
      float* xp = p.out + (size_t)row * 1024 + col;
      const f32x4 x4 = __builtin_nontemporal_load((const f32x4*)xp);
      const float4 xv = make_float4(x4[0], x4[1], x4[2], x4[3]), gv = *(const float4*)(mod + (size_t)mrow_of(row) * 6144 + 5120 + col);
      *(float4*)xp = make_float4(xv.x + gv.x * a[0], xv.y + gv.y * a[1], xv.z + gv.z * a[2], xv.w + gv.w * a[3]);
    };
    gemm_pass((const u16*)(p.ws + OFF_F), LDF, (const u16*)(p.ws + OFF_W2), LDF, 1024, 4096, smem, f_ff2);
    for (int sb = bid; sb < 256; sb += G)
      skinny<1>((const u16*)(p.ws + OFF_F), LDF, RP, 128, (const u16*)(p.ws + OFF_W2), LDF, 4096, [&](int j) { return sb * 4 + (j & 3); },
                [&](int row, int ntl, int q, f32x4 v, int ln) { if (q == 0) f_ff2(row, sb * 4, v); });
  }
  xcd_barrier(xb);

  PH(12) {
    int t12 = threadIdx.x;
    asm volatile("" : "+v"(t12));
    const int lane = t12 & 63, wave = t12 >> 6;
    const int gw = bid * 8 + wave, nw_ = G * 8;
    for (int row = gw; row < R; row += nw_) {
      float* xr = p.out + (size_t)row * 1024;
      float4 v[4]; float ss = 0.f;
#pragma unroll
      for (int i = 0; i < 4; ++i) { const f32x4 t4 = __builtin_nontemporal_load((const f32x4*)(xr + (lane + 64 * i) * 4)); v[i] = make_float4(t4[0], t4[1], t4[2], t4[3]); ss += v[i].x * v[i].x + v[i].y * v[i].y + v[i].z * v[i].z + v[i].w * v[i].w; }
      ss = wsum(ss);
      const float rstd = rsqrtf(ss * (1.f / 1024.f) + EPS);
#pragma unroll
      for (int i = 0; i < 4; ++i) {
        const int c = (lane + 64 * i) * 4;
        const float4 w = *(const float4*)(p.final_norm_w + c);
        f32x4 yv = {v[i].x * rstd * w.x, v[i].y * rstd * w.y, v[i].z * rstd * w.z, v[i].w * rstd * w.w};
        __builtin_nontemporal_store(yv, (f32x4*)(xr + c));
      }
    }
  }
}

extern "C" void kernel_launch(void* const* d_in, const int* in_sizes, int n_in, void* d_out, int out_size, void* d_ws, size_t ws_size,
                              hipStream_t stream) {
  static int grid_blocks = 0;
  if (!grid_blocks) {
    int dev = 0, cus = 0, per_cu = 0;
    hipGetDevice(&dev);
    hipDeviceGetAttribute(&cus, hipDeviceAttributeMultiprocessorCount, dev);
    hipOccupancyMaxActiveBlocksPerMultiprocessor(&per_cu, (const void*)fwd_megakernel, NT, 0);
    if (per_cu > 1) per_cu = 1;
    if (per_cu < 1) per_cu = 1;
    grid_blocks = cus * per_cu;
  }
  Params p{};
  const float** pp = (const float**)&p;
  for (int i = 0; i < 26; ++i) pp[i] = (const float*)d_in[i];
  p.out = (float*)d_out; p.ws = (char*)d_ws;
  if (ws_size < WS_NEED) { fprintf(stderr, "workspace too small: %zu < %zu\n", ws_size, (size_t)WS_NEED); return; }
  hipMemsetAsync(d_ws, 0, XCD_BAR_WORDS * 4, stream);
  void* args[] = {&p};
  hipError_t e = hipLaunchCooperativeKernel((const void*)fwd_megakernel, dim3(grid_blocks), dim3(NT), args, 0, stream);
  if (e != hipSuccess) fprintf(stderr, "cooperative launch failed: %s (grid %d)\n", hipGetErrorString(e), grid_blocks);
}
```

```cpp
#include <hip/hip_runtime.h>
#include <stdint.h>
#include <cstdio>

#define DI __device__ __forceinline__
typedef unsigned short u16;
typedef __bf16 bf2_t __attribute__((ext_vector_type(2)));
typedef float f2_t __attribute__((ext_vector_type(2)));
using bf16x8 = __attribute__((ext_vector_type(8))) short;
using f32x16 = __attribute__((ext_vector_type(16))) float;
using f32x4 = __attribute__((ext_vector_type(4))) float;
using u32x4 = __attribute__((ext_vector_type(4))) unsigned;
#define MFMA(a, b, c) __builtin_amdgcn_mfma_f32_32x32x16_bf16((a), (b), (c), 0, 0, 0)

constexpr int R = 16512, RP = 16384, D = 1024, DC = 512, QKV = 3072, NIN = 4096, DFF = 4096;
constexpr float EPS = 1e-6f;
constexpr int LDF = 4160;
constexpr float QSCALE = 0.08838834764831845f;

constexpr size_t OFF_BAR   = 0;
constexpr size_t OFF_MOD   = 16384;
constexpr size_t OFF_GB    = OFF_MOD + 3342336;
constexpr size_t OFF_EGL   = OFF_GB + 1056768;
constexpr size_t OFF_SSQ   = OFF_EGL + 8192;
constexpr size_t OFF_WIN   = OFF_SSQ + 2113536;
constexpr size_t OFF_WZ    = OFF_WIN + 8650752;
constexpr size_t OFF_WGA   = OFF_WZ + 2097152;
constexpr size_t OFF_WGB   = OFF_WGA + 2097152;
constexpr size_t OFF_WCONF = OFF_WGB + 2097152;
constexpr size_t OFF_WGDN  = OFF_WCONF + 1048576;
constexpr size_t OFF_WO    = OFF_WGDN + 2097152;
constexpr size_t OFF_W1    = OFF_WO + 2097152;
constexpr size_t OFF_W2    = OFF_W1 + 8388608;
constexpr size_t OFF_GLU   = OFF_W2 + 8650752;
constexpr size_t OFF_AACT  = OFF_GLU + 16908288;
constexpr size_t OFF_QKV   = OFF_AACT + 16908288;
constexpr size_t OFF_HALO  = OFF_QKV + 101449728;
constexpr size_t OFF_EXTRA = OFF_HALO + 4718592;
constexpr size_t OFF_WADA  = OFF_EXTRA;
constexpr size_t OFF_AC    = OFF_EXTRA + 12582912;
constexpr size_t OFF_MERGED= OFF_EXTRA;
constexpr size_t OFF_H2    = OFF_GLU;
constexpr size_t OFF_F     = OFF_QKV;
constexpr size_t OFF_TMP2  = OFF_QKV;
constexpr size_t WS_NEED   = OFF_EXTRA + 50331648;
constexpr size_t OUT_Y = 0, OUT_CONFP = 16908288, OUT_QKVP = 17031168, OUT_DELTAP = 17104896,
                 OUT_CONFS = 18153472, OUT_QKVS = 20119552, OUT_DELTAS = 21299200;

constexpr int HALF_SMEM = 73728;
constexpr int SMEM_BYTES = 2 * HALF_SMEM + 1024;
constexpr int NT = 512;
#ifndef PHASE_MASK
#define PHASE_MASK 0xFFFF
#endif
#define PH(k) if constexpr ((PHASE_MASK >> (k)) & 1)

struct Params {
  const float *x_prompt, *x_sample, *c_prompt, *c_sample, *st_conf, *st_qkv, *st_delta;
  const float *w_ada, *b_ada, *norm1_w, *w_in, *conf_dw_w, *conf_dw_b, *conf_ln_w, *conf_ln_b, *w_conf_out,
              *gdn_conv_w, *a_log, *dt_bias, *gdn_norm_w, *w_gdn_out, *w_o, *norm2_w, *w_ff1, *w_ff2, *final_norm_w;
  float* out; char* ws;
};

DI unsigned pk2(float a, float b) { f2_t v = {a, b}; bf2_t r = __builtin_convertvector(v, bf2_t); return __builtin_bit_cast(unsigned, r); }
DI float bf_lo(unsigned u) { return __uint_as_float(u << 16); }
DI float bf_hi(unsigned u) { return __uint_as_float(u & 0xffff0000u); }
DI float bf1(u16 u) { return __uint_as_float(((unsigned)u) << 16); }
DI u16 f2bf(float a) { return (u16)(pk2(a, 0.f) & 0xffffu); }
DI float sigmoidf_(float x) { return __builtin_amdgcn_rcpf(1.f + __expf(-x)); }
DI float siluf_(float x) { return x * __builtin_amdgcn_rcpf(1.f + __expf(-x)); }
DI float softplusf_(float x) { return fmaxf(x, 0.f) + log1pf(__expf(-fabsf(x))); }
DI float dpp_f(float x, const int ctrl_sel) {
  const int xi = __builtin_bit_cast(int, x);
  int r;
  if (ctrl_sel == 0) r = __builtin_amdgcn_update_dpp(xi, xi, 0xB1, 0xF, 0xF, false);
  else if (ctrl_sel == 1) r = __builtin_amdgcn_update_dpp(xi, xi, 0x4E, 0xF, 0xF, false);
  else if (ctrl_sel == 2) r = __builtin_amdgcn_update_dpp(xi, xi, 0x141, 0xF, 0xF, false);
  else r = __builtin_amdgcn_update_dpp(xi, xi, 0x140, 0xF, 0xF, false);
  return __builtin_bit_cast(float, r);
}
DI float wsum(float v) {
  v += dpp_f(v, 0); v += dpp_f(v, 1); v += dpp_f(v, 2); v += dpp_f(v, 3);
  v += __shfl_xor(v, 16, 64); v += __shfl_xor(v, 32, 64);
  return v;
}
DI int crow(int reg, int hh) { return (reg & 3) + 8 * (reg >> 2) + 4 * hh; }
DI int mrow_of(int r) { return r < RP ? (r >> 11) : (8 + r - RP); }
DI bf16x8 pack8(const f32x16& x, int s) {
  uint4 p;
  p.x = pk2(x[8 * s + 0], x[8 * s + 1]); p.y = pk2(x[8 * s + 2], x[8 * s + 3]);
  p.z = pk2(x[8 * s + 4], x[8 * s + 5]); p.w = pk2(x[8 * s + 6], x[8 * s + 7]);
  return __builtin_bit_cast(bf16x8, p);
}
DI f32x16 zero16() { f32x16 z; for (int i = 0; i < 16; ++i) z[i] = 0.f; return z; }

#define XB_TMO      128
#define XB_XCNT(j)  (256  + 64 * (j))
#define XB_XSUB(j)  (1280 + 64 * (j))
#define XB_XGEN(j)  (2304 + 64 * (j))
#define XB_TOP      3328
#define XB_TOPGEN   3392
#define XCD_BAR_WORDS 3456
#define XB_SPIN_CAP (1u << 24)
#define LAS __attribute__((address_space(3)))
DI unsigned xb_ld(unsigned* p) { return __hip_atomic_load(p, __ATOMIC_RELAXED, __HIP_MEMORY_SCOPE_AGENT); }
DI unsigned xb_add(unsigned* p, unsigned v) { return __hip_atomic_fetch_add(p, v, __ATOMIC_RELAXED, __HIP_MEMORY_SCOPE_AGENT); }
DI unsigned xb_xcc_id() { return (unsigned)__builtin_amdgcn_s_getreg((3 << 11) | 20) & 0xFu; }
#define XB_SPIN(cond, bar) do { unsigned _sp = 0; while (cond) { __builtin_amdgcn_s_sleep(1); \
    if ((++_sp & 255u) == 0u) { if (xb_ld(&(bar)[XB_TMO])) break; if (_sp > XB_SPIN_CAP) { atomicAdd(&(bar)[XB_TMO], 1u); break; } } } } while (0)
struct XcdBarrier { unsigned* bar; unsigned x; volatile LAS unsigned* st; };
DI XcdBarrier xcd_barrier_post(unsigned* bar, volatile LAS unsigned* st) {
  XcdBarrier b; b.bar = bar; b.x = xb_xcc_id(); b.st = st;
  if (threadIdx.x == 0) (void)xb_add(&bar[XB_XCNT(b.x)], 1u);
  return b;
}
DI void xcd_barrier_complete(unsigned* bar, unsigned x, unsigned& nloc, unsigned& nx) {
  const unsigned G = gridDim.x * gridDim.y * gridDim.z;
  unsigned sum, cnt, mine, sp = 0u;
  for (;;) {
    sum = 0u; cnt = 0u; mine = 0u;
#pragma unroll
    for (unsigned j = 0; j < 16; ++j) { const unsigned c = xb_ld(&bar[XB_XCNT(j)]); sum += c; cnt += (c > 0u) ? 1u : 0u; mine = (j == x) ? c : mine; }
    if (sum == G) break;
    __builtin_amdgcn_s_sleep(1);
    if ((++sp & 255u) == 0u) { if (xb_ld(&bar[XB_TMO])) break; if (sp > XB_SPIN_CAP) { atomicAdd(&bar[XB_TMO], 1u); break; } }
  }
  nloc = mine > 0u ? mine : 1u; nx = cnt > 0u ? cnt : 1u;
}
DI void xcd_barrier(const XcdBarrier& b) {
  asm volatile("s_waitcnt vmcnt(0)" ::: "memory");
  __syncthreads();
  if (threadIdx.x == 0) {
    unsigned* bar = b.bar;
    __builtin_amdgcn_s_waitcnt(0);
    unsigned nloc = b.st[0], nx = b.st[1];
    if (nloc == 0u) { xcd_barrier_complete(bar, b.x, nloc, nx); b.st[0] = nloc; b.st[1] = nx; }
    const unsigned old = xb_add(&bar[XB_XSUB(b.x)], 1u);
    const unsigned gen = old / nloc;
    if (old + 1u == (gen + 1u) * nloc) {
      __builtin_amdgcn_fence(__ATOMIC_RELEASE, "agent");
      asm volatile("s_waitcnt vmcnt(0)" ::: "memory");
      const unsigned og = xb_add(&bar[XB_TOP], 1u);
      const unsigned tg = og / nx;
      if (og + 1u == (tg + 1u) * nx) xb_add(&bar[XB_TOPGEN], 1u);
      else XB_SPIN(xb_ld(&bar[XB_TOPGEN]) == tg, bar);
      __builtin_amdgcn_fence(__ATOMIC_ACQUIRE, "agent");
      xb_add(&bar[XB_XGEN(b.x)], 1u);
      asm volatile("s_waitcnt vmcnt(0)" ::: "memory");
    } else {
      XB_SPIN(xb_ld(&bar[XB_XGEN(b.x)]) == gen, bar);
      __builtin_amdgcn_fence(__ATOMIC_ACQUIRE, "agent");
      asm volatile("s_waitcnt vmcnt(0)" ::: "memory");
    }
  }
  __syncthreads();
}

constexpr int HTB = 128 * 64 * 2;
DI int lds_byte(int r, int c) { const int st = (r >> 4) * 2 + (c >> 5), rr = r & 15, cc = c & 31, ob = rr * 64 + cc * 2; return st * 1024 + (ob ^ (((ob >> 9) & 1) << 5)); }
DI void stage_rc(int b, int& Rr, int& Cc) { const int st = b / 1024, sb = b % 1024, swz = sb ^ (((sb >> 9) & 1) << 5); Rr = (st >> 1) * 16 + swz / 64; Cc = (st & 1) * 32 + (swz % 64) / 2; }
DI void gemm256(f32x4 (&acc)[2][2][4][2], const u16* __restrict__ A, const int lda, const u16* __restrict__ Bt, const int ldb,
                const int brow, const int bcol, const int K, char* shm) {
#define SA(b, h) (shm + ((b) * 2 + (h)) * HTB)
#define SB(b, h) (shm + (4 + (b) * 2 + (h)) * HTB)
#define STAGE_A(P, br, kt) do { const char* _u = (const char*)A + ((size_t)(br) * lda + (size_t)(kt) * 64) * 2; \
    __builtin_amdgcn_global_load_lds((const unsigned*)(_u + voA0), (unsigned*)((char*)(P) + sb0), 16, 0, 0); \
    __builtin_amdgcn_global_load_lds((const unsigned*)(_u + voA1), (unsigned*)((char*)(P) + sb1), 16, 0, 0); } while (0)
#define STAGE_B(P, br, kt) do { const char* _u = (const char*)Bt + ((size_t)(br) * ldb + (size_t)(kt) * 64) * 2; \
    __builtin_amdgcn_global_load_lds((const unsigned*)(_u + voB0), (unsigned*)((char*)(P) + sb0), 16, 0, 0); \
    __builtin_amdgcn_global_load_lds((const unsigned*)(_u + voB1), (unsigned*)((char*)(P) + sb1), 16, 0, 0); } while (0)
#define LDA(dst, b, h) _Pragma("unroll") for (int m = 0; m < 4; ++m) _Pragma("unroll") for (int k = 0; k < 2; ++k) \
    dst[m][k] = *reinterpret_cast<const bf16x8*>((char*)SA(b, h) + lds_byte(wr * 64 + m * 16 + fr, k * 32 + fq * 8))
#define LDB(dst, b, h) _Pragma("unroll") for (int n = 0; n < 2; ++n) _Pragma("unroll") for (int k = 0; k < 2; ++k) \
    dst[n][k] = *reinterpret_cast<const bf16x8*>((char*)SB(b, h) + lds_byte(wc * 32 + n * 16 + fr, k * 32 + fq * 8))
#define MMA(ai, bj, At_, Bt_) do { __builtin_amdgcn_s_setprio(1); \
    _Pragma("unroll") for (int m = 0; m < 4; ++m) _Pragma("unroll") for (int n = 0; n < 2; ++n) _Pragma("unroll") for (int k = 0; k < 2; ++k) \
      acc[ai][bj][m][n] = __builtin_amdgcn_mfma_f32_16x16x32_bf16(Bt_[n][k], At_[m][k], acc[ai][bj][m][n], 0, 0, 0); \
    __builtin_amdgcn_s_setprio(0); } while (0)
#define WAIT_V(n) asm volatile("s_waitcnt vmcnt(" #n ")" ::: "memory")
#define WAIT_L(n) asm volatile("s_waitcnt lgkmcnt(" #n ")" ::: "memory")
#define BAR __builtin_amdgcn_s_barrier()
#define SCHED __builtin_amdgcn_sched_barrier(0)
  int t_ = threadIdx.x;
  asm volatile("" : "+v"(t_));
  const int wid = __builtin_amdgcn_readfirstlane(t_ >> 6), lane = t_ & 63, wr = wid >> 2, wc = wid & 3, fr = lane & 15, fq = lane >> 4;
  const int sb0 = t_ * 16, sb1 = sb0 + 8192;
  int sr0, sc0, sr1, sc1; stage_rc(sb0, sr0, sc0); stage_rc(sb1, sr1, sc1);
  const unsigned voA0 = (unsigned)(sr0 * lda + sc0) * 2u, voA1 = (unsigned)(sr1 * lda + sc1) * 2u;
  const unsigned voB0 = (unsigned)(sr0 * ldb + sc0) * 2u, voB1 = (unsigned)(sr1 * ldb + sc1) * 2u;
  bf16x8 At[4][2], B0[2][2], B1[2][2];
  const int nt = K / 64;
  STAGE_B(SB(0, 0), bcol, 0); STAGE_A(SA(0, 0), brow, 0);
  STAGE_B(SB(0, 1), bcol + 128, 0); STAGE_A(SA(0, 1), brow + 128, 0);
  if (wr == 1) BAR;
  WAIT_V(4); BAR;
  STAGE_B(SB(1, 0), bcol, 1); STAGE_A(SA(1, 0), brow, 1); STAGE_B(SB(1, 1), bcol + 128, 1);
  WAIT_V(6); BAR;
  for (int t = 0; t < nt - 2; t += 2) {
    LDB(B0, 0, 0); SCHED; LDA(At, 0, 0); STAGE_A(SA(1, 1), brow + 128, t + 1);
    WAIT_L(8); BAR; WAIT_L(0); MMA(0, 0, At, B0); BAR; SCHED;
    LDB(B1, 0, 1); STAGE_B(SB(0, 0), bcol, t + 2);
    BAR; WAIT_L(0); MMA(0, 1, At, B1); BAR;
    LDA(At, 0, 1); STAGE_A(SA(0, 0), brow, t + 2);
    BAR; WAIT_L(0); MMA(1, 0, At, B0); BAR; SCHED;
    STAGE_B(SB(0, 1), bcol + 128, t + 2);
    WAIT_V(6); BAR; MMA(1, 1, At, B1); BAR;
    LDB(B0, 1, 0); SCHED; LDA(At, 1, 0); STAGE_A(SA(0, 1), brow + 128, t + 2);
    WAIT_L(8); BAR; WAIT_L(0); MMA(0, 0, At, B0); BAR; SCHED;
    LDB(B1, 1, 1); STAGE_B(SB(1, 0), bcol, t + 3);
    BAR; WAIT_L(0); MMA(0, 1, At, B1); BAR;
    LDA(At, 1, 1); STAGE_A(SA(1, 0), brow, t + 3);
    BAR; WAIT_L(0); MMA(1, 0, At, B0); BAR; SCHED;
    STAGE_B(SB(1, 1), bcol + 128, t + 3);
    WAIT_V(6); BAR; MMA(1, 1, At, B1); BAR;
  }
  { LDB(B0, 0, 0); LDA(At, 0, 0); STAGE_A(SA(1, 1), brow + 128, nt - 1);
    BAR; WAIT_L(0); MMA(0, 0, At, B0); BAR;
    LDB(B1, 0, 1); BAR; WAIT_L(0); MMA(0, 1, At, B1); BAR;
    LDA(At, 0, 1); WAIT_V(4); BAR; WAIT_L(0); MMA(1, 0, At, B0); MMA(1, 1, At, B1); BAR; }
  { LDB(B0, 1, 0); LDA(At, 1, 0); WAIT_V(2); BAR; WAIT_L(0); MMA(0, 0, At, B0); BAR;
    LDB(B1, 1, 1); WAIT_V(0); BAR; WAIT_L(0); MMA(0, 1, At, B1); BAR;
    LDA(At, 1, 1); BAR; WAIT_L(0); MMA(1, 0, At, B0); MMA(1, 1, At, B1); BAR; }
  if (wr == 0) BAR;
#undef SA
#undef SB
#undef STAGE_A
#undef STAGE_B
#undef LDA
#undef LDB
#undef MMA
}
DI void zero_acc(f32x4 (&acc)[2][2][4][2]) {
#pragma unroll
  for (int a = 0; a < 2; ++a)
#pragma unroll
    for (int b = 0; b < 2; ++b)
#pragma unroll
      for (int m = 0; m < 4; ++m)
#pragma unroll
        for (int n = 0; n < 2; ++n) acc[a][b][m][n] = (f32x4){0.f, 0.f, 0.f, 0.f};
}
template <class F> DI void tile_apply(const f32x4 (&acc)[2][2][4][2], int brow, int bcol, F f) {
  int t_ = threadIdx.x;
  asm volatile("" : "+v"(t_));
  const int wid = t_ >> 6, lane = t_ & 63, wr = wid >> 2, wc = wid & 3, fr = lane & 15, fq = lane >> 4;
#pragma unroll
  for (int ai = 0; ai < 2; ++ai)
#pragma unroll
    for (int m = 0; m < 4; ++m) {
      const int row = brow + ai * 128 + wr * 64 + m * 16 + fr;
#pragma unroll
      for (int bj = 0; bj < 2; ++bj)
#pragma unroll
        for (int n = 0; n < 2; ++n) f(row, bcol + bj * 128 + wc * 32 + n * 16 + 4 * fq, acc[ai][bj][m][n]);
      __builtin_amdgcn_sched_barrier(0);
    }
}
constexpr int TLD = 132;
template <class F> DI void tile_epilogue(const f32x4 (&acc)[2][2][4][2], int brow, int bcol, char* shm, F f) {
  int t_ = threadIdx.x;
  asm volatile("" : "+v"(t_));
  const int wid = t_ >> 6, lane = t_ & 63, wr = wid >> 2, wc = wid & 3, fr = lane & 15, fq = lane >> 4;
  float* T = (float*)shm;
#pragma unroll
  for (int bj = 0; bj < 2; ++bj) {
#pragma unroll
    for (int ai = 0; ai < 2; ++ai)
#pragma unroll
      for (int m = 0; m < 4; ++m)
#pragma unroll
        for (int n = 0; n < 2; ++n)
          *(f32x4*)(T + (ai * 128 + wr * 64 + m * 16 + fr) * TLD + wc * 32 + n * 16 + 4 * fq) = acc[ai][bj][m][n];
    __syncthreads();
    const int cg = (t_ & 31) * 4, r0 = t_ >> 5;
#pragma unroll 4
    for (int i = 0; i < 16; ++i) {
      const int rl = r0 + 16 * i;
      const f32x4 v = *(const f32x4*)(T + rl * TLD + cg);
      f(brow + rl, bcol + bj * 128 + cg, v);
    }
    __syncthreads();
  }
}
template <class F> DI void gemm_pass(const u16* A, int lda, const u16* Bt, int ldb, int N, int K, char* shm, F f) {
  const int nN = N >> 8, nunits = 64 * nN;
  for (int u = blockIdx.x; u < nunits; u += gridDim.x) {
    const int pm = u % 64, pn = u / 64;
    f32x4 acc[2][2][4][2];
    zero_acc(acc);
    gemm256(acc, A, lda, Bt, ldb, pm * 256, pn * 256, K, shm);
    tile_epilogue(acc, pm * 256, pn * 256, shm, f);
  }
}
template <int NTL, class CM, class E> DI void skinny(const u16* __restrict__ A, int lda, int row0, int nrows, const u16* __restrict__ Bt, int ldb, int K, CM cm, E epi) {
  int t_ = threadIdx.x;
  asm volatile("" : "+v"(t_));
  const int wid = t_ >> 6, lane = t_ & 63, fr = lane & 15, fq = lane >> 4;
  for (int mt = wid; mt * 16 < nrows; mt += 8) {
    int rr = mt * 16 + fr; const bool valid = rr < nrows; if (!valid) rr = nrows - 1;
    const u16* ap = A + (size_t)(row0 + rr) * lda + 8 * fq;
#pragma unroll
    for (int ntl = 0; ntl < NTL; ++ntl) {
      const u16* bp = Bt + (size_t)cm(ntl * 16 + fr) * ldb + 8 * fq;
      f32x4 acc = {0.f, 0.f, 0.f, 0.f};
#pragma unroll 16
      for (int ks = 0; ks < (K >> 5); ++ks) {
        const bf16x8 a = *(const bf16x8*)(ap + ks * 32);
        const bf16x8 b = *(const bf16x8*)(bp + ks * 32);
        acc = __builtin_amdgcn_mfma_f32_16x16x32_bf16(b, a, acc, 0, 0, 0);
      }
      if (valid) epi(row0 + rr, ntl, fq, acc, lane);
    }
  }
}
DI int map_in(int n) {
  if (n < 1024) { const int pn = n >> 8, c = n & 255; return c < 128 ? (pn * 128 + c) : (512 + pn * 128 + c - 128); }
  if (n < 4096) return n;
  return n < 4112 ? 5120 + (n - 4096) : 5120;
}
DI void phase_convert(const Params& p, char* smem) {
  float* tile = (float*)smem;
  const int tid = threadIdx.x;
  constexpr int NJ = 10;
  constexpr int pre[NJ + 1] = {0, 1040, 1296, 1552, 1808, 1936, 2192, 2448, 3472, 4496, 6032};
  for (int t = blockIdx.x; t < 6032; t += gridDim.x) {
    int j = 0, base = 0;
#pragma unroll
    for (int q = 1; q < NJ; ++q) if (t >= pre[q]) { j = q; base = pre[q]; }
    const int lt = t - base;
    const float* src; int ld, K; u16* dst; int moff = 0; int ldd = 0;
    switch (j) {
      case 0: src = p.w_in; ld = 7184; K = 1024; dst = (u16*)(p.ws + OFF_WIN); break;
      case 1: src = p.w_in; ld = 7184; K = 1024; dst = (u16*)(p.ws + OFF_WZ); moff = 4096; break;
      case 2: src = p.w_in; ld = 7184; K = 1024; dst = (u16*)(p.ws + OFF_WGA); moff = 5136; break;
      case 3: src = p.w_in; ld = 7184; K = 1024; dst = (u16*)(p.ws + OFF_WGB); moff = 6160; break;
      case 4: src = p.w_conf_out; ld = 1024; K = 512; dst = (u16*)(p.ws + OFF_WCONF); break;
      case 5: src = p.w_gdn_out; ld = 1024; K = 1024; dst = (u16*)(p.ws + OFF_WGDN); break;
      case 6: src = p.w_o; ld = 1024; K = 1024; dst = (u16*)(p.ws + OFF_WO); break;
      case 7: src = p.w_ff1; ld = 4096; K = 1024; dst = (u16*)(p.ws + OFF_W1); break;
      case 8: src = p.w_ff2; ld = 1024; K = 4096; dst = (u16*)(p.ws + OFF_W2); ldd = LDF; break;
      default: src = p.w_ada; ld = 6144; K = 1024; dst = (u16*)(p.ws + OFF_WADA); break;
    }
    const int nkt = K >> 6;
    const int n0 = (lt / nkt) * 64, k0 = (lt % nkt) * 64;
    {
      const int nn = tid & 63, ty = tid >> 6;
      const int sc = (j == 0) ? map_in(n0 + nn) : (n0 + nn + moff);
#pragma unroll
      for (int i = 0; i < 8; ++i) {
        const int kk = ty + 8 * i;
        tile[kk * 65 + nn] = __builtin_nontemporal_load(src + (size_t)(k0 + kk) * ld + sc);
      }
    }
    __syncthreads();
    {
      const int nn = tid >> 3, kq = (tid & 7) * 8;
      uint4 o0;
      const float* tp = tile + kq * 65 + nn;
      o0.x = pk2(tp[0 * 65], tp[1 * 65]);  o0.y = pk2(tp[2 * 65], tp[3 * 65]);
      o0.z = pk2(tp[4 * 65], tp[5 * 65]);  o0.w = pk2(tp[6 * 65], tp[7 * 65]);
      *(uint4*)(dst + (size_t)(n0 + nn) * (ldd ? ldd : K) + k0 + kq) = o0;
    }
    __syncthreads();
  }
  u16* Ac = (u16*)(p.ws + OFF_AC);
  for (int e = blockIdx.x * NT + tid; e < 256 * 256; e += gridDim.x * NT) {
    const int row = e >> 8, c4 = (e & 255) * 4;
    float4 v = make_float4(0.f, 0.f, 0.f, 0.f);
    if (row < 8) v = *(const float4*)(p.c_prompt + row * 1024 + c4);
    else if (row < 136) v = *(const float4*)(p.c_sample + (row - 8) * 1024 + c4);
    uint2 o; o.x = pk2(siluf_(v.x), siluf_(v.y)); o.y = pk2(siluf_(v.z), siluf_(v.w));
    *(uint2*)(Ac + row * 1024 + c4) = o;
  }
}

constexpr int WBA_LD = 1028;
template <bool BA> DI void phase_modnorm(const Params& p, const float* xa, const float* xb, const float* nw, int shift_off, int scale_off, u16* dst, char* smem) {
  int tmn = threadIdx.x;
  asm volatile("" : "+v"(tmn));
  const int lane = tmn & 63;
  const int gw = blockIdx.x * 8 + (tmn >> 6), nw_ = gridDim.x * 8;
  const float* mod = (const float*)(p.ws + OFF_MOD);
  float* wba = (float*)smem;
  if (BA) {
    for (int e = threadIdx.x; e < 16384; e += NT) { const int c = e >> 4, j = e & 15; wba[j * WBA_LD + c] = p.w_in[(size_t)c * 7184 + 5120 + j]; }
    __syncthreads();
  }
  float* gb = (float*)(p.ws + OFF_GB);
  for (int row = gw; row < R; row += nw_) {
    const float* xr = row < RP ? xa + (size_t)row * 1024 : xb + (size_t)(row - RP) * 1024;
    float4 v[4]; float ss = 0.f;
#pragma unroll
    for (int i = 0; i < 4; ++i) {
      { const f32x4 t4 = __builtin_nontemporal_load((const f32x4*)(xr + (lane + 64 * i) * 4)); v[i] = make_float4(t4[0], t4[1], t4[2], t4[3]); }
      ss += v[i].x * v[i].x + v[i].y * v[i].y + v[i].z * v[i].z + v[i].w * v[i].w; }
    ss = wsum(ss);
    const float rstd = rsqrtf(ss * (1.f / 1024.f) + EPS);
    const float* mr = mod + (size_t)mrow_of(row) * 6144;
    float ba[16];
    if (BA) {
#pragma unroll
      for (int j = 0; j < 16; ++j) ba[j] = 0.f;
    }
#pragma unroll
    for (int i = 0; i < 4; ++i) {
      const int c = (lane + 64 * i) * 4;
      const float4 w = *(const float4*)(nw + c), sc = *(const float4*)(mr + scale_off + c), sh = *(const float4*)(mr + shift_off + c);
      const float h0 = v[i].x * rstd * w.x * (1.f + sc.x) + sh.x, h1 = v[i].y * rstd * w.y * (1.f + sc.y) + sh.y;
      const float h2 = v[i].z * rstd * w.z * (1.f + sc.z) + sh.z, h3 = v[i].w * rstd * w.w * (1.f + sc.w) + sh.w;
      uint2 o; o.x = pk2(h0, h1); o.y = pk2(h2, h3);
      *(uint2*)(dst + (size_t)row * 1024 + c) = o;
      if (BA) {
#pragma unroll
        for (int j = 0; j < 16; ++j) { const float4 ww = *(const float4*)(wba + j * WBA_LD + c); ba[j] += h0 * ww.x + h1 * ww.y + h2 * ww.z + h3 * ww.w; }
        __builtin_amdgcn_sched_barrier(0);
      }
    }
    if (BA) {
#pragma unroll
      for (int w = 8; w >= 1; w >>= 1) {
        const bool up = (lane & w) != 0;
#pragma unroll
        for (int j = 0; j < w; ++j) {
          const float keep = up ? ba[j + w] : ba[j];
          const float send = up ? ba[j] : ba[j + w];
          ba[j] = keep + __shfl_xor(send, w, 64);
        }
      }
      float tot = ba[0];
      tot += __shfl_xor(tot, 16, 64); tot += __shfl_xor(tot, 32, 64);
      if (lane < 8) gb[(size_t)row * 16 + lane] = sigmoidf_(tot);
      else if (lane < 16) gb[(size_t)row * 16 + lane] = -__expf(p.a_log[lane - 8]) * softplusf_(tot + p.dt_bias[lane - 8]);
    }
  }
  if (BA) __syncthreads();
}

constexpr int LKN = 136, LKT = 72;
DI void d1_item(const Params& p, int item, char* smem) {
  int tid = threadIdx.x & 255;
  asm volatile("" : "+v"(tid));
  const int lane = tid & 63, wave = __builtin_amdgcn_readfirstlane(tid >> 6);
  const int r = lane & 31, hh = lane >> 5;
  const int h = item & 7, n = (item >> 3) & 31, b = item >> 8;
  const int rowbase = b * 2048 + n * 64;
  u16* kn  = (u16*)smem;
  u16* qn  = (u16*)(smem + 17408);
  u16* knT = (u16*)(smem + 34816);
  u16* vT  = (u16*)(smem + 53248);
  float* Gs = (float*)(smem + 71680);
  float* Bs = Gs + 64;
  float* Amat = (float*)(smem + 17408);
  u16* Tb = (u16*)smem;
  u16* Tg = (u16*)(smem + 17408);
  u16* qkv = (u16*)(p.ws + OFF_QKV);
  const u16* halo = (const u16*)(p.ws + OFF_HALO);
  const float* gb = (const float*)(p.ws + OFF_GB);

  if (wave == 0) {
    float g = gb[(size_t)(rowbase + lane) * 16 + 8 + h];
    const float be = gb[(size_t)(rowbase + lane) * 16 + h];
#pragma unroll
    for (int m = 1; m < 64; m <<= 1) { float t = __shfl_up(g, m, 64); if (lane >= m) g += t; }
    Gs[lane] = g; Bs[lane] = be;
  }
  {
    const int cp = lane;
#pragma unroll
    for (int X = 0; X < 3; ++X) {
      const int cb = X * 1024 + h * 128 + 2 * cp;
      float w[4][2];
#pragma unroll
      for (int j = 0; j < 4; ++j) { float2 t = *(const float2*)(p.gdn_conv_w + j * 3072 + cb); w[j][0] = t.x; w[j][1] = t.y; }
      float xw[3][2];
#pragma unroll
      for (int j = 0; j < 3; ++j) {
        const int rr = wave * 16 - 3 + j;
        unsigned u = 0u;
        if (rr >= 0) u = *(const unsigned*)(qkv + (size_t)(rowbase + rr) * 3072 + cb);
        else if (n > 0) u = *(const unsigned*)(halo + ((size_t)((b * 32 + n - 1) * 3 + (rr + 3))) * 3072 + cb);
        xw[j][0] = bf_lo(u); xw[j][1] = bf_hi(u);
      }
      float o[16][2];
#pragma unroll
      for (int t = 0; t < 16; ++t) {
        const unsigned u = *(const unsigned*)(qkv + (size_t)(rowbase + wave * 16 + t) * 3072 + cb);
        const float x0 = bf_lo(u), x1 = bf_hi(u);
        const float a0 = w[0][0] * xw[0][0] + w[1][0] * xw[1][0] + w[2][0] * xw[2][0] + w[3][0] * x0;
        const float a1 = w[0][1] * xw[0][1] + w[1][1] * xw[1][1] + w[2][1] * xw[2][1] + w[3][1] * x1;
        o[t][0] = siluf_(a0); o[t][1] = siluf_(a1);
        xw[0][0] = xw[1][0]; xw[0][1] = xw[1][1]; xw[1][0] = xw[2][0]; xw[1][1] = xw[2][1]; xw[2][0] = x0; xw[2][1] = x1;
      }
      if (X < 2) {
#pragma unroll
        for (int t = 0; t < 16; ++t) {
          const float ss = wsum(o[t][0] * o[t][0] + o[t][1] * o[t][1]);
          const float rs = rsqrtf(ss + EPS);
          o[t][0] *= rs; o[t][1] *= rs;
        }
      }
#pragma unroll
      for (int t = 0; t < 16; ++t) {
        const int row = wave * 16 + t;
        const unsigned pk = pk2(o[t][0], o[t][1]);
        if (X == 0) { *(unsigned*)(qn + row * LKN + 2 * cp) = pk; }
        else if (X == 1) {
          *(unsigned*)(kn + row * LKN + 2 * cp) = pk;
          knT[(2 * cp) * LKT + row] = (u16)(pk & 0xffffu); knT[(2 * cp + 1) * LKT + row] = (u16)(pk >> 16);
        } else {
          vT[(2 * cp) * LKT + row] = (u16)(pk & 0xffffu); vT[(2 * cp + 1) * LKT + row] = (u16)(pk >> 16);
        }
      }
    }
  }
  __syncthreads();
  const float Glast = Gs[63];
#pragma unroll
  for (int ff = 0; ff < 4; ++ff) {
    const int f = wave * 4 + ff;
    const int it = f >> 3, kb = (f >> 1) & 3, s = f & 1;
    const int i = it * 32 + r;
    const float sc = QSCALE * __expf(Gs[i]);
    const uint2 a = *(const uint2*)(qn + i * LKN + kb * 32 + 16 * s + 4 * hh);
    const uint2 c = *(const uint2*)(qn + i * LKN + kb * 32 + 16 * s + 4 * hh + 8);
    uint4 o;
    o.x = pk2(bf_lo(a.x) * sc, bf_hi(a.x) * sc); o.y = pk2(bf_lo(a.y) * sc, bf_hi(a.y) * sc);
    o.z = pk2(bf_lo(c.x) * sc, bf_hi(c.x) * sc); o.w = pk2(bf_lo(c.y) * sc, bf_hi(c.y) * sc);
    *(uint4*)((char*)qkv + (size_t)(rowbase + 4 * f + (lane >> 4)) * 6144 + h * 256 + (lane & 15) * 16) = o;
  }
  char* ext = p.ws + OFF_EXTRA + (size_t)item * 24576;
#pragma unroll
  for (int ff = 0; ff < 4; ++ff) {
    const int f = wave * 4 + ff;
    const int kt = f >> 2, pb = (f >> 1) & 1, s = f & 1;
    const int k = kt * 32 + r;
    const int p0 = pb * 32 + 16 * s + 4 * hh;
    const uint2 a = *(const uint2*)(knT + k * LKT + p0);
    const uint2 c = *(const uint2*)(knT + k * LKT + p0 + 8);
    const float4 g0 = *(const float4*)(Gs + p0), g1 = *(const float4*)(Gs + p0 + 8);
    uint4 o;
    o.x = pk2(bf_lo(a.x) * __expf(Glast - g0.x), bf_hi(a.x) * __expf(Glast - g0.y));
    o.y = pk2(bf_lo(a.y) * __expf(Glast - g0.z), bf_hi(a.y) * __expf(Glast - g0.w));
    o.z = pk2(bf_lo(c.x) * __expf(Glast - g1.x), bf_hi(c.x) * __expf(Glast - g1.y));
    o.w = pk2(bf_lo(c.y) * __expf(Glast - g1.z), bf_hi(c.y) * __expf(Glast - g1.w));
    *(uint4*)(ext + f * 1024 + lane * 16) = o;
  }
  f32x16 akk = zero16(), aqk = zero16();
  const int ta = (wave == 0) ? 0 : 1, tb = (wave == 2) ? 1 : 0;
  if (wave < 3) {
#pragma unroll
    for (int ks = 0; ks < 8; ++ks) {
      const bf16x8 fa = *(const bf16x8*)(kn + (ta * 32 + r) * LKN + ks * 16 + 8 * hh);
      const bf16x8 fb = *(const bf16x8*)(kn + (tb * 32 + r) * LKN + ks * 16 + 8 * hh);
      const bf16x8 fq = *(const bf16x8*)(qn + (ta * 32 + r) * LKN + ks * 16 + 8 * hh);
      akk = MFMA(fa, fb, akk);
      aqk = MFMA(fb, fq, aqk);
    }
  }
  __syncthreads();
  if (wave < 3) {
    const int m = tb * 32 + r; const float Gm = Gs[m];
#pragma unroll
    for (int reg = 0; reg < 16; ++reg) {
      const int i = ta * 32 + crow(reg, hh);
      const float v = (m < i) ? Bs[i] * akk[reg] * __expf(Gs[i] - Gm) : 0.f;
      Amat[i * 64 + m] = v;
    }
    const int i = ta * 32 + r; const float Gi = Gs[i];
    f32x16 av;
#pragma unroll
    for (int reg = 0; reg < 16; ++reg) {
      const int j = tb * 32 + crow(reg, hh);
      av[reg] = (j <= i) ? aqk[reg] * QSCALE * __expf(Gi - Gs[j]) : 0.f;
    }
    const int fbase = 16 + (wave * 2);
#pragma unroll
    for (int s = 0; s < 2; ++s) {
      bf16x8 fr8 = pack8(av, s);
      *(bf16x8*)(ext + (fbase + s) * 1024 + lane * 16) = fr8;
    }
  } else {
    for (int e = lane; e < 32 * 32; e += 64) Amat[(e >> 5) * 64 + 32 + (e & 31)] = 0.f;
    if (lane == 0) *(float*)(ext + 22 * 1024) = __expf(Glast);
  }
  __syncthreads();
  float* Tq = (float*)(smem + 9216);
  if (wave == 0) {
    float x[32];
    const int c = lane & 31, hb = lane >> 5;
    const float* Ab = Amat + (hb * 32) * 64 + hb * 32;
#pragma unroll
    for (int i = 0; i < 32; ++i) {
      float s0 = (c == i) ? 1.f : 0.f, s1 = 0.f;
#pragma unroll
      for (int m4 = 0; m4 < (i + 3) / 4; ++m4) {
        const float4 a4 = *(const float4*)(Ab + i * 64 + m4 * 4);
        if (m4 * 4 + 0 < i) s0 -= a4.x * x[m4 * 4 + 0];
        if (m4 * 4 + 1 < i) s1 -= a4.y * x[m4 * 4 + 1];
        if (m4 * 4 + 2 < i) s0 -= a4.z * x[m4 * 4 + 2];
        if (m4 * 4 + 3 < i) s1 -= a4.w * x[m4 * 4 + 3];
      }
      x[i] = s0 + s1;
      __builtin_amdgcn_sched_barrier(0);
    }
#pragma unroll
    for (int i = 0; i < 32; ++i) Tq[hb * 1024 + i * 32 + c] = x[i];
  }
  __syncthreads();
  const int c32 = tid & 31, g8 = tid >> 5;
  {
    float bm[4] = {0.f, 0.f, 0.f, 0.f};
#pragma unroll
    for (int j4 = 0; j4 < 8; ++j4) {
      float t[4];
#pragma unroll
      for (int e = 0; e < 4; ++e) t[e] = Tq[(j4 * 4 + e) * 32 + c32];
#pragma unroll
      for (int e = 0; e < 4; ++e) {
        const float4 a4 = *(const float4*)(Amat + (32 + g8 * 4 + e) * 64 + j4 * 4);
        bm[e] += a4.x * t[0] + a4.y * t[1] + a4.z * t[2] + a4.w * t[3];
      }
    }
#pragma unroll
    for (int e = 0; e < 4; ++e) Amat[(g8 * 4 + e) * 64 + 32 + c32] = bm[e];
  }
  __syncthreads();
  float t21[4] = {0.f, 0.f, 0.f, 0.f};
  {
#pragma unroll
    for (int m4 = 0; m4 < 8; ++m4) {
      float bv[4];
#pragma unroll
      for (int e = 0; e < 4; ++e) bv[e] = Amat[(m4 * 4 + e) * 64 + 32 + c32];
#pragma unroll
      for (int e = 0; e < 4; ++e) {
        const float4 a4 = *(const float4*)(Tq + 1024 + (g8 * 4 + e) * 32 + m4 * 4);
        t21[e] -= a4.x * bv[0] + a4.y * bv[1] + a4.z * bv[2] + a4.w * bv[3];
      }
    }
  }
  float t11[4], t22[4];
#pragma unroll
  for (int e = 0; e < 4; ++e) { t11[e] = Tq[(g8 * 4 + e) * 32 + c32]; t22[e] = Tq[1024 + (g8 * 4 + e) * 32 + c32]; }
  const float bcl = Bs[c32], bgl = bcl * __expf(Gs[c32]);
  const float bch = Bs[32 + c32], bgh = bch * __expf(Gs[32 + c32]);
  __syncthreads();
#pragma unroll
  for (int e = 0; e < 4; ++e) {
    const int i = g8 * 4 + e;
    Tb[i * LKT + c32] = f2bf(t11[e] * bcl);               Tg[i * LKT + c32] = f2bf(t11[e] * bgl);
    Tb[i * LKT + 32 + c32] = (u16)0;                      Tg[i * LKT + 32 + c32] = (u16)0;
    Tb[(32 + i) * LKT + c32] = f2bf(t21[e] * bcl);        Tg[(32 + i) * LKT + c32] = f2bf(t21[e] * bgl);
    Tb[(32 + i) * LKT + 32 + c32] = f2bf(t22[e] * bch);   Tg[(32 + i) * LKT + 32 + c32] = f2bf(t22[e] * bgh);
  }
  __syncthreads();
#pragma unroll
  for (int it = 0; it < 2; ++it) {
    f32x16 av = zero16(), ak = zero16();
#pragma unroll
    for (int ks = 0; ks < 4; ++ks) {
      const bf16x8 fT = *(const bf16x8*)(Tb + (it * 32 + r) * LKT + ks * 16 + 8 * hh);
      const bf16x8 fV = *(const bf16x8*)(vT + (wave * 32 + r) * LKT + ks * 16 + 8 * hh);
      const bf16x8 fK = *(const bf16x8*)(knT + (wave * 32 + r) * LKT + ks * 16 + 8 * hh);
      const bf16x8 fG = *(const bf16x8*)(Tg + (it * 32 + r) * LKT + ks * 16 + 8 * hh);
      av = MFMA(fT, fV, av);
      ak = MFMA(fK, fG, ak);
    }
    {
      const int fv = wave * 2 + it;
      char* d = (char*)qkv + (size_t)(rowbase + 8 * fv + (lane >> 3)) * 6144 + 4096 + h * 256 + (lane & 7) * 32;
      *(bf16x8*)d = pack8(av, 0); *(bf16x8*)(d + 16) = pack8(av, 1);
    }
#pragma unroll
    for (int s = 0; s < 2; ++s) {
      const int f = it * 8 + wave * 2 + s;
      *(bf16x8*)((char*)qkv + (size_t)(rowbase + 4 * f + (lane >> 4)) * 6144 + 2048 + h * 256 + (lane & 15) * 16) = pack8(ak, s);
    }
  }
  __syncthreads();
}

DI void d2_issue(u32x4 (&rg)[18], const Params& p, int b, int h, int lt, int n) {
  const char* qseg = p.ws + OFF_QKV + (size_t)(b * 2048 + n * 64) * 6144 + h * 256;
  const char* ext = p.ws + OFF_EXTRA + (size_t)((b * 32 + n) * 8 + h) * 24576;
#pragma unroll
  for (int sg = 0; sg < 3; ++sg)
#pragma unroll
    for (int i = 0; i < 4; ++i) rg[sg * 4 + i] = __builtin_nontemporal_load((const u32x4*)(qseg + (size_t)((lt >> 4) + 16 * i) * 6144 + sg * 2048 + (lt & 15) * 16));
#pragma unroll
  for (int i = 0; i < 6; ++i) rg[12 + i] = __builtin_nontemporal_load((const u32x4*)(ext + lt * 16 + i * 4096));
}
DI void d2_put(const u32x4 (&rg)[18], char* buf, int lt) {
#pragma unroll
  for (int sg = 0; sg < 3; ++sg)
#pragma unroll
    for (int i = 0; i < 4; ++i) *(u32x4*)(buf + sg * 16384 + ((lt >> 4) + 16 * i) * 256 + (lt & 15) * 16) = rg[sg * 4 + i];
#pragma unroll
  for (int i = 0; i < 6; ++i) *(u32x4*)(buf + 49152 + lt * 16 + i * 4096) = rg[12 + i];
}
DI void d2_block(const Params& p, int unit, char* smem) {
  const int tid = threadIdx.x, half = tid >> 8, lt = tid & 255, lane = tid & 63, wave = (tid >> 6) & 3;
  const int r = lane & 31, hh = lane >> 5;
  const int b = unit >> 3, h = unit & 7;
  const char* qkv = p.ws + OFF_QKV;
  const float* egl = (const float*)(p.ws + OFF_EGL);
  u16* obuf = (u16*)((char*)p.out + (size_t)R * 1024 * 2);
  if (half == 1) {
    u32x4 rg0[18], rg1[18];
    u32x4 og[4], sg4;
    u16* obuf_ = (u16*)((char*)p.out + (size_t)R * 1024 * 2);
    float* ssq_ = (float*)(p.ws + OFF_SSQ);
    const int orow = lt >> 2, opos = lt & 3, ocol = 8 * (opos ^ ((orow >> 1) & 3));
    d2_issue(rg0, p, b, h, lt, 0); d2_put(rg0, smem, lt); d2_issue(rg1, p, b, h, lt, 1); d2_issue(rg0, p, b, h, lt, 2);
    __syncthreads();
#define D2_LOADER_STEP(n_, RG)                                                                                              \
    {                                                                                                                        \
      const int n = (n_);                                                                                                    \
      char* ob = smem + ((n + 1) & 1) * HALF_SMEM;                                                                           \
      if (n >= 1) {                                                                                                          \
        _Pragma("unroll") for (int i = 0; i < 4; ++i) og[i] = *(const u32x4*)(ob + 32768 + (lt + 256 * i) * 16);            \
        if (lt >= 192) sg4 = *(const u32x4*)(ob + 49152 + 20480 + lt * 16);                                                  \
      }                                                                                                                      \
      if (n + 1 < 32) { d2_put(RG, ob, lt); if (n + 3 < 32) d2_issue(RG, p, b, h, lt, n + 3); }                              \
      if (n >= 1) {                                                                                                          \
        const int rowbase = b * 2048 + (n - 1) * 64;                                                                         \
        _Pragma("unroll") for (int i = 0; i < 4; ++i)                                                                        \
          *(u32x4*)(obuf_ + (size_t)(rowbase + orow) * 1024 + h * 128 + 32 * i + ocol) = og[i];                              \
        if (lt >= 192) *(u32x4*)(ssq_ + ((size_t)(rowbase + lt - 192) * 8 + h) * 4) = sg4;                                   \
      }                                                                                                                      \
      if (n < 32) { asm volatile("s_waitcnt lgkmcnt(0)" ::: "memory"); __builtin_amdgcn_s_barrier(); asm volatile("" ::: "memory"); } \
    }
#pragma unroll 1
    for (int n2 = 0; n2 <= 32; n2 += 2) {
      D2_LOADER_STEP(n2, rg1)
      if (n2 + 1 <= 32) D2_LOADER_STEP(n2 + 1, rg0)
    }
#undef D2_LOADER_STEP
    return;
  }
  f32x16 S[4];
#pragma unroll
  for (int k = 0; k < 4; ++k) S[k] = zero16();
  const unsigned voff_l = (unsigned)(lane * 16);
  bf16x8 If0, If1;
#pragma unroll
  for (int j = 0; j < 8; ++j) {
    const int k0 = 8 * (j >> 2) + 4 * hh + (j & 3);
    If0[j] = (short)((k0 == r) ? 0x3F80 : 0); If1[j] = (short)((16 + k0 == r) ? 0x3F80 : 0);
  }
  const unsigned voff_v = (unsigned)((16 * wave + (lane >> 3)) * 256 + (lane & 7) * 32);
  __syncthreads();
#pragma unroll 1
  for (int n = 0; n < 32; ++n) {
    const int item = (b * 32 + n) * 8 + h;
    const int rowbase = b * 2048 + n * 64;
    const char* buf = smem + (n & 1) * HALF_SMEM;
    const char* ext = buf + 49152;
    const float eg = *(const float*)(ext + 22 * 1024);
    bf16x8 fk[16];
#pragma unroll
    for (int f = 0; f < 16; ++f) fk[f] = *(const bf16x8*)(buf + 16384 + f * 1024 + voff_l);
    uint4 vv[2][2];
#pragma unroll
    for (int it = 0; it < 2; ++it) { const char* d = buf + 32768 + it * 2048 + voff_v; vv[it][0] = *(const uint4*)d; vv[it][1] = *(const uint4*)(d + 16); }
    bf16x8 Sf[4][2];
#pragma unroll
    for (int kb = 0; kb < 4; ++kb) { Sf[kb][0] = pack8(S[kb], 0); Sf[kb][1] = pack8(S[kb], 1); }
    __builtin_amdgcn_sched_barrier(0);
    f32x16 P1[2];
    P1[0] = zero16(); P1[1] = zero16();
#pragma unroll
    for (int kb = 0; kb < 4; ++kb)
#pragma unroll
      for (int s = 0; s < 2; ++s) {
        P1[0] = MFMA(fk[kb * 2 + s], Sf[kb][s], P1[0]);
        P1[1] = MFMA(fk[8 + kb * 2 + s], Sf[kb][s], P1[1]);
      }
    bf16x8 fq[8];
#pragma unroll
    for (int f = 0; f < 8; ++f) fq[f] = *(const bf16x8*)(buf + f * 1024 + voff_l);
    bf16x8 Vf[2][2];
#pragma unroll
    for (int it = 0; it < 2; ++it) {
      const uint4 v0 = vv[it][0], v1 = vv[it][1];
      f32x16 vn;
      vn[0] = bf_lo(v0.x) - P1[it][0];  vn[1] = bf_hi(v0.x) - P1[it][1];
      vn[2] = bf_lo(v0.y) - P1[it][2];  vn[3] = bf_hi(v0.y) - P1[it][3];
      vn[4] = bf_lo(v0.z) - P1[it][4];  vn[5] = bf_hi(v0.z) - P1[it][5];
      vn[6] = bf_lo(v0.w) - P1[it][6];  vn[7] = bf_hi(v0.w) - P1[it][7];
      vn[8] = bf_lo(v1.x) - P1[it][8];  vn[9] = bf_hi(v1.x) - P1[it][9];
      vn[10] = bf_lo(v1.y) - P1[it][10]; vn[11] = bf_hi(v1.y) - P1[it][11];
      vn[12] = bf_lo(v1.z) - P1[it][12]; vn[13] = bf_hi(v1.z) - P1[it][13];
      vn[14] = bf_lo(v1.w) - P1[it][14]; vn[15] = bf_hi(v1.w) - P1[it][15];
      Vf[it][0] = pack8(vn, 0); Vf[it][1] = pack8(vn, 1);
    }
    bf16x8 fa[6];
#pragma unroll
    for (int i = 0; i < 6; ++i) fa[i] = *(const bf16x8*)(ext + (16 + i) * 1024 + voff_l);
    f32x16 P2[2];
    P2[0] = zero16(); P2[1] = zero16();
#pragma unroll
    for (int kb = 0; kb < 4; ++kb)
#pragma unroll
      for (int s = 0; s < 2; ++s) {
        P2[0] = MFMA(fq[kb * 2 + s], Sf[kb][s], P2[0]);
        const bf16x8 fq1 = *(const bf16x8*)(buf + (8 + kb * 2 + s) * 1024 + voff_l);
        P2[1] = MFMA(fq1, Sf[kb][s], P2[1]);
      }
    __builtin_amdgcn_sched_barrier(0);
    bf16x8 fkd[16];
#pragma unroll
    for (int i = 0; i < 16; ++i) fkd[i] = *(const bf16x8*)(ext + i * 1024 + voff_l);
#pragma unroll
    for (int s = 0; s < 2; ++s) {
      P2[0] = MFMA(fa[0 + s], Vf[0][s], P2[0]);
      P2[1] = MFMA(fa[2 + s], Vf[0][s], P2[1]);
      P2[1] = MFMA(fa[4 + s], Vf[1][s], P2[1]);
    }
    {
      char* ow = (char*)buf + 32768 + wave * 4096;
      float* sqw = (float*)((char*)buf + 49152 + 23 * 1024);
      const int xs = (r >> 1) & 3;
#pragma unroll
      for (int it = 0; it < 2; ++it) {
        f32x16 Z = MFMA(pack8(P2[it], 0), If0, zero16());
        Z = MFMA(pack8(P2[it], 1), If1, Z);
        float ssl = 0.f;
#pragma unroll
        for (int reg = 0; reg < 16; ++reg) ssl += Z[reg] * Z[reg];
        ssl += __shfl_xor(ssl, 32, 64);
        if (hh == 0) sqw[(it * 32 + r) * 4 + wave] = ssl;
#pragma unroll
        for (int g = 0; g < 4; ++g) {
          uint2 pv; pv.x = pk2(Z[4 * g], Z[4 * g + 1]); pv.y = pk2(Z[4 * g + 2], Z[4 * g + 3]);
          *(uint2*)(ow + (it * 32 + r) * 64 + ((g ^ xs) * 16) + hh * 8) = pv;
        }
      }
    }
#pragma unroll
    for (int kt = 0; kt < 4; ++kt) {
#pragma unroll
      for (int reg = 0; reg < 16; ++reg) S[kt][reg] *= eg;
#pragma unroll
      for (int pb = 0; pb < 2; ++pb)
#pragma unroll
        for (int s = 0; s < 2; ++s) {
          S[kt] = MFMA(fkd[kt * 4 + pb * 2 + s], Vf[pb][s], S[kt]);
        }
    }
    asm volatile("s_waitcnt lgkmcnt(0)" ::: "memory"); __builtin_amdgcn_s_barrier(); asm volatile("" ::: "memory");
  }
  float* od = p.out + OUT_DELTAP + (size_t)(b * 8 + h) * 16384;
#pragma unroll
  for (int kt = 0; kt < 4; ++kt)
#pragma unroll
    for (int reg = 0; reg < 16; ++reg) od[(kt * 32 + crow(reg, hh)) * 128 + wave * 32 + r] = S[kt][reg];
}

DI void conf_prompt_item(const Params& p, int item, char* smem) {
  const int tid = threadIdx.x & 255, lane = tid & 63, wave = tid >> 6;
  const int b = item >> 6, t0 = (item & 63) * 32;
  unsigned* tile = (unsigned*)smem;
  float* red = (float*)(smem + 63488);
  const u16* glu = (const u16*)(p.ws + OFF_GLU);
  u16* aact = (u16*)(p.ws + OFF_AACT);
#pragma unroll 1
  for (int hb = 0; hb < 2; ++hb) {
    u32x4 fv[8];
#pragma unroll
    for (int i = 0; i < 8; ++i) {
      const int e = tid + 256 * (hb * 8 + i), rr = e >> 6, c8 = (e & 63) * 8;
      const int t = t0 - 30 + rr;
      fv[i] = (u32x4){0u, 0u, 0u, 0u};
      if (rr < 62 && t >= 0) fv[i] = *(const u32x4*)(glu + (size_t)(b * 2048 + t) * 512 + c8);
    }
#pragma unroll
    for (int i = 0; i < 8; ++i) {
      const int e = tid + 256 * (hb * 8 + i), rr = e >> 6, c8 = (e & 63) * 8;
      if (rr < 62) *(u32x4*)(tile + rr * 256 + (c8 >> 1)) = fv[i];
    }
  }
  float w[31][2];
#pragma unroll
  for (int j = 0; j < 31; ++j) { const float2 t = *(const float2*)(p.conf_dw_w + j * 512 + 2 * tid); w[j][0] = t.x; w[j][1] = t.y; }
  const float2 bias = *(const float2*)(p.conf_dw_b + 2 * tid);
  const float2 lw = *(const float2*)(p.conf_ln_w + 2 * tid), lb = *(const float2*)(p.conf_ln_b + 2 * tid);
  __syncthreads();
#pragma unroll 1
  for (int tg = 0; tg < 4; ++tg) {
    float a[8][2];
#pragma unroll
    for (int t = 0; t < 8; ++t) { a[t][0] = bias.x; a[t][1] = bias.y; }
#pragma unroll
    for (int i = 0; i < 38; ++i) {
      const unsigned u = tile[(tg * 8 + i) * 256 + tid];
      const float x0 = bf_lo(u), x1 = bf_hi(u);
#pragma unroll
      for (int t = 0; t < 8; ++t) {
        const int j = i - t;
        if (j >= 0 && j < 31) { a[t][0] += w[j][0] * x0; a[t][1] += w[j][1] * x1; }
      }
    }
#pragma unroll
    for (int t = 0; t < 8; ++t) {
      const float s1 = wsum(a[t][0] + a[t][1]);
      const float s2 = wsum(a[t][0] * a[t][0] + a[t][1] * a[t][1]);
      if (lane == 0) { red[(wave * 8 + t) * 2] = s1; red[(wave * 8 + t) * 2 + 1] = s2; }
    }
    __syncthreads();
#pragma unroll
    for (int t = 0; t < 8; ++t) {
      const float s1 = red[t * 2] + red[(8 + t) * 2] + red[(16 + t) * 2] + red[(24 + t) * 2];
      const float s2 = red[t * 2 + 1] + red[(8 + t) * 2 + 1] + red[(16 + t) * 2 + 1] + red[(24 + t) * 2 + 1];
      const float mu = s1 * (1.f / 512.f);
      const float var = fmaxf(s2 * (1.f / 512.f) - mu * mu, 0.f);
      const float rs = rsqrtf(var + EPS);
      const float y0 = (a[t][0] - mu) * rs * lw.x + lb.x, y1 = (a[t][1] - mu) * rs * lw.y + lb.y;
      *(unsigned*)(aact + (size_t)(b * 2048 + t0 + tg * 8 + t) * 512 + 2 * tid) = pk2(siluf_(y0), siluf_(y1));
    }
    __syncthreads();
  }
}
DI void conf_sample_item(const Params& p, int item) {
  const int lane = threadIdx.x & 63, wave = (threadIdx.x >> 6) & 3;
  const int s = item * 4 + wave;
  const int c = lane * 8;
  const u16* glu = (const u16*)(p.ws + OFF_GLU);
  u16* aact = (u16*)(p.ws + OFF_AACT);
  float a[8];
  {
    const float4 b0 = *(const float4*)(p.conf_dw_b + c), b1 = *(const float4*)(p.conf_dw_b + c + 4);
    a[0] = b0.x; a[1] = b0.y; a[2] = b0.z; a[3] = b0.w; a[4] = b1.x; a[5] = b1.y; a[6] = b1.z; a[7] = b1.w;
  }
  const float* st = p.st_conf + (size_t)s * 30 * 512;
  float* oc = p.out + OUT_CONFS + (size_t)s * 30 * 512;
#pragma unroll 1
  for (int j = 0; j < 30; ++j) {
    const f32x4 n0 = __builtin_nontemporal_load((const f32x4*)(st + j * 512 + c)), n1 = __builtin_nontemporal_load((const f32x4*)(st + j * 512 + c + 4));
    const float4 x0 = make_float4(n0[0], n0[1], n0[2], n0[3]), x1 = make_float4(n1[0], n1[1], n1[2], n1[3]);
    const float4 w0 = *(const float4*)(p.conf_dw_w + j * 512 + c), w1 = *(const float4*)(p.conf_dw_w + j * 512 + c + 4);
    a[0] += w0.x * x0.x; a[1] += w0.y * x0.y; a[2] += w0.z * x0.z; a[3] += w0.w * x0.w;
    a[4] += w1.x * x1.x; a[5] += w1.y * x1.y; a[6] += w1.z * x1.z; a[7] += w1.w * x1.w;
    if (j >= 1) { __builtin_nontemporal_store(n0, (f32x4*)(oc + (j - 1) * 512 + c)); __builtin_nontemporal_store(n1, (f32x4*)(oc + (j - 1) * 512 + c + 4)); }
  }
  {
    const uint4 g = *(const uint4*)(glu + (size_t)(RP + s) * 512 + c);
    const float4 w0 = *(const float4*)(p.conf_dw_w + 30 * 512 + c), w1 = *(const float4*)(p.conf_dw_w + 30 * 512 + c + 4);
    a[0] += w0.x * bf_lo(g.x); a[1] += w0.y * bf_hi(g.x); a[2] += w0.z * bf_lo(g.y); a[3] += w0.w * bf_hi(g.y);
    a[4] += w1.x * bf_lo(g.z); a[5] += w1.y * bf_hi(g.z); a[6] += w1.z * bf_lo(g.w); a[7] += w1.w * bf_hi(g.w);
  }
  float s1 = 0.f, s2 = 0.f;
#pragma unroll
  for (int i = 0; i < 8; ++i) { s1 += a[i]; s2 += a[i] * a[i]; }
  s1 = wsum(s1); s2 = wsum(s2);
  const float mu = s1 * (1.f / 512.f);
  const float rs = rsqrtf(fmaxf(s2 * (1.f / 512.f) - mu * mu, 0.f) + EPS);
  float y[8];
#pragma unroll
  for (int i = 0; i < 8; ++i) y[i] = siluf_((a[i] - mu) * rs * p.conf_ln_w[c + i] + p.conf_ln_b[c + i]);
  uint4 o; o.x = pk2(y[0], y[1]); o.y = pk2(y[2], y[3]); o.z = pk2(y[4], y[5]); o.w = pk2(y[6], y[7]);
  *(uint4*)(aact + (size_t)(RP + s) * 512 + c) = o;
}
DI void delta_sample_item(const Params& p, int item, char* smem) {
  const int tid = threadIdx.x & 255, lane = tid & 63, wave = tid >> 6;
  const int s = item >> 3, h = item & 7;
  float* qs = (float*)smem; float* ks = qs + 128; float* vs = ks + 128; float* part = vs + 128;
  float* red = part + 768;
  const u16* qkv = (const u16*)(p.ws + OFF_QKV);
  const float* gb = (const float*)(p.ws + OFF_GB);
  const int row = RP + s;
  const int v = tid & 127, kh = tid >> 7;
  const float* S0 = p.st_delta + (size_t)(s * 8 + h) * 16384 + (size_t)(kh * 64) * 128 + v;
  float Sr[64];
#pragma unroll
  for (int kk = 0; kk < 64; ++kk) Sr[kk] = __builtin_nontemporal_load(S0 + kk * 128);
  const float g = gb[(size_t)row * 16 + 8 + h], beta = gb[(size_t)row * 16 + h];
  float cq = 0.f, ck = 0.f, cv = 0.f;
  if (tid < 128) {
    float cx[3];
#pragma unroll
    for (int X = 0; X < 3; ++X) {
      const int cg = X * 1024 + h * 128 + tid;
      const float s0 = p.st_qkv[(size_t)(s * 3 + 0) * 3072 + cg], s1 = p.st_qkv[(size_t)(s * 3 + 1) * 3072 + cg], s2 = p.st_qkv[(size_t)(s * 3 + 2) * 3072 + cg];
      const float x = bf1(qkv[(size_t)row * 3072 + cg]);
      const float a = p.gdn_conv_w[cg] * s0 + p.gdn_conv_w[3072 + cg] * s1 + p.gdn_conv_w[2 * 3072 + cg] * s2 + p.gdn_conv_w[3 * 3072 + cg] * x;
      cx[X] = siluf_(a);
      p.out[OUT_QKVS + (size_t)(s * 3 + 0) * 3072 + cg] = s1;
      p.out[OUT_QKVS + (size_t)(s * 3 + 1) * 3072 + cg] = s2;
    }
    cq = cx[0]; ck = cx[1]; cv = cx[2];
  }
  {
    const float sq = wsum(cq * cq), sk = wsum(ck * ck);
    if (lane == 0) { red[wave * 2] = sq; red[wave * 2 + 1] = sk; }
  }
  __syncthreads();
  if (tid < 128) {
    const float rq = rsqrtf(red[0] + red[2] + EPS), rk = rsqrtf(red[1] + red[3] + EPS);
    qs[tid] = cq * rq * QSCALE; ks[tid] = ck * rk; vs[tid] = cv;
  }
  __syncthreads();
  const float eg = __expf(g);
  float kS = 0.f, qS = 0.f, qk = 0.f;
#pragma unroll
  for (int k4 = 0; k4 < 16; ++k4) {
    const float4 kv = *(const float4*)(ks + kh * 64 + k4 * 4), qv = *(const float4*)(qs + kh * 64 + k4 * 4);
    kS += kv.x * Sr[4 * k4] + kv.y * Sr[4 * k4 + 1] + kv.z * Sr[4 * k4 + 2] + kv.w * Sr[4 * k4 + 3];
    qS += qv.x * Sr[4 * k4] + qv.y * Sr[4 * k4 + 1] + qv.z * Sr[4 * k4 + 2] + qv.w * Sr[4 * k4 + 3];
    qk += kv.x * qv.x + kv.y * qv.y + kv.z * qv.z + kv.w * qv.w;
  }
  part[(kh * 3 + 0) * 128 + v] = kS; part[(kh * 3 + 1) * 128 + v] = qS; part[(kh * 3 + 2) * 128 + v] = qk;
  __syncthreads();
  kS = part[0 * 128 + v] + part[3 * 128 + v];
  qS = part[1 * 128 + v] + part[4 * 128 + v];
  qk = part[2 * 128 + v] + part[5 * 128 + v];
  const float vnew = vs[v] * beta - beta * eg * kS;
  const float o = eg * qS + qk * vnew;
  float* Sd = p.out + OUT_DELTAS + (size_t)(s * 8 + h) * 16384 + (size_t)(kh * 64) * 128 + v;
#pragma unroll
  for (int k4 = 0; k4 < 16; ++k4) {
    const float4 kv = *(const float4*)(ks + kh * 64 + k4 * 4);
    __builtin_nontemporal_store(Sr[4 * k4 + 0] * eg + kv.x * vnew, Sd + (4 * k4 + 0) * 128);
    __builtin_nontemporal_store(Sr[4 * k4 + 1] * eg + kv.y * vnew, Sd + (4 * k4 + 1) * 128);
    __builtin_nontemporal_store(Sr[4 * k4 + 2] * eg + kv.z * vnew, Sd + (4 * k4 + 2) * 128);
    __builtin_nontemporal_store(Sr[4 * k4 + 3] * eg + kv.w * vnew, Sd + (4 * k4 + 3) * 128);
  }
  if (kh == 0) {
    ((u16*)((char*)p.out + (size_t)R * 1024 * 2))[(size_t)row * 1024 + h * 128 + v] = f2bf(o);
    const float so = wsum(o * o);
    if (lane == 0) { float* sq = (float*)(p.ws + OFF_SSQ) + ((size_t)row * 8 + h) * 4; sq[wave] = so; sq[wave + 2] = 0.f; }
  }
  __syncthreads();
}

__global__ void __launch_bounds__(512, 2) fwd_megakernel(Params p) {
  __shared__ __attribute__((aligned(1024))) char smem[SMEM_BYTES];
  const int tid = threadIdx.x, lane = tid & 63, wave = tid >> 6;
  const int fr = lane & 15, fq = lane >> 4;
  uint4* xb_words = (uint4*)(smem + 2 * HALF_SMEM);
  if (tid == 0) *xb_words = make_uint4(0u, 0u, 0u, 0u);
  __syncthreads();
  XcdBarrier xb = xcd_barrier_post((unsigned*)(p.ws + OFF_BAR), (volatile LAS unsigned*)xb_words);
  const int G = gridDim.x, bid = blockIdx.x;
  float* mod = (float*)(p.ws + OFF_MOD);
  u16* hbuf = (u16*)p.out;
  u16* obuf = (u16*)((char*)p.out + (size_t)R * 1024 * 2);
  const float* ssq = (const float*)(p.ws + OFF_SSQ);
  u16* merged = (u16*)(p.ws + OFF_MERGED);
  u16* tmp2 = (u16*)(p.ws + OFF_TMP2);

  PH(0) phase_convert(p, smem);
  xcd_barrier(xb);

  PH(1) for (int sb = bid; sb < 256; sb += G) {
    skinny<2>((const u16*)(p.ws + OFF_AC), 1024, 0, 136, (const u16*)(p.ws + OFF_WADA), 1024, 1024,
      [&](int j) { return sb * 24 + (j < 24 ? j : 23); },
      [&](int row, int ntl, int q, f32x4 v, int ln) {
        const int j = ntl * 16 + 4 * q;
        if (j < 24) {
          const int col = sb * 24 + j;
          const float4 bb = *(const float4*)(p.b_ada + col);
          *(float4*)(mod + (size_t)row * 6144 + col) = make_float4(v[0] + bb.x, v[1] + bb.y, v[2] + bb.z, v[3] + bb.w);
        }
      });
  }
  xcd_barrier(xb);

  PH(2) phase_modnorm<false>(p, p.x_prompt, p.x_sample, p.norm1_w, 0, 1024, hbuf, smem);
  xcd_barrier(xb);

  PH(3) {
    u16* glu = (u16*)(p.ws + OFF_GLU);
    u16* qkv = (u16*)(p.ws + OFF_QKV);
    u16* halo = (u16*)(p.ws + OFF_HALO);
    auto f_glu_st = [&](int row, int ch, f32x4 gl) {
      uint2 o; o.x = pk2(gl[0], gl[1]); o.y = pk2(gl[2], gl[3]);
      *(uint2*)(glu + (size_t)row * 512 + ch) = o;
      if (row < RP) { const int b = row >> 11, tt = row & 2047; if (tt >= 2018) *(float4*)(p.out + OUT_CONFP + (size_t)(b * 30 + tt - 2018) * 512 + ch) = make_float4(gl[0], gl[1], gl[2], gl[3]); }
      else *(float4*)(p.out + OUT_CONFS + (size_t)((row - RP) * 30 + 29) * 512 + ch) = make_float4(gl[0], gl[1], gl[2], gl[3]);
    };
    auto f_glu = [&](int row, int ch, f32x4 a, f32x4 g) {
      f32x4 gl;
#pragma unroll
      for (int j = 0; j < 4; ++j) gl[j] = a[j] * sigmoidf_(g[j]);
      f_glu_st(row, ch, gl);
    };
    auto f_qkv = [&](int row, int col, f32x4 a) {
      const float4 v = make_float4(a[0], a[1], a[2], a[3]);
      uint2 o; o.x = pk2(v.x, v.y); o.y = pk2(v.z, v.w);
      *(uint2*)(qkv + (size_t)row * 3072 + col) = o;
      if (row < RP) {
        const int b = row >> 11, tt = row & 2047;
        if ((tt & 63) >= 61) *(uint2*)(halo + (size_t)((b * 32 + (tt >> 6)) * 3 + (tt & 63) - 61) * 3072 + col) = o;
        if (tt >= 2045) *(float4*)(p.out + OUT_QKVP + (size_t)(b * 3 + tt - 2045) * 3072 + col) = v;
      } else *(float4*)(p.out + OUT_QKVS + (size_t)((row - RP) * 3 + 2) * 3072 + col) = v;
    };
    {
      float* gb = (float*)(p.ws + OFF_GB);
      for (int rb = bid; rb < R / 32; rb += G)
        skinny<1>(hbuf, 1024, rb * 32, 32, (const u16*)(p.ws + OFF_WIN) + (size_t)4096 * 1024, 1024, 1024, [](int j) { return j; },
          [&](int row, int ntl, int q, f32x4 v, int ln) {
            if (q < 2) {
              *(float4*)(gb + (size_t)row * 16 + 4 * q) = make_float4(sigmoidf_(v[0]), sigmoidf_(v[1]), sigmoidf_(v[2]), sigmoidf_(v[3]));
            } else {
              const int hd = 4 * (q - 2);
              float gv[4];
#pragma unroll
              for (int j = 0; j < 4; ++j) gv[j] = -__expf(p.a_log[hd + j]) * softplusf_(v[j] + p.dt_bias[hd + j]);
              *(float4*)(gb + (size_t)row * 16 + 8 + hd) = make_float4(gv[0], gv[1], gv[2], gv[3]);
            }
          });
    }
    int u = bid;
    for (; u < 64 * 4; u += G) {
      const int pm = u % 64, pn = u / 64;
      f32x4 acc[2][2][4][2];
      zero_acc(acc);
      gemm256(acc, hbuf, 1024, (const u16*)(p.ws + OFF_WIN), 1024, pm * 256, pn * 256, 1024, smem);
      {
        int t_ = threadIdx.x;
        asm volatile("" : "+v"(t_));
        const int wr = t_ >> 8, wc = (t_ >> 6) & 3, fr_ = t_ & 15, fq_ = (t_ >> 4) & 3;
        float* T = (float*)smem;
#pragma unroll
        for (int ai = 0; ai < 2; ++ai)
#pragma unroll
          for (int m = 0; m < 4; ++m)
#pragma unroll
            for (int n = 0; n < 2; ++n) {
              f32x4 gl;
#pragma unroll
              for (int j = 0; j < 4; ++j) gl[j] = acc[ai][0][m][n][j] * sigmoidf_(acc[ai][1][m][n][j]);
              *(f32x4*)(T + (ai * 128 + wr * 64 + m * 16 + fr_) * TLD + wc * 32 + n * 16 + 4 * fq_) = gl;
            }
        __syncthreads();
        const int cg = (t_ & 31) * 4, r0 = t_ >> 5;
#pragma unroll 4
        for (int i = 0; i < 16; ++i) {
          const int rl = r0 + 16 * i;
          const f32x4 v = *(const f32x4*)(T + rl * TLD + cg);
          f_glu_st(pm * 256 + rl, pn * 128 + cg, v);
        }
        __syncthreads();
      }
    }
    for (; u < 64 * 16; u += G) {
      const int pm = u % 64, pn = u / 64;
      f32x4 acc[2][2][4][2];
      zero_acc(acc);
      gemm256(acc, hbuf, 1024, (const u16*)(p.ws + OFF_WIN), 1024, pm * 256, pn * 256, 1024, smem);
      tile_epilogue(acc, pm * 256, pn * 256 - 1024, smem, f_qkv);
    }
    for (int sb = bid; sb < 256; sb += G) {
      if (sb < 64) {
        skinny<1>(hbuf, 1024, RP, 128, (const u16*)(p.ws + OFF_WIN), 1024, 1024,
          [&](int j) { const int ch = sb * 8 + (j & 7); return (ch >> 7) * 256 + (ch & 127) + ((j >> 3) << 7); },
          [&](int row, int ntl, int q, f32x4 v, int ln) {
            f32x4 g;
#pragma unroll
            for (int j = 0; j < 4; ++j) g[j] = __shfl(v[j], (ln + 32) & 63, 64);
            if (q < 2) f_glu(row, sb * 8 + 4 * q, v, g);
          });
      } else {
        skinny<1>(hbuf, 1024, RP, 128, (const u16*)(p.ws + OFF_WIN), 1024, 1024,
          [&](int j) { return 1024 + (sb - 64) * 16 + j; },
          [&](int row, int ntl, int q, f32x4 v, int ln) { f_qkv(row, (sb - 64) * 16 + 4 * q, v); });
      }
    }
  }
  xcd_barrier(xb);

  PH(4) for (int base = bid * 2; base < 2048; base += 2 * G) d1_item(p, base + (tid >> 8), smem + (tid >> 8) * HALF_SMEM);
  xcd_barrier(xb);

  PH(5) {
    const int half = tid >> 8;
    char* hs = smem + half * HALF_SMEM;
    for (int u = bid; u < 64; u += G) { d2_block(p, u, smem); __syncthreads(); }
    unsigned* qhead = (unsigned*)(p.ws + OFF_BAR) + 64;
    volatile unsigned* qslot = (volatile unsigned*)(smem + 2 * HALF_SMEM + 32);
    auto deq = [&]() -> int {
      if (tid == 0) *qslot = __hip_atomic_fetch_add(qhead, 1u, __ATOMIC_RELAXED, __HIP_MEMORY_SCOPE_AGENT);
      __syncthreads();
      const int v = __builtin_amdgcn_readfirstlane((int)*qslot);
      __syncthreads();
      return v;
    };
    int idx = deq();
    for (; idx < 256; idx = deq()) conf_prompt_item(p, 2 * idx + half, hs);
    for (; idx < 272; idx = deq()) conf_sample_item(p, 2 * (idx - 256) + half);
    for (; idx < 784; idx = deq()) delta_sample_item(p, 2 * (idx - 272) + half, hs);
  }
  xcd_barrier(xb);

  PH(6) {
    auto f_z = [&](int row, int col, f32x4 a) {
      const float4 sq4 = *(const float4*)(ssq + ((size_t)row * 8 + (col >> 7)) * 4);
      const float rstd = rsqrtf((sq4.x + sq4.y + sq4.z + sq4.w) * (1.f / 128.f) + EPS);
      const float4 gw = *(const float4*)(p.gdn_norm_w + (col & 127));
      u16* op = obuf + (size_t)row * 1024 + col;
      const uint2 u = *(const uint2*)op;
      uint2 o;
      o.x = pk2(bf_lo(u.x) * rstd * gw.x * siluf_(a[0]), bf_hi(u.x) * rstd * gw.y * siluf_(a[1]));
      o.y = pk2(bf_lo(u.y) * rstd * gw.z * siluf_(a[2]), bf_hi(u.y) * rstd * gw.w * siluf_(a[3]));
      *(uint2*)op = o;
    };
    gemm_pass(hbuf, 1024, (const u16*)(p.ws + OFF_WZ), 1024, 1024, 1024, smem, f_z);
    for (int sb = bid; sb < 256; sb += G)
      skinny<1>(hbuf, 1024, RP, 128, (const u16*)(p.ws + OFF_WZ), 1024, 1024, [&](int j) { return sb * 4 + (j & 3); },
                [&](int row, int ntl, int q, f32x4 v, int ln) { if (q == 0) f_z(row, sb * 4, v); });
  }
  xcd_barrier(xb);

  PH(7) {
    auto f_ga = [&](int row, int col, f32x4 a) {
      uint2 o; o.x = pk2(sigmoidf_(a[0]), sigmoidf_(a[1])); o.y = pk2(sigmoidf_(a[2]), sigmoidf_(a[3]));
      *(uint2*)(merged + (size_t)row * 1024 + col) = o;
    };
    auto f_ya = [&](int row, int col, f32x4 a) {
      u16* mp = merged + (size_t)row * 1024 + col;
      const uint2 u = *(const uint2*)mp;
      uint2 o; o.x = pk2(bf_lo(u.x) * a[0], bf_hi(u.x) * a[1]); o.y = pk2(bf_lo(u.y) * a[2], bf_hi(u.y) * a[3]);
      *(uint2*)mp = o;
    };
    auto f_gb = [&](int row, int col, f32x4 a) {
      uint2 o; o.x = pk2(sigmoidf_(a[0]), sigmoidf_(a[1])); o.y = pk2(sigmoidf_(a[2]), sigmoidf_(a[3]));
      *(uint2*)(tmp2 + (size_t)row * 1024 + col) = o;
    };
    auto f_yb = [&](int row, int col, f32x4 a) {
      u16* mp = merged + (size_t)row * 1024 + col;
      const uint2 u = *(const uint2*)mp, s2 = *(const uint2*)(tmp2 + (size_t)row * 1024 + col);
      uint2 o; o.x = pk2(bf_lo(u.x) + bf_lo(s2.x) * a[0], bf_hi(u.x) + bf_hi(s2.x) * a[1]); o.y = pk2(bf_lo(u.y) + bf_lo(s2.y) * a[2], bf_hi(u.y) + bf_hi(s2.y) * a[3]);
      *(uint2*)mp = o;
    };
    auto cm4 = [&](int sb) { return [sb](int j) { return sb * 4 + (j & 3); }; };
    gemm_pass(hbuf, 1024, (const u16*)(p.ws + OFF_WGA), 1024, 1024, 1024, smem, f_ga);
    gemm_pass((const u16*)(p.ws + OFF_AACT), 512, (const u16*)(p.ws + OFF_WCONF), 512, 1024, 512, smem, f_ya);
    gemm_pass(hbuf, 1024, (const u16*)(p.ws + OFF_WGB), 1024, 1024, 1024, smem, f_gb);
    gemm_pass(obuf, 1024, (const u16*)(p.ws + OFF_WGDN), 1024, 1024, 1024, smem, f_yb);
    for (int sb = bid; sb < 256; sb += G) {
      skinny<1>(hbuf, 1024, RP, 128, (const u16*)(p.ws + OFF_WGA), 1024, 1024, cm4(sb), [&](int row, int ntl, int q, f32x4 v, int ln) { if (q == 0) f_ga(row, sb * 4, v); });
      skinny<1>((const u16*)(p.ws + OFF_AACT), 512, RP, 128, (const u16*)(p.ws + OFF_WCONF), 512, 512, cm4(sb), [&](int row, int ntl, int q, f32x4 v, int ln) { if (q == 0) f_ya(row, sb * 4, v); });
      skinny<1>(hbuf, 1024, RP, 128, (const u16*)(p.ws + OFF_WGB), 1024, 1024, cm4(sb), [&](int row, int ntl, int q, f32x4 v, int ln) { if (q == 0) f_gb(row, sb * 4, v); });
      skinny<1>(obuf, 1024, RP, 128, (const u16*)(p.ws + OFF_WGDN), 1024, 1024, cm4(sb), [&](int row, int ntl, int q, f32x4 v, int ln) { if (q == 0) f_yb(row, sb * 4, v); });
    }
  }
  xcd_barrier(xb);

  PH(8) {
    auto f_o = [&](int row, int col, f32x4 a) {
      const float* xr = row < RP ? p.x_prompt + (size_t)row * 1024 : p.x_sample + (size_t)(row - RP) * 1024;
      const f32x4 x4 = __builtin_nontemporal_load((const f32x4*)(xr + col));
      const float4 xv = make_float4(x4[0], x4[1], x4[2], x4[3]), gv = *(const float4*)(mod + (size_t)mrow_of(row) * 6144 + 2048 + col);
      *(float4*)(p.out + (size_t)row * 1024 + col) = make_float4(xv.x + gv.x * a[0], xv.y + gv.y * a[1], xv.z + gv.z * a[2], xv.w + gv.w * a[3]);
    };
    gemm_pass(merged, 1024, (const u16*)(p.ws + OFF_WO), 1024, 1024, 1024, smem, f_o);
    for (int sb = bid; sb < 256; sb += G)
      skinny<1>(merged, 1024, RP, 128, (const u16*)(p.ws + OFF_WO), 1024, 1024, [&](int j) { return sb * 4 + (j & 3); },
                [&](int row, int ntl, int q, f32x4 v, int ln) { if (q == 0) f_o(row, sb * 4, v); });
  }
  xcd_barrier(xb);

  PH(9) phase_modnorm<false>(p, p.out, p.out + (size_t)RP * 1024, p.norm2_w, 3072, 4096, (u16*)(p.ws + OFF_H2), smem);
  xcd_barrier(xb);

  PH(10) {
    u16* f = (u16*)(p.ws + OFF_F);
    auto f_ff1 = [&](int row, int col, f32x4 a) {
      float v[4];
#pragma unroll
      for (int j = 0; j < 4; ++j) { const float t = fmaxf(a[j], 0.f); v[j] = t * t; }
      uint2 o; o.x = pk2(v[0], v[1]); o.y = pk2(v[2], v[3]);
      *(uint2*)(f + (size_t)row * LDF + col) = o;
    };
    gemm_pass((const u16*)(p.ws + OFF_H2), 1024, (const u16*)(p.ws + OFF_W1), 1024, 4096, 1024, smem, f_ff1);
    for (int sb = bid; sb < 256; sb += G)
      skinny<1>((const u16*)(p.ws + OFF_H2), 1024, RP, 128, (const u16*)(p.ws + OFF_W1), 1024, 1024, [&](int j) { return sb * 16 + j; },
                [&](int row, int ntl, int q, f32x4 v, int ln) { f_ff1(row, sb * 16 + 4 * q, v); });
  }
  xcd_barrier(xb);

  PH(11) {
    auto f_ff2 = [&](int row, int col, f32x4 a) {
      float* xp = p.out + (size_t)row * 1024 + col;
      const f32x4 x4 = __builtin_nontemporal_load((const f32x4*)xp);
      const float4 xv = make_float4(x4[0], x4[1], x4[2], x4[3]), gv = *(const float4*)(mod + (size_t)mrow_of(row) * 6144 + 5120 + col);
      *(float4*)xp = make_float4(xv.x + gv.x * a[0], xv.y + gv.y * a[1], xv.z + gv.z * a[2], xv.w + gv.w * a[3]);
    };
    gemm_pass((const u16*)(p.ws + OFF_F), LDF, (const u16*)(p.ws + OFF_W2), LDF, 1024, 4096, smem, f_ff2);
    for (int sb = bid; sb < 256; sb += G)
      skinny<1>((const u16*)(p.ws + OFF_F), LDF, RP, 128, (const u16*)(p.ws + OFF_W2), LDF, 4096, [&](int j) { return sb * 4 + (j & 3); },
                [&](int row, int ntl, int q, f32x4 v, int ln) { if (q == 0) f_ff2(row, sb * 4, v); });
  }
  xcd_barrier(xb);

  PH(12) {
    int t12 = threadIdx.x;
    asm volatile("" : "+v"(t12));
    const int lane = t12 & 63, wave = t12 >> 6;
    const int gw = bid * 8 + wave, nw_ = G * 8;
    for (int row = gw; row < R; row += nw_) {
      float* xr = p.out + (size_t)row * 1024;
      float4 v[4]; float ss = 0.f;
#pragma unroll
      for (int i = 0; i < 4; ++i) { const f32x4 t4 = __builtin_nontemporal_load((const f32x4*)(xr + (lane + 64 * i) * 4)); v[i] = make_float4(t4[0], t4[1], t4[2], t4[3]); ss += v[i].x * v[i].x + v[i].y * v[i].y + v[i].z * v[i].z + v[i].w * v[i].w; }
      ss = wsum(ss);
      const float rstd = rsqrtf(ss * (1.f / 1024.f) + EPS);
#pragma unroll
      for (int i = 0; i < 4; ++i) {
        const int c = (lane + 64 * i) * 4;
        const float4 w = *(const float4*)(p.final_norm_w + c);
        f32x4 yv = {v[i].x * rstd * w.x, v[i].y * rstd * w.y, v[i].z * rstd * w.z, v[i].w * rstd * w.w};
        __builtin_nontemporal_store(yv, (f32x4*)(xr + c));
      }
    }
  }
}

extern "C" void kernel_launch(void* const* d_in, const int* in_sizes, int n_in, void* d_out, int out_size, void* d_ws, size_t ws_size,
                              hipStream_t stream) {
  static int grid_blocks = 0;
  if (!grid_blocks) {
    int dev = 0, cus = 0, per_cu = 0;
    hipGetDevice(&dev);
    hipDeviceGetAttribute(&cus, hipDeviceAttributeMultiprocessorCount, dev);
    hipOccupancyMaxActiveBlocksPerMultiprocessor(&per_cu, (const void*)fwd_megakernel, NT, 0);
    if (per_cu > 1) per_cu = 1;
    if (per_cu < 1) per_cu = 1;
    grid_blocks = cus * per_cu;
  }
  Params p{};
  const float** pp = (const float**)&p;
  for (int i = 0; i < 26; ++i) pp[i] = (const float*)d_in[i];
  p.out = (float*)d_out; p.ws = (char*)d_ws;
  if (ws_size < WS_NEED) { fprintf(stderr, "workspace too small: %zu < %zu\n", ws_size, (size_t)WS_NEED); return; }
  hipMemsetAsync(d_ws, 0, XCD_BAR_WORDS * 4, stream);
  void* args[] = {&p};
  hipError_t e = hipLaunchCooperativeKernel((const void*)fwd_megakernel, dim3(grid_blocks), dim3(NT), args, 0, stream);
  if (e != hipSuccess) fprintf(stderr, "cooperative launch failed: %s (grid %d)\n", hipGetErrorString(e), grid_blocks);
}
```

```cpp
#include <hip/hip_runtime.h>
#include <stdint.h>
#include <cstdio>

#define DI __device__ __forceinline__
typedef unsigned short u16;
typedef __bf16 bf2_t __attribute__((ext_vector_type(2)));
typedef float f2_t __attribute__((ext_vector_type(2)));
using bf16x8 = __attribute__((ext_vector_type(8))) short;
using f32x16 = __attribute__((ext_vector_type(16))) float;
using f32x4 = __attribute__((ext_vector_type(4))) float;
using u32x4 = __attribute__((ext_vector_type(4))) unsigned;
#define MFMA(a, b, c) __builtin_amdgcn_mfma_f32_32x32x16_bf16((a), (b), (c), 0, 0, 0)

constexpr int R = 16512, RP = 16384, D = 1024, DC = 512, QKV = 3072, NIN = 4096, DFF = 4096;
constexpr float EPS = 1e-6f;
constexpr int LDF = 4160;
constexpr float QSCALE = 0.08838834764831845f;

constexpr size_t OFF_BAR   = 0;
constexpr size_t OFF_MOD   = 16384;
constexpr size_t OFF_GB    = OFF_MOD + 3342336;
constexpr size_t OFF_EGL   = OFF_GB + 1056768;
constexpr size_t OFF_SSQ   = OFF_EGL + 8192;
constexpr size_t OFF_WIN   = OFF_SSQ + 2113536;
constexpr size_t OFF_WZ    = OFF_WIN + 8650752;
constexpr size_t OFF_WGA   = OFF_WZ + 2097152;
constexpr size_t OFF_WGB   = OFF_WGA + 2097152;
constexpr size_t OFF_WCONF = OFF_WGB + 2097152;
constexpr size_t OFF_WGDN  = OFF_WCONF + 1048576;
constexpr size_t OFF_WO    = OFF_WGDN + 2097152;
constexpr size_t OFF_W1    = OFF_WO + 2097152;
constexpr size_t OFF_W2    = OFF_W1 + 8388608;
constexpr size_t OFF_GLU   = OFF_W2 + 8650752;
constexpr size_t OFF_AACT  = OFF_GLU + 16908288;
constexpr size_t OFF_QKV   = OFF_AACT + 16908288;
constexpr size_t OFF_HALO  = OFF_QKV + 101449728;
constexpr size_t OFF_EXTRA = OFF_HALO + 4718592;
constexpr size_t OFF_WADA  = OFF_EXTRA;
constexpr size_t OFF_AC    = OFF_EXTRA + 12582912;
constexpr size_t OFF_MERGED= OFF_EXTRA;
constexpr size_t OFF_H2    = OFF_GLU;
constexpr size_t OFF_F     = OFF_QKV;
constexpr size_t OFF_TMP2  = OFF_QKV;
constexpr size_t WS_NEED   = OFF_EXTRA + 50331648;
constexpr size_t OUT_Y = 0, OUT_CONFP = 16908288, OUT_QKVP = 17031168, OUT_DELTAP = 17104896,
                 OUT_CONFS = 18153472, OUT_QKVS = 20119552, OUT_DELTAS = 21299200;

constexpr int HALF_SMEM = 73728;
constexpr int SMEM_BYTES = 2 * HALF_SMEM + 1024;
constexpr int NT = 512;
#ifndef PHASE_MASK
#define PHASE_MASK 0xFFFF
#endif
#define PH(k) if constexpr ((PHASE_MASK >> (k)) & 1)

struct Params {
  const float *x_prompt, *x_sample, *c_prompt, *c_sample, *st_conf, *st_qkv, *st_delta;
  const float *w_ada, *b_ada, *norm1_w, *w_in, *conf_dw_w, *conf_dw_b, *conf_ln_w, *conf_ln_b, *w_conf_out,
              *gdn_conv_w, *a_log, *dt_bias, *gdn_norm_w, *w_gdn_out, *w_o, *norm2_w, *w_ff1, *w_ff2, *final_norm_w;
  float* out; char* ws;
};

DI unsigned pk2(float a, float b) { f2_t v = {a, b}; bf2_t r = __builtin_convertvector(v, bf2_t); return __builtin_bit_cast(unsigned, r); }
DI float bf_lo(unsigned u) { return __uint_as_float(u << 16); }
DI float bf_hi(unsigned u) { return __uint_as_float(u & 0xffff0000u); }
DI float bf1(u16 u) { return __uint_as_float(((unsigned)u) << 16); }
DI u16 f2bf(float a) { return (u16)(pk2(a, 0.f) & 0xffffu); }
DI float sigmoidf_(float x) { return __builtin_amdgcn_rcpf(1.f + __expf(-x)); }
DI float siluf_(float x) { return x * __builtin_amdgcn_rcpf(1.f + __expf(-x)); }
DI float softplusf_(float x) { return fmaxf(x, 0.f) + log1pf(__expf(-fabsf(x))); }
DI float dpp_f(float x, const int ctrl_sel) {
  const int xi = __builtin_bit_cast(int, x);
  int r;
  if (ctrl_sel == 0) r = __builtin_amdgcn_update_dpp(xi, xi, 0xB1, 0xF, 0xF, false);
  else if (ctrl_sel == 1) r = __builtin_amdgcn_update_dpp(xi, xi, 0x4E, 0xF, 0xF, false);
  else if (ctrl_sel == 2) r = __builtin_amdgcn_update_dpp(xi, xi, 0x141, 0xF, 0xF, false);
  else r = __builtin_amdgcn_update_dpp(xi, xi, 0x140, 0xF, 0xF, false);
  return __builtin_bit_cast(float, r);
}
DI float wsum(float v) {
  v += dpp_f(v, 0); v += dpp_f(v, 1); v += dpp_f(v, 2); v += dpp_f(v, 3);
  v += __shfl_xor(v, 16, 64); v += __shfl_xor(v, 32, 64);
  return v;
}
DI int crow(int reg, int hh) { return (reg & 3) + 8 * (reg >> 2) + 4 * hh; }
DI int mrow_of(int r) { return r < RP ? (r >> 11) : (8 + r - RP); }
DI bf16x8 pack8(const f32x16& x, int s) {
  uint4 p;
  p.x = pk2(x[8 * s + 0], x[8 * s + 1]); p.y = pk2(x[8 * s + 2], x[8 * s + 3]);
  p.z = pk2(x[8 * s + 4], x[8 * s + 5]); p.w = pk2(x[8 * s + 6], x[8 * s + 7]);
  return __builtin_bit_cast(bf16x8, p);
}
DI f32x16 zero16() { f32x16 z; for (int i = 0; i < 16; ++i) z[i] = 0.f; return z; }

#define XB_TMO      128
#define XB_XCNT(j)  (256  + 64 * (j))
#define XB_XSUB(j)  (1280 + 64 * (j))
#define XB_XGEN(j)  (2304 + 64 * (j))
#define XB_TOP      3328
#define XB_TOPGEN   3392
#define XCD_BAR_WORDS 3456
#define XB_SPIN_CAP (1u << 24)
#define LAS __attribute__((address_space(3)))
DI unsigned xb_ld(unsigned* p) { return __hip_atomic_load(p, __ATOMIC_RELAXED, __HIP_MEMORY_SCOPE_AGENT); }
DI unsigned xb_add(unsigned* p, unsigned v) { return __hip_atomic_fetch_add(p, v, __ATOMIC_RELAXED, __HIP_MEMORY_SCOPE_AGENT); }
DI unsigned xb_xcc_id() { return (unsigned)__builtin_amdgcn_s_getreg((3 << 11) | 20) & 0xFu; }
#define XB_SPIN(cond, bar) do { unsigned _sp = 0; while (cond) { __builtin_amdgcn_s_sleep(1); \
    if ((++_sp & 255u) == 0u) { if (xb_ld(&(bar)[XB_TMO])) break; if (_sp > XB_SPIN_CAP) { atomicAdd(&(bar)[XB_TMO], 1u); break; } } } } while (0)
struct XcdBarrier { unsigned* bar; unsigned x; volatile LAS unsigned* st; };
DI XcdBarrier xcd_barrier_post(unsigned* bar, volatile LAS unsigned* st) {
  XcdBarrier b; b.bar = bar; b.x = xb_xcc_id(); b.st = st;
  if (threadIdx.x == 0) (void)xb_add(&bar[XB_XCNT(b.x)], 1u);
  return b;
}
DI void xcd_barrier_complete(unsigned* bar, unsigned x, unsigned& nloc, unsigned& nx) {
  const unsigned G = gridDim.x * gridDim.y * gridDim.z;
  unsigned sum, cnt, mine, sp = 0u;
  for (;;) {
    sum = 0u; cnt = 0u; mine = 0u;
#pragma unroll
    for (unsigned j = 0; j < 16; ++j) { const unsigned c = xb_ld(&bar[XB_XCNT(j)]); sum += c; cnt += (c > 0u) ? 1u : 0u; mine = (j == x) ? c : mine; }
    if (sum == G) break;
    __builtin_amdgcn_s_sleep(1);
    if ((++sp & 255u) == 0u) { if (xb_ld(&bar[XB_TMO])) break; if (sp > XB_SPIN_CAP) { atomicAdd(&bar[XB_TMO], 1u); break; } }
  }
  nloc = mine > 0u ? mine : 1u; nx = cnt > 0u ? cnt : 1u;
}
DI void xcd_barrier(const XcdBarrier& b) {
  asm volatile("s_waitcnt vmcnt(0)" ::: "memory");
  __syncthreads();
  if (threadIdx.x == 0) {
    unsigned* bar = b.bar;
    __builtin_amdgcn_s_waitcnt(0);
    unsigned nloc = b.st[0], nx = b.st[1];
    if (nloc == 0u) { xcd_barrier_complete(bar, b.x, nloc, nx); b.st[0] = nloc; b.st[1] = nx; }
    const unsigned old = xb_add(&bar[XB_XSUB(b.x)], 1u);
    const unsigned gen = old / nloc;
    if (old + 1u == (gen + 1u) * nloc) {
      __builtin_amdgcn_fence(__ATOMIC_RELEASE, "agent");
      asm volatile("s_waitcnt vmcnt(0)" ::: "memory");
      const unsigned og = xb_add(&bar[XB_TOP], 1u);
      const unsigned tg = og / nx;
      if (og + 1u == (tg + 1u) * nx) xb_add(&bar[XB_TOPGEN], 1u);
      else XB_SPIN(xb_ld(&bar[XB_TOPGEN]) == tg, bar);
      __builtin_amdgcn_fence(__ATOMIC_ACQUIRE, "agent");
      xb_add(&bar[XB_XGEN(b.x)], 1u);
      asm volatile("s_waitcnt vmcnt(0)" ::: "memory");
    } else {
      XB_SPIN(xb_ld(&bar[XB_XGEN(b.x)]) == gen, bar);
      __builtin_amdgcn_fence(__ATOMIC_ACQUIRE, "agent");
      asm volatile("s_waitcnt vmcnt(0)" ::: "memory");
    }
  }
  __syncthreads();
}

constexpr int HTB = 128 * 64 * 2;
DI int lds_byte(int r, int c) { const int st = (r >> 4) * 2 + (c >> 5), rr = r & 15, cc = c & 31, ob = rr * 64 + cc * 2; return st * 1024 + (ob ^ (((ob >> 9) & 1) << 5)); }
DI void stage_rc(int b, int& Rr, int& Cc) { const int st = b / 1024, sb = b % 1024, swz = sb ^ (((sb >> 9) & 1) << 5); Rr = (st >> 1) * 16 + swz / 64; Cc = (st & 1) * 32 + (swz % 64) / 2; }
DI void gemm256(f32x4 (&acc)[2][2][4][2], const u16* __restrict__ A, const int lda, const u16* __restrict__ Bt, const int ldb,
                const int brow, const int bcol, const int K, char* shm) {
#define SA(b, h) (shm + ((b) * 2 + (h)) * HTB)
#define SB(b, h) (shm + (4 + (b) * 2 + (h)) * HTB)
#define STAGE_A(P, br, kt) do { const char* _u = (const char*)A + ((size_t)(br) * lda + (size_t)(kt) * 64) * 2; \
    __builtin_amdgcn_global_load_lds((const unsigned*)(_u + voA0), (unsigned*)((char*)(P) + sb0), 16, 0, 0); \
    __builtin_amdgcn_global_load_lds((const unsigned*)(_u + voA1), (unsigned*)((char*)(P) + sb1), 16, 0, 0); } while (0)
#define STAGE_B(P, br, kt) do { const char* _u = (const char*)Bt + ((size_t)(br) * ldb + (size_t)(kt) * 64) * 2; \
    __builtin_amdgcn_global_load_lds((const unsigned*)(_u + voB0), (unsigned*)((char*)(P) + sb0), 16, 0, 0); \
    __builtin_amdgcn_global_load_lds((const unsigned*)(_u + voB1), (unsigned*)((char*)(P) + sb1), 16, 0, 0); } while (0)
#define LDA(dst, b, h) _Pragma("unroll") for (int m = 0; m < 4; ++m) _Pragma("unroll") for (int k = 0; k < 2; ++k) \
    dst[m][k] = *reinterpret_cast<const bf16x8*>((char*)SA(b, h) + lds_byte(wr * 64 + m * 16 + fr, k * 32 + fq * 8))
#define LDB(dst, b, h) _Pragma("unroll") for (int n = 0; n < 2; ++n) _Pragma("unroll") for (int k = 0; k < 2; ++k) \
    dst[n][k] = *reinterpret_cast<const bf16x8*>((char*)SB(b, h) + lds_byte(wc * 32 + n * 16 + fr, k * 32 + fq * 8))
#define MMA(ai, bj, At_, Bt_) do { __builtin_amdgcn_s_setprio(1); \
    _Pragma("unroll") for (int m = 0; m < 4; ++m) _Pragma("unroll") for (int n = 0; n < 2; ++n) _Pragma("unroll") for (int k = 0; k < 2; ++k) \
      acc[ai][bj][m][n] = __builtin_amdgcn_mfma_f32_16x16x32_bf16(Bt_[n][k], At_[m][k], acc[ai][bj][m][n], 0, 0, 0); \
    __builtin_amdgcn_s_setprio(0); } while (0)
#define WAIT_V(n) asm volatile("s_waitcnt vmcnt(" #n ")" ::: "memory")
#define WAIT_L(n) asm volatile("s_waitcnt lgkmcnt(" #n ")" ::: "memory")
#define BAR __builtin_amdgcn_s_barrier()
#define SCHED __builtin_amdgcn_sched_barrier(0)
  int t_ = threadIdx.x;
  asm volatile("" : "+v"(t_));
  const int wid = __builtin_amdgcn_readfirstlane(t_ >> 6), lane = t_ & 63, wr = wid >> 2, wc = wid & 3, fr = lane & 15, fq = lane >> 4;
  const int sb0 = t_ * 16, sb1 = sb0 + 8192;
  int sr0, sc0, sr1, sc1; stage_rc(sb0, sr0, sc0); stage_rc(sb1, sr1, sc1);
  const unsigned voA0 = (unsigned)(sr0 * lda + sc0) * 2u, voA1 = (unsigned)(sr1 * lda + sc1) * 2u;
  const unsigned voB0 = (unsigned)(sr0 * ldb + sc0) * 2u, voB1 = (unsigned)(sr1 * ldb + sc1) * 2u;
  bf16x8 At[4][2], B0[2][2], B1[2][2];
  const int nt = K / 64;
  STAGE_B(SB(0, 0), bcol, 0); STAGE_A(SA(0, 0), brow, 0);
  STAGE_B(SB(0, 1), bcol + 128, 0); STAGE_A(SA(0, 1), brow + 128, 0);
  if (wr == 1) BAR;
  WAIT_V(4); BAR;
  STAGE_B(SB(1, 0), bcol, 1); STAGE_A(SA(1, 0), brow, 1); STAGE_B(SB(1, 1), bcol + 128, 1);
  WAIT_V(6); BAR;
  for (int t = 0; t < nt - 2; t += 2) {
    LDB(B0, 0, 0); SCHED; LDA(At, 0, 0); STAGE_A(SA(1, 1), brow + 128, t + 1);
    WAIT_L(8); BAR; WAIT_L(0); MMA(0, 0, At, B0); BAR; SCHED;
    LDB(B1, 0, 1); STAGE_B(SB(0, 0), bcol, t + 2);
    BAR; WAIT_L(0); MMA(0, 1, At, B1); BAR;
    LDA(At, 0, 1); STAGE_A(SA(0, 0), brow, t + 2);
    BAR; WAIT_L(0); MMA(1, 0, At, B0); BAR; SCHED;
    STAGE_B(SB(0, 1), bcol + 128, t + 2);
    WAIT_V(6); BAR; MMA(1, 1, At, B1); BAR;
    LDB(B0, 1, 0); SCHED; LDA(At, 1, 0); STAGE_A(SA(0, 1), brow + 128, t + 2);
    WAIT_L(8); BAR; WAIT_L(0); MMA(0, 0, At, B0); BAR; SCHED;
    LDB(B1, 1, 1); STAGE_B(SB(1, 0), bcol, t + 3);
    BAR; WAIT_L(0); MMA(0, 1, At, B1); BAR;
    LDA(At, 1, 1); STAGE_A(SA(1, 0), brow, t + 3);
    BAR; WAIT_L(0); MMA(1, 0, At, B0); BAR; SCHED;
    STAGE_B(SB(1, 1), bcol + 128, t + 3);
    WAIT_V(6); BAR; MMA(1, 1, At, B1); BAR;
  }
  { LDB(B0, 0, 0); LDA(At, 0, 0); STAGE_A(SA(1, 1), brow + 128, nt - 1);
    BAR; WAIT_L(0); MMA(0, 0, At, B0); BAR;
    LDB(B1, 0, 1); BAR; WAIT_L(0); MMA(0, 1, At, B1); BAR;
    LDA(At, 0, 1); WAIT_V(4); BAR; WAIT_L(0); MMA(1, 0, At, B0); MMA(1, 1, At, B1); BAR; }
  { LDB(B0, 1, 0); LDA(At, 1, 0); WAIT_V(2); BAR; WAIT_L(0); MMA(0, 0, At, B0); BAR;
    LDB(B1, 1, 1); WAIT_V(0); BAR; WAIT_L(0); MMA(0, 1, At, B1); BAR;
    LDA(At, 1, 1); BAR; WAIT_L(0); MMA(1, 0, At, B0); MMA(1, 1, At, B1); BAR; }
  if (wr == 0) BAR;
#undef SA
#undef SB
#undef STAGE_A
#undef STAGE_B
#undef LDA
#undef LDB
#undef MMA
}
DI void zero_acc(f32x4 (&acc)[2][2][4][2]) {
#pragma unroll
  for (int a = 0; a < 2; ++a)
#pragma unroll
    for (int b = 0; b < 2; ++b)
#pragma unroll
      for (int m = 0; m < 4; ++m)
#pragma unroll
        for (int n = 0; n < 2; ++n) acc[a][b][m][n] = (f32x4){0.f, 0.f, 0.f, 0.f};
}
template <class F> DI void tile_apply(const f32x4 (&acc)[2][2][4][2], int brow, int bcol, F f) {
  int t_ = threadIdx.x;
  asm volatile("" : "+v"(t_));
  const int wid = t_ >> 6, lane = t_ & 63, wr = wid >> 2, wc = wid & 3, fr = lane & 15, fq = lane >> 4;
#pragma unroll
  for (int ai = 0; ai < 2; ++ai)
#pragma unroll
    for (int m = 0; m < 4; ++m) {
      const int row = brow + ai * 128 + wr * 64 + m * 16 + fr;
#pragma unroll
      for (int bj = 0; bj < 2; ++bj)
#pragma unroll
        for (int n = 0; n < 2; ++n) f(row, bcol + bj * 128 + wc * 32 + n * 16 + 4 * fq, acc[ai][bj][m][n]);
      __builtin_amdgcn_sched_barrier(0);
    }
}
constexpr int TLD = 132;
template <class F> DI void tile_epilogue(const f32x4 (&acc)[2][2][4][2], int brow, int bcol, char* shm, F f) {
  int t_ = threadIdx.x;
  asm volatile("" : "+v"(t_));
  const int wid = t_ >> 6, lane = t_ & 63, wr = wid >> 2, wc = wid & 3, fr = lane & 15, fq = lane >> 4;
  float* T = (float*)shm;
#pragma unroll
  for (int bj = 0; bj < 2; ++bj) {
#pragma unroll
    for (int ai = 0; ai < 2; ++ai)
#pragma unroll
      for (int m = 0; m < 4; ++m)
#pragma unroll
        for (int n = 0; n < 2; ++n)
          *(f32x4*)(T + (ai * 128 + wr * 64 + m * 16 + fr) * TLD + wc * 32 + n * 16 + 4 * fq) = acc[ai][bj][m][n];
    __syncthreads();
    const int cg = (t_ & 31) * 4, r0 = t_ >> 5;
#pragma unroll 4
    for (int i = 0; i < 16; ++i) {
      const int rl = r0 + 16 * i;
      const f32x4 v = *(const f32x4*)(T + rl * TLD + cg);
      f(brow + rl, bcol + bj * 128 + cg, v);
    }
    __syncthreads();
  }
}
template <class F> DI void gemm_pass(const u16* A, int lda, const u16* Bt, int ldb, int N, int K, char* shm, F f) {
  const int nN = N >> 8, nunits = 64 * nN;
  for (int u = blockIdx.x; u < nunits; u += gridDim.x) {
    const int pm = u % 64, pn = u / 64;
    f32x4 acc[2][2][4][2];
    zero_acc(acc);
    gemm256(acc, A, lda, Bt, ldb, pm * 256, pn * 256, K, shm);
    tile_epilogue(acc, pm * 256, pn * 256, shm, f);
  }
}
template <int NTL, class CM, class E> DI void skinny(const u16* __restrict__ A, int lda, int row0, int nrows, const u16* __restrict__ Bt, int ldb, int K, CM cm, E epi) {
  int t_ = threadIdx.x;
  asm volatile("" : "+v"(t_));
  const int wid = t_ >> 6, lane = t_ & 63, fr = lane & 15, fq = lane >> 4;
  for (int mt = wid; mt * 16 < nrows; mt += 8) {
    int rr = mt * 16 + fr; const bool valid = rr < nrows; if (!valid) rr = nrows - 1;
    const u16* ap = A + (size_t)(row0 + rr) * lda + 8 * fq;
#pragma unroll
    for (int ntl = 0; ntl < NTL; ++ntl) {
      const u16* bp = Bt + (size_t)cm(ntl * 16 + fr) * ldb + 8 * fq;
      f32x4 acc = {0.f, 0.f, 0.f, 0.f};
#pragma unroll 16
      for (int ks = 0; ks < (K >> 5); ++ks) {
        const bf16x8 a = *(const bf16x8*)(ap + ks * 32);
        const bf16x8 b = *(const bf16x8*)(bp + ks * 32);
        acc = __builtin_amdgcn_mfma_f32_16x16x32_bf16(b, a, acc, 0, 0, 0);
      }
      if (valid) epi(row0 + rr, ntl, fq, acc, lane);
    }
  }
}
DI int map_in(int n) {
  if (n < 1024) { const int pn = n >> 8, c = n & 255; return c < 128 ? (pn * 128 + c) : (512 + pn * 128 + c - 128); }
  if (n < 4096) return n;
  return n < 4112 ? 5120 + (n - 4096) : 5120;
}
DI void phase_convert(const Params& p, char* smem) {
  float* tile = (float*)smem;
  const int tid = threadIdx.x;
  constexpr int NJ = 10;
  constexpr int pre[NJ + 1] = {0, 1040, 1296, 1552, 1808, 1936, 2192, 2448, 3472, 4496, 6032};
  for (int t = blockIdx.x; t < 6032; t += gridDim.x) {
    int j = 0, base = 0;
#pragma unroll
    for (int q = 1; q < NJ; ++q) if (t >= pre[q]) { j = q; base = pre[q]; }
    const int lt = t - base;
    const float* src; int ld, K; u16* dst; int moff = 0; int ldd = 0;
    switch (j) {
      case 0: src = p.w_in; ld = 7184; K = 1024; dst = (u16*)(p.ws + OFF_WIN); break;
      case 1: src = p.w_in; ld = 7184; K = 1024; dst = (u16*)(p.ws + OFF_WZ); moff = 4096; break;
      case 2: src = p.w_in; ld = 7184; K = 1024; dst = (u16*)(p.ws + OFF_WGA); moff = 5136; break;
      case 3: src = p.w_in; ld = 7184; K = 1024; dst = (u16*)(p.ws + OFF_WGB); moff = 6160; break;
      case 4: src = p.w_conf_out; ld = 1024; K = 512; dst = (u16*)(p.ws + OFF_WCONF); break;
      case 5: src = p.w_gdn_out; ld = 1024; K = 1024; dst = (u16*)(p.ws + OFF_WGDN); break;
      case 6: src = p.w_o; ld = 1024; K = 1024; dst = (u16*)(p.ws + OFF_WO); break;
      case 7: src = p.w_ff1; ld = 4096; K = 1024; dst = (u16*)(p.ws + OFF_W1); break;
      case 8: src = p.w_ff2; ld = 1024; K = 4096; dst = (u16*)(p.ws + OFF_W2); ldd = LDF; break;
      default: src = p.w_ada; ld = 6144; K = 1024; dst = (u16*)(p.ws + OFF_WADA); break;
    }
    const int nkt = K >> 6;
    const int n0 = (lt / nkt) * 64, k0 = (lt % nkt) * 64;
    {
      const int q4 = (tid & 15) * 4, ty = tid >> 4;
      const int sc = (j == 0) ? map_in(n0 + q4) : (n0 + q4 + moff);
#pragma unroll
      for (int i = 0; i < 2; ++i) {
        const int kk = ty + 32 * i;
        const f32x4 v4 = __builtin_nontemporal_load((const f32x4*)(src + (size_t)(k0 + kk) * ld + sc));
        float* tp = tile + kk * 65 + q4;
        tp[0] = v4[0]; tp[1] = v4[1]; tp[2] = v4[2]; tp[3] = v4[3];
      }
    }
    __syncthreads();
    {
      const int nn = tid >> 3, kq = (tid & 7) * 8;
      uint4 o0;
      const float* tp = tile + kq * 65 + nn;
      o0.x = pk2(tp[0 * 65], tp[1 * 65]);  o0.y = pk2(tp[2 * 65], tp[3 * 65]);
      o0.z = pk2(tp[4 * 65], tp[5 * 65]);  o0.w = pk2(tp[6 * 65], tp[7 * 65]);
      *(uint4*)(dst + (size_t)(n0 + nn) * (ldd ? ldd : K) + k0 + kq) = o0;
    }
    __syncthreads();
  }
  u16* Ac = (u16*)(p.ws + OFF_AC);
  for (int e = blockIdx.x * NT + tid; e < 256 * 256; e += gridDim.x * NT) {
    const int row = e >> 8, c4 = (e & 255) * 4;
    float4 v = make_float4(0.f, 0.f, 0.f, 0.f);
    if (row < 8) v = *(const float4*)(p.c_prompt + row * 1024 + c4);
    else if (row < 136) v = *(const float4*)(p.c_sample + (row - 8) * 1024 + c4);
    uint2 o; o.x = pk2(siluf_(v.x), siluf_(v.y)); o.y = pk2(siluf_(v.z), siluf_(v.w));
    *(uint2*)(Ac + row * 1024 + c4) = o;
  }
}

constexpr int WBA_LD = 1028;
template <bool BA> DI void phase_modnorm(const Params& p, const float* xa, const float* xb, const float* nw, int shift_off, int scale_off, u16* dst, char* smem) {
  int tmn = threadIdx.x;
  asm volatile("" : "+v"(tmn));
  const int lane = tmn & 63;
  const int gw = blockIdx.x * 8 + (tmn >> 6), nw_ = gridDim.x * 8;
  const float* mod = (const float*)(p.ws + OFF_MOD);
  float* wba = (float*)smem;
  if (BA) {
    for (int e = threadIdx.x; e < 16384; e += NT) { const int c = e >> 4, j = e & 15; wba[j * WBA_LD + c] = p.w_in[(size_t)c * 7184 + 5120 + j]; }
    __syncthreads();
  }
  float* gb = (float*)(p.ws + OFF_GB);
  for (int row = gw; row < R; row += nw_) {
    const float* xr = row < RP ? xa + (size_t)row * 1024 : xb + (size_t)(row - RP) * 1024;
    float4 v[4]; float ss = 0.f;
#pragma unroll
    for (int i = 0; i < 4; ++i) {
      { const f32x4 t4 = __builtin_nontemporal_load((const f32x4*)(xr + (lane + 64 * i) * 4)); v[i] = make_float4(t4[0], t4[1], t4[2], t4[3]); }
      ss += v[i].x * v[i].x + v[i].y * v[i].y + v[i].z * v[i].z + v[i].w * v[i].w; }
    ss = wsum(ss);
    const float rstd = rsqrtf(ss * (1.f / 1024.f) + EPS);
    const float* mr = mod + (size_t)mrow_of(row) * 6144;
    float ba[16];
    if (BA) {
#pragma unroll
      for (int j = 0; j < 16; ++j) ba[j] = 0.f;
    }
#pragma unroll
    for (int i = 0; i < 4; ++i) {
      const int c = (lane + 64 * i) * 4;
      const float4 w = *(const float4*)(nw + c), sc = *(const float4*)(mr + scale_off + c), sh = *(const float4*)(mr + shift_off + c);
      const float h0 = v[i].x * rstd * w.x * (1.f + sc.x) + sh.x, h1 = v[i].y * rstd * w.y * (1.f + sc.y) + sh.y;
      const float h2 = v[i].z * rstd * w.z * (1.f + sc.z) + sh.z, h3 = v[i].w * rstd * w.w * (1.f + sc.w) + sh.w;
      uint2 o; o.x = pk2(h0, h1); o.y = pk2(h2, h3);
      *(uint2*)(dst + (size_t)row * 1024 + c) = o;
      if (BA) {
#pragma unroll
        for (int j = 0; j < 16; ++j) { const float4 ww = *(const float4*)(wba + j * WBA_LD + c); ba[j] += h0 * ww.x + h1 * ww.y + h2 * ww.z + h3 * ww.w; }
        __builtin_amdgcn_sched_barrier(0);
      }
    }
    if (BA) {
#pragma unroll
      for (int w = 8; w >= 1; w >>= 1) {
        const bool up = (lane & w) != 0;
#pragma unroll
        for (int j = 0; j < w; ++j) {
          const float keep = up ? ba[j + w] : ba[j];
          const float send = up ? ba[j] : ba[j + w];
          ba[j] = keep + __shfl_xor(send, w, 64);
        }
      }
      float tot = ba[0];
      tot += __shfl_xor(tot, 16, 64); tot += __shfl_xor(tot, 32, 64);
      if (lane < 8) gb[(size_t)row * 16 + lane] = sigmoidf_(tot);
      else if (lane < 16) gb[(size_t)row * 16 + lane] = -__expf(p.a_log[lane - 8]) * softplusf_(tot + p.dt_bias[lane - 8]);
    }
  }
  if (BA) __syncthreads();
}

constexpr int LKN = 136, LKT = 72;
DI void d1_item(const Params& p, int item, char* smem) {
  int tid = threadIdx.x & 255;
  asm volatile("" : "+v"(tid));
  const int lane = tid & 63, wave = __builtin_amdgcn_readfirstlane(tid >> 6);
  const int r = lane & 31, hh = lane >> 5;
  const int h = item & 7, n = (item >> 3) & 31, b = item >> 8;
  const int rowbase = b * 2048 + n * 64;
  u16* kn  = (u16*)smem;
  u16* qn  = (u16*)(smem + 17408);
  u16* knT = (u16*)(smem + 34816);
  u16* vT  = (u16*)(smem + 53248);
  float* Gs = (float*)(smem + 71680);
  float* Bs = Gs + 64;
  float* Amat = (float*)(smem + 17408);
  u16* Tb = (u16*)smem;
  u16* Tg = (u16*)(smem + 17408);
  u16* qkv = (u16*)(p.ws + OFF_QKV);
  const u16* halo = (const u16*)(p.ws + OFF_HALO);
  const float* gb = (const float*)(p.ws + OFF_GB);

  if (wave == 0) {
    float g = gb[(size_t)(rowbase + lane) * 16 + 8 + h];
    const float be = gb[(size_t)(rowbase + lane) * 16 + h];
#pragma unroll
    for (int m = 1; m < 64; m <<= 1) { float t = __shfl_up(g, m, 64); if (lane >= m) g += t; }
    Gs[lane] = g; Bs[lane] = be;
  }
  {
    const int cp = lane;
#pragma unroll
    for (int X = 0; X < 3; ++X) {
      const int cb = X * 1024 + h * 128 + 2 * cp;
      float w[4][2];
#pragma unroll
      for (int j = 0; j < 4; ++j) { float2 t = *(const float2*)(p.gdn_conv_w + j * 3072 + cb); w[j][0] = t.x; w[j][1] = t.y; }
      float xw[3][2];
#pragma unroll
      for (int j = 0; j < 3; ++j) {
        const int rr = wave * 16 - 3 + j;
        unsigned u = 0u;
        if (rr >= 0) u = *(const unsigned*)(qkv + (size_t)(rowbase + rr) * 3072 + cb);
        else if (n > 0) u = *(const unsigned*)(halo + ((size_t)((b * 32 + n - 1) * 3 + (rr + 3))) * 3072 + cb);
        xw[j][0] = bf_lo(u); xw[j][1] = bf_hi(u);
      }
      float o[16][2];
#pragma unroll
      for (int t = 0; t < 16; ++t) {
        const unsigned u = *(const unsigned*)(qkv + (size_t)(rowbase + wave * 16 + t) * 3072 + cb);
        const float x0 = bf_lo(u), x1 = bf_hi(u);
        const float a0 = w[0][0] * xw[0][0] + w[1][0] * xw[1][0] + w[2][0] * xw[2][0] + w[3][0] * x0;
        const float a1 = w[0][1] * xw[0][1] + w[1][1] * xw[1][1] + w[2][1] * xw[2][1] + w[3][1] * x1;
        o[t][0] = siluf_(a0); o[t][1] = siluf_(a1);
        xw[0][0] = xw[1][0]; xw[0][1] = xw[1][1]; xw[1][0] = xw[2][0]; xw[1][1] = xw[2][1]; xw[2][0] = x0; xw[2][1] = x1;
      }
      if (X < 2) {
#pragma unroll
        for (int t = 0; t < 16; ++t) {
          const float ss = wsum(o[t][0] * o[t][0] + o[t][1] * o[t][1]);
          const float rs = rsqrtf(ss + EPS);
          o[t][0] *= rs; o[t][1] *= rs;
        }
      }
#pragma unroll
      for (int t = 0; t < 16; ++t) {
        const int row = wave * 16 + t;
        const unsigned pk = pk2(o[t][0], o[t][1]);
        if (X == 0) { *(unsigned*)(qn + row * LKN + 2 * cp) = pk; }
        else if (X == 1) {
          *(unsigned*)(kn + row * LKN + 2 * cp) = pk;
          knT[(2 * cp) * LKT + row] = (u16)(pk & 0xffffu); knT[(2 * cp + 1) * LKT + row] = (u16)(pk >> 16);
        } else {
          vT[(2 * cp) * LKT + row] = (u16)(pk & 0xffffu); vT[(2 * cp + 1) * LKT + row] = (u16)(pk >> 16);
        }
      }
    }
  }
  __syncthreads();
  const float Glast = Gs[63];
#pragma unroll
  for (int ff = 0; ff < 4; ++ff) {
    const int f = wave * 4 + ff;
    const int it = f >> 3, kb = (f >> 1) & 3, s = f & 1;
    const int i = it * 32 + r;
    const float sc = QSCALE * __expf(Gs[i]);
    const uint2 a = *(const uint2*)(qn + i * LKN + kb * 32 + 16 * s + 4 * hh);
    const uint2 c = *(const uint2*)(qn + i * LKN + kb * 32 + 16 * s + 4 * hh + 8);
    uint4 o;
    o.x = pk2(bf_lo(a.x) * sc, bf_hi(a.x) * sc); o.y = pk2(bf_lo(a.y) * sc, bf_hi(a.y) * sc);
    o.z = pk2(bf_lo(c.x) * sc, bf_hi(c.x) * sc); o.w = pk2(bf_lo(c.y) * sc, bf_hi(c.y) * sc);
    *(uint4*)((char*)qkv + (size_t)(rowbase + 4 * f + (lane >> 4)) * 6144 + h * 256 + (lane & 15) * 16) = o;
  }
  char* ext = p.ws + OFF_EXTRA + (size_t)item * 24576;
#pragma unroll
  for (int ff = 0; ff < 4; ++ff) {
    const int f = wave * 4 + ff;
    const int kt = f >> 2, pb = (f >> 1) & 1, s = f & 1;
    const int k = kt * 32 + r;
    const int p0 = pb * 32 + 16 * s + 4 * hh;
    const uint2 a = *(const uint2*)(knT + k * LKT + p0);
    const uint2 c = *(const uint2*)(knT + k * LKT + p0 + 8);
    const float4 g0 = *(const float4*)(Gs + p0), g1 = *(const float4*)(Gs + p0 + 8);
    uint4 o;
    o.x = pk2(bf_lo(a.x) * __expf(Glast - g0.x), bf_hi(a.x) * __expf(Glast - g0.y));
    o.y = pk2(bf_lo(a.y) * __expf(Glast - g0.z), bf_hi(a.y) * __expf(Glast - g0.w));
    o.z = pk2(bf_lo(c.x) * __expf(Glast - g1.x), bf_hi(c.x) * __expf(Glast - g1.y));
    o.w = pk2(bf_lo(c.y) * __expf(Glast - g1.z), bf_hi(c.y) * __expf(Glast - g1.w));
    *(uint4*)(ext + f * 1024 + lane * 16) = o;
  }
  f32x16 akk = zero16(), aqk = zero16();
  const int ta = (wave == 0) ? 0 : 1, tb = (wave == 2) ? 1 : 0;
  if (wave < 3) {
#pragma unroll
    for (int ks = 0; ks < 8; ++ks) {
      const bf16x8 fa = *(const bf16x8*)(kn + (ta * 32 + r) * LKN + ks * 16 + 8 * hh);
      const bf16x8 fb = *(const bf16x8*)(kn + (tb * 32 + r) * LKN + ks * 16 + 8 * hh);
      const bf16x8 fq = *(const bf16x8*)(qn + (ta * 32 + r) * LKN + ks * 16 + 8 * hh);
      akk = MFMA(fa, fb, akk);
      aqk = MFMA(fb, fq, aqk);
    }
  }
  __syncthreads();
  if (wave < 3) {
    const int m = tb * 32 + r; const float Gm = Gs[m];
#pragma unroll
    for (int reg = 0; reg < 16; ++reg) {
      const int i = ta * 32 + crow(reg, hh);
      const float v = (m < i) ? Bs[i] * akk[reg] * __expf(Gs[i] - Gm) : 0.f;
      Amat[i * 64 + m] = v;
    }
    const int i = ta * 32 + r; const float Gi = Gs[i];
    f32x16 av;
#pragma unroll
    for (int reg = 0; reg < 16; ++reg) {
      const int j = tb * 32 + crow(reg, hh);
      av[reg] = (j <= i) ? aqk[reg] * QSCALE * __expf(Gi - Gs[j]) : 0.f;
    }
    const int fbase = 16 + (wave * 2);
#pragma unroll
    for (int s = 0; s < 2; ++s) {
      bf16x8 fr8 = pack8(av, s);
      *(bf16x8*)(ext + (fbase + s) * 1024 + lane * 16) = fr8;
    }
  } else {
    for (int e = lane; e < 32 * 32; e += 64) Amat[(e >> 5) * 64 + 32 + (e & 31)] = 0.f;
    if (lane == 0) *(float*)(ext + 22 * 1024) = __expf(Glast);
  }
  __syncthreads();
  float* Tq = (float*)(smem + 9216);
  if (wave == 0) {
    float x[32];
    const int c = lane & 31, hb = lane >> 5;
    const float* Ab = Amat + (hb * 32) * 64 + hb * 32;
#pragma unroll
    for (int i = 0; i < 32; ++i) {
      float s0 = (c == i) ? 1.f : 0.f, s1 = 0.f;
#pragma unroll
      for (int m4 = 0; m4 < (i + 3) / 4; ++m4) {
        const float4 a4 = *(const float4*)(Ab + i * 64 + m4 * 4);
        if (m4 * 4 + 0 < i) s0 -= a4.x * x[m4 * 4 + 0];
        if (m4 * 4 + 1 < i) s1 -= a4.y * x[m4 * 4 + 1];
        if (m4 * 4 + 2 < i) s0 -= a4.z * x[m4 * 4 + 2];
        if (m4 * 4 + 3 < i) s1 -= a4.w * x[m4 * 4 + 3];
      }
      x[i] = s0 + s1;
      __builtin_amdgcn_sched_barrier(0);
    }
#pragma unroll
    for (int i = 0; i < 32; ++i) Tq[hb * 1024 + i * 32 + c] = x[i];
  }
  __syncthreads();
  const int c32 = tid & 31, g8 = tid >> 5;
  {
    float bm[4] = {0.f, 0.f, 0.f, 0.f};
#pragma unroll
    for (int j4 = 0; j4 < 8; ++j4) {
      float t[4];
#pragma unroll
      for (int e = 0; e < 4; ++e) t[e] = Tq[(j4 * 4 + e) * 32 + c32];
#pragma unroll
      for (int e = 0; e < 4; ++e) {
        const float4 a4 = *(const float4*)(Amat + (32 + g8 * 4 + e) * 64 + j4 * 4);
        bm[e] += a4.x * t[0] + a4.y * t[1] + a4.z * t[2] + a4.w * t[3];
      }
    }
#pragma unroll
    for (int e = 0; e < 4; ++e) Amat[(g8 * 4 + e) * 64 + 32 + c32] = bm[e];
  }
  __syncthreads();
  float t21[4] = {0.f, 0.f, 0.f, 0.f};
  {
#pragma unroll
    for (int m4 = 0; m4 < 8; ++m4) {
      float bv[4];
#pragma unroll
      for (int e = 0; e < 4; ++e) bv[e] = Amat[(m4 * 4 + e) * 64 + 32 + c32];
#pragma unroll
      for (int e = 0; e < 4; ++e) {
        const float4 a4 = *(const float4*)(Tq + 1024 + (g8 * 4 + e) * 32 + m4 * 4);
        t21[e] -= a4.x * bv[0] + a4.y * bv[1] + a4.z * bv[2] + a4.w * bv[3];
      }
    }
  }
  float t11[4], t22[4];
#pragma unroll
  for (int e = 0; e < 4; ++e) { t11[e] = Tq[(g8 * 4 + e) * 32 + c32]; t22[e] = Tq[1024 + (g8 * 4 + e) * 32 + c32]; }
  const float bcl = Bs[c32], bgl = bcl * __expf(Gs[c32]);
  const float bch = Bs[32 + c32], bgh = bch * __expf(Gs[32 + c32]);
  __syncthreads();
#pragma unroll
  for (int e = 0; e < 4; ++e) {
    const int i = g8 * 4 + e;
    Tb[i * LKT + c32] = f2bf(t11[e] * bcl);               Tg[i * LKT + c32] = f2bf(t11[e] * bgl);
    Tb[i * LKT + 32 + c32] = (u16)0;                      Tg[i * LKT + 32 + c32] = (u16)0;
    Tb[(32 + i) * LKT + c32] = f2bf(t21[e] * bcl);        Tg[(32 + i) * LKT + c32] = f2bf(t21[e] * bgl);
    Tb[(32 + i) * LKT + 32 + c32] = f2bf(t22[e] * bch);   Tg[(32 + i) * LKT + 32 + c32] = f2bf(t22[e] * bgh);
  }
  __syncthreads();
#pragma unroll
  for (int it = 0; it < 2; ++it) {
    f32x16 av = zero16(), ak = zero16();
#pragma unroll
    for (int ks = 0; ks < 4; ++ks) {
      const bf16x8 fT = *(const bf16x8*)(Tb + (it * 32 + r) * LKT + ks * 16 + 8 * hh);
      const bf16x8 fV = *(const bf16x8*)(vT + (wave * 32 + r) * LKT + ks * 16 + 8 * hh);
      const bf16x8 fK = *(const bf16x8*)(knT + (wave * 32 + r) * LKT + ks * 16 + 8 * hh);
      const bf16x8 fG = *(const bf16x8*)(Tg + (it * 32 + r) * LKT + ks * 16 + 8 * hh);
      av = MFMA(fT, fV, av);
      ak = MFMA(fK, fG, ak);
    }
    {
      const int fv = wave * 2 + it;
      char* d = (char*)qkv + (size_t)(rowbase + 8 * fv + (lane >> 3)) * 6144 + 4096 + h * 256 + (lane & 7) * 32;
      *(bf16x8*)d = pack8(av, 0); *(bf16x8*)(d + 16) = pack8(av, 1);
    }
#pragma unroll
    for (int s = 0; s < 2; ++s) {
      const int f = it * 8 + wave * 2 + s;
      *(bf16x8*)((char*)qkv + (size_t)(rowbase + 4 * f + (lane >> 4)) * 6144 + 2048 + h * 256 + (lane & 15) * 16) = pack8(ak, s);
    }
  }
  __syncthreads();
}

DI void d2_issue(u32x4 (&rg)[18], const Params& p, int b, int h, int lt, int n) {
  const char* qseg = p.ws + OFF_QKV + (size_t)(b * 2048 + n * 64) * 6144 + h * 256;
  const char* ext = p.ws + OFF_EXTRA + (size_t)((b * 32 + n) * 8 + h) * 24576;
#pragma unroll
  for (int sg = 0; sg < 3; ++sg)
#pragma unroll
    for (int i = 0; i < 4; ++i) rg[sg * 4 + i] = __builtin_nontemporal_load((const u32x4*)(qseg + (size_t)((lt >> 4) + 16 * i) * 6144 + sg * 2048 + (lt & 15) * 16));
#pragma unroll
  for (int i = 0; i < 6; ++i) rg[12 + i] = __builtin_nontemporal_load((const u32x4*)(ext + lt * 16 + i * 4096));
}
DI void d2_put(const u32x4 (&rg)[18], char* buf, int lt) {
#pragma unroll
  for (int sg = 0; sg < 3; ++sg)
#pragma unroll
    for (int i = 0; i < 4; ++i) *(u32x4*)(buf + sg * 16384 + ((lt >> 4) + 16 * i) * 256 + (lt & 15) * 16) = rg[sg * 4 + i];
#pragma unroll
  for (int i = 0; i < 6; ++i) *(u32x4*)(buf + 49152 + lt * 16 + i * 4096) = rg[12 + i];
}
DI void d2_block(const Params& p, int unit, char* smem) {
  const int tid = threadIdx.x, half = tid >> 8, lt = tid & 255, lane = tid & 63, wave = (tid >> 6) & 3;
  const int r = lane & 31, hh = lane >> 5;
  const int b = unit >> 3, h = unit & 7;
  const char* qkv = p.ws + OFF_QKV;
  const float* egl = (const float*)(p.ws + OFF_EGL);
  u16* obuf = (u16*)((char*)p.out + (size_t)R * 1024 * 2);
  if (half == 1) {
    u32x4 rg0[18], rg1[18];
    u32x4 og[4], sg4;
    u16* obuf_ = (u16*)((char*)p.out + (size_t)R * 1024 * 2);
    float* ssq_ = (float*)(p.ws + OFF_SSQ);
    const int orow = lt >> 2, opos = lt & 3, ocol = 8 * (opos ^ ((orow >> 1) & 3));
    d2_issue(rg0, p, b, h, lt, 0); d2_put(rg0, smem, lt); d2_issue(rg1, p, b, h, lt, 1); d2_issue(rg0, p, b, h, lt, 2);
    __syncthreads();
#define D2_LOADER_STEP(n_, RG)                                                                                              \
    {                                                                                                                        \
      const int n = (n_);                                                                                                    \
      char* ob = smem + ((n + 1) & 1) * HALF_SMEM;                                                                           \
      if (n >= 1) {                                                                                                          \
        _Pragma("unroll") for (int i = 0; i < 4; ++i) og[i] = *(const u32x4*)(ob + 32768 + (lt + 256 * i) * 16);            \
        if (lt >= 192) sg4 = *(const u32x4*)(ob + 49152 + 20480 + lt * 16);                                                  \
      }                                                                                                                      \
      if (n + 1 < 32) { d2_put(RG, ob, lt); if (n + 3 < 32) d2_issue(RG, p, b, h, lt, n + 3); }                              \
      if (n >= 1) {                                                                                                          \
        const int rowbase = b * 2048 + (n - 1) * 64;                                                                         \
        _Pragma("unroll") for (int i = 0; i < 4; ++i)                                                                        \
          *(u32x4*)(obuf_ + (size_t)(rowbase + orow) * 1024 + h * 128 + 32 * i + ocol) = og[i];                              \
        if (lt >= 192) *(u32x4*)(ssq_ + ((size_t)(rowbase + lt - 192) * 8 + h) * 4) = sg4;                                   \
      }                                                                                                                      \
      if (n < 32) { asm volatile("s_waitcnt lgkmcnt(0)" ::: "memory"); __builtin_amdgcn_s_barrier(); asm volatile("" ::: "memory"); } \
    }
#pragma unroll 1
    for (int n2 = 0; n2 <= 32; n2 += 2) {
      D2_LOADER_STEP(n2, rg1)
      if (n2 + 1 <= 32) D2_LOADER_STEP(n2 + 1, rg0)
    }
#undef D2_LOADER_STEP
    return;
  }
  f32x16 S[4];
#pragma unroll
  for (int k = 0; k < 4; ++k) S[k] = zero16();
  const unsigned voff_l = (unsigned)(lane * 16);
  bf16x8 If0, If1;
#pragma unroll
  for (int j = 0; j < 8; ++j) {
    const int k0 = 8 * (j >> 2) + 4 * hh + (j & 3);
    If0[j] = (short)((k0 == r) ? 0x3F80 : 0); If1[j] = (short)((16 + k0 == r) ? 0x3F80 : 0);
  }
  const unsigned voff_v = (unsigned)((16 * wave + (lane >> 3)) * 256 + (lane & 7) * 32);
  __syncthreads();
#pragma unroll 1
  for (int n = 0; n < 32; ++n) {
    const int item = (b * 32 + n) * 8 + h;
    const int rowbase = b * 2048 + n * 64;
    const char* buf = smem + (n & 1) * HALF_SMEM;
    const char* ext = buf + 49152;
    const float eg = *(const float*)(ext + 22 * 1024);
    bf16x8 fk[16];
#pragma unroll
    for (int f = 0; f < 16; ++f) fk[f] = *(const bf16x8*)(buf + 16384 + f * 1024 + voff_l);
    uint4 vv[2][2];
#pragma unroll
    for (int it = 0; it < 2; ++it) { const char* d = buf + 32768 + it * 2048 + voff_v; vv[it][0] = *(const uint4*)d; vv[it][1] = *(const uint4*)(d + 16); }
    bf16x8 Sf[4][2];
#pragma unroll
    for (int kb = 0; kb < 4; ++kb) { Sf[kb][0] = pack8(S[kb], 0); Sf[kb][1] = pack8(S[kb], 1); }
    __builtin_amdgcn_sched_barrier(0);
    f32x16 P1[2];
    P1[0] = zero16(); P1[1] = zero16();
#pragma unroll
    for (int kb = 0; kb < 4; ++kb)
#pragma unroll
      for (int s = 0; s < 2; ++s) {
        P1[0] = MFMA(fk[kb * 2 + s], Sf[kb][s], P1[0]);
        P1[1] = MFMA(fk[8 + kb * 2 + s], Sf[kb][s], P1[1]);
      }
    bf16x8 fq[8];
#pragma unroll
    for (int f = 0; f < 8; ++f) fq[f] = *(const bf16x8*)(buf + f * 1024 + voff_l);
    bf16x8 Vf[2][2];
#pragma unroll
    for (int it = 0; it < 2; ++it) {
      const uint4 v0 = vv[it][0], v1 = vv[it][1];
      f32x16 vn;
      vn[0] = bf_lo(v0.x) - P1[it][0];  vn[1] = bf_hi(v0.x) - P1[it][1];
      vn[2] = bf_lo(v0.y) - P1[it][2];  vn[3] = bf_hi(v0.y) - P1[it][3];
      vn[4] = bf_lo(v0.z) - P1[it][4];  vn[5] = bf_hi(v0.z) - P1[it][5];
      vn[6] = bf_lo(v0.w) - P1[it][6];  vn[7] = bf_hi(v0.w) - P1[it][7];
      vn[8] = bf_lo(v1.x) - P1[it][8];  vn[9] = bf_hi(v1.x) - P1[it][9];
      vn[10] = bf_lo(v1.y) - P1[it][10]; vn[11] = bf_hi(v1.y) - P1[it][11];
      vn[12] = bf_lo(v1.z) - P1[it][12]; vn[13] = bf_hi(v1.z) - P1[it][13];
      vn[14] = bf_lo(v1.w) - P1[it][14]; vn[15] = bf_hi(v1.w) - P1[it][15];
      Vf[it][0] = pack8(vn, 0); Vf[it][1] = pack8(vn, 1);
    }
    bf16x8 fa[6];
#pragma unroll
    for (int i = 0; i < 6; ++i) fa[i] = *(const bf16x8*)(ext + (16 + i) * 1024 + voff_l);
    f32x16 P2[2];
    P2[0] = zero16(); P2[1] = zero16();
#pragma unroll
    for (int kb = 0; kb < 4; ++kb)
#pragma unroll
      for (int s = 0; s < 2; ++s) {
        P2[0] = MFMA(fq[kb * 2 + s], Sf[kb][s], P2[0]);
        const bf16x8 fq1 = *(const bf16x8*)(buf + (8 + kb * 2 + s) * 1024 + voff_l);
        P2[1] = MFMA(fq1, Sf[kb][s], P2[1]);
      }
    __builtin_amdgcn_sched_barrier(0);
    bf16x8 fkd[16];
#pragma unroll
    for (int i = 0; i < 16; ++i) fkd[i] = *(const bf16x8*)(ext + i * 1024 + voff_l);
#pragma unroll
    for (int s = 0; s < 2; ++s) {
      P2[0] = MFMA(fa[0 + s], Vf[0][s], P2[0]);
      P2[1] = MFMA(fa[2 + s], Vf[0][s], P2[1]);
      P2[1] = MFMA(fa[4 + s], Vf[1][s], P2[1]);
    }
    {
      char* ow = (char*)buf + 32768 + wave * 4096;
      float* sqw = (float*)((char*)buf + 49152 + 23 * 1024);
      const int xs = (r >> 1) & 3;
#pragma unroll
      for (int it = 0; it < 2; ++it) {
        f32x16 Z = MFMA(pack8(P2[it], 0), If0, zero16());
        Z = MFMA(pack8(P2[it], 1), If1, Z);
        float ssl = 0.f;
#pragma unroll
        for (int reg = 0; reg < 16; ++reg) ssl += Z[reg] * Z[reg];
        ssl += __shfl_xor(ssl, 32, 64);
        if (hh == 0) sqw[(it * 32 + r) * 4 + wave] = ssl;
#pragma unroll
        for (int g = 0; g < 4; ++g) {
          uint2 pv; pv.x = pk2(Z[4 * g], Z[4 * g + 1]); pv.y = pk2(Z[4 * g + 2], Z[4 * g + 3]);
          *(uint2*)(ow + (it * 32 + r) * 64 + ((g ^ xs) * 16) + hh * 8) = pv;
        }
      }
    }
#pragma unroll
    for (int kt = 0; kt < 4; ++kt) {
#pragma unroll
      for (int reg = 0; reg < 16; ++reg) S[kt][reg] *= eg;
#pragma unroll
      for (int pb = 0; pb < 2; ++pb)
#pragma unroll
        for (int s = 0; s < 2; ++s) {
          S[kt] = MFMA(fkd[kt * 4 + pb * 2 + s], Vf[pb][s], S[kt]);
        }
    }
    asm volatile("s_waitcnt lgkmcnt(0)" ::: "memory"); __builtin_amdgcn_s_barrier(); asm volatile("" ::: "memory");
  }
  float* od = p.out + OUT_DELTAP + (size_t)(b * 8 + h) * 16384;
#pragma unroll
  for (int kt = 0; kt < 4; ++kt)
#pragma unroll
    for (int reg = 0; reg < 16; ++reg) od[(kt * 32 + crow(reg, hh)) * 128 + wave * 32 + r] = S[kt][reg];
}

DI void conf_prompt_item(const Params& p, int item, char* smem) {
  const int tid = threadIdx.x & 255, lane = tid & 63, wave = tid >> 6;
  const int b = item >> 6, t0 = (item & 63) * 32;
  unsigned* tile = (unsigned*)smem;
  float* red = (float*)(smem + 63488);
  const u16* glu = (const u16*)(p.ws + OFF_GLU);
  u16* aact = (u16*)(p.ws + OFF_AACT);
#pragma unroll 1
  for (int hb = 0; hb < 2; ++hb) {
    u32x4 fv[8];
#pragma unroll
    for (int i = 0; i < 8; ++i) {
      const int e = tid + 256 * (hb * 8 + i), rr = e >> 6, c8 = (e & 63) * 8;
      const int t = t0 - 30 + rr;
      fv[i] = (u32x4){0u, 0u, 0u, 0u};
      if (rr < 62 && t >= 0) fv[i] = *(const u32x4*)(glu + (size_t)(b * 2048 + t) * 512 + c8);
    }
#pragma unroll
    for (int i = 0; i < 8; ++i) {
      const int e = tid + 256 * (hb * 8 + i), rr = e >> 6, c8 = (e & 63) * 8;
      if (rr < 62) *(u32x4*)(tile + rr * 256 + (c8 >> 1)) = fv[i];
    }
  }
  float w[31][2];
#pragma unroll
  for (int j = 0; j < 31; ++j) { const float2 t = *(const float2*)(p.conf_dw_w + j * 512 + 2 * tid); w[j][0] = t.x; w[j][1] = t.y; }
  const float2 bias = *(const float2*)(p.conf_dw_b + 2 * tid);
  const float2 lw = *(const float2*)(p.conf_ln_w + 2 * tid), lb = *(const float2*)(p.conf_ln_b + 2 * tid);
  __syncthreads();
#pragma unroll 1
  for (int tg = 0; tg < 4; ++tg) {
    float a[8][2];
#pragma unroll
    for (int t = 0; t < 8; ++t) { a[t][0] = bias.x; a[t][1] = bias.y; }
#pragma unroll
    for (int i = 0; i < 38; ++i) {
      const unsigned u = tile[(tg * 8 + i) * 256 + tid];
      const float x0 = bf_lo(u), x1 = bf_hi(u);
#pragma unroll
      for (int t = 0; t < 8; ++t) {
        const int j = i - t;
        if (j >= 0 && j < 31) { a[t][0] += w[j][0] * x0; a[t][1] += w[j][1] * x1; }
      }
    }
#pragma unroll
    for (int t = 0; t < 8; ++t) {
      const float s1 = wsum(a[t][0] + a[t][1]);
      const float s2 = wsum(a[t][0] * a[t][0] + a[t][1] * a[t][1]);
      if (lane == 0) { red[(wave * 8 + t) * 2] = s1; red[(wave * 8 + t) * 2 + 1] = s2; }
    }
    __syncthreads();
#pragma unroll
    for (int t = 0; t < 8; ++t) {
      const float s1 = red[t * 2] + red[(8 + t) * 2] + red[(16 + t) * 2] + red[(24 + t) * 2];
      const float s2 = red[t * 2 + 1] + red[(8 + t) * 2 + 1] + red[(16 + t) * 2 + 1] + red[(24 + t) * 2 + 1];
      const float mu = s1 * (1.f / 512.f);
      const float var = fmaxf(s2 * (1.f / 512.f) - mu * mu, 0.f);
      const float rs = rsqrtf(var + EPS);
      const float y0 = (a[t][0] - mu) * rs * lw.x + lb.x, y1 = (a[t][1] - mu) * rs * lw.y + lb.y;
      *(unsigned*)(aact + (size_t)(b * 2048 + t0 + tg * 8 + t) * 512 + 2 * tid) = pk2(siluf_(y0), siluf_(y1));
    }
    __syncthreads();
  }
}
DI void conf_sample_item(const Params& p, int item) {
  const int lane = threadIdx.x & 63, wave = (threadIdx.x >> 6) & 3;
  const int s = item * 4 + wave;
  const int c = lane * 8;
  const u16* glu = (const u16*)(p.ws + OFF_GLU);
  u16* aact = (u16*)(p.ws + OFF_AACT);
  float a[8];
  {
    const float4 b0 = *(const float4*)(p.conf_dw_b + c), b1 = *(const float4*)(p.conf_dw_b + c + 4);
    a[0] = b0.x; a[1] = b0.y; a[2] = b0.z; a[3] = b0.w; a[4] = b1.x; a[5] = b1.y; a[6] = b1.z; a[7] = b1.w;
  }
  const float* st = p.st_conf + (size_t)s * 30 * 512;
  float* oc = p.out + OUT_CONFS + (size_t)s * 30 * 512;
#pragma unroll 1
  for (int j = 0; j < 30; ++j) {
    const f32x4 n0 = __builtin_nontemporal_load((const f32x4*)(st + j * 512 + c)), n1 = __builtin_nontemporal_load((const f32x4*)(st + j * 512 + c + 4));
    const float4 x0 = make_float4(n0[0], n0[1], n0[2], n0[3]), x1 = make_float4(n1[0], n1[1], n1[2], n1[3]);
    const float4 w0 = *(const float4*)(p.conf_dw_w + j * 512 + c), w1 = *(const float4*)(p.conf_dw_w + j * 512 + c + 4);
    a[0] += w0.x * x0.x; a[1] += w0.y * x0.y; a[2] += w0.z * x0.z; a[3] += w0.w * x0.w;
    a[4] += w1.x * x1.x; a[5] += w1.y * x1.y; a[6] += w1.z * x1.z; a[7] += w1.w * x1.w;
    if (j >= 1) { __builtin_nontemporal_store(n0, (f32x4*)(oc + (j - 1) * 512 + c)); __builtin_nontemporal_store(n1, (f32x4*)(oc + (j - 1) * 512 + c + 4)); }
  }
  {
    const uint4 g = *(const uint4*)(glu + (size_t)(RP + s) * 512 + c);
    const float4 w0 = *(const float4*)(p.conf_dw_w + 30 * 512 + c), w1 = *(const float4*)(p.conf_dw_w + 30 * 512 + c + 4);
    a[0] += w0.x * bf_lo(g.x); a[1] += w0.y * bf_hi(g.x); a[2] += w0.z * bf_lo(g.y); a[3] += w0.w * bf_hi(g.y);
    a[4] += w1.x * bf_lo(g.z); a[5] += w1.y * bf_hi(g.z); a[6] += w1.z * bf_lo(g.w); a[7] += w1.w * bf_hi(g.w);
  }
  float s1 = 0.f, s2 = 0.f;
#pragma unroll
  for (int i = 0; i < 8; ++i) { s1 += a[i]; s2 += a[i] * a[i]; }
  s1 = wsum(s1); s2 = wsum(s2);
  const float mu = s1 * (1.f / 512.f);
  const float rs = rsqrtf(fmaxf(s2 * (1.f / 512.f) - mu * mu, 0.f) + EPS);
  float y[8];
#pragma unroll
  for (int i = 0; i < 8; ++i) y[i] = siluf_((a[i] - mu) * rs * p.conf_ln_w[c + i] + p.conf_ln_b[c + i]);
  uint4 o; o.x = pk2(y[0], y[1]); o.y = pk2(y[2], y[3]); o.z = pk2(y[4], y[5]); o.w = pk2(y[6], y[7]);
  *(uint4*)(aact + (size_t)(RP + s) * 512 + c) = o;
}
DI void delta_sample_item(const Params& p, int item, char* smem) {
  const int tid = threadIdx.x & 255, lane = tid & 63, wave = tid >> 6;
  const int s = item >> 3, h = item & 7;
  float* qs = (float*)smem; float* ks = qs + 128; float* vs = ks + 128; float* part = vs + 128;
  float* red = part + 768;
  const u16* qkv = (const u16*)(p.ws + OFF_QKV);
  const float* gb = (const float*)(p.ws + OFF_GB);
  const int row = RP + s;
  const int v = tid & 127, kh = tid >> 7;
  const float* S0 = p.st_delta + (size_t)(s * 8 + h) * 16384 + (size_t)(kh * 64) * 128 + v;
  float Sr[64];
#pragma unroll
  for (int kk = 0; kk < 64; ++kk) Sr[kk] = __builtin_nontemporal_load(S0 + kk * 128);
  const float g = gb[(size_t)row * 16 + 8 + h], beta = gb[(size_t)row * 16 + h];
  float cq = 0.f, ck = 0.f, cv = 0.f;
  if (tid < 128) {
    float cx[3];
#pragma unroll
    for (int X = 0; X < 3; ++X) {
      const int cg = X * 1024 + h * 128 + tid;
      const float s0 = p.st_qkv[(size_t)(s * 3 + 0) * 3072 + cg], s1 = p.st_qkv[(size_t)(s * 3 + 1) * 3072 + cg], s2 = p.st_qkv[(size_t)(s * 3 + 2) * 3072 + cg];
      const float x = bf1(qkv[(size_t)row * 3072 + cg]);
      const float a = p.gdn_conv_w[cg] * s0 + p.gdn_conv_w[3072 + cg] * s1 + p.gdn_conv_w[2 * 3072 + cg] * s2 + p.gdn_conv_w[3 * 3072 + cg] * x;
      cx[X] = siluf_(a);
      p.out[OUT_QKVS + (size_t)(s * 3 + 0) * 3072 + cg] = s1;
      p.out[OUT_QKVS + (size_t)(s * 3 + 1) * 3072 + cg] = s2;
    }
    cq = cx[0]; ck = cx[1]; cv = cx[2];
  }
  {
    const float sq = wsum(cq * cq), sk = wsum(ck * ck);
    if (lane == 0) { red[wave * 2] = sq; red[wave * 2 + 1] = sk; }
  }
  __syncthreads();
  if (tid < 128) {
    const float rq = rsqrtf(red[0] + red[2] + EPS), rk = rsqrtf(red[1] + red[3] + EPS);
    qs[tid] = cq * rq * QSCALE; ks[tid] = ck * rk; vs[tid] = cv;
  }
  __syncthreads();
  const float eg = __expf(g);
  float kS = 0.f, qS = 0.f, qk = 0.f;
#pragma unroll
  for (int k4 = 0; k4 < 16; ++k4) {
    const float4 kv = *(const float4*)(ks + kh * 64 + k4 * 4), qv = *(const float4*)(qs + kh * 64 + k4 * 4);
    kS += kv.x * Sr[4 * k4] + kv.y * Sr[4 * k4 + 1] + kv.z * Sr[4 * k4 + 2] + kv.w * Sr[4 * k4 + 3];
    qS += qv.x * Sr[4 * k4] + qv.y * Sr[4 * k4 + 1] + qv.z * Sr[4 * k4 + 2] + qv.w * Sr[4 * k4 + 3];
    qk += kv.x * qv.x + kv.y * qv.y + kv.z * qv.z + kv.w * qv.w;
  }
  part[(kh * 3 + 0) * 128 + v] = kS; part[(kh * 3 + 1) * 128 + v] = qS; part[(kh * 3 + 2) * 128 + v] = qk;
  __syncthreads();
  kS = part[0 * 128 + v] + part[3 * 128 + v];
  qS = part[1 * 128 + v] + part[4 * 128 + v];
  qk = part[2 * 128 + v] + part[5 * 128 + v];
  const float vnew = vs[v] * beta - beta * eg * kS;
  const float o = eg * qS + qk * vnew;
  float* Sd = p.out + OUT_DELTAS + (size_t)(s * 8 + h) * 16384 + (size_t)(kh * 64) * 128 + v;
#pragma unroll
  for (int k4 = 0; k4 < 16; ++k4) {
    const float4 kv = *(const float4*)(ks + kh * 64 + k4 * 4);
    __builtin_nontemporal_store(Sr[4 * k4 + 0] * eg + kv.x * vnew, Sd + (4 * k4 + 0) * 128);
    __builtin_nontemporal_store(Sr[4 * k4 + 1] * eg + kv.y * vnew, Sd + (4 * k4 + 1) * 128);
    __builtin_nontemporal_store(Sr[4 * k4 + 2] * eg + kv.z * vnew, Sd + (4 * k4 + 2) * 128);
    __builtin_nontemporal_store(Sr[4 * k4 + 3] * eg + kv.w * vnew, Sd + (4 * k4 + 3) * 128);
  }
  if (kh == 0) {
    ((u16*)((char*)p.out + (size_t)R * 1024 * 2))[(size_t)row * 1024 + h * 128 + v] = f2bf(o);
    const float so = wsum(o * o);
    if (lane == 0) { float* sq = (float*)(p.ws + OFF_SSQ) + ((size_t)row * 8 + h) * 4; sq[wave] = so; sq[wave + 2] = 0.f; }
  }
  __syncthreads();
}

__global__ void __launch_bounds__(512, 2) fwd_megakernel(Params p) {
  __shared__ __attribute__((aligned(1024))) char smem[SMEM_BYTES];
  const int tid = threadIdx.x, lane = tid & 63, wave = tid >> 6;
  const int fr = lane & 15, fq = lane >> 4;
  uint4* xb_words = (uint4*)(smem + 2 * HALF_SMEM);
  if (tid == 0) *xb_words = make_uint4(0u, 0u, 0u, 0u);
  __syncthreads();
  XcdBarrier xb = xcd_barrier_post((unsigned*)(p.ws + OFF_BAR), (volatile LAS unsigned*)xb_words);
  const int G = gridDim.x, bid = blockIdx.x;
  float* mod = (float*)(p.ws + OFF_MOD);
  u16* hbuf = (u16*)p.out;
  u16* obuf = (u16*)((char*)p.out + (size_t)R * 1024 * 2);
  const float* ssq = (const float*)(p.ws + OFF_SSQ);
  u16* merged = (u16*)(p.ws + OFF_MERGED);
  u16* tmp2 = (u16*)(p.ws + OFF_TMP2);

  PH(0) phase_convert(p, smem);
  xcd_barrier(xb);

  PH(1) for (int sb = bid; sb < 256; sb += G) {
    skinny<2>((const u16*)(p.ws + OFF_AC), 1024, 0, 136, (const u16*)(p.ws + OFF_WADA), 1024, 1024,
      [&](int j) { return sb * 24 + (j < 24 ? j : 23); },
      [&](int row, int ntl, int q, f32x4 v, int ln) {
        const int j = ntl * 16 + 4 * q;
        if (j < 24) {
          const int col = sb * 24 + j;
          const float4 bb = *(const float4*)(p.b_ada + col);
          *(float4*)(mod + (size_t)row * 6144 + col) = make_float4(v[0] + bb.x, v[1] + bb.y, v[2] + bb.z, v[3] + bb.w);
        }
      });
  }
  xcd_barrier(xb);

  PH(2) phase_modnorm<false>(p, p.x_prompt, p.x_sample, p.norm1_w, 0, 1024, hbuf, smem);
  xcd_barrier(xb);

  PH(3) {
    u16* glu = (u16*)(p.ws + OFF_GLU);
    u16* qkv = (u16*)(p.ws + OFF_QKV);
    u16* halo = (u16*)(p.ws + OFF_HALO);
    auto f_glu_st = [&](int row, int ch, f32x4 gl) {
      uint2 o; o.x = pk2(gl[0], gl[1]); o.y = pk2(gl[2], gl[3]);
      *(uint2*)(glu + (size_t)row * 512 + ch) = o;
      if (row < RP) { const int b = row >> 11, tt = row & 2047; if (tt >= 2018) *(float4*)(p.out + OUT_CONFP + (size_t)(b * 30 + tt - 2018) * 512 + ch) = make_float4(gl[0], gl[1], gl[2], gl[3]); }
      else *(float4*)(p.out + OUT_CONFS + (size_t)((row - RP) * 30 + 29) * 512 + ch) = make_float4(gl[0], gl[1], gl[2], gl[3]);
    };
    auto f_glu = [&](int row, int ch, f32x4 a, f32x4 g) {
      f32x4 gl;
#pragma unroll
      for (int j = 0; j < 4; ++j) gl[j] = a[j] * sigmoidf_(g[j]);
      f_glu_st(row, ch, gl);
    };
    auto f_qkv = [&](int row, int col, f32x4 a) {
      const float4 v = make_float4(a[0], a[1], a[2], a[3]);
      uint2 o; o.x = pk2(v.x, v.y); o.y = pk2(v.z, v.w);
      *(uint2*)(qkv + (size_t)row * 3072 + col) = o;
      if (row < RP) {
        const int b = row >> 11, tt = row & 2047;
        if ((tt & 63) >= 61) *(uint2*)(halo + (size_t)((b * 32 + (tt >> 6)) * 3 + (tt & 63) - 61) * 3072 + col) = o;
        if (tt >= 2045) *(float4*)(p.out + OUT_QKVP + (size_t)(b * 3 + tt - 2045) * 3072 + col) = v;
      } else *(float4*)(p.out + OUT_QKVS + (size_t)((row - RP) * 3 + 2) * 3072 + col) = v;
    };
    {
      float* gb = (float*)(p.ws + OFF_GB);
      for (int rb = bid; rb < R / 32; rb += G)
        skinny<1>(hbuf, 1024, rb * 32, 32, (const u16*)(p.ws + OFF_WIN) + (size_t)4096 * 1024, 1024, 1024, [](int j) { return j; },
          [&](int row, int ntl, int q, f32x4 v, int ln) {
            if (q < 2) {
              *(float4*)(gb + (size_t)row * 16 + 4 * q) = make_float4(sigmoidf_(v[0]), sigmoidf_(v[1]), sigmoidf_(v[2]), sigmoidf_(v[3]));
            } else {
              const int hd = 4 * (q - 2);
              float gv[4];
#pragma unroll
              for (int j = 0; j < 4; ++j) gv[j] = -__expf(p.a_log[hd + j]) * softplusf_(v[j] + p.dt_bias[hd + j]);
              *(float4*)(gb + (size_t)row * 16 + 8 + hd) = make_float4(gv[0], gv[1], gv[2], gv[3]);
            }
          });
    }
    int u = bid;
    for (; u < 64 * 4; u += G) {
      const int pm = u % 64, pn = u / 64;
      f32x4 acc[2][2][4][2];
      zero_acc(acc);
      gemm256(acc, hbuf, 1024, (const u16*)(p.ws + OFF_WIN), 1024, pm * 256, pn * 256, 1024, smem);
      {
        int t_ = threadIdx.x;
        asm volatile("" : "+v"(t_));
        const int wr = t_ >> 8, wc = (t_ >> 6) & 3, fr_ = t_ & 15, fq_ = (t_ >> 4) & 3;
        float* T = (float*)smem;
#pragma unroll
        for (int ai = 0; ai < 2; ++ai)
#pragma unroll
          for (int m = 0; m < 4; ++m)
#pragma unroll
            for (int n = 0; n < 2; ++n) {
              f32x4 gl;
#pragma unroll
              for (int j = 0; j < 4; ++j) gl[j] = acc[ai][0][m][n][j] * sigmoidf_(acc[ai][1][m][n][j]);
              *(f32x4*)(T + (ai * 128 + wr * 64 + m * 16 + fr_) * TLD + wc * 32 + n * 16 + 4 * fq_) = gl;
            }
        __syncthreads();
        const int cg = (t_ & 31) * 4, r0 = t_ >> 5;
#pragma unroll 4
        for (int i = 0; i < 16; ++i) {
          const int rl = r0 + 16 * i;
          const f32x4 v = *(const f32x4*)(T + rl * TLD + cg);
          f_glu_st(pm * 256 + rl, pn * 128 + cg, v);
        }
        __syncthreads();
      }
    }
    for (; u < 64 * 16; u += G) {
      const int pm = u % 64, pn = u / 64;
      f32x4 acc[2][2][4][2];
      zero_acc(acc);
      gemm256(acc, hbuf, 1024, (const u16*)(p.ws + OFF_WIN), 1024, pm * 256, pn * 256, 1024, smem);
      tile_epilogue(acc, pm * 256, pn * 256 - 1024, smem, f_qkv);
    }
    for (int sb = bid; sb < 256; sb += G) {
      if (sb < 64) {
        skinny<1>(hbuf, 1024, RP, 128, (const u16*)(p.ws + OFF_WIN), 1024, 1024,
          [&](int j) { const int ch = sb * 8 + (j & 7); return (ch >> 7) * 256 + (ch & 127) + ((j >> 3) << 7); },
          [&](int row, int ntl, int q, f32x4 v, int ln) {
            f32x4 g;
#pragma unroll
            for (int j = 0; j < 4; ++j) g[j] = __shfl(v[j], (ln + 32) & 63, 64);
            if (q < 2) f_glu(row, sb * 8 + 4 * q, v, g);
          });
      } else {
        skinny<1>(hbuf, 1024, RP, 128, (const u16*)(p.ws + OFF_WIN), 1024, 1024,
          [&](int j) { return 1024 + (sb - 64) * 16 + j; },
          [&](int row, int ntl, int q, f32x4 v, int ln) { f_qkv(row, (sb - 64) * 16 + 4 * q, v); });
      }
    }
  }
  xcd_barrier(xb);

  PH(4) for (int base = bid * 2; base < 2048; base += 2 * G) d1_item(p, base + (tid >> 8), smem + (tid >> 8) * HALF_SMEM);
  xcd_barrier(xb);

  PH(5) {
    const int half = tid >> 8;
    char* hs = smem + half * HALF_SMEM;
    for (int u = bid; u < 64; u += G) { d2_block(p, u, smem); __syncthreads(); }
    unsigned* qhead = (unsigned*)(p.ws + OFF_BAR) + 64;
    volatile unsigned* qslot = (volatile unsigned*)(smem + 2 * HALF_SMEM + 32);
    auto deq = [&]() -> int {
      if (tid == 0) *qslot = __hip_atomic_fetch_add(qhead, 1u, __ATOMIC_RELAXED, __HIP_MEMORY_SCOPE_AGENT);
      __syncthreads();
      const int v = __builtin_amdgcn_readfirstlane((int)*qslot);
      __syncthreads();
      return v;
    };
    int idx = deq();
    for (; idx < 256; idx = deq()) conf_prompt_item(p, 2 * idx + half, hs);
    for (; idx < 272; idx = deq()) conf_sample_item(p, 2 * (idx - 256) + half);
    for (; idx < 784; idx = deq()) delta_sample_item(p, 2 * (idx - 272) + half, hs);
  }
  xcd_barrier(xb);

  PH(6) {
    auto f_z = [&](int row, int col, f32x4 a) {
      const float4 sq4 = *(const float4*)(ssq + ((size_t)row * 8 + (col >> 7)) * 4);
      const float rstd = rsqrtf((sq4.x + sq4.y + sq4.z + sq4.w) * (1.f / 128.f) + EPS);
      const float4 gw = *(const float4*)(p.gdn_norm_w + (col & 127));
      u16* op = obuf + (size_t)row * 1024 + col;
      const uint2 u = *(const uint2*)op;
      uint2 o;
      o.x = pk2(bf_lo(u.x) * rstd * gw.x * siluf_(a[0]), bf_hi(u.x) * rstd * gw.y * siluf_(a[1]));
      o.y = pk2(bf_lo(u.y) * rstd * gw.z * siluf_(a[2]), bf_hi(u.y) * rstd * gw.w * siluf_(a[3]));
      *(uint2*)op = o;
    };
    gemm_pass(hbuf, 1024, (const u16*)(p.ws + OFF_WZ), 1024, 1024, 1024, smem, f_z);
    for (int sb = bid; sb < 256; sb += G)
      skinny<1>(hbuf, 1024, RP, 128, (const u16*)(p.ws + OFF_WZ), 1024, 1024, [&](int j) { return sb * 4 + (j & 3); },
                [&](int row, int ntl, int q, f32x4 v, int ln) { if (q == 0) f_z(row, sb * 4, v); });
  }
  xcd_barrier(xb);

  PH(7) {
    auto f_ga = [&](int row, int col, f32x4 a) {
      uint2 o; o.x = pk2(sigmoidf_(a[0]), sigmoidf_(a[1])); o.y = pk2(sigmoidf_(a[2]), sigmoidf_(a[3]));
      *(uint2*)(merged + (size_t)row * 1024 + col) = o;
    };
    auto f_ya = [&](int row, int col, f32x4 a) {
      u16* mp = merged + (size_t)row * 1024 + col;
      const uint2 u = *(const uint2*)mp;
      uint2 o; o.x = pk2(bf_lo(u.x) * a[0], bf_hi(u.x) * a[1]); o.y = pk2(bf_lo(u.y) * a[2], bf_hi(u.y) * a[3]);
      *(uint2*)mp = o;
    };
    auto f_gb = [&](int row, int col, f32x4 a) {
      uint2 o; o.x = pk2(sigmoidf_(a[0]), sigmoidf_(a[1])); o.y = pk2(sigmoidf_(a[2]), sigmoidf_(a[3]));
      *(uint2*)(tmp2 + (size_t)row * 1024 + col) = o;
    };
    auto f_yb = [&](int row, int col, f32x4 a) {
      u16* mp = merged + (size_t)row * 1024 + col;
      const uint2 u = *(const uint2*)mp, s2 = *(const uint2*)(tmp2 + (size_t)row * 1024 + col);
      uint2 o; o.x = pk2(bf_lo(u.x) + bf_lo(s2.x) * a[0], bf_hi(u.x) + bf_hi(s2.x) * a[1]); o.y = pk2(bf_lo(u.y) + bf_lo(s2.y) * a[2], bf_hi(u.y) + bf_hi(s2.y) * a[3]);
      *(uint2*)mp = o;
    };
    auto cm4 = [&](int sb) { return [sb](int j) { return sb * 4 + (j & 3); }; };
    gemm_pass(hbuf, 1024, (const u16*)(p.ws + OFF_WGA), 1024, 1024, 1024, smem, f_ga);
    gemm_pass((const u16*)(p.ws + OFF_AACT), 512, (const u16*)(p.ws + OFF_WCONF), 512, 1024, 512, smem, f_ya);
    gemm_pass(hbuf, 1024, (const u16*)(p.ws + OFF_WGB), 1024, 1024, 1024, smem, f_gb);
    gemm_pass(obuf, 1024, (const u16*)(p.ws + OFF_WGDN), 1024, 1024, 1024, smem, f_yb);
    for (int sb = bid; sb < 256; sb += G) {
      skinny<1>(hbuf, 1024, RP, 128, (const u16*)(p.ws + OFF_WGA), 1024, 1024, cm4(sb), [&](int row, int ntl, int q, f32x4 v, int ln) { if (q == 0) f_ga(row, sb * 4, v); });
      skinny<1>((const u16*)(p.ws + OFF_AACT), 512, RP, 128, (const u16*)(p.ws + OFF_WCONF), 512, 512, cm4(sb), [&](int row, int ntl, int q, f32x4 v, int ln) { if (q == 0) f_ya(row, sb * 4, v); });
      skinny<1>(hbuf, 1024, RP, 128, (const u16*)(p.ws + OFF_WGB), 1024, 1024, cm4(sb), [&](int row, int ntl, int q, f32x4 v, int ln) { if (q == 0) f_gb(row, sb * 4, v); });
      skinny<1>(obuf, 1024, RP, 128, (const u16*)(p.ws + OFF_WGDN), 1024, 1024, cm4(sb), [&](int row, int ntl, int q, f32x4 v, int ln) { if (q == 0) f_yb(row, sb * 4, v); });
    }
  }
  xcd_barrier(xb);

  PH(8) {
    auto f_o = [&](int row, int col, f32x4 a) {
      const float* xr = row < RP ? p.x_prompt + (size_t)row * 1024 : p.x_sample + (size_t)(row - RP) * 1024;
      const f32x4 x4 = __builtin_nontemporal_load((const f32x4*)(xr + col));
      const float4 xv = make_float4(x4[0], x4[1], x4[2], x4[3]), gv = *(const float4*)(mod + (size_t)mrow_of(row) * 6144 + 2048 + col);
      *(float4*)(p.out + (size_t)row * 1024 + col) = make_float4(xv.x + gv.x * a[0], xv.y + gv.y * a[1], xv.z + gv.z * a[2], xv.w + gv.w * a[3]);
    };
    gemm_pass(merged, 1024, (const u16*)(p.ws + OFF_WO), 1024, 1024, 1024, smem, f_o);
    for (int sb = bid; sb < 256; sb += G)
      skinny<1>(merged, 1024, RP, 128, (const u16*)(p.ws + OFF_WO), 1024, 1024, [&](int j) { return sb * 4 + (j & 3); },
                [&](int row, int ntl, int q, f32x4 v, int ln) { if (q == 0) f_o(row, sb * 4, v); });
  }
  xcd_barrier(xb);

  PH(9) phase_modnorm<false>(p, p.out, p.out + (size_t)RP * 1024, p.norm2_w, 3072, 4096, (u16*)(p.ws + OFF_H2), smem);
  xcd_barrier(xb);

  PH(10) {
    u16* f = (u16*)(p.ws + OFF_F);
    auto f_ff1 = [&](int row, int col, f32x4 a) {
      float v[4];
#pragma unroll
      for (int j = 0; j < 4; ++j) { const float t = fmaxf(a[j], 0.f); v[j] = t * t; }
      uint2 o; o.x = pk2(v[0], v[1]); o.y = pk2(v[2], v[3]);
      *(uint2*)(f + (size_t)row * LDF + col) = o;
    };
    gemm_pass((const u16*)(p.ws + OFF_H2), 1024, (const u16*)(p.ws + OFF_W1), 1024, 4096, 1024, smem, f_ff1);
    for (int sb = bid; sb < 256; sb += G)
      skinny<1>((const u16*)(p.ws + OFF_H2), 1024, RP, 128, (const u16*)(p.ws + OFF_W1), 1024, 1024, [&](int j) { return sb * 16 + j; },
                [&](int row, int ntl, int q, f32x4 v, int ln) { f_ff1(row, sb * 16 + 4 * q, v); });
  }
  xcd_barrier(xb);

  PH(11) {
    auto f_ff2 = [&](int row, int col, f32x4 a) {
      float* xp = p.out + (size_t)row * 1024 + col;
      const f32x4 x4 = __builtin_nontemporal_load((const f32x4*)xp);
      const float4 xv = make_float4(x4[0], x4[1], x4[2], x4[3]), gv = *(const float4*)(mod + (size_t)mrow_of(row) * 6144 + 5120 + col);
      *(float4*)xp = make_float4(xv.x + gv.x * a[0], xv.y + gv.y * a[1], xv.z + gv.z * a[2], xv.w + gv.w * a[3]);
    };
    gemm_pass((const u16*)(p.ws + OFF_F), LDF, (const u16*)(p.ws + OFF_W2), LDF, 1024, 4096, smem, f_ff2);
    for (int sb = bid; sb < 256; sb += G)
      skinny<1>((const u16*)(p.ws + OFF_F), LDF, RP, 128, (const u16*)(p.ws + OFF_W2), LDF, 4096, [&](int j) { return sb * 4 + (j & 3); },
                [&](int row, int ntl, int q, f32x4 v, int ln) { if (q == 0) f_ff2(row, sb * 4, v); });
  }
  xcd_barrier(xb);

  PH(12) {
    int t12 = threadIdx.x;
    asm volatile("" : "+v"(t12));
    const int lane = t12 & 63, wave = t12 >> 6;
    const int gw = bid * 8 + wave, nw_ = G * 8;
    for (int row = gw; row < R; row += nw_) {
      float* xr = p.out + (size_t)row * 1024;
      float4 v[4]; float ss = 0.f;
#pragma unroll
      for (int i = 0; i < 4; ++i) { const f32x4 t4 = __builtin_nontemporal_load((const f32x4*)(xr + (lane + 64 * i) * 4)); v[i] = make_float4(t4[0], t4[1], t4[2], t4[3]); ss += v[i].x * v[i].x + v[i].y * v[i].y + v[i].z * v[i].z + v[i].w * v[i].w; }
      ss = wsum(ss);
      const float rstd = rsqrtf(ss * (1.f / 1024.f) + EPS);
#pragma unroll
      for (int i = 0; i < 4; ++i) {
        const int c = (lane + 64 * i) * 4;
        const float4 w = *(const float4*)(p.final_norm_w + c);
        f32x4 yv = {v[i].x * rstd * w.x, v[i].y * rstd * w.y, v[i].z * rstd * w.z, v[i].w * rstd * w.w};
        __builtin_nontemporal_store(yv, (f32x4*)(xr + c));
      }
    }
  }
}

extern "C" void kernel_launch(void* const* d_in, const int* in_sizes, int n_in, void* d_out, int out_size, void* d_ws, size_t ws_size,
                              hipStream_t stream) {
  static int grid_blocks = 0;
  if (!grid_blocks) {
    int dev = 0, cus = 0, per_cu = 0;
    hipGetDevice(&dev);
    hipDeviceGetAttribute(&cus, hipDeviceAttributeMultiprocessorCount, dev);
    hipOccupancyMaxActiveBlocksPerMultiprocessor(&per_cu, (const void*)fwd_megakernel, NT, 0);
    if (per_cu > 1) per_cu = 1;
    if (per_cu < 1) per_cu = 1;
    grid_blocks = cus * per_cu;
  }
  Params p{};
  const float** pp = (const float**)&p;
  for (int i = 0; i < 26; ++i) pp[i] = (const float*)d_in[i];
  p.out = (float*)d_out; p.ws = (char*)d_ws;
  if (ws_size < WS_NEED) { fprintf(stderr, "workspace too small: %zu < %zu\n", ws_size, (size_t)WS_NEED); return; }
  hipMemsetAsync(d_ws, 0, XCD_BAR_WORDS * 4, stream);
  void* args[] = {&p};
  hipError_t e = hipLaunchCooperativeKernel((const void*)fwd_megakernel, dim3(grid_blocks), dim3(NT), args, 0, stream);
  if (e != hipSuccess) fprintf(stderr, "cooperative launch failed: %s (grid %d)\n", hipGetErrorString(e), grid_blocks);
}
```

```cpp
#include <hip/hip_runtime.h>
#include <stdint.h>
#include <cstdio>

#define DI __device__ __forceinline__
typedef unsigned short u16;
typedef __bf16 bf2_t __attribute__((ext_vector_type(2)));
typedef float f2_t __attribute__((ext_vector_type(2)));
using bf16x8 = __attribute__((ext_vector_type(8))) short;
using f32x16 = __attribute__((ext_vector_type(16))) float;
using f32x4 = __attribute__((ext_vector_type(4))) float;
using u32x4 = __attribute__((ext_vector_type(4))) unsigned;
#define MFMA(a, b, c) __builtin_amdgcn_mfma_f32_32x32x16_bf16((a), (b), (c), 0, 0, 0)

constexpr int R = 16512, RP = 16384, D = 1024, DC = 512, QKV = 3072, NIN = 4096, DFF = 4096;
constexpr float EPS = 1e-6f;
constexpr int LDF = 4160;
constexpr float QSCALE = 0.08838834764831845f;

constexpr size_t OFF_BAR   = 0;
constexpr size_t OFF_MOD   = 16384;
constexpr size_t OFF_GB    = OFF_MOD + 3342336;
constexpr size_t OFF_EGL   = OFF_GB + 1056768;
constexpr size_t OFF_SSQ   = OFF_EGL + 8192;
constexpr size_t OFF_WIN   = OFF_SSQ + 2113536;
constexpr size_t OFF_WZ    = OFF_WIN + 8650752;
constexpr size_t OFF_WGA   = OFF_WZ + 2097152;
constexpr size_t OFF_WGB   = OFF_WGA + 2097152;
constexpr size_t OFF_WCONF = OFF_WGB + 2097152;
constexpr size_t OFF_WGDN  = OFF_WCONF + 1048576;
constexpr size_t OFF_WO    = OFF_WGDN + 2097152;
constexpr size_t OFF_W1    = OFF_WO + 2097152;
constexpr size_t OFF_W2    = OFF_W1 + 8388608;
constexpr size_t OFF_GLU   = OFF_W2 + 8650752;
constexpr size_t OFF_AACT  = OFF_GLU + 16908288;
constexpr size_t OFF_QKV   = OFF_AACT + 16908288;
constexpr size_t OFF_HALO  = OFF_QKV + 101449728;
constexpr size_t OFF_EXTRA = OFF_HALO + 4718592;
constexpr size_t OFF_WADA  = OFF_EXTRA;
constexpr size_t OFF_AC    = OFF_EXTRA + 12582912;
constexpr size_t OFF_MERGED= OFF_EXTRA;
constexpr size_t OFF_H2    = OFF_GLU;
constexpr size_t OFF_F     = OFF_QKV;
constexpr size_t OFF_TMP2  = OFF_QKV;
constexpr size_t WS_NEED   = OFF_EXTRA + 50331648;
constexpr size_t OUT_Y = 0, OUT_CONFP = 16908288, OUT_QKVP = 17031168, OUT_DELTAP = 17104896,
                 OUT_CONFS = 18153472, OUT_QKVS = 20119552, OUT_DELTAS = 21299200;

constexpr int HALF_SMEM = 73728;
constexpr int SMEM_BYTES = 2 * HALF_SMEM + 1024;
constexpr int NT = 512;
#ifndef PHASE_MASK
#define PHASE_MASK 0xFFFF
#endif
#define PH(k) if constexpr ((PHASE_MASK >> (k)) & 1)

struct Params {
  const float *x_prompt, *x_sample, *c_prompt, *c_sample, *st_conf, *st_qkv, *st_delta;
  const float *w_ada, *b_ada, *norm1_w, *w_in, *conf_dw_w, *conf_dw_b, *conf_ln_w, *conf_ln_b, *w_conf_out,
              *gdn_conv_w, *a_log, *dt_bias, *gdn_norm_w, *w_gdn_out, *w_o, *norm2_w, *w_ff1, *w_ff2, *final_norm_w;
  float* out; char* ws;
};

DI unsigned pk2(float a, float b) { f2_t v = {a, b}; bf2_t r = __builtin_convertvector(v, bf2_t); return __builtin_bit_cast(unsigned, r); }
DI float bf_lo(unsigned u) { return __uint_as_float(u << 16); }
DI float bf_hi(unsigned u) { return __uint_as_float(u & 0xffff0000u); }
DI float bf1(u16 u) { return __uint_as_float(((unsigned)u) << 16); }
DI u16 f2bf(float a) { return (u16)(pk2(a, 0.f) & 0xffffu); }
DI float sigmoidf_(float x) { return __builtin_amdgcn_rcpf(1.f + __expf(-x)); }
DI float siluf_(float x) { return x * __builtin_amdgcn_rcpf(1.f + __expf(-x)); }
DI float softplusf_(float x) { return fmaxf(x, 0.f) + log1pf(__expf(-fabsf(x))); }
DI float dpp_f(float x, const int ctrl_sel) {
  const int xi = __builtin_bit_cast(int, x);
  int r;
  if (ctrl_sel == 0) r = __builtin_amdgcn_update_dpp(xi, xi, 0xB1, 0xF, 0xF, false);
  else if (ctrl_sel == 1) r = __builtin_amdgcn_update_dpp(xi, xi, 0x4E, 0xF, 0xF, false);
  else if (ctrl_sel == 2) r = __builtin_amdgcn_update_dpp(xi, xi, 0x141, 0xF, 0xF, false);
  else r = __builtin_amdgcn_update_dpp(xi, xi, 0x140, 0xF, 0xF, false);
  return __builtin_bit_cast(float, r);
}
DI float wsum(float v) {
  v += dpp_f(v, 0); v += dpp_f(v, 1); v += dpp_f(v, 2); v += dpp_f(v, 3);
  v += __shfl_xor(v, 16, 64); v += __shfl_xor(v, 32, 64);
  return v;
}
DI int crow(int reg, int hh) { return (reg & 3) + 8 * (reg >> 2) + 4 * hh; }
DI int mrow_of(int r) { return r < RP ? (r >> 11) : (8 + r - RP); }
DI bf16x8 pack8(const f32x16& x, int s) {
  uint4 p;
  p.x = pk2(x[8 * s + 0], x[8 * s + 1]); p.y = pk2(x[8 * s + 2], x[8 * s + 3]);
  p.z = pk2(x[8 * s + 4], x[8 * s + 5]); p.w = pk2(x[8 * s + 6], x[8 * s + 7]);
  return __builtin_bit_cast(bf16x8, p);
}
DI f32x16 zero16() { f32x16 z; for (int i = 0; i < 16; ++i) z[i] = 0.f; return z; }

#define XB_TMO      128
#define XB_XCNT(j)  (256  + 64 * (j))
#define XB_XSUB(j)  (1280 + 64 * (j))
#define XB_XGEN(j)  (2304 + 64 * (j))
#define XB_TOP      3328
#define XB_TOPGEN   3392
#define XCD_BAR_WORDS 3456
#define XB_SPIN_CAP (1u << 24)
#define LAS __attribute__((address_space(3)))
DI unsigned xb_ld(unsigned* p) { return __hip_atomic_load(p, __ATOMIC_RELAXED, __HIP_MEMORY_SCOPE_AGENT); }
DI unsigned xb_add(unsigned* p, unsigned v) { return __hip_atomic_fetch_add(p, v, __ATOMIC_RELAXED, __HIP_MEMORY_SCOPE_AGENT); }
DI unsigned xb_xcc_id() { return (unsigned)__builtin_amdgcn_s_getreg((3 << 11) | 20) & 0xFu; }
#define XB_SPIN(cond, bar) do { unsigned _sp = 0; while (cond) { __builtin_amdgcn_s_sleep(1); \
    if ((++_sp & 255u) == 0u) { if (xb_ld(&(bar)[XB_TMO])) break; if (_sp > XB_SPIN_CAP) { atomicAdd(&(bar)[XB_TMO], 1u); break; } } } } while (0)
struct XcdBarrier { unsigned* bar; unsigned x; volatile LAS unsigned* st; };
DI XcdBarrier xcd_barrier_post(unsigned* bar, volatile LAS unsigned* st) {
  XcdBarrier b; b.bar = bar; b.x = xb_xcc_id(); b.st = st;
  if (threadIdx.x == 0) (void)xb_add(&bar[XB_XCNT(b.x)], 1u);
  return b;
}
DI void xcd_barrier_complete(unsigned* bar, unsigned x, unsigned& nloc, unsigned& nx) {
  const unsigned G = gridDim.x * gridDim.y * gridDim.z;
  unsigned sum, cnt, mine, sp = 0u;
  for (;;) {
    sum = 0u; cnt = 0u; mine = 0u;
#pragma unroll
    for (unsigned j = 0; j < 16; ++j) { const unsigned c = xb_ld(&bar[XB_XCNT(j)]); sum += c; cnt += (c > 0u) ? 1u : 0u; mine = (j == x) ? c : mine; }
    if (sum == G) break;
    __builtin_amdgcn_s_sleep(1);
    if ((++sp & 255u) == 0u) { if (xb_ld(&bar[XB_TMO])) break; if (sp > XB_SPIN_CAP) { atomicAdd(&bar[XB_TMO], 1u); break; } }
  }
  nloc = mine > 0u ? mine : 1u; nx = cnt > 0u ? cnt : 1u;
}
DI void xcd_barrier(const XcdBarrier& b) {
  asm volatile("s_waitcnt vmcnt(0)" ::: "memory");
  __syncthreads();
  if (threadIdx.x == 0) {
    unsigned* bar = b.bar;
    __builtin_amdgcn_s_waitcnt(0);
    unsigned nloc = b.st[0], nx = b.st[1];
    if (nloc == 0u) { xcd_barrier_complete(bar, b.x, nloc, nx); b.st[0] = nloc; b.st[1] = nx; }
    const unsigned old = xb_add(&bar[XB_XSUB(b.x)], 1u);
    const unsigned gen = old / nloc;
    if (old + 1u == (gen + 1u) * nloc) {
      __builtin_amdgcn_fence(__ATOMIC_RELEASE, "agent");
      asm volatile("s_waitcnt vmcnt(0)" ::: "memory");
      const unsigned og = xb_add(&bar[XB_TOP], 1u);
      const unsigned tg = og / nx;
      if (og + 1u == (tg + 1u) * nx) xb_add(&bar[XB_TOPGEN], 1u);
      else XB_SPIN(xb_ld(&bar[XB_TOPGEN]) == tg, bar);
      __builtin_amdgcn_fence(__ATOMIC_ACQUIRE, "agent");
      xb_add(&bar[XB_XGEN(b.x)], 1u);
      asm volatile("s_waitcnt vmcnt(0)" ::: "memory");
    } else {
      XB_SPIN(xb_ld(&bar[XB_XGEN(b.x)]) == gen, bar);
      __builtin_amdgcn_fence(__ATOMIC_ACQUIRE, "agent");
      asm volatile("s_waitcnt vmcnt(0)" ::: "memory");
    }
  }
  __syncthreads();
}

constexpr int HTB = 128 * 64 * 2;
DI int lds_byte(int r, int c) { const int st = (r >> 4) * 2 + (c >> 5), rr = r & 15, cc = c & 31, ob = rr * 64 + cc * 2; return st * 1024 + (ob ^ (((ob >> 9) & 1) << 5)); }
DI void stage_rc(int b, int& Rr, int& Cc) { const int st = b / 1024, sb = b % 1024, swz = sb ^ (((sb >> 9) & 1) << 5); Rr = (st >> 1) * 16 + swz / 64; Cc = (st & 1) * 32 + (swz % 64) / 2; }
DI void gemm256(f32x4 (&acc)[2][2][4][2], const u16* __restrict__ A, const int lda, const u16* __restrict__ Bt, const int ldb,
                const int brow, const int bcol, const int K, char* shm) {
#define SA(b, h) (shm + ((b) * 2 + (h)) * HTB)
#define SB(b, h) (shm + (4 + (b) * 2 + (h)) * HTB)
#define STAGE_A(P, br, kt) do { const char* _u = (const char*)A + ((size_t)(br) * lda + (size_t)(kt) * 64) * 2; \
    __builtin_amdgcn_global_load_lds((const unsigned*)(_u + voA0), (unsigned*)((char*)(P) + sb0), 16, 0, 0); \
    __builtin_amdgcn_global_load_lds((const unsigned*)(_u + voA1), (unsigned*)((char*)(P) + sb1), 16, 0, 0); } while (0)
#define STAGE_B(P, br, kt) do { const char* _u = (const char*)Bt + ((size_t)(br) * ldb + (size_t)(kt) * 64) * 2; \
    __builtin_amdgcn_global_load_lds((const unsigned*)(_u + voB0), (unsigned*)((char*)(P) + sb0), 16, 0, 0); \
    __builtin_amdgcn_global_load_lds((const unsigned*)(_u + voB1), (unsigned*)((char*)(P) + sb1), 16, 0, 0); } while (0)
#define LDA(dst, b, h) _Pragma("unroll") for (int m = 0; m < 4; ++m) _Pragma("unroll") for (int k = 0; k < 2; ++k) \
    dst[m][k] = *reinterpret_cast<const bf16x8*>((char*)SA(b, h) + lds_byte(wr * 64 + m * 16 + fr, k * 32 + fq * 8))
#define LDB(dst, b, h) _Pragma("unroll") for (int n = 0; n < 2; ++n) _Pragma("unroll") for (int k = 0; k < 2; ++k) \
    dst[n][k] = *reinterpret_cast<const bf16x8*>((char*)SB(b, h) + lds_byte(wc * 32 + n * 16 + fr, k * 32 + fq * 8))
#define MMA(ai, bj, At_, Bt_) do { __builtin_amdgcn_s_setprio(1); \
    _Pragma("unroll") for (int m = 0; m < 4; ++m) _Pragma("unroll") for (int n = 0; n < 2; ++n) _Pragma("unroll") for (int k = 0; k < 2; ++k) \
      acc[ai][bj][m][n] = __builtin_amdgcn_mfma_f32_16x16x32_bf16(Bt_[n][k], At_[m][k], acc[ai][bj][m][n], 0, 0, 0); \
    __builtin_amdgcn_s_setprio(0); } while (0)
#define WAIT_V(n) asm volatile("s_waitcnt vmcnt(" #n ")" ::: "memory")
#define WAIT_L(n) asm volatile("s_waitcnt lgkmcnt(" #n ")" ::: "memory")
#define BAR __builtin_amdgcn_s_barrier()
#define SCHED __builtin_amdgcn_sched_barrier(0)
  int t_ = threadIdx.x;
  asm volatile("" : "+v"(t_));
  const int wid = __builtin_amdgcn_readfirstlane(t_ >> 6), lane = t_ & 63, wr = wid >> 2, wc = wid & 3, fr = lane & 15, fq = lane >> 4;
  const int sb0 = t_ * 16, sb1 = sb0 + 8192;
  int sr0, sc0, sr1, sc1; stage_rc(sb0, sr0, sc0); stage_rc(sb1, sr1, sc1);
  const unsigned voA0 = (unsigned)(sr0 * lda + sc0) * 2u, voA1 = (unsigned)(sr1 * lda + sc1) * 2u;
  const unsigned voB0 = (unsigned)(sr0 * ldb + sc0) * 2u, voB1 = (unsigned)(sr1 * ldb + sc1) * 2u;
  bf16x8 At[4][2], B0[2][2], B1[2][2];
  const int nt = K / 64;
  STAGE_B(SB(0, 0), bcol, 0); STAGE_A(SA(0, 0), brow, 0);
  STAGE_B(SB(0, 1), bcol + 128, 0); STAGE_A(SA(0, 1), brow + 128, 0);
  if (wr == 1) BAR;
  WAIT_V(4); BAR;
  STAGE_B(SB(1, 0), bcol, 1); STAGE_A(SA(1, 0), brow, 1); STAGE_B(SB(1, 1), bcol + 128, 1);
  WAIT_V(6); BAR;
  for (int t = 0; t < nt - 2; t += 2) {
    LDB(B0, 0, 0); SCHED; LDA(At, 0, 0); STAGE_A(SA(1, 1), brow + 128, t + 1);
    WAIT_L(8); BAR; WAIT_L(0); MMA(0, 0, At, B0); BAR; SCHED;
    LDB(B1, 0, 1); STAGE_B(SB(0, 0), bcol, t + 2);
    BAR; WAIT_L(0); MMA(0, 1, At, B1); BAR;
    LDA(At, 0, 1); STAGE_A(SA(0, 0), brow, t + 2);
    BAR; WAIT_L(0); MMA(1, 0, At, B0); BAR; SCHED;
    STAGE_B(SB(0, 1), bcol + 128, t + 2);
    WAIT_V(6); BAR; MMA(1, 1, At, B1); BAR;
    LDB(B0, 1, 0); SCHED; LDA(At, 1, 0); STAGE_A(SA(0, 1), brow + 128, t + 2);
    WAIT_L(8); BAR; WAIT_L(0); MMA(0, 0, At, B0); BAR; SCHED;
    LDB(B1, 1, 1); STAGE_B(SB(1, 0), bcol, t + 3);
    BAR; WAIT_L(0); MMA(0, 1, At, B1); BAR;
    LDA(At, 1, 1); STAGE_A(SA(1, 0), brow, t + 3);
    BAR; WAIT_L(0); MMA(1, 0, At, B0); BAR; SCHED;
    STAGE_B(SB(1, 1), bcol + 128, t + 3);
    WAIT_V(6); BAR; MMA(1, 1, At, B1); BAR;
  }
  { LDB(B0, 0, 0); LDA(At, 0, 0); STAGE_A(SA(1, 1), brow + 128, nt - 1);
    BAR; WAIT_L(0); MMA(0, 0, At, B0); BAR;
    LDB(B1, 0, 1); BAR; WAIT_L(0); MMA(0, 1, At, B1); BAR;
    LDA(At, 0, 1); WAIT_V(4); BAR; WAIT_L(0); MMA(1, 0, At, B0); MMA(1, 1, At, B1); BAR; }
  { LDB(B0, 1, 0); LDA(At, 1, 0); WAIT_V(2); BAR; WAIT_L(0); MMA(0, 0, At, B0); BAR;
    LDB(B1, 1, 1); WAIT_V(0); BAR; WAIT_L(0); MMA(0, 1, At, B1); BAR;
    LDA(At, 1, 1); BAR; WAIT_L(0); MMA(1, 0, At, B0); MMA(1, 1, At, B1); BAR; }
  if (wr == 0) BAR;
#undef SA
#undef SB
#undef STAGE_A
#undef STAGE_B
#undef LDA
#undef LDB
#undef MMA
}
DI void zero_acc(f32x4 (&acc)[2][2][4][2]) {
#pragma unroll
  for (int a = 0; a < 2; ++a)
#pragma unroll
    for (int b = 0; b < 2; ++b)
#pragma unroll
      for (int m = 0; m < 4; ++m)
#pragma unroll
        for (int n = 0; n < 2; ++n) acc[a][b][m][n] = (f32x4){0.f, 0.f, 0.f, 0.f};
}
template <class F> DI void tile_apply(const f32x4 (&acc)[2][2][4][2], int brow, int bcol, F f) {
  int t_ = threadIdx.x;
  asm volatile("" : "+v"(t_));
  const int wid = t_ >> 6, lane = t_ & 63, wr = wid >> 2, wc = wid & 3, fr = lane & 15, fq = lane >> 4;
#pragma unroll
  for (int ai = 0; ai < 2; ++ai)
#pragma unroll
    for (int m = 0; m < 4; ++m) {
      const int row = brow + ai * 128 + wr * 64 + m * 16 + fr;
#pragma unroll
      for (int bj = 0; bj < 2; ++bj)
#pragma unroll
        for (int n = 0; n < 2; ++n) f(row, bcol + bj * 128 + wc * 32 + n * 16 + 4 * fq, acc[ai][bj][m][n]);
      __builtin_amdgcn_sched_barrier(0);
    }
}
constexpr int TLD = 132;
template <class F> DI void tile_epilogue(const f32x4 (&acc)[2][2][4][2], int brow, int bcol, char* shm, F f) {
  int t_ = threadIdx.x;
  asm volatile("" : "+v"(t_));
  const int wid = t_ >> 6, lane = t_ & 63, wr = wid >> 2, wc = wid & 3, fr = lane & 15, fq = lane >> 4;
  float* T = (float*)shm;
#pragma unroll
  for (int bj = 0; bj < 2; ++bj) {
#pragma unroll
    for (int ai = 0; ai < 2; ++ai)
#pragma unroll
      for (int m = 0; m < 4; ++m)
#pragma unroll
        for (int n = 0; n < 2; ++n)
          *(f32x4*)(T + (ai * 128 + wr * 64 + m * 16 + fr) * TLD + wc * 32 + n * 16 + 4 * fq) = acc[ai][bj][m][n];
    __syncthreads();
    const int cg = (t_ & 31) * 4, r0 = t_ >> 5;
#pragma unroll 4
    for (int i = 0; i < 16; ++i) {
      const int rl = r0 + 16 * i;
      const f32x4 v = *(const f32x4*)(T + rl * TLD + cg);
      f(brow + rl, bcol + bj * 128 + cg, v);
    }
    __syncthreads();
  }
}
template <class F> DI void gemm_pass(const u16* A, int lda, const u16* Bt, int ldb, int N, int K, char* shm, F f) {
  const int nN = N >> 8, nunits = 64 * nN;
  for (int u = blockIdx.x; u < nunits; u += gridDim.x) {
    const int pm = u % 64, pn = u / 64;
    f32x4 acc[2][2][4][2];
    zero_acc(acc);
    gemm256(acc, A, lda, Bt, ldb, pm * 256, pn * 256, K, shm);
    tile_epilogue(acc, pm * 256, pn * 256, shm, f);
  }
}
template <int NTL, class CM, class E> DI void skinny(const u16* __restrict__ A, int lda, int row0, int nrows, const u16* __restrict__ Bt, int ldb, int K, CM cm, E epi) {
  int t_ = threadIdx.x;
  asm volatile("" : "+v"(t_));
  const int wid = t_ >> 6, lane = t_ & 63, fr = lane & 15, fq = lane >> 4;
  for (int mt = wid; mt * 16 < nrows; mt += 8) {
    int rr = mt * 16 + fr; const bool valid = rr < nrows; if (!valid) rr = nrows - 1;
    const u16* ap = A + (size_t)(row0 + rr) * lda + 8 * fq;
#pragma unroll
    for (int ntl = 0; ntl < NTL; ++ntl) {
      const u16* bp = Bt + (size_t)cm(ntl * 16 + fr) * ldb + 8 * fq;
      f32x4 acc = {0.f, 0.f, 0.f, 0.f};
#pragma unroll 16
      for (int ks = 0; ks < (K >> 5); ++ks) {
        const bf16x8 a = *(const bf16x8*)(ap + ks * 32);
        const bf16x8 b = *(const bf16x8*)(bp + ks * 32);
        acc = __builtin_amdgcn_mfma_f32_16x16x32_bf16(b, a, acc, 0, 0, 0);
      }
      if (valid) epi(row0 + rr, ntl, fq, acc, lane);
    }
  }
}
DI int map_in(int n) {
  if (n < 1024) { const int pn = n >> 8, c = n & 255; return c < 128 ? (pn * 128 + c) : (512 + pn * 128 + c - 128); }
  if (n < 4096) return n;
  return n < 4112 ? 5120 + (n - 4096) : 5120;
}
DI void phase_convert(const Params& p, char* smem) {
  float* tile = (float*)smem;
  const int tid = threadIdx.x;
  constexpr int NJ = 10;
  constexpr int pre[NJ + 1] = {0, 1040, 1296, 1552, 1808, 1936, 2192, 2448, 3472, 4496, 6032};
  for (int t = blockIdx.x; t < 6032; t += gridDim.x) {
    int j = 0, base = 0;
#pragma unroll
    for (int q = 1; q < NJ; ++q) if (t >= pre[q]) { j = q; base = pre[q]; }
    const int lt = t - base;
    const float* src; int ld, K; u16* dst; int moff = 0; int ldd = 0;
    switch (j) {
      case 0: src = p.w_in; ld = 7184; K = 1024; dst = (u16*)(p.ws + OFF_WIN); break;
      case 1: src = p.w_in; ld = 7184; K = 1024; dst = (u16*)(p.ws + OFF_WZ); moff = 4096; break;
      case 2: src = p.w_in; ld = 7184; K = 1024; dst = (u16*)(p.ws + OFF_WGA); moff = 5136; break;
      case 3: src = p.w_in; ld = 7184; K = 1024; dst = (u16*)(p.ws + OFF_WGB); moff = 6160; break;
      case 4: src = p.w_conf_out; ld = 1024; K = 512; dst = (u16*)(p.ws + OFF_WCONF); break;
      case 5: src = p.w_gdn_out; ld = 1024; K = 1024; dst = (u16*)(p.ws + OFF_WGDN); break;
      case 6: src = p.w_o; ld = 1024; K = 1024; dst = (u16*)(p.ws + OFF_WO); break;
      case 7: src = p.w_ff1; ld = 4096; K = 1024; dst = (u16*)(p.ws + OFF_W1); break;
      case 8: src = p.w_ff2; ld = 1024; K = 4096; dst = (u16*)(p.ws + OFF_W2); ldd = LDF; break;
      default: src = p.w_ada; ld = 6144; K = 1024; dst = (u16*)(p.ws + OFF_WADA); break;
    }
    const int nkt = K >> 6;
    const int n0 = (lt / nkt) * 64, k0 = (lt % nkt) * 64;
    {
      const int q4 = (tid & 15) * 4, ty = tid >> 4;
      const int sc = (j == 0) ? map_in(n0 + q4) : (n0 + q4 + moff);
#pragma unroll
      for (int i = 0; i < 2; ++i) {
        const int kk = ty + 32 * i;
        const f32x4 v4 = __builtin_nontemporal_load((const f32x4*)(src + (size_t)(k0 + kk) * ld + sc));
        float* tp = tile + kk * 65 + q4;
        tp[0] = v4[0]; tp[1] = v4[1]; tp[2] = v4[2]; tp[3] = v4[3];
      }
    }
    __syncthreads();
    {
      const int nn = tid >> 3, kq = (tid & 7) * 8;
      uint4 o0;
      const float* tp = tile + kq * 65 + nn;
      o0.x = pk2(tp[0 * 65], tp[1 * 65]);  o0.y = pk2(tp[2 * 65], tp[3 * 65]);
      o0.z = pk2(tp[4 * 65], tp[5 * 65]);  o0.w = pk2(tp[6 * 65], tp[7 * 65]);
      *(uint4*)(dst + (size_t)(n0 + nn) * (ldd ? ldd : K) + k0 + kq) = o0;
    }
    __syncthreads();
  }
  u16* Ac = (u16*)(p.ws + OFF_AC);
  for (int e = blockIdx.x * NT + tid; e < 256 * 256; e += gridDim.x * NT) {
    const int row = e >> 8, c4 = (e & 255) * 4;
    float4 v = make_float4(0.f, 0.f, 0.f, 0.f);
    if (row < 8) v = *(const float4*)(p.c_prompt + row * 1024 + c4);
    else if (row < 136) v = *(const float4*)(p.c_sample + (row - 8) * 1024 + c4);
    uint2 o; o.x = pk2(siluf_(v.x), siluf_(v.y)); o.y = pk2(siluf_(v.z), siluf_(v.w));
    *(uint2*)(Ac + row * 1024 + c4) = o;
  }
}

constexpr int WBA_LD = 1028;
template <bool BA> DI void phase_modnorm(const Params& p, const float* xa, const float* xb, const float* nw, int shift_off, int scale_off, u16* dst, char* smem) {
  int tmn = threadIdx.x;
  asm volatile("" : "+v"(tmn));
  const int lane = tmn & 63;
  const int gw = blockIdx.x * 8 + (tmn >> 6), nw_ = gridDim.x * 8;
  const float* mod = (const float*)(p.ws + OFF_MOD);
  float* wba = (float*)smem;
  if (BA) {
    for (int e = threadIdx.x; e < 16384; e += NT) { const int c = e >> 4, j = e & 15; wba[j * WBA_LD + c] = p.w_in[(size_t)c * 7184 + 5120 + j]; }
    __syncthreads();
  }
  float* gb = (float*)(p.ws + OFF_GB);
  for (int row = gw; row < R; row += nw_) {
    const float* xr = row < RP ? xa + (size_t)row * 1024 : xb + (size_t)(row - RP) * 1024;
    float4 v[4]; float ss = 0.f;
#pragma unroll
    for (int i = 0; i < 4; ++i) {
      { const f32x4 t4 = __builtin_nontemporal_load((const f32x4*)(xr + (lane + 64 * i) * 4)); v[i] = make_float4(t4[0], t4[1], t4[2], t4[3]); }
      ss += v[i].x * v[i].x + v[i].y * v[i].y + v[i].z * v[i].z + v[i].w * v[i].w; }
    ss = wsum(ss);
    const float rstd = rsqrtf(ss * (1.f / 1024.f) + EPS);
    const float* mr = mod + (size_t)mrow_of(row) * 6144;
    float ba[16];
    if (BA) {
#pragma unroll
      for (int j = 0; j < 16; ++j) ba[j] = 0.f;
    }
#pragma unroll
    for (int i = 0; i < 4; ++i) {
      const int c = (lane + 64 * i) * 4;
      const float4 w = *(const float4*)(nw + c), sc = *(const float4*)(mr + scale_off + c), sh = *(const float4*)(mr + shift_off + c);
      const float h0 = v[i].x * rstd * w.x * (1.f + sc.x) + sh.x, h1 = v[i].y * rstd * w.y * (1.f + sc.y) + sh.y;
      const float h2 = v[i].z * rstd * w.z * (1.f + sc.z) + sh.z, h3 = v[i].w * rstd * w.w * (1.f + sc.w) + sh.w;
      uint2 o; o.x = pk2(h0, h1); o.y = pk2(h2, h3);
      *(uint2*)(dst + (size_t)row * 1024 + c) = o;
      if (BA) {
#pragma unroll
        for (int j = 0; j < 16; ++j) { const float4 ww = *(const float4*)(wba + j * WBA_LD + c); ba[j] += h0 * ww.x + h1 * ww.y + h2 * ww.z + h3 * ww.w; }
        __builtin_amdgcn_sched_barrier(0);
      }
    }
    if (BA) {
#pragma unroll
      for (int w = 8; w >= 1; w >>= 1) {
        const bool up = (lane & w) != 0;
#pragma unroll
        for (int j = 0; j < w; ++j) {
          const float keep = up ? ba[j + w] : ba[j];
          const float send = up ? ba[j] : ba[j + w];
          ba[j] = keep + __shfl_xor(send, w, 64);
        }
      }
      float tot = ba[0];
      tot += __shfl_xor(tot, 16, 64); tot += __shfl_xor(tot, 32, 64);
      if (lane < 8) gb[(size_t)row * 16 + lane] = sigmoidf_(tot);
      else if (lane < 16) gb[(size_t)row * 16 + lane] = -__expf(p.a_log[lane - 8]) * softplusf_(tot + p.dt_bias[lane - 8]);
    }
  }
  if (BA) __syncthreads();
}

constexpr int LKN = 136, LKT = 72;
DI void d1_item(const Params& p, int item, char* smem) {
  int tid = threadIdx.x & 255;
  asm volatile("" : "+v"(tid));
  const int lane = tid & 63, wave = __builtin_amdgcn_readfirstlane(tid >> 6);
  const int r = lane & 31, hh = lane >> 5;
  const int h = item & 7, n = (item >> 3) & 31, b = item >> 8;
  const int rowbase = b * 2048 + n * 64;
  u16* kn  = (u16*)smem;
  u16* qn  = (u16*)(smem + 17408);
  u16* knT = (u16*)(smem + 34816);
  u16* vT  = (u16*)(smem + 53248);
  float* Gs = (float*)(smem + 71680);
  float* Bs = Gs + 64;
  float* Amat = (float*)(smem + 17408);
  u16* Tb = (u16*)smem;
  u16* Tg = (u16*)(smem + 17408);
  u16* qkv = (u16*)(p.ws + OFF_QKV);
  const u16* halo = (const u16*)(p.ws + OFF_HALO);
  const float* gb = (const float*)(p.ws + OFF_GB);

  if (wave == 0) {
    float g = gb[(size_t)(rowbase + lane) * 16 + 8 + h];
    const float be = gb[(size_t)(rowbase + lane) * 16 + h];
#pragma unroll
    for (int m = 1; m < 64; m <<= 1) { float t = __shfl_up(g, m, 64); if (lane >= m) g += t; }
    Gs[lane] = g; Bs[lane] = be;
  }
  {
    const int cp = lane;
#pragma unroll
    for (int X = 0; X < 3; ++X) {
      const int cb = X * 1024 + h * 128 + 2 * cp;
      float w[4][2];
#pragma unroll
      for (int j = 0; j < 4; ++j) { float2 t = *(const float2*)(p.gdn_conv_w + j * 3072 + cb); w[j][0] = t.x; w[j][1] = t.y; }
      float xw[3][2];
#pragma unroll
      for (int j = 0; j < 3; ++j) {
        const int rr = wave * 16 - 3 + j;
        unsigned u = 0u;
        if (rr >= 0) u = *(const unsigned*)(qkv + (size_t)(rowbase + rr) * 3072 + cb);
        else if (n > 0) u = *(const unsigned*)(halo + ((size_t)((b * 32 + n - 1) * 3 + (rr + 3))) * 3072 + cb);
        xw[j][0] = bf_lo(u); xw[j][1] = bf_hi(u);
      }
      float o[16][2];
#pragma unroll
      for (int t = 0; t < 16; ++t) {
        const unsigned u = *(const unsigned*)(qkv + (size_t)(rowbase + wave * 16 + t) * 3072 + cb);
        const float x0 = bf_lo(u), x1 = bf_hi(u);
        const float a0 = w[0][0] * xw[0][0] + w[1][0] * xw[1][0] + w[2][0] * xw[2][0] + w[3][0] * x0;
        const float a1 = w[0][1] * xw[0][1] + w[1][1] * xw[1][1] + w[2][1] * xw[2][1] + w[3][1] * x1;
        o[t][0] = siluf_(a0); o[t][1] = siluf_(a1);
        xw[0][0] = xw[1][0]; xw[0][1] = xw[1][1]; xw[1][0] = xw[2][0]; xw[1][1] = xw[2][1]; xw[2][0] = x0; xw[2][1] = x1;
      }
      if (X < 2) {
#pragma unroll
        for (int t = 0; t < 16; ++t) {
          const float ss = wsum(o[t][0] * o[t][0] + o[t][1] * o[t][1]);
          const float rs = rsqrtf(ss + EPS);
          o[t][0] *= rs; o[t][1] *= rs;
        }
      }
#pragma unroll
      for (int t = 0; t < 16; ++t) {
        const int row = wave * 16 + t;
        const unsigned pk = pk2(o[t][0], o[t][1]);
        if (X == 0) { *(unsigned*)(qn + row * LKN + 2 * cp) = pk; }
        else if (X == 1) {
          *(unsigned*)(kn + row * LKN + 2 * cp) = pk;
          knT[(2 * cp) * LKT + row] = (u16)(pk & 0xffffu); knT[(2 * cp + 1) * LKT + row] = (u16)(pk >> 16);
        } else {
          vT[(2 * cp) * LKT + row] = (u16)(pk & 0xffffu); vT[(2 * cp + 1) * LKT + row] = (u16)(pk >> 16);
        }
      }
    }
  }
  __syncthreads();
  const float Glast = Gs[63];
#pragma unroll
  for (int ff = 0; ff < 4; ++ff) {
    const int f = wave * 4 + ff;
    const int it = f >> 3, kb = (f >> 1) & 3, s = f & 1;
    const int i = it * 32 + r;
    const float sc = QSCALE * __expf(Gs[i]);
    const uint2 a = *(const uint2*)(qn + i * LKN + kb * 32 + 16 * s + 4 * hh);
    const uint2 c = *(const uint2*)(qn + i * LKN + kb * 32 + 16 * s + 4 * hh + 8);
    uint4 o;
    o.x = pk2(bf_lo(a.x) * sc, bf_hi(a.x) * sc); o.y = pk2(bf_lo(a.y) * sc, bf_hi(a.y) * sc);
    o.z = pk2(bf_lo(c.x) * sc, bf_hi(c.x) * sc); o.w = pk2(bf_lo(c.y) * sc, bf_hi(c.y) * sc);
    *(uint4*)((char*)qkv + (size_t)(rowbase + 4 * f + (lane >> 4)) * 6144 + h * 256 + (lane & 15) * 16) = o;
  }
  char* ext = p.ws + OFF_EXTRA + (size_t)item * 24576;
#pragma unroll
  for (int ff = 0; ff < 4; ++ff) {
    const int f = wave * 4 + ff;
    const int kt = f >> 2, pb = (f >> 1) & 1, s = f & 1;
    const int k = kt * 32 + r;
    const int p0 = pb * 32 + 16 * s + 4 * hh;
    const uint2 a = *(const uint2*)(knT + k * LKT + p0);
    const uint2 c = *(const uint2*)(knT + k * LKT + p0 + 8);
    const float4 g0 = *(const float4*)(Gs + p0), g1 = *(const float4*)(Gs + p0 + 8);
    uint4 o;
    o.x = pk2(bf_lo(a.x) * __expf(Glast - g0.x), bf_hi(a.x) * __expf(Glast - g0.y));
    o.y = pk2(bf_lo(a.y) * __expf(Glast - g0.z), bf_hi(a.y) * __expf(Glast - g0.w));
    o.z = pk2(bf_lo(c.x) * __expf(Glast - g1.x), bf_hi(c.x) * __expf(Glast - g1.y));
    o.w = pk2(bf_lo(c.y) * __expf(Glast - g1.z), bf_hi(c.y) * __expf(Glast - g1.w));
    *(uint4*)(ext + f * 1024 + lane * 16) = o;
  }
  f32x16 akk = zero16(), aqk = zero16();
  const int ta = (wave == 0) ? 0 : 1, tb = (wave == 2) ? 1 : 0;
  if (wave < 3) {
#pragma unroll
    for (int ks = 0; ks < 8; ++ks) {
      const bf16x8 fa = *(const bf16x8*)(kn + (ta * 32 + r) * LKN + ks * 16 + 8 * hh);
      const bf16x8 fb = *(const bf16x8*)(kn + (tb * 32 + r) * LKN + ks * 16 + 8 * hh);
      const bf16x8 fq = *(const bf16x8*)(qn + (ta * 32 + r) * LKN + ks * 16 + 8 * hh);
      akk = MFMA(fa, fb, akk);
      aqk = MFMA(fb, fq, aqk);
    }
  }
  __syncthreads();
  if (wave < 3) {
    const int m = tb * 32 + r; const float Gm = Gs[m];
#pragma unroll
    for (int reg = 0; reg < 16; ++reg) {
      const int i = ta * 32 + crow(reg, hh);
      const float v = (m < i) ? Bs[i] * akk[reg] * __expf(Gs[i] - Gm) : 0.f;
      Amat[i * 64 + m] = v;
    }
    const int i = ta * 32 + r; const float Gi = Gs[i];
    f32x16 av;
#pragma unroll
    for (int reg = 0; reg < 16; ++reg) {
      const int j = tb * 32 + crow(reg, hh);
      av[reg] = (j <= i) ? aqk[reg] * QSCALE * __expf(Gi - Gs[j]) : 0.f;
    }
    const int fbase = 16 + (wave * 2);
#pragma unroll
    for (int s = 0; s < 2; ++s) {
      bf16x8 fr8 = pack8(av, s);
      *(bf16x8*)(ext + (fbase + s) * 1024 + lane * 16) = fr8;
    }
  } else {
    for (int e = lane; e < 32 * 32; e += 64) Amat[(e >> 5) * 64 + 32 + (e & 31)] = 0.f;
    if (lane == 0) *(float*)(ext + 22 * 1024) = __expf(Glast);
  }
  __syncthreads();
  float* Tq = (float*)(smem + 9216);
  if (wave == 0) {
    float x[32];
    const int c = lane & 31, hb = lane >> 5;
    const float* Ab = Amat + (hb * 32) * 64 + hb * 32;
#pragma unroll
    for (int i = 0; i < 32; ++i) {
      float s0 = (c == i) ? 1.f : 0.f, s1 = 0.f;
#pragma unroll
      for (int m4 = 0; m4 < (i + 3) / 4; ++m4) {
        const float4 a4 = *(const float4*)(Ab + i * 64 + m4 * 4);
        if (m4 * 4 + 0 < i) s0 -= a4.x * x[m4 * 4 + 0];
        if (m4 * 4 + 1 < i) s1 -= a4.y * x[m4 * 4 + 1];
        if (m4 * 4 + 2 < i) s0 -= a4.z * x[m4 * 4 + 2];
        if (m4 * 4 + 3 < i) s1 -= a4.w * x[m4 * 4 + 3];
      }
      x[i] = s0 + s1;
      __builtin_amdgcn_sched_barrier(0);
    }
#pragma unroll
    for (int i = 0; i < 32; ++i) Tq[hb * 1024 + i * 32 + c] = x[i];
  }
  __syncthreads();
  const int c32 = tid & 31, g8 = tid >> 5;
  {
    float bm[4] = {0.f, 0.f, 0.f, 0.f};
#pragma unroll
    for (int j4 = 0; j4 < 8; ++j4) {
      float t[4];
#pragma unroll
      for (int e = 0; e < 4; ++e) t[e] = Tq[(j4 * 4 + e) * 32 + c32];
#pragma unroll
      for (int e = 0; e < 4; ++e) {
        const float4 a4 = *(const float4*)(Amat + (32 + g8 * 4 + e) * 64 + j4 * 4);
        bm[e] += a4.x * t[0] + a4.y * t[1] + a4.z * t[2] + a4.w * t[3];
      }
    }
#pragma unroll
    for (int e = 0; e < 4; ++e) Amat[(g8 * 4 + e) * 64 + 32 + c32] = bm[e];
  }
  __syncthreads();
  float t21[4] = {0.f, 0.f, 0.f, 0.f};
  {
#pragma unroll
    for (int m4 = 0; m4 < 8; ++m4) {
      float bv[4];
#pragma unroll
      for (int e = 0; e < 4; ++e) bv[e] = Amat[(m4 * 4 + e) * 64 + 32 + c32];
#pragma unroll
      for (int e = 0; e < 4; ++e) {
        const float4 a4 = *(const float4*)(Tq + 1024 + (g8 * 4 + e) * 32 + m4 * 4);
        t21[e] -= a4.x * bv[0] + a4.y * bv[1] + a4.z * bv[2] + a4.w * bv[3];
      }
    }
  }
  float t11[4], t22[4];
#pragma unroll
  for (int e = 0; e < 4; ++e) { t11[e] = Tq[(g8 * 4 + e) * 32 + c32]; t22[e] = Tq[1024 + (g8 * 4 + e) * 32 + c32]; }
  const float bcl = Bs[c32], bgl = bcl * __expf(Gs[c32]);
  const float bch = Bs[32 + c32], bgh = bch * __expf(Gs[32 + c32]);
  __syncthreads();
#pragma unroll
  for (int e = 0; e < 4; ++e) {
    const int i = g8 * 4 + e;
    Tb[i * LKT + c32] = f2bf(t11[e] * bcl);               Tg[i * LKT + c32] = f2bf(t11[e] * bgl);
    Tb[i * LKT + 32 + c32] = (u16)0;                      Tg[i * LKT + 32 + c32] = (u16)0;
    Tb[(32 + i) * LKT + c32] = f2bf(t21[e] * bcl);        Tg[(32 + i) * LKT + c32] = f2bf(t21[e] * bgl);
    Tb[(32 + i) * LKT + 32 + c32] = f2bf(t22[e] * bch);   Tg[(32 + i) * LKT + 32 + c32] = f2bf(t22[e] * bgh);
  }
  __syncthreads();
#pragma unroll
  for (int it = 0; it < 2; ++it) {
    f32x16 av = zero16(), ak = zero16();
#pragma unroll
    for (int ks = 0; ks < 4; ++ks) {
      const bf16x8 fT = *(const bf16x8*)(Tb + (it * 32 + r) * LKT + ks * 16 + 8 * hh);
      const bf16x8 fV = *(const bf16x8*)(vT + (wave * 32 + r) * LKT + ks * 16 + 8 * hh);
      const bf16x8 fK = *(const bf16x8*)(knT + (wave * 32 + r) * LKT + ks * 16 + 8 * hh);
      const bf16x8 fG = *(const bf16x8*)(Tg + (it * 32 + r) * LKT + ks * 16 + 8 * hh);
      av = MFMA(fT, fV, av);
      ak = MFMA(fK, fG, ak);
    }
    {
      const int fv = wave * 2 + it;
      char* d = (char*)qkv + (size_t)(rowbase + 8 * fv + (lane >> 3)) * 6144 + 4096 + h * 256 + (lane & 7) * 32;
      *(bf16x8*)d = pack8(av, 0); *(bf16x8*)(d + 16) = pack8(av, 1);
    }
#pragma unroll
    for (int s = 0; s < 2; ++s) {
      const int f = it * 8 + wave * 2 + s;
      *(bf16x8*)((char*)qkv + (size_t)(rowbase + 4 * f + (lane >> 4)) * 6144 + 2048 + h * 256 + (lane & 15) * 16) = pack8(ak, s);
    }
  }
  __syncthreads();
}

DI void d2_issue(u32x4 (&rg)[18], const Params& p, int b, int h, int lt, int n) {
  const char* qseg = p.ws + OFF_QKV + (size_t)(b * 2048 + n * 64) * 6144 + h * 256;
  const char* ext = p.ws + OFF_EXTRA + (size_t)((b * 32 + n) * 8 + h) * 24576;
#pragma unroll
  for (int sg = 0; sg < 3; ++sg)
#pragma unroll
    for (int i = 0; i < 4; ++i) rg[sg * 4 + i] = __builtin_nontemporal_load((const u32x4*)(qseg + (size_t)((lt >> 4) + 16 * i) * 6144 + sg * 2048 + (lt & 15) * 16));
#pragma unroll
  for (int i = 0; i < 6; ++i) rg[12 + i] = __builtin_nontemporal_load((const u32x4*)(ext + lt * 16 + i * 4096));
}
DI void d2_put(const u32x4 (&rg)[18], char* buf, int lt) {
#pragma unroll
  for (int sg = 0; sg < 3; ++sg)
#pragma unroll
    for (int i = 0; i < 4; ++i) *(u32x4*)(buf + sg * 16384 + ((lt >> 4) + 16 * i) * 256 + (lt & 15) * 16) = rg[sg * 4 + i];
#pragma unroll
  for (int i = 0; i < 6; ++i) *(u32x4*)(buf + 49152 + lt * 16 + i * 4096) = rg[12 + i];
}
DI void d2_block(const Params& p, int unit, char* smem) {
  const int tid = threadIdx.x, half = tid >> 8, lt = tid & 255, lane = tid & 63, wave = (tid >> 6) & 3;
  const int r = lane & 31, hh = lane >> 5;
  const int b = unit >> 3, h = unit & 7;
  const char* qkv = p.ws + OFF_QKV;
  const float* egl = (const float*)(p.ws + OFF_EGL);
  u16* obuf = (u16*)((char*)p.out + (size_t)R * 1024 * 2);
  if (half == 1) {
    u32x4 rg0[18], rg1[18];
    u32x4 og[4], sg4;
    u16* obuf_ = (u16*)((char*)p.out + (size_t)R * 1024 * 2);
    float* ssq_ = (float*)(p.ws + OFF_SSQ);
    const int orow = lt >> 2, opos = lt & 3, ocol = 8 * (opos ^ ((orow >> 1) & 3));
    d2_issue(rg0, p, b, h, lt, 0); d2_put(rg0, smem, lt); d2_issue(rg1, p, b, h, lt, 1); d2_issue(rg0, p, b, h, lt, 2);
    __syncthreads();
#define D2_LOADER_STEP(n_, RG)                                                                                              \
    {                                                                                                                        \
      const int n = (n_);                                                                                                    \
      char* ob = smem + ((n + 1) & 1) * HALF_SMEM;                                                                           \
      if (n >= 1) {                                                                                                          \
        _Pragma("unroll") for (int i = 0; i < 4; ++i) og[i] = *(const u32x4*)(ob + 32768 + (lt + 256 * i) * 16);            \
        if (lt >= 192) sg4 = *(const u32x4*)(ob + 49152 + 20480 + lt * 16);                                                  \
      }                                                                                                                      \
      if (n + 1 < 32) { d2_put(RG, ob, lt); if (n + 3 < 32) d2_issue(RG, p, b, h, lt, n + 3); }                              \
      if (n >= 1) {                                                                                                          \
        const int rowbase = b * 2048 + (n - 1) * 64;                                                                         \
        _Pragma("unroll") for (int i = 0; i < 4; ++i)                                                                        \
          *(u32x4*)(obuf_ + (size_t)(rowbase + orow) * 1024 + h * 128 + 32 * i + ocol) = og[i];                              \
        if (lt >= 192) *(u32x4*)(ssq_ + ((size_t)(rowbase + lt - 192) * 8 + h) * 4) = sg4;                                   \
      }                                                                                                                      \
      if (n < 32) { asm volatile("s_waitcnt lgkmcnt(0)" ::: "memory"); __builtin_amdgcn_s_barrier(); asm volatile("" ::: "memory"); } \
    }
#pragma unroll 1
    for (int n2 = 0; n2 <= 32; n2 += 2) {
      D2_LOADER_STEP(n2, rg1)
      if (n2 + 1 <= 32) D2_LOADER_STEP(n2 + 1, rg0)
    }
#undef D2_LOADER_STEP
    return;
  }
  f32x16 S[4];
#pragma unroll
  for (int k = 0; k < 4; ++k) S[k] = zero16();
  const unsigned voff_l = (unsigned)(lane * 16);
  bf16x8 If0, If1;
#pragma unroll
  for (int j = 0; j < 8; ++j) {
    const int k0 = 8 * (j >> 2) + 4 * hh + (j & 3);
    If0[j] = (short)((k0 == r) ? 0x3F80 : 0); If1[j] = (short)((16 + k0 == r) ? 0x3F80 : 0);
  }
  const unsigned voff_v = (unsigned)((16 * wave + (lane >> 3)) * 256 + (lane & 7) * 32);
  __syncthreads();
#pragma unroll 1
  for (int n = 0; n < 32; ++n) {
    const int item = (b * 32 + n) * 8 + h;
    const int rowbase = b * 2048 + n * 64;
    const char* buf = smem + (n & 1) * HALF_SMEM;
    const char* ext = buf + 49152;
    const float eg = *(const float*)(ext + 22 * 1024);
    bf16x8 fk[16];
#pragma unroll
    for (int f = 0; f < 16; ++f) fk[f] = *(const bf16x8*)(buf + 16384 + f * 1024 + voff_l);
    uint4 vv[2][2];
#pragma unroll
    for (int it = 0; it < 2; ++it) { const char* d = buf + 32768 + it * 2048 + voff_v; vv[it][0] = *(const uint4*)d; vv[it][1] = *(const uint4*)(d + 16); }
    bf16x8 Sf[4][2];
#pragma unroll
    for (int kb = 0; kb < 4; ++kb) { Sf[kb][0] = pack8(S[kb], 0); Sf[kb][1] = pack8(S[kb], 1); }
    __builtin_amdgcn_sched_barrier(0);
    f32x16 P1[2];
    P1[0] = zero16(); P1[1] = zero16();
#pragma unroll
    for (int kb = 0; kb < 4; ++kb)
#pragma unroll
      for (int s = 0; s < 2; ++s) {
        P1[0] = MFMA(fk[kb * 2 + s], Sf[kb][s], P1[0]);
        P1[1] = MFMA(fk[8 + kb * 2 + s], Sf[kb][s], P1[1]);
      }
    bf16x8 fq[8];
#pragma unroll
    for (int f = 0; f < 8; ++f) fq[f] = *(const bf16x8*)(buf + f * 1024 + voff_l);
    bf16x8 Vf[2][2];
#pragma unroll
    for (int it = 0; it < 2; ++it) {
      const uint4 v0 = vv[it][0], v1 = vv[it][1];
      f32x16 vn;
      vn[0] = bf_lo(v0.x) - P1[it][0];  vn[1] = bf_hi(v0.x) - P1[it][1];
      vn[2] = bf_lo(v0.y) - P1[it][2];  vn[3] = bf_hi(v0.y) - P1[it][3];
      vn[4] = bf_lo(v0.z) - P1[it][4];  vn[5] = bf_hi(v0.z) - P1[it][5];
      vn[6] = bf_lo(v0.w) - P1[it][6];  vn[7] = bf_hi(v0.w) - P1[it][7];
      vn[8] = bf_lo(v1.x) - P1[it][8];  vn[9] = bf_hi(v1.x) - P1[it][9];
      vn[10] = bf_lo(v1.y) - P1[it][10]; vn[11] = bf_hi(v1.y) - P1[it][11];
      vn[12] = bf_lo(v1.z) - P1[it][12]; vn[13] = bf_hi(v1.z) - P1[it][13];
      vn[14] = bf_lo(v1.w) - P1[it][14]; vn[15] = bf_hi(v1.w) - P1[it][15];
      Vf[it][0] = pack8(vn, 0); Vf[it][1] = pack8(vn, 1);
    }
    bf16x8 fa[6];
#pragma unroll
    for (int i = 0; i < 6; ++i) fa[i] = *(const bf16x8*)(ext + (16 + i) * 1024 + voff_l);
    f32x16 P2[2];
    P2[0] = zero16(); P2[1] = zero16();
#pragma unroll
    for (int kb = 0; kb < 4; ++kb)
#pragma unroll
      for (int s = 0; s < 2; ++s) {
        P2[0] = MFMA(fq[kb * 2 + s], Sf[kb][s], P2[0]);
        const bf16x8 fq1 = *(const bf16x8*)(buf + (8 + kb * 2 + s) * 1024 + voff_l);
        P2[1] = MFMA(fq1, Sf[kb][s], P2[1]);
      }
    __builtin_amdgcn_sched_barrier(0);
    bf16x8 fkd[16];
#pragma unroll
    for (int i = 0; i < 16; ++i) fkd[i] = *(const bf16x8*)(ext + i * 1024 + voff_l);
#pragma unroll
    for (int s = 0; s < 2; ++s) {
      P2[0] = MFMA(fa[0 + s], Vf[0][s], P2[0]);
      P2[1] = MFMA(fa[2 + s], Vf[0][s], P2[1]);
      P2[1] = MFMA(fa[4 + s], Vf[1][s], P2[1]);
    }
    {
      char* ow = (char*)buf + 32768 + wave * 4096;
      float* sqw = (float*)((char*)buf + 49152 + 23 * 1024);
      const int xs = (r >> 1) & 3;
#pragma unroll
      for (int it = 0; it < 2; ++it) {
        f32x16 Z = MFMA(pack8(P2[it], 0), If0, zero16());
        Z = MFMA(pack8(P2[it], 1), If1, Z);
        float ssl = 0.f;
#pragma unroll
        for (int reg = 0; reg < 16; ++reg) ssl += Z[reg] * Z[reg];
        ssl += __shfl_xor(ssl, 32, 64);
        if (hh == 0) sqw[(it * 32 + r) * 4 + wave] = ssl;
#pragma unroll
        for (int g = 0; g < 4; ++g) {
          uint2 pv; pv.x = pk2(Z[4 * g], Z[4 * g + 1]); pv.y = pk2(Z[4 * g + 2], Z[4 * g + 3]);
          *(uint2*)(ow + (it * 32 + r) * 64 + ((g ^ xs) * 16) + hh * 8) = pv;
        }
      }
    }
#pragma unroll
    for (int kt = 0; kt < 4; ++kt) {
#pragma unroll
      for (int reg = 0; reg < 16; ++reg) S[kt][reg] *= eg;
#pragma unroll
      for (int pb = 0; pb < 2; ++pb)
#pragma unroll
        for (int s = 0; s < 2; ++s) {
          S[kt] = MFMA(fkd[kt * 4 + pb * 2 + s], Vf[pb][s], S[kt]);
        }
    }
    asm volatile("s_waitcnt lgkmcnt(0)" ::: "memory"); __builtin_amdgcn_s_barrier(); asm volatile("" ::: "memory");
  }
  float* od = p.out + OUT_DELTAP + (size_t)(b * 8 + h) * 16384;
#pragma unroll
  for (int kt = 0; kt < 4; ++kt)
#pragma unroll
    for (int reg = 0; reg < 16; ++reg) od[(kt * 32 + crow(reg, hh)) * 128 + wave * 32 + r] = S[kt][reg];
}

DI void conf_prompt_item(const Params& p, int item, char* smem) {
  const int tid = threadIdx.x & 255, lane = tid & 63, wave = tid >> 6;
  const int b = item >> 6, t0 = (item & 63) * 32;
  unsigned* tile = (unsigned*)smem;
  float* red = (float*)(smem + 63488);
  const u16* glu = (const u16*)(p.ws + OFF_GLU);
  u16* aact = (u16*)(p.ws + OFF_AACT);
#pragma unroll 1
  for (int hb = 0; hb < 2; ++hb) {
    u32x4 fv[8];
#pragma unroll
    for (int i = 0; i < 8; ++i) {
      const int e = tid + 256 * (hb * 8 + i), rr = e >> 6, c8 = (e & 63) * 8;
      const int t = t0 - 30 + rr;
      fv[i] = (u32x4){0u, 0u, 0u, 0u};
      if (rr < 62 && t >= 0) fv[i] = *(const u32x4*)(glu + (size_t)(b * 2048 + t) * 512 + c8);
    }
#pragma unroll
    for (int i = 0; i < 8; ++i) {
      const int e = tid + 256 * (hb * 8 + i), rr = e >> 6, c8 = (e & 63) * 8;
      if (rr < 62) *(u32x4*)(tile + rr * 256 + (c8 >> 1)) = fv[i];
    }
  }
  float w[31][2];
#pragma unroll
  for (int j = 0; j < 31; ++j) { const float2 t = *(const float2*)(p.conf_dw_w + j * 512 + 2 * tid); w[j][0] = t.x; w[j][1] = t.y; }
  const float2 bias = *(const float2*)(p.conf_dw_b + 2 * tid);
  const float2 lw = *(const float2*)(p.conf_ln_w + 2 * tid), lb = *(const float2*)(p.conf_ln_b + 2 * tid);
  __syncthreads();
#pragma unroll 1
  for (int tg = 0; tg < 4; ++tg) {
    float a[8][2];
#pragma unroll
    for (int t = 0; t < 8; ++t) { a[t][0] = bias.x; a[t][1] = bias.y; }
#pragma unroll
    for (int i = 0; i < 38; ++i) {
      const unsigned u = tile[(tg * 8 + i) * 256 + tid];
      const float x0 = bf_lo(u), x1 = bf_hi(u);
#pragma unroll
      for (int t = 0; t < 8; ++t) {
        const int j = i - t;
        if (j >= 0 && j < 31) { a[t][0] += w[j][0] * x0; a[t][1] += w[j][1] * x1; }
      }
    }
#pragma unroll
    for (int t = 0; t < 8; ++t) {
      const float s1 = wsum(a[t][0] + a[t][1]);
      const float s2 = wsum(a[t][0] * a[t][0] + a[t][1] * a[t][1]);
      if (lane == 0) { red[(wave * 8 + t) * 2] = s1; red[(wave * 8 + t) * 2 + 1] = s2; }
    }
    __syncthreads();
#pragma unroll
    for (int t = 0; t < 8; ++t) {
      const float s1 = red[t * 2] + red[(8 + t) * 2] + red[(16 + t) * 2] + red[(24 + t) * 2];
      const float s2 = red[t * 2 + 1] + red[(8 + t) * 2 + 1] + red[(16 + t) * 2 + 1] + red[(24 + t) * 2 + 1];
      const float mu = s1 * (1.f / 512.f);
      const float var = fmaxf(s2 * (1.f / 512.f) - mu * mu, 0.f);
      const float rs = rsqrtf(var + EPS);
      const float y0 = (a[t][0] - mu) * rs * lw.x + lb.x, y1 = (a[t][1] - mu) * rs * lw.y + lb.y;
      *(unsigned*)(aact + (size_t)(b * 2048 + t0 + tg * 8 + t) * 512 + 2 * tid) = pk2(siluf_(y0), siluf_(y1));
    }
    __syncthreads();
  }
}
DI void conf_sample_item(const Params& p, int item) {
  const int lane = threadIdx.x & 63, wave = (threadIdx.x >> 6) & 3;
  const int s = item * 4 + wave;
  const int c = lane * 8;
  const u16* glu = (const u16*)(p.ws + OFF_GLU);
  u16* aact = (u16*)(p.ws + OFF_AACT);
  float a[8];
  {
    const float4 b0 = *(const float4*)(p.conf_dw_b + c), b1 = *(const float4*)(p.conf_dw_b + c + 4);
    a[0] = b0.x; a[1] = b0.y; a[2] = b0.z; a[3] = b0.w; a[4] = b1.x; a[5] = b1.y; a[6] = b1.z; a[7] = b1.w;
  }
  const float* st = p.st_conf + (size_t)s * 30 * 512;
  float* oc = p.out + OUT_CONFS + (size_t)s * 30 * 512;
#pragma unroll 1
  for (int j = 0; j < 30; ++j) {
    const f32x4 n0 = __builtin_nontemporal_load((const f32x4*)(st + j * 512 + c)), n1 = __builtin_nontemporal_load((const f32x4*)(st + j * 512 + c + 4));
    const float4 x0 = make_float4(n0[0], n0[1], n0[2], n0[3]), x1 = make_float4(n1[0], n1[1], n1[2], n1[3]);
    const float4 w0 = *(const float4*)(p.conf_dw_w + j * 512 + c), w1 = *(const float4*)(p.conf_dw_w + j * 512 + c + 4);
    a[0] += w0.x * x0.x; a[1] += w0.y * x0.y; a[2] += w0.z * x0.z; a[3] += w0.w * x0.w;
    a[4] += w1.x * x1.x; a[5] += w1.y * x1.y; a[6] += w1.z * x1.z; a[7] += w1.w * x1.w;
    if (j >= 1) { __builtin_nontemporal_store(n0, (f32x4*)(oc + (j - 1) * 512 + c)); __builtin_nontemporal_store(n1, (f32x4*)(oc + (j - 1) * 512 + c + 4)); }
  }
  {
    const uint4 g = *(const uint4*)(glu + (size_t)(RP + s) * 512 + c);
    const float4 w0 = *(const float4*)(p.conf_dw_w + 30 * 512 + c), w1 = *(const float4*)(p.conf_dw_w + 30 * 512 + c + 4);
    a[0] += w0.x * bf_lo(g.x); a[1] += w0.y * bf_hi(g.x); a[2] += w0.z * bf_lo(g.y); a[3] += w0.w * bf_hi(g.y);
    a[4] += w1.x * bf_lo(g.z); a[5] += w1.y * bf_hi(g.z); a[6] += w1.z * bf_lo(g.w); a[7] += w1.w * bf_hi(g.w);
  }
  float s1 = 0.f, s2 = 0.f;
#pragma unroll
  for (int i = 0; i < 8; ++i) { s1 += a[i]; s2 += a[i] * a[i]; }
  s1 = wsum(s1); s2 = wsum(s2);
  const float mu = s1 * (1.f / 512.f);
  const float rs = rsqrtf(fmaxf(s2 * (1.f / 512.f) - mu * mu, 0.f) + EPS);
  float y[8];
#pragma unroll
  for (int i = 0; i < 8; ++i) y[i] = siluf_((a[i] - mu) * rs * p.conf_ln_w[c + i] + p.conf_ln_b[c + i]);
  uint4 o; o.x = pk2(y[0], y[1]); o.y = pk2(y[2], y[3]); o.z = pk2(y[4], y[5]); o.w = pk2(y[6], y[7]);
  *(uint4*)(aact + (size_t)(RP + s) * 512 + c) = o;
}
DI void delta_sample_item(const Params& p, int item, char* smem) {
  const int tid = threadIdx.x & 255, lane = tid & 63, wave = tid >> 6;
  const int s = item >> 3, h = item & 7;
  float* qs = (float*)smem; float* ks = qs + 128; float* vs = ks + 128; float* part = vs + 128;
  float* red = part + 768;
  const u16* qkv = (const u16*)(p.ws + OFF_QKV);
  const float* gb = (const float*)(p.ws + OFF_GB);
  const int row = RP + s;
  const int v = tid & 127, kh = tid >> 7;
  const float* S0 = p.st_delta + (size_t)(s * 8 + h) * 16384 + (size_t)(kh * 64) * 128 + v;
  float Sr[64];
#pragma unroll
  for (int kk = 0; kk < 64; ++kk) Sr[kk] = __builtin_nontemporal_load(S0 + kk * 128);
  const float g = gb[(size_t)row * 16 + 8 + h], beta = gb[(size_t)row * 16 + h];
  float cq = 0.f, ck = 0.f, cv = 0.f;
  if (tid < 128) {
    float cx[3];
#pragma unroll
    for (int X = 0; X < 3; ++X) {
      const int cg = X * 1024 + h * 128 + tid;
      const float s0 = p.st_qkv[(size_t)(s * 3 + 0) * 3072 + cg], s1 = p.st_qkv[(size_t)(s * 3 + 1) * 3072 + cg], s2 = p.st_qkv[(size_t)(s * 3 + 2) * 3072 + cg];
      const float x = bf1(qkv[(size_t)row * 3072 + cg]);
      const float a = p.gdn_conv_w[cg] * s0 + p.gdn_conv_w[3072 + cg] * s1 + p.gdn_conv_w[2 * 3072 + cg] * s2 + p.gdn_conv_w[3 * 3072 + cg] * x;
      cx[X] = siluf_(a);
      p.out[OUT_QKVS + (size_t)(s * 3 + 0) * 3072 + cg] = s1;
      p.out[OUT_QKVS + (size_t)(s * 3 + 1) * 3072 + cg] = s2;
    }
    cq = cx[0]; ck = cx[1]; cv = cx[2];
  }
  {
    const float sq = wsum(cq * cq), sk = wsum(ck * ck);
    if (lane == 0) { red[wave * 2] = sq; red[wave * 2 + 1] = sk; }
  }
  __syncthreads();
  if (tid < 128) {
    const float rq = rsqrtf(red[0] + red[2] + EPS), rk = rsqrtf(red[1] + red[3] + EPS);
    qs[tid] = cq * rq * QSCALE; ks[tid] = ck * rk; vs[tid] = cv;
  }
  __syncthreads();
  const float eg = __expf(g);
  float kS = 0.f, qS = 0.f, qk = 0.f;
#pragma unroll
  for (int k4 = 0; k4 < 16; ++k4) {
    const float4 kv = *(const float4*)(ks + kh * 64 + k4 * 4), qv = *(const float4*)(qs + kh * 64 + k4 * 4);
    kS += kv.x * Sr[4 * k4] + kv.y * Sr[4 * k4 + 1] + kv.z * Sr[4 * k4 + 2] + kv.w * Sr[4 * k4 + 3];
    qS += qv.x * Sr[4 * k4] + qv.y * Sr[4 * k4 + 1] + qv.z * Sr[4 * k4 + 2] + qv.w * Sr[4 * k4 + 3];
    qk += kv.x * qv.x + kv.y * qv.y + kv.z * qv.z + kv.w * qv.w;
  }
  part[(kh * 3 + 0) * 128 + v] = kS; part[(kh * 3 + 1) * 128 + v] = qS; part[(kh * 3 + 2) * 128 + v] = qk;
  __syncthreads();
  kS = part[0 * 128 + v] + part[3 * 128 + v];
  qS = part[1 * 128 + v] + part[4 * 128 + v];
  qk = part[2 * 128 + v] + part[5 * 128 + v];
  const float vnew = vs[v] * beta - beta * eg * kS;
  const float o = eg * qS + qk * vnew;
  float* Sd = p.out + OUT_DELTAS + (size_t)(s * 8 + h) * 16384 + (size_t)(kh * 64) * 128 + v;
#pragma unroll
  for (int k4 = 0; k4 < 16; ++k4) {
    const float4 kv = *(const float4*)(ks + kh * 64 + k4 * 4);
    __builtin_nontemporal_store(Sr[4 * k4 + 0] * eg + kv.x * vnew, Sd + (4 * k4 + 0) * 128);
    __builtin_nontemporal_store(Sr[4 * k4 + 1] * eg + kv.y * vnew, Sd + (4 * k4 + 1) * 128);
    __builtin_nontemporal_store(Sr[4 * k4 + 2] * eg + kv.z * vnew, Sd + (4 * k4 + 2) * 128);
    __builtin_nontemporal_store(Sr[4 * k4 + 3] * eg + kv.w * vnew, Sd + (4 * k4 + 3) * 128);
  }
  if (kh == 0) {
    ((u16*)((char*)p.out + (size_t)R * 1024 * 2))[(size_t)row * 1024 + h * 128 + v] = f2bf(o);
    const float so = wsum(o * o);
    if (lane == 0) { float* sq = (float*)(p.ws + OFF_SSQ) + ((size_t)row * 8 + h) * 4; sq[wave] = so; sq[wave + 2] = 0.f; }
  }
  __syncthreads();
}

__global__ void __launch_bounds__(512, 2) fwd_megakernel(Params p) {
  __shared__ __attribute__((aligned(1024))) char smem[SMEM_BYTES];
  const int tid = threadIdx.x, lane = tid & 63, wave = tid >> 6;
  const int fr = lane & 15, fq = lane >> 4;
  uint4* xb_words = (uint4*)(smem + 2 * HALF_SMEM);
  if (tid == 0) *xb_words = make_uint4(0u, 0u, 0u, 0u);
  __syncthreads();
  XcdBarrier xb = xcd_barrier_post((unsigned*)(p.ws + OFF_BAR), (volatile LAS unsigned*)xb_words);
  const int G = gridDim.x, bid = blockIdx.x;
  float* mod = (float*)(p.ws + OFF_MOD);
  u16* hbuf = (u16*)p.out;
  u16* obuf = (u16*)((char*)p.out + (size_t)R * 1024 * 2);
  const float* ssq = (const float*)(p.ws + OFF_SSQ);
  u16* merged = (u16*)(p.ws + OFF_MERGED);
  u16* tmp2 = (u16*)(p.ws + OFF_TMP2);

  PH(0) phase_convert(p, smem);
  xcd_barrier(xb);

  PH(1) for (int sb = bid; sb < 256; sb += G) {
    skinny<2>((const u16*)(p.ws + OFF_AC), 1024, 0, 136, (const u16*)(p.ws + OFF_WADA), 1024, 1024,
      [&](int j) { return sb * 24 + (j < 24 ? j : 23); },
      [&](int row, int ntl, int q, f32x4 v, int ln) {
        const int j = ntl * 16 + 4 * q;
        if (j < 24) {
          const int col = sb * 24 + j;
          const float4 bb = *(const float4*)(p.b_ada + col);
          *(float4*)(mod + (size_t)row * 6144 + col) = make_float4(v[0] + bb.x, v[1] + bb.y, v[2] + bb.z, v[3] + bb.w);
        }
      });
  }
  xcd_barrier(xb);

  PH(2) phase_modnorm<false>(p, p.x_prompt, p.x_sample, p.norm1_w, 0, 1024, hbuf, smem);
  xcd_barrier(xb);

  PH(3) {
    u16* glu = (u16*)(p.ws + OFF_GLU);
    u16* qkv = (u16*)(p.ws + OFF_QKV);
    u16* halo = (u16*)(p.ws + OFF_HALO);
    auto f_glu_st = [&](int row, int ch, f32x4 gl) {
      uint2 o; o.x = pk2(gl[0], gl[1]); o.y = pk2(gl[2], gl[3]);
      *(uint2*)(glu + (size_t)row * 512 + ch) = o;
      if (row < RP) { const int b = row >> 11, tt = row & 2047; if (tt >= 2018) *(float4*)(p.out + OUT_CONFP + (size_t)(b * 30 + tt - 2018) * 512 + ch) = make_float4(gl[0], gl[1], gl[2], gl[3]); }
      else *(float4*)(p.out + OUT_CONFS + (size_t)((row - RP) * 30 + 29) * 512 + ch) = make_float4(gl[0], gl[1], gl[2], gl[3]);
    };
    auto f_glu = [&](int row, int ch, f32x4 a, f32x4 g) {
      f32x4 gl;
#pragma unroll
      for (int j = 0; j < 4; ++j) gl[j] = a[j] * sigmoidf_(g[j]);
      f_glu_st(row, ch, gl);
    };
    auto f_qkv = [&](int row, int col, f32x4 a) {
      const float4 v = make_float4(a[0], a[1], a[2], a[3]);
      uint2 o; o.x = pk2(v.x, v.y); o.y = pk2(v.z, v.w);
      *(uint2*)(qkv + (size_t)row * 3072 + col) = o;
      if (row < RP) {
        const int b = row >> 11, tt = row & 2047;
        if ((tt & 63) >= 61) *(uint2*)(halo + (size_t)((b * 32 + (tt >> 6)) * 3 + (tt & 63) - 61) * 3072 + col) = o;
        if (tt >= 2045) *(float4*)(p.out + OUT_QKVP + (size_t)(b * 3 + tt - 2045) * 3072 + col) = v;
      } else *(float4*)(p.out + OUT_QKVS + (size_t)((row - RP) * 3 + 2) * 3072 + col) = v;
    };
    {
      float* gb = (float*)(p.ws + OFF_GB);
      for (int rb = bid; rb < R / 32; rb += G)
        skinny<1>(hbuf, 1024, rb * 32, 32, (const u16*)(p.ws + OFF_WIN) + (size_t)4096 * 1024, 1024, 1024, [](int j) { return j; },
          [&](int row, int ntl, int q, f32x4 v, int ln) {
            if (q < 2) {
              *(float4*)(gb + (size_t)row * 16 + 4 * q) = make_float4(sigmoidf_(v[0]), sigmoidf_(v[1]), sigmoidf_(v[2]), sigmoidf_(v[3]));
            } else {
              const int hd = 4 * (q - 2);
              float gv[4];
#pragma unroll
              for (int j = 0; j < 4; ++j) gv[j] = -__expf(p.a_log[hd + j]) * softplusf_(v[j] + p.dt_bias[hd + j]);
              *(float4*)(gb + (size_t)row * 16 + 8 + hd) = make_float4(gv[0], gv[1], gv[2], gv[3]);
            }
          });
    }
    int u = bid;
    for (; u < 64 * 4; u += G) {
      const int pm = u % 64, pn = u / 64;
      f32x4 acc[2][2][4][2];
      zero_acc(acc);
      gemm256(acc, hbuf, 1024, (const u16*)(p.ws + OFF_WIN), 1024, pm * 256, pn * 256, 1024, smem);
      {
        int t_ = threadIdx.x;
        asm volatile("" : "+v"(t_));
        const int wr = t_ >> 8, wc = (t_ >> 6) & 3, fr_ = t_ & 15, fq_ = (t_ >> 4) & 3;
        float* T = (float*)smem;
#pragma unroll
        for (int ai = 0; ai < 2; ++ai)
#pragma unroll
          for (int m = 0; m < 4; ++m)
#pragma unroll
            for (int n = 0; n < 2; ++n) {
              f32x4 gl;
#pragma unroll
              for (int j = 0; j < 4; ++j) gl[j] = acc[ai][0][m][n][j] * sigmoidf_(acc[ai][1][m][n][j]);
              *(f32x4*)(T + (ai * 128 + wr * 64 + m * 16 + fr_) * TLD + wc * 32 + n * 16 + 4 * fq_) = gl;
            }
        __syncthreads();
        const int cg = (t_ & 31) * 4, r0 = t_ >> 5;
#pragma unroll 4
        for (int i = 0; i < 16; ++i) {
          const int rl = r0 + 16 * i;
          const f32x4 v = *(const f32x4*)(T + rl * TLD + cg);
          f_glu_st(pm * 256 + rl, pn * 128 + cg, v);
        }
        __syncthreads();
      }
    }
    for (; u < 64 * 16; u += G) {
      const int pm = u % 64, pn = u / 64;
      f32x4 acc[2][2][4][2];
      zero_acc(acc);
      gemm256(acc, hbuf, 1024, (const u16*)(p.ws + OFF_WIN), 1024, pm * 256, pn * 256, 1024, smem);
      tile_epilogue(acc, pm * 256, pn * 256 - 1024, smem, f_qkv);
    }
    for (int sb = bid; sb < 256; sb += G) {
      if (sb < 64) {
        skinny<1>(hbuf, 1024, RP, 128, (const u16*)(p.ws + OFF_WIN), 1024, 1024,
          [&](int j) { const int ch = sb * 8 + (j & 7); return (ch >> 7) * 256 + (ch & 127) + ((j >> 3) << 7); },
          [&](int row, int ntl, int q, f32x4 v, int ln) {
            f32x4 g;
#pragma unroll
            for (int j = 0; j < 4; ++j) g[j] = __shfl(v[j], (ln + 32) & 63, 64);
            if (q < 2) f_glu(row, sb * 8 + 4 * q, v, g);
          });
      } else {
        skinny<1>(hbuf, 1024, RP, 128, (const u16*)(p.ws + OFF_WIN), 1024, 1024,
          [&](int j) { return 1024 + (sb - 64) * 16 + j; },
          [&](int row, int ntl, int q, f32x4 v, int ln) { f_qkv(row, (sb - 64) * 16 + 4 * q, v); });
      }
    }
  }
  xcd_barrier(xb);

  PH(4) for (int base = bid * 2; base < 2048; base += 2 * G) d1_item(p, base + (tid >> 8), smem + (tid >> 8) * HALF_SMEM);
  xcd_barrier(xb);

  PH(5) {
    const int half = tid >> 8;
    char* hs = smem + half * HALF_SMEM;
    for (int u = bid; u < 64; u += G) { d2_block(p, u, smem); __syncthreads(); }
    unsigned* qhead = (unsigned*)(p.ws + OFF_BAR) + 64;
    volatile unsigned* qslot = (volatile unsigned*)(smem + 2 * HALF_SMEM + 32);
    auto deq = [&]() -> int {
      if (tid == 0) *qslot = __hip_atomic_fetch_add(qhead, 1u, __ATOMIC_RELAXED, __HIP_MEMORY_SCOPE_AGENT);
      __syncthreads();
      const int v = __builtin_amdgcn_readfirstlane((int)*qslot);
      __syncthreads();
      return v;
    };
    int idx = deq();
    for (; idx < 256; idx = deq()) conf_prompt_item(p, 2 * idx + half, hs);
    for (; idx < 272; idx = deq()) conf_sample_item(p, 2 * (idx - 256) + half);
    for (; idx < 784; idx = deq()) delta_sample_item(p, 2 * (idx - 272) + half, hs);
  }
  xcd_barrier(xb);

  PH(6) {
    auto f_z = [&](int row, int col, f32x4 a) {
      const float4 sq4 = *(const float4*)(ssq + ((size_t)row * 8 + (col >> 7)) * 4);
      const float rstd = rsqrtf((sq4.x + sq4.y + sq4.z + sq4.w) * (1.f / 128.f) + EPS);
      const float4 gw = *(const float4*)(p.gdn_norm_w + (col & 127));
      u16* op = obuf + (size_t)row * 1024 + col;
      const uint2 u = *(const uint2*)op;
      uint2 o;
      o.x = pk2(bf_lo(u.x) * rstd * gw.x * siluf_(a[0]), bf_hi(u.x) * rstd * gw.y * siluf_(a[1]));
      o.y = pk2(bf_lo(u.y) * rstd * gw.z * siluf_(a[2]), bf_hi(u.y) * rstd * gw.w * siluf_(a[3]));
      *(uint2*)op = o;
    };
    gemm_pass(hbuf, 1024, (const u16*)(p.ws + OFF_WZ), 1024, 1024, 1024, smem, f_z);
    for (int sb = bid; sb < 256; sb += G)
      skinny<1>(hbuf, 1024, RP, 128, (const u16*)(p.ws + OFF_WZ), 1024, 1024, [&](int j) { return sb * 4 + (j & 3); },
                [&](int row, int ntl, int q, f32x4 v, int ln) { if (q == 0) f_z(row, sb * 4, v); });
  }
  xcd_barrier(xb);

  PH(7) {
    auto f_ga = [&](int row, int col, f32x4 a) {
      uint2 o; o.x = pk2(sigmoidf_(a[0]), sigmoidf_(a[1])); o.y = pk2(sigmoidf_(a[2]), sigmoidf_(a[3]));
      *(uint2*)(merged + (size_t)row * 1024 + col) = o;
    };
    auto f_ya = [&](int row, int col, f32x4 a) {
      u16* mp = merged + (size_t)row * 1024 + col;
      const uint2 u = *(const uint2*)mp;
      uint2 o; o.x = pk2(bf_lo(u.x) * a[0], bf_hi(u.x) * a[1]); o.y = pk2(bf_lo(u.y) * a[2], bf_hi(u.y) * a[3]);
      *(uint2*)mp = o;
    };
    auto f_gb = [&](int row, int col, f32x4 a) {
      uint2 o; o.x = pk2(sigmoidf_(a[0]), sigmoidf_(a[1])); o.y = pk2(sigmoidf_(a[2]), sigmoidf_(a[3]));
      *(uint2*)(tmp2 + (size_t)row * 1024 + col) = o;
    };
    auto f_yb = [&](int row, int col, f32x4 a) {
      u16* mp = merged + (size_t)row * 1024 + col;
      const uint2 u = *(const uint2*)mp, s2 = *(const uint2*)(tmp2 + (size_t)row * 1024 + col);
      uint2 o; o.x = pk2(bf_lo(u.x) + bf_lo(s2.x) * a[0], bf_hi(u.x) + bf_hi(s2.x) * a[1]); o.y = pk2(bf_lo(u.y) + bf_lo(s2.y) * a[2], bf_hi(u.y) + bf_hi(s2.y) * a[3]);
      *(uint2*)mp = o;
    };
    auto cm4 = [&](int sb) { return [sb](int j) { return sb * 4 + (j & 3); }; };
    gemm_pass(hbuf, 1024, (const u16*)(p.ws + OFF_WGA), 1024, 1024, 1024, smem, f_ga);
    gemm_pass((const u16*)(p.ws + OFF_AACT), 512, (const u16*)(p.ws + OFF_WCONF), 512, 1024, 512, smem, f_ya);
    gemm_pass(hbuf, 1024, (const u16*)(p.ws + OFF_WGB), 1024, 1024, 1024, smem, f_gb);
    gemm_pass(obuf, 1024, (const u16*)(p.ws + OFF_WGDN), 1024, 1024, 1024, smem, f_yb);
    for (int sb = bid; sb < 256; sb += G) {
      skinny<2>(hbuf, 1024, RP, 128, (const u16*)(p.ws + OFF_WGA), 1024, 1024, [sb](int j) { return (j < 16 ? 0 : 1024) + sb * 4 + (j & 3); },
                [&](int row, int ntl, int q, f32x4 v, int ln) { if (q == 0) { if (ntl == 0) f_ga(row, sb * 4, v); else f_gb(row, sb * 4, v); } });
      skinny<1>((const u16*)(p.ws + OFF_AACT), 512, RP, 128, (const u16*)(p.ws + OFF_WCONF), 512, 512, cm4(sb), [&](int row, int ntl, int q, f32x4 v, int ln) { if (q == 0) f_ya(row, sb * 4, v); });
      skinny<1>(obuf, 1024, RP, 128, (const u16*)(p.ws + OFF_WGDN), 1024, 1024, cm4(sb), [&](int row, int ntl, int q, f32x4 v, int ln) { if (q == 0) f_yb(row, sb * 4, v); });
    }
  }
  xcd_barrier(xb);

  PH(8) {
    auto f_o = [&](int row, int col, f32x4 a) {
      const float* xr = row < RP ? p.x_prompt + (size_t)row * 1024 : p.x_sample + (size_t)(row - RP) * 1024;
      const f32x4 x4 = __builtin_nontemporal_load((const f32x4*)(xr + col));
      const float4 xv = make_float4(x4[0], x4[1], x4[2], x4[3]), gv = *(const float4*)(mod + (size_t)mrow_of(row) * 6144 + 2048 + col);
      *(float4*)(p.out + (size_t)row * 1024 + col) = make_float4(xv.x + gv.x * a[0], xv.y + gv.y * a[1], xv.z + gv.z * a[2], xv.w + gv.w * a[3]);
    };
    gemm_pass(merged, 1024, (const u16*)(p.ws + OFF_WO), 1024, 1024, 1024, smem, f_o);
    for (int sb = bid; sb < 256; sb += G)
      skinny<1>(merged, 1024, RP, 128, (const u16*)(p.ws + OFF_WO), 1024, 1024, [&](int j) { return sb * 4 + (j & 3); },
                [&](int row, int ntl, int q, f32x4 v, int ln) { if (q == 0) f_o(row, sb * 4, v); });
  }
  xcd_barrier(xb);

  PH(9) phase_modnorm<false>(p, p.out, p.out + (size_t)RP * 1024, p.norm2_w, 3072, 4096, (u16*)(p.ws + OFF_H2), smem);
  xcd_barrier(xb);

  PH(10) {
    u16* f = (u16*)(p.ws + OFF_F);
    auto f_ff1 = [&](int row, int col, f32x4 a) {
      float v[4];
#pragma unroll
      for (int j = 0; j < 4; ++j) { const float t = fmaxf(a[j], 0.f); v[j] = t * t; }
      uint2 o; o.x = pk2(v[0], v[1]); o.y = pk2(v[2], v[3]);
      *(uint2*)(f + (size_t)row * LDF + col) = o;
    };
    gemm_pass((const u16*)(p.ws + OFF_H2), 1024, (const u16*)(p.ws + OFF_W1), 1024, 4096, 1024, smem, f_ff1);
    for (int sb = bid; sb < 256; sb += G)
      skinny<1>((const u16*)(p.ws + OFF_H2), 1024, RP, 128, (const u16*)(p.ws + OFF_W1), 1024, 1024, [&](int j) { return sb * 16 + j; },
                [&](int row, int ntl, int q, f32x4 v, int ln) { f_ff1(row, sb * 16 + 4 * q, v); });
  }
  xcd_barrier(xb);

  PH(11) {
    auto f_ff2 = [&](int row, int col, f32x4 a) {
      float* xp = p.out + (size_t)row * 1024 + col;
      const f32x4 x4 = __builtin_nontemporal_load((const f32x4*)xp);
      const float4 xv = make_float4(x4[0], x4[1], x4[2], x4[3]), gv = *(const float4*)(mod + (size_t)mrow_of(row) * 6144 + 5120 + col);
      *(float4*)xp = make_float4(xv.x + gv.x * a[0], xv.y + gv.y * a[1], xv.z + gv.z * a[2], xv.w + gv.w * a[3]);
    };
    gemm_pass((const u16*)(p.ws + OFF_F), LDF, (const u16*)(p.ws + OFF_W2), LDF, 1024, 4096, smem, f_ff2);
    for (int sb = bid; sb < 256; sb += G)
      skinny<1>((const u16*)(p.ws + OFF_F), LDF, RP, 128, (const u16*)(p.ws + OFF_W2), LDF, 4096, [&](int j) { return sb * 4 + (j & 3); },
                [&](int row, int ntl, int q, f32x4 v, int ln) { if (q == 0) f_ff2(row, sb * 4, v); });
  }
  xcd_barrier(xb);

  PH(12) {
    int t12 = threadIdx.x;
    asm volatile("" : "+v"(t12));
    const int lane = t12 & 63, wave = t12 >> 6;
    const int gw = bid * 8 + wave, nw_ = G * 8;
    for (int row = gw; row < R; row += nw_) {
      float* xr = p.out + (size_t)row * 1024;
      float4 v[4]; float ss = 0.f;
#pragma unroll
      for (int i = 0; i < 4; ++i) { const f32x4 t4 = __builtin_nontemporal_load((const f32x4*)(xr + (lane + 64 * i) * 4)); v[i] = make_float4(t4[0], t4[1], t4[2], t4[3]); ss += v[i].x * v[i].x + v[i].y * v[i].y + v[i].z * v[i].z + v[i].w * v[i].w; }
      ss = wsum(ss);
      const float rstd = rsqrtf(ss * (1.f / 1024.f) + EPS);
#pragma unroll
      for (int i = 0; i < 4; ++i) {
        const int c = (lane + 64 * i) * 4;
        const float4 w = *(const float4*)(p.final_norm_w + c);
        f32x4 yv = {v[i].x * rstd * w.x, v[i].y * rstd * w.y, v[i].z * rstd * w.z, v[i].w * rstd * w.w};
        __builtin_nontemporal_store(yv, (f32x4*)(xr + c));
      }
    }
  }
}

extern "C" void kernel_launch(void* const* d_in, const int* in_sizes, int n_in, void* d_out, int out_size, void* d_ws, size_t ws_size,
                              hipStream_t stream) {
  static int grid_blocks = 0;
  if (!grid_blocks) {
    int dev = 0, cus = 0, per_cu = 0;
    hipGetDevice(&dev);
    hipDeviceGetAttribute(&cus, hipDeviceAttributeMultiprocessorCount, dev);
    hipOccupancyMaxActiveBlocksPerMultiprocessor(&per_cu, (const void*)fwd_megakernel, NT, 0);
    if (per_cu > 1) per_cu = 1;
    if (per_cu < 1) per_cu = 1;
    grid_blocks = cus * per_cu;
  }
  Params p{};
  const float** pp = (const float**)&p;
  for (int i = 0; i < 26; ++i) pp[i] = (const float*)d_in[i];
  p.out = (float*)d_out; p.ws = (char*)d_ws;
  if (ws_size < WS_NEED) { fprintf(stderr, "workspace too small: %zu < %zu\n", ws_size, (size_t)WS_NEED); return; }
  hipMemsetAsync(d_ws, 0, XCD_BAR_WORDS * 4, stream);
  void* args[] = {&p};
  hipError_t e = hipLaunchCooperativeKernel((const void*)fwd_megakernel, dim3(grid_blocks), dim3(NT), args, 0, stream);
  if (e != hipSuccess) fprintf(stderr, "cooperative launch failed: %s (grid %d)\n", hipGetErrorString(e), grid_blocks);
}
```
